# Optimizing an MI355X kernel written in HIP

```python
import jax
import jax.numpy as jnp
from jax import lax
import numpy as np

D_MODEL = 1024
BATCH = 16
SEQ = 2048
DEPTH = 1

HEAD_DIM = 64
RWKV_HEADS = 8
RWKV_DIM = RWKV_HEADS * HEAD_DIM
LORA_W = 64
LORA_A = 64
LORA_G = 128
RWKV_COLS = 3 * RWKV_DIM + LORA_W + LORA_A + LORA_G
ATTN_PATTERNS = ((128, 1), (512, 4), (2048, 16))
ATTN_HEADS_PER_GROUP = 4
ATTN_HEADS = ATTN_HEADS_PER_GROUP * len(ATTN_PATTERNS)
ATTN_DIM = ATTN_HEADS * HEAD_DIM
ATTN_COLS = 3 * ATTN_DIM
ATTN_OUT_DIM = ATTN_HEADS_PER_GROUP * HEAD_DIM
ROT_DIM = HEAD_DIM // 4
ROPE_THETA = 500000.0
N_BRANCH = 2
IN_COLS = RWKV_COLS + ATTN_COLS + N_BRANCH * D_MODEL
MOE_GROUPS = 4
EXPERTS_PER_GROUP = 8
N_EXPERTS = MOE_GROUPS * EXPERTS_PER_GROUP
TOP_K_INNER = 2
D_EXPERT = D_MODEL // 2
MOE_BLOCK = 128
NORM_EPS = 1e-6
GN_EPS = 64e-5

kernel_name = 'hybrid_rwkv7_dilated_attn_hier_moe'


def rmsnorm(x, g, eps=NORM_EPS):
    xf = x.astype(jnp.float32)
    y = xf * lax.rsqrt(jnp.mean(xf * xf, axis=-1, keepdims=True) + eps)
    return (y * g.astype(jnp.float32)).astype(x.dtype)


def partial_rope(t, positions):
    half = ROT_DIM // 2
    inv_freq = ROPE_THETA ** (-(jnp.arange(half, dtype=jnp.float32) * (2.0 / ROT_DIM)))
    ang = positions.astype(jnp.float32)[:, :, None] * inv_freq
    cos = jnp.cos(ang)[:, :, None, :]
    sin = jnp.sin(ang)[:, :, None, :]
    t1 = t[..., :half].astype(jnp.float32)
    t2 = t[..., half:ROT_DIM].astype(jnp.float32)
    rot = jnp.concatenate([t1 * cos - t2 * sin, t2 * cos + t1 * sin], axis=-1).astype(t.dtype)
    return jnp.concatenate([rot, t[..., ROT_DIM:]], axis=-1)


def wkv7_scan(r, w, k, v, a, b, reverse):
    B, T, H, N = r.shape
    seq = tuple(t.astype(jnp.float32).transpose(1, 0, 2, 3) for t in (r, w, k, v, a, b))

    def step(S, inp):
        r_t, w_t, k_t, v_t, a_t, b_t = inp
        sa = jnp.einsum('bhij,bhj->bhi', S, a_t)
        S = S * w_t[:, :, None, :] + sa[..., None] * b_t[:, :, None, :] + v_t[..., None] * k_t[:, :, None, :]
        return S, jnp.einsum('bhij,bhj->bhi', S, r_t)

    S0 = jnp.zeros((B, H, N, N), jnp.float32)
    _, y = lax.scan(step, S0, seq, reverse=reverse)
    return y.transpose(1, 0, 2, 3)


def rwkv7_branch(u, mu_prev, mu_next, w_decay0, w_decay_up, a_gate0, a_gate_up, g_up,
                 k_k, k_a, r_k, gn_w, gn_b):
    B, T, _ = u.shape
    H, N = RWKV_HEADS, HEAD_DIM
    u_prev = jnp.pad(u, ((0, 0), (1, 0), (0, 0)))[:, :T]
    u_next = jnp.pad(u, ((0, 0), (0, 1), (0, 0)))[:, 1:]
    u = u + mu_prev * (u_prev - u) + mu_next * (u_next - u)
    c = [int(i) for i in np.cumsum([0, RWKV_DIM, RWKV_DIM, RWKV_DIM, LORA_W, LORA_A, LORA_G])]
    r, k, v, xw, xa, xg = (u[..., c[i]:c[i + 1]] for i in range(6))

    def heads(t):
        return t.reshape(B, T, H, N)

    g = jax.nn.sigmoid(xg) @ g_up
    kk = heads(k * k_k).astype(jnp.float32)
    kk = kk / jnp.maximum(jnp.sqrt(jnp.sum(kk * kk, axis=-1, keepdims=True)), 1e-12)
    rh, vh = heads(r), heads(v)
    wkv = 0.0
    bonus = 0.0
    for d, reverse in enumerate((False, True)):
        w_log = -jax.nn.softplus(-(w_decay0[d] + jnp.tanh(xw) @ w_decay_up[d]).astype(jnp.float32)) - 0.5
        decay = jnp.exp(-jnp.exp(w_log))
        a = jax.nn.sigmoid(a_gate0[d] + xa @ a_gate_up[d])
        kd = heads(k * (1.0 + (a - 1.0) * k_a))
        ah = heads(a).astype(jnp.float32)
        wkv = wkv + wkv7_scan(rh, heads(decay), kd, vh, -kk, kk * ah, reverse)
        bonus = bonus + jnp.sum(rh * kd * r_k, axis=-1, keepdims=True) * vh
    mean = jnp.mean(wkv, axis=-1, keepdims=True)
    var = jnp.mean(jnp.square(wkv - mean), axis=-1, keepdims=True)
    y = ((wkv - mean) * lax.rsqrt(var + GN_EPS)).reshape(B, T, RWKV_DIM) * gn_w + gn_b
    y = y + bonus.reshape(B, T, RWKV_DIM).astype(jnp.float32)
    return (y * g).astype(u.dtype)


def banded_attention(q, k, v, band):
    B, H, L, Dh = q.shape
    nb = -(-L // band)
    Lp = nb * band
    qb = jnp.pad(q, ((0, 0), (0, 0), (0, Lp - L), (0, 0))).reshape(B, H, nb, band, Dh)

    def windows(t):
        tb = jnp.pad(t, ((0, 0), (0, 0), (band, Lp - L + band), (0, 0))).reshape(B, H, nb + 2, band, Dh)
        return jnp.concatenate([tb[:, :, :-2], tb[:, :, 1:-1], tb[:, :, 2:]], axis=3)

    kw, vw = windows(k), windows(v)
    s = jnp.einsum('bhnqd,bhnkd->bhnqk', qb, kw, preferred_element_type=jnp.float32) * (Dh ** -0.5)
    qpos = jnp.arange(nb)[:, None, None] * band + jnp.arange(band)[None, :, None]
    kpos = (jnp.arange(nb)[:, None, None] - 1) * band + jnp.arange(3 * band)[None, None, :]
    mask = (jnp.abs(kpos - qpos) <= band) & (kpos >= 0) & (kpos < L)
    s = jnp.where(mask, s, -jnp.inf)
    lse = jax.nn.logsumexp(s, axis=-1)
    p = jnp.exp(s - lse[..., None])
    o = jnp.einsum('bhnqk,bhnkd->bhnqd', p, vw.astype(jnp.float32))
    o = o.reshape(B, H, Lp, Dh)[:, :, :L].astype(v.dtype)
    return o, lse.reshape(B, H, Lp)[:, :, :L]


def dilated_window_attention(q, k, v, dilation, band):
    B, H, T, Dh = q.shape
    L = T // dilation

    def to_sub(t):
        return t.reshape(B, H, L, dilation, Dh).transpose(0, 1, 3, 2, 4).reshape(B, H * dilation, L, Dh)

    o, lse = banded_attention(to_sub(q), to_sub(k), to_sub(v), band)
    o = o.reshape(B, H, dilation, L, Dh).transpose(0, 1, 3, 2, 4).reshape(B, H, T, Dh)
    lse = lse.reshape(B, H, dilation, L).transpose(0, 1, 3, 2).reshape(B, H, T)
    return o, lse


def dilated_attention_branch(u, positions, q_norm_g, k_norm_g):
    B, T, _ = u.shape
    q = u[..., :ATTN_DIM].reshape(B, T, ATTN_HEADS, HEAD_DIM)
    k = u[..., ATTN_DIM:2 * ATTN_DIM].reshape(B, T, ATTN_HEADS, HEAD_DIM)
    v = u[..., 2 * ATTN_DIM:].reshape(B, T, ATTN_HEADS, HEAD_DIM)
    q = partial_rope(rmsnorm(q, q_norm_g), positions)
    k = partial_rope(rmsnorm(k, k_norm_g), positions)
    q, k, v = (t.transpose(0, 2, 1, 3) for t in (q, k, v))
    outs, lses = [], []
    for gi, (window, dilation) in enumerate(ATTN_PATTERNS):
        hs = slice(gi * ATTN_HEADS_PER_GROUP, (gi + 1) * ATTN_HEADS_PER_GROUP)
        o, l = dilated_window_attention(q[:, hs], k[:, hs], v[:, hs], dilation, window // (2 * dilation))
        outs.append(o)
        lses.append(l)
    alpha = jax.nn.softmax(jnp.stack(lses), axis=0)
    o = jnp.sum(alpha[..., None] * jnp.stack(outs).astype(jnp.float32), axis=0)
    return o.transpose(0, 2, 1, 3).reshape(B, T, ATTN_OUT_DIM).astype(u.dtype)


def hier_moe(h, w_router_group, b_router_group, w_router_expert, b_router_expert, w_gate, w_up, w_down):
    N, D = h.shape
    tok_idx = jnp.arange(N, dtype=jnp.int32)
    grp_logits = (h @ w_router_group).astype(jnp.float32) + b_router_group.astype(jnp.float32)
    grp_probs = jax.nn.softmax(grp_logits, axis=-1)
    grp = jnp.argmax(grp_logits, axis=-1).astype(jnp.int32)
    grp_p = grp_probs[tok_idx, grp][:, None]
    exp_logits = ((h @ w_router_expert).astype(jnp.float32)
                  + b_router_expert.astype(jnp.float32)).reshape(N, MOE_GROUPS, EXPERTS_PER_GROUP)
    exp_logits = exp_logits[tok_idx, grp]
    top_v, top_i = lax.top_k(exp_logits, TOP_K_INNER)
    gate = grp_p * jax.nn.softmax(top_v, axis=-1)
    eid = (grp[:, None] * EXPERTS_PER_GROUP + top_i).reshape(-1)
    tok = jnp.repeat(tok_idx, TOP_K_INNER)
    wts = gate.reshape(-1)
    A = N * TOP_K_INNER
    order = jnp.argsort(eid)
    e_sorted = eid[order]
    counts = jnp.bincount(eid, length=N_EXPERTS)
    padded = (counts + MOE_BLOCK - 1) // MOE_BLOCK * MOE_BLOCK
    pad_end = jnp.cumsum(padded)
    pad_start = pad_end - padded
    start = jnp.cumsum(counts) - counts
    dest = pad_start[e_sorted] + jnp.arange(A, dtype=jnp.int32) - start[e_sorted]
    M = (-(-A // MOE_BLOCK) + N_EXPERTS) * MOE_BLOCK
    n_blk = M // MOE_BLOCK
    row_tok = jnp.full((M,), N, jnp.int32).at[dest].set(tok[order])
    row_w = jnp.zeros((M,), jnp.float32).at[dest].set(wts[order])
    blk_e = jnp.minimum(jnp.searchsorted(pad_end, jnp.arange(n_blk, dtype=jnp.int32) * MOE_BLOCK, side='right'),
                        N_EXPERTS - 1)
    h_pad = jnp.concatenate([h, jnp.zeros((1, D), h.dtype)], axis=0)
    xb = h_pad[row_tok].reshape(n_blk, MOE_BLOCK, D)

    def expert_block(args):
        xblk, e = args
        return (jax.nn.silu(xblk @ w_gate[e]) * (xblk @ w_up[e])) @ w_down[e]

    yb = lax.map(expert_block, (xb, blk_e)).reshape(M, D)
    y = jnp.zeros((N + 1, D), h.dtype).at[row_tok].add(yb * row_w[:, None].astype(h.dtype))
    return y[:N]


def hybrid_layer(x, positions, norm1_g, w_in, mu_prev, mu_next, w_decay0, w_decay_up, a_gate0, a_gate_up,
                 g_up, k_k, k_a, r_k, gn_w, gn_b, w_rwkv_out, q_norm_g, k_norm_g, w_attn_out, b_merge, w_out,
                 norm2_g, w_router_group, b_router_group, w_router_expert, b_router_expert, w_gate, w_up, w_down):
    B, T, D = x.shape
    h = rmsnorm(x, norm1_g)
    proj = h @ w_in
    u_rwkv = proj[..., :RWKV_COLS]
    u_attn = proj[..., RWKV_COLS:RWKV_COLS + ATTN_COLS]
    gate_logits = proj[..., RWKV_COLS + ATTN_COLS:].reshape(B, T, N_BRANCH, D) + b_merge
    y_rwkv = rwkv7_branch(u_rwkv, mu_prev, mu_next, w_decay0, w_decay_up, a_gate0, a_gate_up, g_up,
                          k_k, k_a, r_k, gn_w, gn_b) @ w_rwkv_out
    y_attn = dilated_attention_branch(u_attn, positions, q_norm_g, k_norm_g) @ w_attn_out
    gates = jax.nn.sigmoid(gate_logits)
    x = x + (gates[:, :, 0] * y_rwkv + gates[:, :, 1] * y_attn) @ w_out
    h2 = rmsnorm(x, norm2_g)
    moe = hier_moe(h2.reshape(B * T, D), w_router_group, b_router_group, w_router_expert, b_router_expert,
                   w_gate, w_up, w_down)
    return x + moe.reshape(B, T, D)


def setup_inputs(seed: int = 0) -> dict:
    key = jax.random.key(seed)
    ks = iter(jax.random.split(key, 32))

    def nrm(shape, scale):
        return scale * jax.random.normal(next(ks), shape, jnp.float32)

    def unif(shape, lo, hi):
        return jax.random.uniform(next(ks), shape, dtype=jnp.float32, minval=lo, maxval=hi)

    L = DEPTH
    x = nrm((BATCH, SEQ, D_MODEL), 1.0)
    positions = (jnp.arange(SEQ, dtype=jnp.int32)[None, :]
                 + jax.random.randint(next(ks), (BATCH, 1), 0, 1024, dtype=jnp.int32))
    return {
        'x': x,
        'positions': positions,
        'norm1_g': 1.0 + nrm((L, D_MODEL), 0.02),
        'w_in': nrm((L, D_MODEL, IN_COLS), D_MODEL ** -0.5),
        'mu_prev': unif((L, RWKV_COLS), 0.0, 0.5),
        'mu_next': unif((L, RWKV_COLS), 0.0, 0.5),
        'w_decay0': unif((L, 2, RWKV_DIM), -5.0, -1.0),
        'w_decay_up': nrm((L, 2, LORA_W, RWKV_DIM), 0.5 * LORA_W ** -0.5),
        'a_gate0': nrm((L, 2, RWKV_DIM), 0.1),
        'a_gate_up': nrm((L, 2, LORA_A, RWKV_DIM), LORA_A ** -0.5),
        'g_up': nrm((L, LORA_G, RWKV_DIM), LORA_G ** -0.5),
        'k_k': 0.85 + nrm((L, RWKV_DIM), 0.05),
        'k_a': 1.0 + nrm((L, RWKV_DIM), 0.05),
        'r_k': nrm((L, RWKV_HEADS, HEAD_DIM), 0.1),
        'gn_w': 1.0 + nrm((L, RWKV_DIM), 0.02),
        'gn_b': nrm((L, RWKV_DIM), 0.02),
        'w_rwkv_out': nrm((L, RWKV_DIM, D_MODEL), RWKV_DIM ** -0.5),
        'q_norm_g': 1.0 + nrm((L, HEAD_DIM), 0.02),
        'k_norm_g': 1.0 + nrm((L, HEAD_DIM), 0.02),
        'w_attn_out': nrm((L, ATTN_OUT_DIM, D_MODEL), ATTN_OUT_DIM ** -0.5),
        'b_merge': nrm((L, N_BRANCH, D_MODEL), 0.02),
        'w_out': nrm((L, D_MODEL, D_MODEL), D_MODEL ** -0.5),
        'norm2_g': 1.0 + nrm((L, D_MODEL), 0.02),
        'w_router_group': nrm((L, D_MODEL, MOE_GROUPS), D_MODEL ** -0.5),
        'b_router_group': nrm((L, MOE_GROUPS), 0.01),
        'w_router_expert': nrm((L, D_MODEL, N_EXPERTS), D_MODEL ** -0.5),
        'b_router_expert': nrm((L, N_EXPERTS), 0.01),
        'w_gate': nrm((L, N_EXPERTS, D_MODEL, D_EXPERT), D_MODEL ** -0.5),
        'w_up': nrm((L, N_EXPERTS, D_MODEL, D_EXPERT), D_MODEL ** -0.5),
        'w_down': nrm((L, N_EXPERTS, D_EXPERT, D_MODEL), D_EXPERT ** -0.5),
    }


def reference(x, positions, norm1_g, w_in, mu_prev, mu_next, w_decay0, w_decay_up, a_gate0, a_gate_up,
              g_up, k_k, k_a, r_k, gn_w, gn_b, w_rwkv_out, q_norm_g, k_norm_g, w_attn_out, b_merge, w_out,
              norm2_g, w_router_group, b_router_group, w_router_expert, b_router_expert, w_gate, w_up, w_down):
    for l in range(DEPTH):
        x = hybrid_layer(x, positions, norm1_g[l], w_in[l], mu_prev[l], mu_next[l], w_decay0[l], w_decay_up[l],
                         a_gate0[l], a_gate_up[l], g_up[l], k_k[l], k_a[l], r_k[l], gn_w[l], gn_b[l],
                         w_rwkv_out[l], q_norm_g[l], k_norm_g[l], w_attn_out[l], b_merge[l], w_out[l],
                         norm2_g[l], w_router_group[l], b_router_group[l], w_router_expert[l],
                         b_router_expert[l], w_gate[l], w_up[l], w_down[l])
    return x
```

```cpp
#include <hip/hip_runtime.h>
#include <cstdio>
#include <cstdint>

constexpr int BATCH = 16, SEQ = 2048, DM = 1024, NTOK = BATCH * SEQ;
constexpr int RW_COLS = 1792, AT_COLS = 2304, G_COLS = 2048, IN_COLS = 6144;
constexpr int NEXP = 32, DEXP = 512;
constexpr int MAXTILES = 288;
constexpr float NORM_EPS = 1e-6f, GN_EPS = 64e-5f;

#define GAS __attribute__((address_space(1)))
#define LAS __attribute__((address_space(3)))
typedef unsigned short bf16;
typedef unsigned v4u __attribute__((ext_vector_type(4)));
typedef unsigned v2u __attribute__((ext_vector_type(2)));
typedef float f32x4 __attribute__((ext_vector_type(4)));
typedef float f32x2 __attribute__((ext_vector_type(2)));
typedef float f32x16 __attribute__((ext_vector_type(16)));
typedef short bf16x8 __attribute__((ext_vector_type(8)));
typedef __bf16 bf16x2_t __attribute__((ext_vector_type(2)));
typedef GAS unsigned gu32;
#define RLX_AGENT __ATOMIC_RELAXED, __HIP_MEMORY_SCOPE_AGENT
#define LDS_WAIT() asm volatile("s_waitcnt lgkmcnt(0)" ::: "memory")
#define VM_WAIT() asm volatile("s_waitcnt vmcnt(0)" ::: "memory")
#define DI __device__ __forceinline__
#define LAUNDER(x) asm volatile("" : "+v"(x))

DI unsigned pk2(float lo, float hi) { f32x2 v = {lo, hi}; bf16x2_t b = __builtin_convertvector(v, bf16x2_t); return __builtin_bit_cast(unsigned, b); }
DI float bflo(unsigned u) { return __builtin_bit_cast(float, u << 16); }
DI float bfhi(unsigned u) { return __builtin_bit_cast(float, u & 0xffff0000u); }
DI float sigmoidf_(float x) { return __builtin_amdgcn_rcpf(1.f + __builtin_amdgcn_exp2f(-1.44269504f * x)); }
DI float wave_sum(float v) {
#pragma unroll
    for (int o = 1; o < 64; o <<= 1) v += __shfl_xor(v, o);
    return v;
}
DI int crow(int reg, int h) { return (reg & 3) + 8 * (reg >> 2) + 4 * h; }
#define MFMA32(a, b, c) __builtin_amdgcn_mfma_f32_32x32x16_bf16((a), (b), (c), 0, 0, 0)

constexpr size_t MiB = 1u << 20;
constexpr size_t WS_CTL = 0, CTL_ZERO_BYTES = 1 * MiB;
constexpr size_t WS_WIN_T = 1 * MiB;
constexpr size_t WS_WR_T = 13 * MiB;
constexpr size_t WS_WA_T = 14 * MiB;
constexpr size_t WS_WOUT_T = 15 * MiB;
constexpr size_t WS_GUP_T = 17 * MiB;
constexpr size_t WS_RT_HI = 17 * MiB + 256 * 1024;
constexpr size_t WS_RT_LO = 17 * MiB + 384 * 1024;
constexpr size_t WS_WUP_T = 17 * MiB + 512 * 1024;
constexpr size_t WS_AUP_T = 17 * MiB + 640 * 1024;
constexpr size_t RG_A = 18 * MiB, RG_B = 82 * MiB, RG_C = 194 * MiB, RG_D = 338 * MiB, RG_E = 466 * MiB, WS_END = 512 * MiB;
constexpr size_t WS_HB = RG_A;
constexpr size_t WS_PR = RG_B;
constexpr size_t WS_PT = RG_C;
constexpr size_t WS_G = RG_D;
constexpr size_t WS_OG = RG_A;
constexpr size_t WS_LSE = RG_A + 48 * MiB;
constexpr size_t WS_YA = RG_E;
constexpr size_t WS_BSUM = RG_E + 16 * MiB;
constexpr size_t WS_WKV = RG_C;
constexpr size_t WS_YR = RG_A;
constexpr size_t WS_Z1 = RG_C;
constexpr size_t WS_Z = RG_C + 64 * MiB;
constexpr size_t WS_H2 = RG_B;
constexpr size_t WS_LTOK = RG_E + 20 * MiB;
constexpr size_t WS_LW = RG_E + 24 * MiB;
constexpr size_t WS_ROWTOK = RG_E + 28 * MiB;
constexpr size_t WS_ROWW = RG_E + 29 * MiB;
constexpr size_t WS_WGU_T = RG_D;
constexpr size_t WS_WD_T = RG_D + 64 * MiB;
constexpr size_t WS_XG = RG_C;
constexpr size_t WS_HH = RG_B;
constexpr int CW_BAR = 4096;
constexpr int CW_CNT = 8192;

constexpr int RING_BYTES = 131072;
constexpr int MISC_OFF = RING_BYTES + 320;
constexpr int TAB_OFF = RING_BYTES + 1024;
constexpr int LDS_BYTES = 147456;
constexpr int NWAVES = 8;

namespace pg8 {
constexpr int BM = 256, BK = 64, HALF = 128, HTB = HALF * BK * 2, STAGE_BYTES = 8 * HTB, NXCD = 8, WGM = 8;
__host__ __device__ __forceinline__ int lds_byte(int r, int c) { const int st = (r >> 4) * 2 + (c >> 5), rr = r & 15, cc = c & 31, ob = rr * 64 + cc * 2; return st * 1024 + (ob ^ (((ob >> 9) & 1) << 5)); }
__host__ __device__ __forceinline__ void stage_rc(int b, int& R, int& C) { const int st = b / 1024, sb = b % 1024, swz = sb ^ (((sb >> 9) & 1) << 5); R = (st >> 1) * 16 + swz / 64; C = (st & 1) * 32 + (swz % 64) / 2; }
__host__ __device__ __forceinline__ int perm32(int rho) { const int n = rho >> 4, i = rho & 15; return 8 * (i >> 2) + 4 * n + (i & 3); }

struct Unit { int pm, pn, e; };
struct Gemm { const bf16* A; const bf16* Bt; int K; size_t bgroup; };

struct StaticOrder {
    int nM, nN, nwg, G, c;
    __device__ void init(int M, int N, int G_, int c_) { nM = M / BM; nN = N / BM; nwg = nM * nN; G = G_; c = c_; }
    __device__ bool next(int i, Unit& u) const {
        const long L = (long)i * G + c; if (L >= nwg) return false;
        int wgid = (int)L; { const int q = nwg / NXCD, r = nwg % NXCD, xcd = wgid % NXCD, off = wgid / NXCD; wgid = (xcd < r ? xcd * (q + 1) : r * (q + 1) + (xcd - r) * q) + off; }
        const int nig = WGM * nN, gid = wgid / nig, fm = gid * WGM, gsz = (nM - fm) < WGM ? (nM - fm) : WGM;
        u.pm = fm + ((wgid % nig) % gsz); u.pn = (wgid % nig) / gsz; u.e = 0; return true;
    }
};
struct GroupedOrder {
    const LAS int* tstart; int nT, G, c;
    __device__ bool next(int i, Unit& u) const {
        const int L = i * G + c; if (L >= nT * 4) return false;
        u.pm = L >> 2; u.pn = L & 3; int e = 0;
        for (int k = 1; k < NEXP; ++k) e += (tstart[k] <= u.pm) ? 1 : 0;
        u.e = e; return true;
    }
};

template <class Epi, class Sched, bool ALIGN_EPI = false, bool SP2 = false>
__device__ __forceinline__ void gemm_phase(LAS unsigned char* lds, const Gemm g, const Sched& S, const Epi& E) {
    const int tid = threadIdx.x, wid = __builtin_amdgcn_readfirstlane(tid >> 6), lane = tid & 63, wr = wid >> 2, wc = wid & 3, fr = lane & 15, fq = lane >> 4;
    const int K = g.K, nt = K / BK;
    unsigned voffA[2], voffB[2];
#pragma unroll
    for (int i = 0; i < 2; ++i) { int R, C; stage_rc(tid * 16 + i * 8192, R, C); const int Rb = Epi::PERM ? ((R & ~31) + perm32(R & 31)) : R;
        voffA[i] = (unsigned)(R * K + C) * 2u; voffB[i] = (unsigned)(Rb * K + C) * 2u; }
    const size_t kstep = (size_t)(BK * 2);
    const size_t hstep = (size_t)HALF * K * 2;
    const size_t tstep = 2 * hstep;
    const unsigned ldsw = (unsigned)wid * 1024u;
    const int aoff = lds_byte(wr * 64 + fr, fq * 8), boff = lds_byte(wc * 32 + fr, fq * 8);
#define PG8_SA(b, h) (((b) * 2 + (h)) * HTB)
#define PG8_SB(b, h) ((4 + (b) * 2 + (h)) * HTB)
#define PG8_STAGE(bufoff, gbase, voff) do { _Pragma("unroll") for (int _i = 0; _i < 2; ++_i) \
        __builtin_amdgcn_global_load_lds((const unsigned*)((const char*)(gbase) + (voff)[_i]), (LAS unsigned*)(lds + (bufoff) + ldsw + _i * 8192), 16, 0, 0); } while (0)
#define PG8_LDA(dst, b, h) do { _Pragma("unroll") for (int m = 0; m < 4; ++m) _Pragma("unroll") for (int k = 0; k < 2; ++k) dst[m][k] = *(const LAS bf16x8*)(lds + PG8_SA(b, h) + aoff + m * 2048 + k * 1024); } while (0)
#define PG8_LDB(dst, b, h) do { _Pragma("unroll") for (int n = 0; n < 2; ++n) _Pragma("unroll") for (int k = 0; k < 2; ++k) dst[n][k] = *(const LAS bf16x8*)(lds + PG8_SB(b, h) + boff + n * 2048 + k * 1024); } while (0)
#define PG8_MMA(ai, bj, At, Bt) do { __builtin_amdgcn_s_setprio(1); _Pragma("unroll") for (int m = 0; m < 4; ++m) _Pragma("unroll") for (int n = 0; n < 2; ++n) _Pragma("unroll") for (int k = 0; k < 2; ++k) \
        acc[ai][bj][m][n] = __builtin_amdgcn_mfma_f32_16x16x32_bf16(Bt[n][k], At[m][k], acc[ai][bj][m][n], 0, 0, 0); __builtin_amdgcn_s_setprio(0); } while (0)
#define PG8_WAIT_V(n) asm volatile("s_waitcnt vmcnt(" #n ")" ::: "memory")
#define PG8_WAIT_L(n) asm volatile("s_waitcnt lgkmcnt(" #n ")" ::: "memory")
#define PG8_BAR __builtin_amdgcn_s_barrier()
#define PG8_SCHED __builtin_amdgcn_sched_barrier(0)
    Unit cur, nxt; int ui = 0;
    if (!S.next(0, cur)) return;
    f32x4 acc[2][2][4][2];
#pragma unroll
    for (int a = 0; a < 2; ++a)
#pragma unroll
        for (int b = 0; b < 2; ++b)
#pragma unroll
            for (int m = 0; m < 4; ++m)
#pragma unroll
                for (int n = 0; n < 2; ++n) acc[a][b][m][n] = (f32x4){0.f, 0.f, 0.f, 0.f};
    bf16x8 At[4][2], B0[2][2], B1[2][2];
    const char* cA = (const char*)g.A + (size_t)cur.pm * tstep; const char* cB = (const char*)g.Bt + (size_t)cur.e * g.bgroup + (size_t)cur.pn * tstep;
    if constexpr (SP2) {
        PG8_STAGE(PG8_SB(0, 0), cB, voffB); PG8_STAGE(PG8_SB(0, 1), cB + hstep, voffB); PG8_STAGE(PG8_SA(0, 0), cA, voffA); PG8_STAGE(PG8_SA(0, 1), cA + hstep, voffA);
        if (wr == 1) PG8_BAR;
        PG8_WAIT_V(2); PG8_BAR;
        PG8_STAGE(PG8_SB(1, 0), cB + kstep, voffB); PG8_STAGE(PG8_SA(1, 0), cA + kstep, voffA); PG8_STAGE(PG8_SB(1, 1), cB + hstep + kstep, voffB);
        PG8_WAIT_V(6); PG8_BAR;
    } else {
        PG8_STAGE(PG8_SB(0, 0), cB, voffB); PG8_STAGE(PG8_SA(0, 0), cA, voffA); PG8_STAGE(PG8_SB(0, 1), cB + hstep, voffB); PG8_STAGE(PG8_SA(0, 1), cA + hstep, voffA);
        if (wr == 1) PG8_BAR;
        PG8_WAIT_V(4); PG8_BAR;
        PG8_STAGE(PG8_SB(1, 0), cB + kstep, voffB); PG8_STAGE(PG8_SA(1, 0), cA + kstep, voffA); PG8_STAGE(PG8_SB(1, 1), cB + hstep + kstep, voffB);
        PG8_WAIT_V(6); PG8_BAR;
    }
    for (;;) {
        const bool has_next = S.next(ui + 1, nxt);
        const char* nA = has_next ? (const char*)g.A + (size_t)nxt.pm * tstep : cA; const char* nB = has_next ? (const char*)g.Bt + (size_t)nxt.e * g.bgroup + (size_t)nxt.pn * tstep : cB;
        for (int t = 0; t < nt; t += 2) {
            const bool last = (t == nt - 2);
            const char* a1 = cA + (size_t)(t + 1) * kstep;
            const char* a2 = last ? nA : cA + (size_t)(t + 2) * kstep; const char* b2 = last ? nB : cB + (size_t)(t + 2) * kstep;
            const char* a3 = a2 + kstep; const char* b3 = b2 + kstep;
            if constexpr (SP2) {
            PG8_LDB(B0, 0, 0); PG8_LDB(B1, 0, 1); PG8_SCHED; PG8_LDA(At, 0, 0); PG8_STAGE(PG8_SA(1, 1), a1 + hstep, voffA);
            PG8_WAIT_V(8); PG8_WAIT_L(0); PG8_BAR; PG8_MMA(0, 0, At, B0); PG8_MMA(0, 1, At, B1); PG8_BAR; PG8_SCHED;
            PG8_LDA(At, 0, 1); PG8_STAGE(PG8_SB(0, 0), b2, voffB); PG8_STAGE(PG8_SB(0, 1), b2 + hstep, voffB); PG8_STAGE(PG8_SA(0, 0), a2, voffA);
            PG8_WAIT_V(8); PG8_WAIT_L(0); PG8_BAR; PG8_MMA(1, 0, At, B0); PG8_MMA(1, 1, At, B1); PG8_BAR; PG8_SCHED;
            PG8_LDB(B0, 1, 0); PG8_LDB(B1, 1, 1); PG8_SCHED; PG8_LDA(At, 1, 0); PG8_STAGE(PG8_SA(0, 1), a2 + hstep, voffA);
            PG8_WAIT_V(8); PG8_WAIT_L(0); PG8_BAR; PG8_MMA(0, 0, At, B0); PG8_MMA(0, 1, At, B1); PG8_BAR; PG8_SCHED;
            PG8_LDA(At, 1, 1); PG8_STAGE(PG8_SB(1, 0), b3, voffB); PG8_STAGE(PG8_SB(1, 1), b3 + hstep, voffB); PG8_STAGE(PG8_SA(1, 0), a3, voffA);
            PG8_WAIT_V(8); PG8_WAIT_L(0); PG8_BAR; PG8_MMA(1, 0, At, B0); PG8_MMA(1, 1, At, B1); PG8_BAR; PG8_SCHED;
            } else {
            PG8_LDB(B0, 0, 0); PG8_SCHED; PG8_LDA(At, 0, 0); PG8_STAGE(PG8_SA(1, 1), a1 + hstep, voffA);
            PG8_WAIT_L(8); PG8_BAR; PG8_WAIT_L(0); PG8_MMA(0, 0, At, B0); PG8_BAR; PG8_SCHED;
            PG8_LDB(B1, 0, 1); PG8_STAGE(PG8_SB(0, 0), b2, voffB);
            PG8_BAR; PG8_WAIT_L(0); PG8_MMA(0, 1, At, B1); PG8_BAR;
            PG8_LDA(At, 0, 1); PG8_STAGE(PG8_SA(0, 0), a2, voffA);
            PG8_BAR; PG8_WAIT_L(0); PG8_MMA(1, 0, At, B0); PG8_BAR; PG8_SCHED;
            PG8_STAGE(PG8_SB(0, 1), b2 + hstep, voffB);
            PG8_WAIT_V(6); PG8_BAR; PG8_MMA(1, 1, At, B1); PG8_BAR;
            PG8_LDB(B0, 1, 0); PG8_SCHED; PG8_LDA(At, 1, 0); PG8_STAGE(PG8_SA(0, 1), a2 + hstep, voffA);
            PG8_WAIT_L(8); PG8_BAR; PG8_WAIT_L(0); PG8_MMA(0, 0, At, B0); PG8_BAR; PG8_SCHED;
            PG8_LDB(B1, 1, 1); PG8_STAGE(PG8_SB(1, 0), b3, voffB);
            PG8_BAR; PG8_WAIT_L(0); PG8_MMA(0, 1, At, B1); PG8_BAR;
            PG8_LDA(At, 1, 1); PG8_STAGE(PG8_SA(1, 0), a3, voffA);
            PG8_BAR; PG8_WAIT_L(0); PG8_MMA(1, 0, At, B0); PG8_BAR; PG8_SCHED;
            PG8_STAGE(PG8_SB(1, 1), b3 + hstep, voffB);
            PG8_WAIT_V(6); PG8_BAR; PG8_MMA(1, 1, At, B1); PG8_BAR;
            }
        }
        if constexpr (ALIGN_EPI) { if (wr == 0) PG8_BAR; }
        E(acc, cur, wr, wc, fr, fq);
        if (!has_next) break;
#pragma unroll
        for (int a = 0; a < 2; ++a)
#pragma unroll
            for (int b = 0; b < 2; ++b)
#pragma unroll
                for (int m = 0; m < 4; ++m)
#pragma unroll
                    for (int n = 0; n < 2; ++n) acc[a][b][m][n] = (f32x4){0.f, 0.f, 0.f, 0.f};
        cur = nxt; cA = nA; cB = nB; ++ui;
        if constexpr (ALIGN_EPI) { if (wr == 1) PG8_BAR; }
    }
    PG8_WAIT_V(0);
    if constexpr (!ALIGN_EPI) { if (wr == 0) PG8_BAR; }
    PG8_BAR;
#undef PG8_SA
#undef PG8_SB
#undef PG8_STAGE
#undef PG8_LDA
#undef PG8_LDB
#undef PG8_MMA
#undef PG8_WAIT_V
#undef PG8_WAIT_L
#undef PG8_BAR
#undef PG8_SCHED
}

struct EpiIn {
    static constexpr bool PERM = true;
    bf16* PR; bf16* PT; bf16* G; const float* bmerge;
    __device__ __forceinline__ void operator()(const f32x4 (&acc)[2][2][4][2], const Unit& u, int wr, int wc, int fr, int fq) const {
        const int row0 = u.pm * BM + wr * 64 + fr; const int pn = u.pn;
        bf16* base; int ldc, colt;
        if (pn < 7) { base = PR; ldc = RW_COLS; colt = pn * BM; } else if (pn < 16) { base = PT; ldc = AT_COLS; colt = (pn - 7) * BM; } else { base = G; ldc = G_COLS; colt = (pn - 16) * BM; }
        const bool gate = pn >= 16;
        const int col0 = colt + wc * 32 + 8 * fq;
        f32x4 bv[2][2];
#pragma unroll
        for (int bj = 0; bj < 2; ++bj)
#pragma unroll
            for (int n = 0; n < 2; ++n) bv[bj][n] = gate ? *(const f32x4*)(bmerge + col0 + bj * HALF + 4 * n) : (f32x4){0.f, 0.f, 0.f, 0.f};
#pragma unroll
        for (int ai = 0; ai < 2; ++ai)
#pragma unroll
            for (int m = 0; m < 4; ++m) { bf16* rowp = base + (size_t)(row0 + ai * HALF + m * 16) * ldc + col0;
#pragma unroll
                for (int bj = 0; bj < 2; ++bj) { f32x4 v0 = acc[ai][bj][m][0] + bv[bj][0], v1 = acc[ai][bj][m][1] + bv[bj][1];
                    if (gate) {
#pragma unroll
                        for (int j = 0; j < 4; ++j) { v0[j] = sigmoidf_(v0[j]); v1[j] = sigmoidf_(v1[j]); } }
                    v4u w; w.x = pk2(v0[0], v0[1]); w.y = pk2(v0[2], v0[3]); w.z = pk2(v1[0], v1[1]); w.w = pk2(v1[2], v1[3]);
                    *(v4u*)(rowp + bj * HALF) = w; } }
    }
};
template <int MODE> struct EpiMix {
    static constexpr bool PERM = true;
    const bf16* G; const bf16* Zin; bf16* Zout;
    __device__ __forceinline__ void operator()(const f32x4 (&acc)[2][2][4][2], const Unit& u, int wr, int wc, int fr, int fq) const {
        const int row0 = u.pm * BM + wr * 64 + fr, col0 = u.pn * BM + wc * 32 + 8 * fq;
#pragma unroll
        for (int ai = 0; ai < 2; ++ai)
#pragma unroll
            for (int m = 0; m < 4; ++m) { const size_t r = (size_t)(row0 + ai * HALF + m * 16);
#pragma unroll
                for (int bj = 0; bj < 2; ++bj) {
                    const int c = col0 + bj * HALF;
                    const v4u gv = *(const v4u*)(G + r * G_COLS + MODE * DM + c);
                    f32x4 v0 = acc[ai][bj][m][0], v1 = acc[ai][bj][m][1];
                    v0[0] *= bflo(gv.x); v0[1] *= bfhi(gv.x); v0[2] *= bflo(gv.y); v0[3] *= bfhi(gv.y);
                    v1[0] *= bflo(gv.z); v1[1] *= bfhi(gv.z); v1[2] *= bflo(gv.w); v1[3] *= bfhi(gv.w);
                    if (MODE == 1) { const v4u zv = *(const v4u*)(Zin + r * DM + c);
                        v0[0] += bflo(zv.x); v0[1] += bfhi(zv.x); v0[2] += bflo(zv.y); v0[3] += bfhi(zv.y);
                        v1[0] += bflo(zv.z); v1[1] += bfhi(zv.z); v1[2] += bflo(zv.w); v1[3] += bfhi(zv.w); }
                    v4u w; w.x = pk2(v0[0], v0[1]); w.y = pk2(v0[2], v0[3]); w.z = pk2(v1[0], v1[1]); w.w = pk2(v1[2], v1[3]);
                    *(v4u*)(Zout + r * DM + c) = w; } }
    }
};
struct EpiRes {
    static constexpr bool PERM = false;
    const float* X; float* O;
    __device__ __forceinline__ void operator()(const f32x4 (&acc)[2][2][4][2], const Unit& u, int wr, int wc, int fr, int fq) const {
        const int row0 = u.pm * BM + wr * 64 + fr, col0 = u.pn * BM + wc * 32 + 4 * fq;
#pragma unroll
        for (int ai = 0; ai < 2; ++ai)
#pragma unroll
            for (int m = 0; m < 4; ++m) { const size_t off = (size_t)(row0 + ai * HALF + m * 16) * DM + col0;
#pragma unroll
                for (int bj = 0; bj < 2; ++bj)
#pragma unroll
                    for (int n = 0; n < 2; ++n) { const f32x4 xv = *(const f32x4*)(X + off + bj * HALF + n * 16); *(f32x4*)(O + off + bj * HALF + n * 16) = xv + acc[ai][bj][m][n]; } }
    }
};
struct EpiSwiglu {
    static constexpr bool PERM = false;
    bf16* H;
    __device__ __forceinline__ void operator()(const f32x4 (&acc)[2][2][4][2], const Unit& u, int wr, int wc, int fr, int fq) const {
        const int row0 = u.pm * BM + wr * 64 + fr, col0 = u.pn * 128 + wc * 16 + 4 * fq;
#pragma unroll
        for (int ai = 0; ai < 2; ++ai)
#pragma unroll
            for (int m = 0; m < 4; ++m) { bf16* rowp = H + (size_t)(row0 + ai * HALF + m * 16) * DEXP + col0;
#pragma unroll
                for (int bj = 0; bj < 2; ++bj) { const f32x4 gt = acc[ai][bj][m][0], up = acc[ai][bj][m][1]; f32x4 o;
#pragma unroll
                    for (int j = 0; j < 4; ++j) o[j] = gt[j] * sigmoidf_(gt[j]) * up[j];
                    v2u w; w.x = pk2(o[0], o[1]); w.y = pk2(o[2], o[3]);
                    *(v2u*)(rowp + bj * 64) = w; } }
    }
};
struct EpiScatter {
    static constexpr bool PERM = false;
    const int* rowtok; const float* roww; float* O;
    __device__ __forceinline__ void operator()(const f32x4 (&acc)[2][2][4][2], const Unit& u, int wr, int wc, int fr, int fq) const {
        const int row0 = u.pm * BM + wr * 64 + fr, col0 = u.pn * BM + wc * 32 + 4 * fq;
#pragma unroll
        for (int ai = 0; ai < 2; ++ai)
#pragma unroll
            for (int m = 0; m < 4; ++m) { const int r = row0 + ai * HALF + m * 16; const int tok = rowtok[r]; const float w = roww[r];
                if (tok >= 0) { float* op = O + (size_t)tok * DM + col0;
#pragma unroll
                    for (int bj = 0; bj < 2; ++bj)
#pragma unroll
                        for (int n = 0; n < 2; ++n) { const f32x4 v = acc[ai][bj][m][n] * w; float* p = op + bj * HALF + n * 16;
                            unsafeAtomicAdd(p + 0, v[0]); unsafeAtomicAdd(p + 1, v[1]); unsafeAtomicAdd(p + 2, v[2]); unsafeAtomicAdd(p + 3, v[3]); } } }
    }
};
}

#define XB_TMO      128
#define XB_XCNT(j)  (256  + 64 * (j))
#define XB_XSUB(j)  (1280 + 64 * (j))
#define XB_XGEN(j)  (2304 + 64 * (j))
#define XB_TOP      3328
#define XB_TOPGEN   3392
#define XCD_BAR_WORDS 3456
#define XB_SPIN_CAP (1u << 18)
__device__ __forceinline__ unsigned xb_ld(unsigned* p)              { return __hip_atomic_load(p, __ATOMIC_RELAXED, __HIP_MEMORY_SCOPE_AGENT); }
__device__ __forceinline__ unsigned xb_add(unsigned* p, unsigned v) { return __hip_atomic_fetch_add(p, v, __ATOMIC_RELAXED, __HIP_MEMORY_SCOPE_AGENT); }
__device__ __forceinline__ unsigned xb_xcc_id() { return (unsigned)__builtin_amdgcn_s_getreg((3 << 11) | 20) & 0xFu; }
#define XB_SPIN(cond, bar) do { unsigned _sp = 0; while (cond) { __builtin_amdgcn_s_sleep(1); \
    if ((++_sp & 255u) == 0u) { if (xb_ld(&(bar)[XB_TMO])) break; if (_sp > XB_SPIN_CAP) { atomicAdd(&(bar)[XB_TMO], 1u); break; } } } } while (0)
struct XcdBarrier { unsigned* bar; unsigned x; volatile LAS unsigned* st; };
__device__ __forceinline__ XcdBarrier xcd_barrier_post(unsigned* bar, volatile LAS unsigned* st) {
    XcdBarrier b; b.bar = bar; b.x = xb_xcc_id(); b.st = st;
    if (threadIdx.x == 0) (void)xb_add(&bar[XB_XCNT(b.x)], 1u);
    return b;
}
__device__ __forceinline__ void xcd_barrier_complete(unsigned* bar, unsigned x, unsigned& nloc, unsigned& nx) {
    const unsigned G = gridDim.x * gridDim.y * gridDim.z;
    unsigned sum, cnt, mine, sp = 0u;
    for (;;) {
        sum = 0u; cnt = 0u; mine = 0u;
#pragma unroll
        for (unsigned j = 0; j < 16; ++j) { const unsigned c = xb_ld(&bar[XB_XCNT(j)]); sum += c; cnt += (c > 0u) ? 1u : 0u; mine = (j == x) ? c : mine; }
        if (sum == G) break;
        __builtin_amdgcn_s_sleep(1);
        if ((++sp & 255u) == 0u) { if (xb_ld(&bar[XB_TMO])) break; if (sp > XB_SPIN_CAP) { atomicAdd(&bar[XB_TMO], 1u); break; } }
    }
    nloc = mine > 0u ? mine : 1u; nx = cnt > 0u ? cnt : 1u;
}
__device__ __forceinline__ void xcd_barrier(const XcdBarrier& b) {
    asm volatile("s_waitcnt vmcnt(0)" ::: "memory");
    __syncthreads();
    if (threadIdx.x == 0) {
        unsigned* bar = b.bar;
        __builtin_amdgcn_s_waitcnt(0);
        unsigned nloc = b.st[0], nx = b.st[1];
        if (nloc == 0u) { xcd_barrier_complete(bar, b.x, nloc, nx); b.st[0] = nloc; b.st[1] = nx; }
        const unsigned old = xb_add(&bar[XB_XSUB(b.x)], 1u);
        const unsigned gen = old / nloc;
        if (old + 1u == (gen + 1u) * nloc) {
            __builtin_amdgcn_fence(__ATOMIC_RELEASE, "agent");
            asm volatile("s_waitcnt vmcnt(0)" ::: "memory");
            const unsigned og = xb_add(&bar[XB_TOP], 1u);
            const unsigned tg = og / nx;
            if (og + 1u == (tg + 1u) * nx) xb_add(&bar[XB_TOPGEN], 1u);
            else XB_SPIN(xb_ld(&bar[XB_TOPGEN]) == tg, bar);
            __builtin_amdgcn_fence(__ATOMIC_ACQUIRE, "agent");
            xb_add(&bar[XB_XGEN(b.x)], 1u);
            asm volatile("s_waitcnt vmcnt(0)" ::: "memory");
        } else {
            XB_SPIN(xb_ld(&bar[XB_XGEN(b.x)]) == gen, bar);
            __builtin_amdgcn_fence(__ATOMIC_ACQUIRE, "agent");
            asm volatile("s_waitcnt vmcnt(0)" ::: "memory");
        }
    }
    __syncthreads();
}

struct Args { const void* in[30]; float* out; unsigned char* ws; int ph_lo, ph_hi; };
struct Frame {
    LAS unsigned char* lds; volatile LAS unsigned* MISC;
    int tid, lane, wave, G, bid;
    unsigned char* ws;
};
enum { I_X = 0, I_POS, I_N1G, I_WIN, I_MUP, I_MUN, I_WD0, I_WDUP, I_AG0, I_AGUP, I_GUP, I_KK, I_KA, I_RK, I_GNW, I_GNB, I_WROUT, I_QNG, I_KNG, I_WAOUT, I_BMERGE, I_WOUT,
       I_N2G, I_WRG, I_BRG, I_WRE, I_BRE, I_WGATE, I_WUP, I_WDOWN };

template <class RowMap>
DI void transpose_item(const float* W, int K, int N, bf16* WT, const RowMap& rm, LAS float* scr, int item, int lane) {
    const int nblk = N / 32, kb = item / nblk, nb = item % nblk, k0 = 64 * kb, n0 = 32 * nb;
#pragma unroll 8
    for (int i = 0; i < 32; ++i) { const int kk = 2 * i + (lane >> 5); scr[kk * 33 + (lane & 31)] = W[(size_t)(k0 + kk) * N + n0 + (lane & 31)]; }
    LDS_WAIT(); asm volatile("" ::: "memory");
    const int c = lane & 7;
#pragma unroll
    for (int j = 0; j < 4; ++j) { const int n = (lane >> 3) + 8 * j; const LAS float* s = scr + (8 * c) * 33 + n;
        v4u o; o.x = pk2(s[0 * 33], s[1 * 33]); o.y = pk2(s[2 * 33], s[3 * 33]); o.z = pk2(s[4 * 33], s[5 * 33]); o.w = pk2(s[6 * 33], s[7 * 33]);
        *(GAS v4u*)(WT + (size_t)rm(n0 + n) * K + k0 + 8 * c) = o; }
    LDS_WAIT(); asm volatile("" ::: "memory");
}
struct RmId { DI int operator()(int n) const { return n; } };
struct RmGate { DI int operator()(int n) const { return 32 * (n >> 4) + (n & 15); } };
struct RmUp { DI int operator()(int n) const { return 32 * (n >> 4) + 16 + (n & 15); } };

DI void p0_prologue(Frame& F, const Args& a) {
    LAS float* scr = (LAS float*)(F.lds + F.wave * 16384);
    const int gw = F.bid * NWAVES + F.wave, NGW = F.G * NWAVES;
    unsigned char* ws = F.ws;
    constexpr int I_IN = (DM / 64) * (IN_COLS / 32), I_R = (512 / 64) * (DM / 32), I_A = (256 / 64) * (DM / 32), I_O = (DM / 64) * (DM / 32), I_G = (128 / 64) * (512 / 32), I_L = 512 / 32;
    constexpr int NITEMS = I_IN + I_R + I_A + I_O + I_G + 4 * I_L;
    for (int it = gw; it < NITEMS; it += NGW) {
        int r = it;
        if (r < I_IN) { transpose_item((const float*)a.in[I_WIN], DM, IN_COLS, (bf16*)(ws + WS_WIN_T), RmId(), scr, r, F.lane); continue; } r -= I_IN;
        if (r < I_R) { transpose_item((const float*)a.in[I_WROUT], 512, DM, (bf16*)(ws + WS_WR_T), RmId(), scr, r, F.lane); continue; } r -= I_R;
        if (r < I_A) { transpose_item((const float*)a.in[I_WAOUT], 256, DM, (bf16*)(ws + WS_WA_T), RmId(), scr, r, F.lane); continue; } r -= I_A;
        if (r < I_O) { transpose_item((const float*)a.in[I_WOUT], DM, DM, (bf16*)(ws + WS_WOUT_T), RmId(), scr, r, F.lane); continue; } r -= I_O;
        if (r < I_G) { transpose_item((const float*)a.in[I_GUP], 128, 512, (bf16*)(ws + WS_GUP_T), RmId(), scr, r, F.lane); continue; } r -= I_G;
        { const int d = r / I_L, rr = r % I_L;
          if (d < 2) transpose_item((const float*)a.in[I_WDUP] + (size_t)d * 64 * 512, 64, 512, (bf16*)(ws + WS_WUP_T) + (size_t)d * 512 * 64, RmId(), scr, rr, F.lane);
          else transpose_item((const float*)a.in[I_AGUP] + (size_t)(d - 2) * 64 * 512, 64, 512, (bf16*)(ws + WS_AUP_T) + (size_t)(d - 2) * 512 * 64, RmId(), scr, rr, F.lane); }
    }
    { const float* g2 = (const float*)a.in[I_N2G]; const float* wre = (const float*)a.in[I_WRE]; const float* wrg = (const float*)a.in[I_WRG];
      bf16* hi = (bf16*)(ws + WS_RT_HI); bf16* lo = (bf16*)(ws + WS_RT_LO);
      for (int i = F.bid * 512 + F.tid; i < 64 * DM; i += F.G * 512) { const int n = i / DM, k = i % DM;
          float v = 0.f; if (n < 32) v = g2[k] * wre[k * 32 + n]; else if (n < 36) v = g2[k] * wrg[k * 4 + (n - 32)];
          const unsigned h = pk2(v, 0.f) & 0xffffu; const float hf = bflo(h); hi[i] = (bf16)h; lo[i] = (bf16)(pk2(v - hf, 0.f) & 0xffffu); } }
    { const float* x = (const float*)a.in[I_X]; const float* g1 = (const float*)a.in[I_N1G]; bf16* hb = (bf16*)(ws + WS_HB);
      f32x4 gv[4];
#pragma unroll
      for (int j = 0; j < 4; ++j) gv[j] = ((const f32x4*)g1)[F.lane + 64 * j];
      for (int m = gw; m < NTOK; m += NGW) {
          const GAS f32x4* xr = (const GAS f32x4*)(x + (size_t)m * DM) + F.lane; f32x4 v[4]; float s = 0.f;
#pragma unroll
          for (int j = 0; j < 4; ++j) { v[j] = xr[64 * j]; s += (v[j].x * v[j].x + v[j].y * v[j].y) + (v[j].z * v[j].z + v[j].w * v[j].w); }
          const float rstd = 1.f / sqrtf(wave_sum(s) * (1.f / DM) + NORM_EPS);
          GAS v2u* o8 = (GAS v2u*)(hb + (size_t)m * DM) + F.lane;
#pragma unroll
          for (int j = 0; j < 4; ++j) { v2u w; w.x = pk2(v[j].x * rstd * gv[j].x, v[j].y * rstd * gv[j].y); w.y = pk2(v[j].z * rstd * gv[j].z, v[j].w * rstd * gv[j].w); o8[64 * j] = w; } } }
}

DI void p1b_qkprep(Frame& F, const Args& a) {
    bf16* PT = (bf16*)(F.ws + WS_PT);
    const int* pos = (const int*)a.in[I_POS];
    const int sub = F.lane & 7;
    const f32x4 qg0 = ((const f32x4*)a.in[I_QNG])[2 * sub], qg1 = ((const f32x4*)a.in[I_QNG])[2 * sub + 1];
    const f32x4 kg0 = ((const f32x4*)a.in[I_KNG])[2 * sub], kg1 = ((const f32x4*)a.in[I_KNG])[2 * sub + 1];
    constexpr float IF2PI[8] = {0.15915494309189535f, 0.03086376340470123f, 0.005985185712713705f, 0.001160663641240061f, 0.00022507907903927653f, 4.364795279280289e-05f, 8.464330808241401e-06f, 1.6414262627950345e-06f};
    const int nvec = NTOK * 24;
    for (int vid = (F.bid * 512 + F.tid) >> 3; vid < nvec; vid += (F.G * 512) >> 3) {
        const int tok = vid / 24, v = vid % 24; const bool isq = v < 12; const int head = isq ? v : v - 12;
        bf16* p = PT + (size_t)tok * AT_COLS + (isq ? 0 : 768) + head * 64 + sub * 8;
        const v4u raw = *(const v4u*)p;
        float y[8] = {bflo(raw.x), bfhi(raw.x), bflo(raw.y), bfhi(raw.y), bflo(raw.z), bfhi(raw.z), bflo(raw.w), bfhi(raw.w)};
        float ss = 0.f;
#pragma unroll
        for (int j = 0; j < 8; ++j) ss += y[j] * y[j];
        ss += __shfl_xor(ss, 1); ss += __shfl_xor(ss, 2); ss += __shfl_xor(ss, 4);
        const float rstd = 1.f / sqrtf(ss * (1.f / 64.f) + NORM_EPS);
        const f32x4 g0 = isq ? qg0 : kg0, g1 = isq ? qg1 : kg1;
#pragma unroll
        for (int j = 0; j < 4; ++j) { y[j] = y[j] * rstd * g0[j]; y[4 + j] = y[4 + j] * rstd * g1[j]; }
        const float pf = (float)pos[tok];
#pragma unroll
        for (int j = 0; j < 8; ++j) {
            const float partner = __shfl_xor(y[j], 1);
            float r = pf * IF2PI[j]; r = r - floorf(r);
            const float sn = __builtin_amdgcn_sinf(r), cs = __builtin_amdgcn_cosf(r);
            const float rot = y[j] * cs + (sub == 0 ? -partner : partner) * sn;
            if (sub < 2) y[j] = rot;
        }
        if (isq) {
#pragma unroll
            for (int j = 0; j < 8; ++j) y[j] *= 0.18033688011112042f;
        }
        v4u o; o.x = pk2(y[0], y[1]); o.y = pk2(y[2], y[3]); o.z = pk2(y[4], y[5]); o.w = pk2(y[6], y[7]);
        *(v4u*)p = o;
    }
}

DI bf16x8 pack8(float a0, float a1, float a2, float a3, float a4, float a5, float a6, float a7) {
    v4u p; p.x = pk2(a0, a1); p.y = pk2(a2, a3); p.z = pk2(a4, a5); p.w = pk2(a6, a7); return __builtin_bit_cast(bf16x8, p);
}
DI void attn_unit(Frame& F, int b, int hh, int span) {
    const bf16* PT = (const bf16*)(F.ws + WS_PT); bf16* Og = (bf16*)(F.ws + WS_OG); float* Lse = (float*)(F.ws + WS_LSE); bf16* YA = (bf16*)(F.ws + WS_YA);
    LAS unsigned char* vbuf = F.lds + F.wave * 9216;
    const int lane = F.lane, n = lane & 31, half = lane >> 5;
    const int T0 = span * 512; const size_t rowbase = (size_t)b * SEQ;
    for (int su = F.wave; su < 48; su += 8) {
        const int g = su >> 4, s16 = su & 15, dsh = 2 * g, L = SEQ >> dsh, per_r = 16 >> dsh;
        const int r = s16 / per_r, sb = s16 % per_r, l0 = (T0 >> dsh) + sb * 32, head = 4 * g + hh;
        const int tq = ((l0 + n) << dsh) + r;
        const bf16* qp = PT + (rowbase + tq) * AT_COLS + head * 64 + 8 * half;
        bf16x8 qf[4];
#pragma unroll
        for (int kk = 0; kk < 4; ++kk) qf[kk] = *(const bf16x8*)(qp + 16 * kk);
        f32x16 o0, o1;
#pragma unroll
        for (int i = 0; i < 16; ++i) { o0[i] = 0.f; o1[i] = 0.f; }
        float mrun = -1e30f, lrun = 0.f;
        for (int kb = 0; kb < 5; ++kb) {
            const int lk0 = l0 - 64 + 32 * kb;
            if (lk0 < 0 || lk0 >= L) continue;
            LAS unsigned char* vb = vbuf + (kb & 1) * 4608;
#pragma unroll
            for (int j = 0; j < 4; ++j) { const int idx = lane + 64 * j, key = idx >> 3, ch = idx & 7; const int tk = ((lk0 + key) << dsh) + r;
                const v4u vv = *(const v4u*)(PT + (rowbase + tk) * AT_COLS + 1536 + head * 64 + ch * 8);
                *(LAS v4u*)(vb + key * 144 + ch * 16) = vv; }
            const int tk = ((lk0 + n) << dsh) + r;
            const bf16* kp = PT + (rowbase + tk) * AT_COLS + 768 + head * 64 + 8 * half;
            f32x16 s;
#pragma unroll
            for (int i = 0; i < 16; ++i) s[i] = 0.f;
#pragma unroll
            for (int kk = 0; kk < 4; ++kk) s = MFMA32(*(const bf16x8*)(kp + 16 * kk), qf[kk], s);
            if (kb == 0) {
#pragma unroll
                for (int i = 0; i < 16; ++i) if (crow(i, half) < n) s[i] = -1e30f; }
            if (kb == 4) {
#pragma unroll
                for (int i = 0; i < 16; ++i) if (crow(i, half) > n) s[i] = -1e30f; }
            float mx = s[0];
#pragma unroll
            for (int i = 1; i < 16; ++i) mx = fmaxf(mx, s[i]);
            mx = fmaxf(mx, __shfl_xor(mx, 32));
            const float mnew = fmaxf(mrun, mx), alpha = __builtin_amdgcn_exp2f(mrun - mnew); mrun = mnew;
            float ps = 0.f;
#pragma unroll
            for (int i = 0; i < 16; ++i) { s[i] = __builtin_amdgcn_exp2f(s[i] - mnew); ps += s[i]; }
            lrun = lrun * alpha + ps;
#pragma unroll
            for (int i = 0; i < 16; ++i) { o0[i] *= alpha; o1[i] *= alpha; }
            const bf16x8 pf0 = pack8(s[0], s[1], s[2], s[3], s[4], s[5], s[6], s[7]), pf1 = pack8(s[8], s[9], s[10], s[11], s[12], s[13], s[14], s[15]);
#pragma unroll
            for (int g2 = 0; g2 < 2; ++g2) {
                bf16x8 vf0, vf1;
#pragma unroll
                for (int si = 0; si < 8; ++si) { const int key = 16 * g2 + (si & 3) + 8 * (si >> 2) + 4 * half;
                    vf0[si] = *(const LAS short*)(vb + key * 144 + n * 2); vf1[si] = *(const LAS short*)(vb + key * 144 + (n + 32) * 2); }
                o0 = MFMA32(vf0, g2 ? pf1 : pf0, o0); o1 = MFMA32(vf1, g2 ? pf1 : pf0, o1);
            }
        }
        const float ltot = lrun + __shfl_xor(lrun, 32), inv = 1.f / ltot;
        bf16* op = Og + ((size_t)g * NTOK + rowbase + tq) * 256 + hh * 64;
#pragma unroll
        for (int q4 = 0; q4 < 4; ++q4) { const int d0 = 8 * q4 + 4 * half;
            v2u w0; w0.x = pk2(o0[4 * q4] * inv, o0[4 * q4 + 1] * inv); w0.y = pk2(o0[4 * q4 + 2] * inv, o0[4 * q4 + 3] * inv); *(v2u*)(op + d0) = w0;
            v2u w1; w1.x = pk2(o1[4 * q4] * inv, o1[4 * q4 + 1] * inv); w1.y = pk2(o1[4 * q4 + 2] * inv, o1[4 * q4 + 3] * inv); *(v2u*)(op + 32 + d0) = w1; }
        if (half == 0) Lse[((size_t)g * NTOK + rowbase + tq) * 4 + hh] = mrun + __builtin_amdgcn_logf(ltot);
    }
    VM_WAIT(); __syncthreads();
    __builtin_amdgcn_fence(__ATOMIC_ACQUIRE, "agent"); VM_WAIT();
    {
        const size_t tok = rowbase + T0 + F.tid;
        const float l0 = Lse[(0 * (size_t)NTOK + tok) * 4 + hh], l1 = Lse[(1 * (size_t)NTOK + tok) * 4 + hh], l2 = Lse[(2 * (size_t)NTOK + tok) * 4 + hh];
        const float mx = fmaxf(l0, fmaxf(l1, l2));
        float a0 = __builtin_amdgcn_exp2f(l0 - mx), a1 = __builtin_amdgcn_exp2f(l1 - mx), a2 = __builtin_amdgcn_exp2f(l2 - mx);
        const float inv = 1.f / (a0 + a1 + a2); a0 *= inv; a1 *= inv; a2 *= inv;
        const bf16* p0 = Og + (0 * (size_t)NTOK + tok) * 256 + hh * 64; const bf16* p1 = Og + (1 * (size_t)NTOK + tok) * 256 + hh * 64; const bf16* p2 = Og + (2 * (size_t)NTOK + tok) * 256 + hh * 64;
        bf16* yo = YA + tok * 256 + hh * 64;
#pragma unroll
        for (int c = 0; c < 8; ++c) { const v4u x0 = *(const v4u*)(p0 + 8 * c), x1 = *(const v4u*)(p1 + 8 * c), x2 = *(const v4u*)(p2 + 8 * c); v4u o;
            o.x = pk2(a0 * bflo(x0.x) + a1 * bflo(x1.x) + a2 * bflo(x2.x), a0 * bfhi(x0.x) + a1 * bfhi(x1.x) + a2 * bfhi(x2.x));
            o.y = pk2(a0 * bflo(x0.y) + a1 * bflo(x1.y) + a2 * bflo(x2.y), a0 * bfhi(x0.y) + a1 * bfhi(x1.y) + a2 * bfhi(x2.y));
            o.z = pk2(a0 * bflo(x0.z) + a1 * bflo(x1.z) + a2 * bflo(x2.z), a0 * bfhi(x0.z) + a1 * bfhi(x1.z) + a2 * bfhi(x2.z));
            o.w = pk2(a0 * bflo(x0.w) + a1 * bflo(x1.w) + a2 * bflo(x2.w), a0 * bfhi(x0.w) + a1 * bfhi(x1.w) + a2 * bfhi(x2.w));
            *(v4u*)(yo + 8 * c) = o; }
    }
    __syncthreads();
}

DI f32x4 ld4bf(const bf16* p) { const v2u u = *(const v2u*)p; return (f32x4){bflo(u.x), bfhi(u.x), bflo(u.y), bfhi(u.y)}; }
DI f32x4 shift4(const bf16* prow, bool hasp, bool hasn, const float* mup, const float* mun, int col) {
    const f32x4 u = ld4bf(prow + col);
    const float mp = hasp ? 1.f : 0.f, mn = hasn ? 1.f : 0.f;
    const f32x4 up = ld4bf(prow + (hasp ? -RW_COLS : 0) + col) * mp, un = ld4bf(prow + (hasn ? RW_COLS : 0) + col) * mn;
    return u + *(const f32x4*)(mup + col) * (up - u) + *(const f32x4*)(mun + col) * (un - u);
}
DI float red8(float v) {
    v += __builtin_bit_cast(float, __builtin_amdgcn_update_dpp(0, __builtin_bit_cast(int, v), 0xB1, 0xF, 0xF, true));
    v += __builtin_bit_cast(float, __builtin_amdgcn_update_dpp(0, __builtin_bit_cast(int, v), 0x4E, 0xF, 0xF, true));
    v += __builtin_bit_cast(float, __builtin_amdgcn_update_dpp(0, __builtin_bit_cast(int, v), 0x141, 0xF, 0xF, true));
    return v;
}
constexpr int SC_CH = 32, SC_NCH = SEQ / SC_CH;
#define SC_BUF(bi, arr) ((LAS float*)F.lds + ((bi) * 6 + (arr)) * 2048)
DI void scan_prep(Frame& F, const Args& a, int b, int h, int dir, int c, int bi) {
    const int q = F.wave - 4, jt = q & 1, kind = q >> 1, lane = F.lane, n = lane & 31, half = lane >> 5;
    const bf16* PR = (const bf16*)(F.ws + WS_PR);
    const float* mup = (const float*)a.in[I_MUP]; const float* mun = (const float*)a.in[I_MUN];
    const int tl = SC_CH * c + n, t = dir ? (SEQ - 1 - tl) : tl; const bool hasp = t > 0, hasn = t < SEQ - 1;
    const size_t tokrow = (size_t)b * SEQ + t;
    const bf16* pr = PR + tokrow * RW_COLS;
    const int xcol = kind ? 1600 : 1536;
    const bf16* WT = (const bf16*)(F.ws + (kind ? WS_AUP_T : WS_WUP_T)) + ((size_t)dir * 512 + h * 64 + 32 * jt + n) * 64 + 8 * half;
    f32x16 D;
#pragma unroll
    for (int i = 0; i < 16; ++i) D[i] = 0.f;
#pragma unroll
    for (int kk = 0; kk < 4; ++kk) {
        int ho8 = 8 * half; LAUNDER(ho8);
        const int col = xcol + 16 * kk + ho8;
        f32x4 x0 = shift4(pr, hasp, hasn, mup, mun, col), x1 = shift4(pr, hasp, hasn, mup, mun, col + 4);
        if (kind == 0) {
#pragma unroll
            for (int j = 0; j < 4; ++j) { x0[j] = 1.f - 2.f * __builtin_amdgcn_rcpf(1.f + __builtin_amdgcn_exp2f(2.88539008f * x0[j])); x1[j] = 1.f - 2.f * __builtin_amdgcn_rcpf(1.f + __builtin_amdgcn_exp2f(2.88539008f * x1[j])); } }
        const bf16x8 bfr = pack8(x0[0], x0[1], x0[2], x0[3], x1[0], x1[1], x1[2], x1[3]);
        D = MFMA32(*(const bf16x8*)(WT + 16 * kk), bfr, D);
        asm volatile("" ::: "memory");
    }
    const int hc = h * 64;
    if (kind == 0) {
        const float* w0 = (const float*)a.in[I_WD0] + dir * 512 + hc;
#pragma unroll
        for (int q4 = 0; q4 < 4; ++q4) { int ho4 = 32 * jt + 4 * half; LAUNDER(ho4); const int j = 8 * q4 + ho4;
            const f32x4 wz = *(const f32x4*)(w0 + j); f32x4 wv;
#pragma unroll
            for (int jj = 0; jj < 4; ++jj) { const float e = 0.6065306597126334f * sigmoidf_(D[4 * q4 + jj] + wz[jj]); wv[jj] = __builtin_amdgcn_exp2f(-1.44269504f * e); }
            *(LAS f32x4*)(SC_BUF(bi, 0) + n * 64 + j) = wv;
            *(LAS f32x4*)(SC_BUF(bi, 4) + n * 64 + j) = shift4(pr, hasp, hasn, mup, mun, hc + j);
            *(LAS f32x4*)(SC_BUF(bi, 5) + n * 64 + j) = shift4(pr, hasp, hasn, mup, mun, 1024 + hc + j); asm volatile("" ::: "memory"); }
    } else {
        const float* a0 = (const float*)a.in[I_AG0] + dir * 512 + hc; const float* kkw = (const float*)a.in[I_KK] + hc; const float* kaw = (const float*)a.in[I_KA] + hc; const float* rkw = (const float*)a.in[I_RK] + hc;
        f32x4 kown0, kown1, kown2, kown3; float ss = 0.f;
#define KP_LOAD(dst, q4) do { int ho4 = 4 * half; LAUNDER(ho4); const int j = 32 * jt + 8 * (q4) + ho4, jo = 32 * (1 - jt) + 8 * (q4) + ho4; \
            dst = shift4(pr, hasp, hasn, mup, mun, 512 + hc + j); const f32x4 kr = dst * *(const f32x4*)(kkw + j); ss += (kr[0] * kr[0] + kr[1] * kr[1]) + (kr[2] * kr[2] + kr[3] * kr[3]); \
            const f32x4 ko = shift4(pr, hasp, hasn, mup, mun, 512 + hc + jo) * *(const f32x4*)(kkw + jo); ss += (ko[0] * ko[0] + ko[1] * ko[1]) + (ko[2] * ko[2] + ko[3] * ko[3]); asm volatile("" ::: "memory"); } while (0)
        KP_LOAD(kown0, 0); KP_LOAD(kown1, 1); KP_LOAD(kown2, 2); KP_LOAD(kown3, 3);
#undef KP_LOAD
        ss += __shfl_xor(ss, 32);
        const float inv = 1.f / fmaxf(sqrtf(ss), 1e-12f);
        float bs = 0.f;
#pragma unroll
        for (int q4 = 0; q4 < 4; ++q4) { int ho4 = 32 * jt + 4 * half; LAUNDER(ho4); const int j = 8 * q4 + ho4;
            const f32x4 az = *(const f32x4*)(a0 + j), kkv = *(const f32x4*)(kkw + j), kav = *(const f32x4*)(kaw + j), rkv = *(const f32x4*)(rkw + j);
            const f32x4 kpr = q4 == 0 ? kown0 : (q4 == 1 ? kown1 : (q4 == 2 ? kown2 : kown3));
            const f32x4 rr = shift4(pr, hasp, hasn, mup, mun, hc + j);
            f32x4 av, kk4, kd4;
#pragma unroll
            for (int jj = 0; jj < 4; ++jj) { av[jj] = sigmoidf_(D[4 * q4 + jj] + az[jj]); kk4[jj] = kpr[jj] * kkv[jj] * inv; kd4[jj] = kpr[jj] * (1.f + (av[jj] - 1.f) * kav[jj]); bs += rr[jj] * kd4[jj] * rkv[jj]; }
            *(LAS f32x4*)(SC_BUF(bi, 1) + n * 64 + j) = kd4;
            *(LAS f32x4*)(SC_BUF(bi, 2) + n * 64 + j) = kk4 * av;
            *(LAS f32x4*)(SC_BUF(bi, 3) + n * 64 + j) = -kk4; asm volatile("" ::: "memory"); }
        bs += __shfl_xor(bs, 32);
        if (half == 0) ((float*)(F.ws + WS_BSUM))[(((size_t)dir * NTOK + tokrow) * 8 + h) * 2 + jt] = bs;
    }
}
DI void scan_unit(Frame& F, const Args& a, int b, int h, int dir) {
    const int lane = F.lane, rp = lane >> 3, cg = lane & 7, i0 = 16 * (F.wave & 3) + 2 * rp;
    float* wkv = (float*)(F.ws + WS_WKV) + ((size_t)dir * NTOK + (size_t)b * SEQ) * 512 + h * 64 + i0;
    f32x2 s0[4], s1[4];
#pragma unroll
    for (int q = 0; q < 4; ++q) { s0[q] = (f32x2){0.f, 0.f}; s1[q] = (f32x2){0.f, 0.f}; }
    if (F.wave >= 4) scan_prep(F, a, b, h, dir, 0, 0);
    __syncthreads();
    for (int c = 0; c < SC_NCH; ++c) {
        const int bi = c & 1;
        if (F.wave >= 4) { if (c + 1 < SC_NCH) scan_prep(F, a, b, h, dir, c + 1, bi ^ 1); }
        else {
            const LAS float* Wb = SC_BUF(bi, 0) + 8 * cg; const LAS float* KDb = SC_BUF(bi, 1) + 8 * cg; const LAS float* BBb = SC_BUF(bi, 2) + 8 * cg;
            const LAS float* AAb = SC_BUF(bi, 3) + 8 * cg; const LAS float* Rb = SC_BUF(bi, 4) + 8 * cg; const LAS float* Vb = SC_BUF(bi, 5) + i0;
#pragma unroll 2
            for (int tau = 0; tau < SC_CH; ++tau) {
                const int o = tau * 64;
                const f32x4 wA = *(const LAS f32x4*)(Wb + o), wB = *(const LAS f32x4*)(Wb + o + 4);
                const f32x4 kA = *(const LAS f32x4*)(KDb + o), kB = *(const LAS f32x4*)(KDb + o + 4);
                const f32x4 bA = *(const LAS f32x4*)(BBb + o), bB = *(const LAS f32x4*)(BBb + o + 4);
                const f32x4 aA = *(const LAS f32x4*)(AAb + o), aB = *(const LAS f32x4*)(AAb + o + 4);
                const f32x4 rA = *(const LAS f32x4*)(Rb + o), rB = *(const LAS f32x4*)(Rb + o + 4);
                const f32x2 vv = *(const LAS f32x2*)(Vb + o);
                const f32x2 w2[4] = {{wA[0], wA[1]}, {wA[2], wA[3]}, {wB[0], wB[1]}, {wB[2], wB[3]}};
                const f32x2 k2[4] = {{kA[0], kA[1]}, {kA[2], kA[3]}, {kB[0], kB[1]}, {kB[2], kB[3]}};
                const f32x2 b2[4] = {{bA[0], bA[1]}, {bA[2], bA[3]}, {bB[0], bB[1]}, {bB[2], bB[3]}};
                const f32x2 a2[4] = {{aA[0], aA[1]}, {aA[2], aA[3]}, {aB[0], aB[1]}, {aB[2], aB[3]}};
                const f32x2 r2[4] = {{rA[0], rA[1]}, {rA[2], rA[3]}, {rB[0], rB[1]}, {rB[2], rB[3]}};
                f32x2 p0 = s0[0] * a2[0], p1 = s1[0] * a2[0];
#pragma unroll
                for (int q = 1; q < 4; ++q) { p0 += s0[q] * a2[q]; p1 += s1[q] * a2[q]; }
                const float sa0 = red8(p0.x + p0.y), sa1 = red8(p1.x + p1.y);
                const f32x2 sa0v = {sa0, sa0}, sa1v = {sa1, sa1}, v0v = {vv.x, vv.x}, v1v = {vv.y, vv.y};
#pragma unroll
                for (int q = 0; q < 4; ++q) { s0[q] = s0[q] * w2[q] + sa0v * b2[q] + v0v * k2[q]; s1[q] = s1[q] * w2[q] + sa1v * b2[q] + v1v * k2[q]; }
                f32x2 y0 = s0[0] * r2[0], y1 = s1[0] * r2[0];
#pragma unroll
                for (int q = 1; q < 4; ++q) { y0 += s0[q] * r2[q]; y1 += s1[q] * r2[q]; }
                const float yy0 = red8(y0.x + y0.y), yy1 = red8(y1.x + y1.y);
                if (cg == 0) { const int tl = SC_CH * c + tau, t = dir ? (SEQ - 1 - tl) : tl; *(f32x2*)(wkv + (size_t)t * 512) = (f32x2){yy0, yy1}; }
            }
        }
        __syncthreads();
    }
}

DI void post_tile(Frame& F, const Args& a, int tile) {
    const int lane = F.lane, n = lane & 31, half = lane >> 5;
    const bf16* PR = (const bf16*)(F.ws + WS_PR); const bf16* GT = (const bf16*)(F.ws + WS_GUP_T);
    const float* WKV = (const float*)(F.ws + WS_WKV); const float* BS = (const float*)(F.ws + WS_BSUM); bf16* YR = (bf16*)(F.ws + WS_YR);
    const float* mup = (const float*)a.in[I_MUP]; const float* mun = (const float*)a.in[I_MUN];
    const float* gnw = (const float*)a.in[I_GNW]; const float* gnb = (const float*)a.in[I_GNB];
    const size_t tok = (size_t)tile * 32 + n; const int t = (int)(tok % SEQ); const bool hasp = t > 0, hasn = t < SEQ - 1;
    const bf16* pr = PR + tok * RW_COLS;
    bf16x8 bfr[8];
#pragma unroll
    for (int kk = 0; kk < 8; ++kk) { int ho8 = 8 * half; LAUNDER(ho8); const int col = 1664 + 16 * kk + ho8;
        f32x4 x0 = shift4(pr, hasp, hasn, mup, mun, col), x1 = shift4(pr, hasp, hasn, mup, mun, col + 4);
        bfr[kk] = pack8(sigmoidf_(x0[0]), sigmoidf_(x0[1]), sigmoidf_(x0[2]), sigmoidf_(x0[3]), sigmoidf_(x1[0]), sigmoidf_(x1[1]), sigmoidf_(x1[2]), sigmoidf_(x1[3])); asm volatile("" ::: "memory"); }
#pragma unroll 1
    for (int h = 0; h < 8; ++h) {
        const int hc = h * 64;
        f32x16 g0, g1;
#pragma unroll
        for (int i = 0; i < 16; ++i) { g0[i] = 0.f; g1[i] = 0.f; }
        const bf16* gp = GT + (size_t)(hc + n) * 128 + 8 * half;
#pragma unroll
        for (int kk = 0; kk < 8; ++kk) { g0 = MFMA32(*(const bf16x8*)(gp + 16 * kk), bfr[kk], g0); g1 = MFMA32(*(const bf16x8*)(gp + 32 * 128 + 16 * kk), bfr[kk], g1); }
        f32x4 x[2][4]; float s = 0.f;
#pragma unroll
        for (int ct = 0; ct < 2; ++ct)
#pragma unroll
            for (int q4 = 0; q4 < 4; ++q4) { int ho4 = hc + 4 * half; LAUNDER(ho4); const int c = 32 * ct + 8 * q4 + ho4;
                x[ct][q4] = *(const f32x4*)(WKV + tok * 512 + c) + *(const f32x4*)(WKV + ((size_t)NTOK + tok) * 512 + c);
                s += (x[ct][q4][0] + x[ct][q4][1]) + (x[ct][q4][2] + x[ct][q4][3]); }
        s += __shfl_xor(s, 32);
        const float mean = s * (1.f / 64.f); float vs = 0.f;
#pragma unroll
        for (int ct = 0; ct < 2; ++ct)
#pragma unroll
            for (int q4 = 0; q4 < 4; ++q4) { const f32x4 d = x[ct][q4] - mean; vs += (d[0] * d[0] + d[1] * d[1]) + (d[2] * d[2] + d[3] * d[3]); }
        vs += __shfl_xor(vs, 32);
        const float rstd = 1.f / sqrtf(vs * (1.f / 64.f) + GN_EPS);
        const f32x2 b0 = *(const f32x2*)(BS + (tok * 8 + h) * 2), b1 = *(const f32x2*)(BS + (((size_t)NTOK + tok) * 8 + h) * 2);
        const float bsum = (b0.x + b0.y) + (b1.x + b1.y);
#pragma unroll
        for (int ct = 0; ct < 2; ++ct)
#pragma unroll
            for (int q4 = 0; q4 < 4; ++q4) { int ho4 = hc + 4 * half; LAUNDER(ho4); const int c = 32 * ct + 8 * q4 + ho4;
                const f32x4 vsh = shift4(pr, hasp, hasn, mup, mun, 1024 + c);
                const f32x4 y = (x[ct][q4] - mean) * rstd * *(const f32x4*)(gnw + c) + *(const f32x4*)(gnb + c) + vsh * bsum;
                f32x4 gg; if (ct == 0) gg = (f32x4){g0[4 * q4], g0[4 * q4 + 1], g0[4 * q4 + 2], g0[4 * q4 + 3]}; else gg = (f32x4){g1[4 * q4], g1[4 * q4 + 1], g1[4 * q4 + 2], g1[4 * q4 + 3]};
                const f32x4 o = y * gg; v2u w; w.x = pk2(o[0], o[1]); w.y = pk2(o[2], o[3]);
                *(v2u*)(YR + tok * 512 + c) = w; asm volatile("" ::: "memory"); }
    }
}


DI void p5_router_tile(Frame& F, const Args& a, int tile) {
    const int lane = F.lane, n = lane & 31, half = lane >> 5;
    const size_t tok = (size_t)tile * 32 + n;
    const float* xr = a.out + tok * DM + 8 * half;
    const bf16* RH = (const bf16*)(F.ws + WS_RT_HI) + (size_t)n * DM + 8 * half; const bf16* RL = (const bf16*)(F.ws + WS_RT_LO) + (size_t)n * DM + 8 * half;
    f32x16 d0, d1;
#pragma unroll
    for (int i = 0; i < 16; ++i) { d0[i] = 0.f; d1[i] = 0.f; }
    float ss = 0.f;
#pragma unroll 2
    for (int kk = 0; kk < 64; ++kk) {
        const f32x4 xa = *(const f32x4*)(xr + 16 * kk), xb = *(const f32x4*)(xr + 16 * kk + 4);
        ss += (xa[0] * xa[0] + xa[1] * xa[1]) + (xa[2] * xa[2] + xa[3] * xa[3]) + (xb[0] * xb[0] + xb[1] * xb[1]) + (xb[2] * xb[2] + xb[3] * xb[3]);
        v4u hp; hp.x = pk2(xa[0], xa[1]); hp.y = pk2(xa[2], xa[3]); hp.z = pk2(xb[0], xb[1]); hp.w = pk2(xb[2], xb[3]);
        v4u lp; lp.x = pk2(xa[0] - bflo(hp.x), xa[1] - bfhi(hp.x)); lp.y = pk2(xa[2] - bflo(hp.y), xa[3] - bfhi(hp.y)); lp.z = pk2(xb[0] - bflo(hp.z), xb[1] - bfhi(hp.z)); lp.w = pk2(xb[2] - bflo(hp.w), xb[3] - bfhi(hp.w));
        const bf16x8 bh = __builtin_bit_cast(bf16x8, hp), bl = __builtin_bit_cast(bf16x8, lp);
        const bf16x8 ah0 = *(const bf16x8*)(RH + 16 * kk), ah1 = *(const bf16x8*)(RH + 32 * DM + 16 * kk), al0 = *(const bf16x8*)(RL + 16 * kk), al1 = *(const bf16x8*)(RL + 32 * DM + 16 * kk);
        d0 = MFMA32(ah0, bh, d0); d0 = MFMA32(ah0, bl, d0); d0 = MFMA32(al0, bh, d0);
        d1 = MFMA32(ah1, bh, d1); d1 = MFMA32(ah1, bl, d1); d1 = MFMA32(al1, bh, d1);
    }
    ss += __shfl_xor(ss, 32);
    const float rstd = 1.f / sqrtf(ss * (1.f / DM) + NORM_EPS);
    const float* brg = (const float*)a.in[I_BRG]; const float* bre = (const float*)a.in[I_BRE];
    float gl[4];
#pragma unroll
    for (int j = 0; j < 4; ++j) gl[j] = __shfl(d1[j] * rstd + brg[j], n);
    int grp = 0; float gmax = gl[0];
#pragma unroll
    for (int j = 1; j < 4; ++j) if (gl[j] > gmax) { gmax = gl[j]; grp = j; }
    float gsum = 0.f;
#pragma unroll
    for (int j = 0; j < 4; ++j) gsum += __expf(gl[j] - gmax);
    const float grp_p = 1.f / gsum;
    const f32x4 bv = *(const f32x4*)(bre + 8 * grp + 4 * half);
    float cv[4];
#pragma unroll
    for (int j = 0; j < 4; ++j) { float v = d0[j]; v = grp == 1 ? d0[4 + j] : v; v = grp == 2 ? d0[8 + j] : v; v = grp == 3 ? d0[12 + j] : v; cv[j] = v * rstd + bv[j]; }
    float m1v = cv[0]; int m1i = 0;
#pragma unroll
    for (int j = 1; j < 4; ++j) if (cv[j] > m1v) { m1v = cv[j]; m1i = j; }
    float m2v = -3.0e38f; int m2i = 0;
#pragma unroll
    for (int j = 0; j < 4; ++j) if (j != m1i && cv[j] > m2v) { m2v = cv[j]; m2i = j; }
    m1i += 4 * half; m2i += 4 * half;
    const float t1v = __shfl_xor(m1v, 32), t2v = __shfl_xor(m2v, 32); const int t1i = __shfl_xor(m1i, 32), t2i = __shfl_xor(m2i, 32);
    auto better = [](float av, int ai, float bv_, int bi) { return av > bv_ || (av == bv_ && ai < bi); };
    float top1v, top2v; int top1i, top2i;
    if (better(m1v, m1i, t1v, t1i)) { top1v = m1v; top1i = m1i; if (better(m2v, m2i, t1v, t1i)) { top2v = m2v; top2i = m2i; } else { top2v = t1v; top2i = t1i; } }
    else { top1v = t1v; top1i = t1i; if (better(m1v, m1i, t2v, t2i)) { top2v = m1v; top2i = m1i; } else { top2v = t2v; top2i = t2i; } }
    const float w0 = grp_p / (1.f + __expf(top2v - top1v)), w1 = grp_p - w0;
    const int mye = 8 * grp + (half ? top2i : top1i); const float myw = half ? w1 : w0;
    unsigned long long mymask = 0ull; int cnt_l = 0;
    for (int e = 0; e < NEXP; ++e) { const unsigned long long m = __ballot(mye == e); if (mye == e) mymask = m; if (lane == e) cnt_l = __popcll(m); }
    int base_l = 0;
    if (lane < NEXP && cnt_l > 0) base_l = (int)__hip_atomic_fetch_add((unsigned*)(F.ws + WS_CTL) + CW_CNT + 64 * lane, (unsigned)cnt_l, RLX_AGENT);
    const int mybase = __shfl(base_l, mye);
    const int pos = mybase + __popcll(mymask & ((1ull << lane) - 1ull));
    ((int*)(F.ws + WS_LTOK))[(size_t)mye * NTOK + pos] = (int)tok;
    ((float*)(F.ws + WS_LW))[(size_t)mye * NTOK + pos] = myw;
    const float* g2 = (const float*)a.in[I_N2G] + 8 * half; bf16* h2 = (bf16*)(F.ws + WS_H2) + tok * DM + 8 * half;
#pragma unroll 4
    for (int kk = 0; kk < 64; ++kk) {
        const f32x4 xa = *(const f32x4*)(xr + 16 * kk) * rstd * *(const f32x4*)(g2 + 16 * kk), xb = *(const f32x4*)(xr + 16 * kk + 4) * rstd * *(const f32x4*)(g2 + 16 * kk + 4);
        v4u o; o.x = pk2(xa[0], xa[1]); o.y = pk2(xa[2], xa[3]); o.z = pk2(xb[0], xb[1]); o.w = pk2(xb[2], xb[3]);
        *(v4u*)(h2 + 16 * kk) = o; }
}
DI void p5_phase(Frame& F, const Args& a) {
    const int gw = F.bid * NWAVES + F.wave, NGW = F.G * NWAVES;
    for (int tile = gw; tile < NTOK / 32; tile += NGW) p5_router_tile(F, a, tile);
    if (F.bid == 0 && F.tid < 128) ((v4u*)((bf16*)(F.ws + WS_H2) + (size_t)NTOK * DM))[F.tid] = (v4u){0u, 0u, 0u, 0u};
    LAS float* scr = (LAS float*)(F.lds + F.wave * 16384);
    constexpr int IPE = 256;
    for (int it = gw; it < NEXP * 3 * IPE; it += NGW) {
        const int e = it / (3 * IPE), r = it % (3 * IPE), which = r / IPE, item = r % IPE;
        if (which == 0) transpose_item((const float*)a.in[I_WGATE] + (size_t)e * DM * DEXP, DM, DEXP, (bf16*)(F.ws + WS_WGU_T) + (size_t)e * DM * DM, RmGate(), scr, item, F.lane);
        else if (which == 1) transpose_item((const float*)a.in[I_WUP] + (size_t)e * DM * DEXP, DM, DEXP, (bf16*)(F.ws + WS_WGU_T) + (size_t)e * DM * DM, RmUp(), scr, item, F.lane);
        else transpose_item((const float*)a.in[I_WDOWN] + (size_t)e * DEXP * DM, DEXP, DM, (bf16*)(F.ws + WS_WD_T) + (size_t)e * DM * DEXP, RmId(), scr, item, F.lane);
    }
}
DI int moe_table(Frame& F) {
    LAS int* tab = (LAS int*)(F.lds + TAB_OFF);
    if (F.tid == 0) { int acc = 0;
        for (int e = 0; e < NEXP; ++e) { const int c = (int)__hip_atomic_load((unsigned*)(F.ws + WS_CTL) + CW_CNT + 64 * e, RLX_AGENT); tab[e] = acc; tab[33 + e] = c; acc += (c + 255) >> 8; }
        tab[32] = acc; }
    __syncthreads();
    return tab[32];
}
DI void p6_gather(Frame& F) {
    const int nT = moe_table(F);
    const LAS int* tab = (const LAS int*)(F.lds + TAB_OFF);
    const bf16* h2 = (const bf16*)(F.ws + WS_H2); bf16* Xg = (bf16*)(F.ws + WS_XG);
    const int* ltok = (const int*)(F.ws + WS_LTOK); const float* lw = (const float*)(F.ws + WS_LW);
    for (int R = F.bid * NWAVES + F.wave; R < nT * 256; R += F.G * NWAVES) {
        const int tile = R >> 8; int e = 0;
        for (int k = 1; k < NEXP; ++k) e += (tab[k] <= tile) ? 1 : 0;
        const int slot = R - tab[e] * 256; int tok = -1; float w = 0.f;
        if (slot < tab[33 + e]) { tok = ltok[(size_t)e * NTOK + slot]; w = lw[(size_t)e * NTOK + slot]; }
        const v4u* src = (const v4u*)(h2 + (size_t)(tok < 0 ? NTOK : tok) * DM); v4u* dst = (v4u*)(Xg + (size_t)R * DM);
        dst[F.lane] = src[F.lane]; dst[F.lane + 64] = src[F.lane + 64];
        if (F.lane == 0) { ((int*)(F.ws + WS_ROWTOK))[R] = tok; ((float*)(F.ws + WS_ROWW))[R] = w; }
    }
}

__global__ void __launch_bounds__(NWAVES * 64, 2) mk_fwd(Args args) {
    extern __shared__ __attribute__((aligned(16))) unsigned char lds[];
    Frame F;
    F.lds = (LAS unsigned char*)lds; F.MISC = (volatile LAS unsigned*)(F.lds + MISC_OFF);
    F.tid = threadIdx.x; F.lane = F.tid & 63; F.wave = __builtin_amdgcn_readfirstlane(F.tid >> 6); F.G = gridDim.x; F.bid = blockIdx.x; F.ws = args.ws;
    for (int u = F.tid; u < (LDS_BYTES - RING_BYTES) / 4; u += NWAVES * 64) ((LAS unsigned*)(F.lds + RING_BYTES))[u] = 0u;
    __syncthreads();
    const int lo = args.ph_lo, hi = args.ph_hi;
    const bool multi = (hi - lo) > 1;
    XcdBarrier bar; bar.bar = (unsigned*)(args.ws + WS_CTL) + CW_BAR; bar.x = 0; bar.st = nullptr;
    if (multi) bar = xcd_barrier_post((unsigned*)(args.ws + WS_CTL) + CW_BAR, F.MISC + 8);
#ifndef PH_MASK
#define PH_MASK 0xFFFFFFFFu
#endif
#define IN(k) ((((PH_MASK) >> (k)) & 1u) && lo <= (k) && (k) < hi)
#define SEAM(k) do { if (IN(k) && IN((k) + 1)) xcd_barrier(bar); } while (0)
    unsigned char* ws = args.ws;

    if (IN(0)) { p0_prologue(F, args); } SEAM(0);
    if (IN(1)) {
        pg8::Gemm g{(const bf16*)(ws + WS_HB), (const bf16*)(ws + WS_WIN_T), DM, 0}; pg8::StaticOrder S; S.init(NTOK, IN_COLS, F.G, F.bid);
        pg8::EpiIn E{(bf16*)(ws + WS_PR), (bf16*)(ws + WS_PT), (bf16*)(ws + WS_G), (const float*)args.in[I_BMERGE]};
        pg8::gemm_phase<pg8::EpiIn, pg8::StaticOrder, true, true>(F.lds, g, S, E);
    } SEAM(1);
    if (IN(2)) { p1b_qkprep(F, args); } SEAM(2);
    if (IN(3)) { for (int u = F.bid; u < 256; u += F.G) attn_unit(F, u >> 4, (u >> 2) & 3, u & 3); } SEAM(3);
    if (IN(4)) { for (int u = F.bid; u < 256; u += F.G) scan_unit(F, args, u >> 4, (u >> 1) & 7, u & 1); } SEAM(4);
    if (IN(5)) { for (int tile = F.bid * NWAVES + F.wave; tile < NTOK / 32; tile += F.G * NWAVES) post_tile(F, args, tile); } SEAM(5);
    if (IN(6)) {
        pg8::Gemm g{(const bf16*)(ws + WS_YR), (const bf16*)(ws + WS_WR_T), 512, 0}; pg8::StaticOrder S; S.init(NTOK, DM, F.G, F.bid);
        pg8::EpiMix<0> E{(const bf16*)(ws + WS_G), nullptr, (bf16*)(ws + WS_Z1)};
        pg8::gemm_phase<pg8::EpiMix<0>, pg8::StaticOrder, true, true>(F.lds, g, S, E);
    } SEAM(6);
    if (IN(7)) {
        pg8::Gemm g{(const bf16*)(ws + WS_YA), (const bf16*)(ws + WS_WA_T), 256, 0}; pg8::StaticOrder S; S.init(NTOK, DM, F.G, F.bid);
        pg8::EpiMix<1> E{(const bf16*)(ws + WS_G), (const bf16*)(ws + WS_Z1), (bf16*)(ws + WS_Z)};
        pg8::gemm_phase<pg8::EpiMix<1>, pg8::StaticOrder, true, true>(F.lds, g, S, E);
    } SEAM(7);
    if (IN(8)) {
        pg8::Gemm g{(const bf16*)(ws + WS_Z), (const bf16*)(ws + WS_WOUT_T), DM, 0}; pg8::StaticOrder S; S.init(NTOK, DM, F.G, F.bid);
        pg8::EpiRes E{(const float*)args.in[I_X], args.out};
        pg8::gemm_phase<pg8::EpiRes, pg8::StaticOrder, true, true>(F.lds, g, S, E);
    } SEAM(8);
    if (IN(9)) { p5_phase(F, args); } SEAM(9);
    if (IN(10)) { p6_gather(F); } SEAM(10);
    if (IN(11)) {
        const int nT = moe_table(F);
        pg8::Gemm g{(const bf16*)(ws + WS_XG), (const bf16*)(ws + WS_WGU_T), DM, (size_t)DM * DM * 2}; pg8::GroupedOrder S{(const LAS int*)(F.lds + TAB_OFF), nT, F.G, F.bid};
        pg8::EpiSwiglu E{(bf16*)(ws + WS_HH)};
        pg8::gemm_phase<pg8::EpiSwiglu, pg8::GroupedOrder, true, true>(F.lds, g, S, E);
    } SEAM(11);
    if (IN(12)) {
        const int nT = moe_table(F);
        pg8::Gemm g{(const bf16*)(ws + WS_HH), (const bf16*)(ws + WS_WD_T), DEXP, (size_t)DM * DEXP * 2}; pg8::GroupedOrder S{(const LAS int*)(F.lds + TAB_OFF), nT, F.G, F.bid};
        pg8::EpiScatter E{(const int*)(ws + WS_ROWTOK), (const float*)(ws + WS_ROWW), args.out};
        pg8::gemm_phase<pg8::EpiScatter, pg8::GroupedOrder, true, true>(F.lds, g, S, E);
    }
#undef IN
#undef SEAM
}

constexpr int NPHASE = 13;
extern "C" void kernel_launch(void* const* d_in, const int* in_sizes, int n_in, void* d_out, int out_size, void* d_ws, size_t ws_size, hipStream_t stream) {
    static int grid = 0;
    if (grid == 0) {
        if (n_in != 30 || ws_size < WS_END) { fprintf(stderr, "kernel_launch: need 30 inputs and >= %zu bytes of workspace (got %d, %zu)\n", (size_t)WS_END, n_in, ws_size); grid = -1; return; }
        int dev = 0, cus = 0;
        if (hipGetDevice(&dev) != hipSuccess || hipDeviceGetAttribute(&cus, hipDeviceAttributeMultiprocessorCount, dev) != hipSuccess) { grid = -1; return; }
        if (hipFuncSetAttribute((const void*)mk_fwd, hipFuncAttributeMaxDynamicSharedMemorySize, LDS_BYTES) != hipSuccess) { fprintf(stderr, "kernel_launch: hipFuncSetAttribute failed\n"); grid = -1; return; }
        int per_cu = 0;
        if (hipOccupancyMaxActiveBlocksPerMultiprocessor(&per_cu, (const void*)mk_fwd, NWAVES * 64, LDS_BYTES) != hipSuccess || per_cu < 1) fprintf(stderr, "kernel_launch: occupancy query reports %d\n", per_cu);
        (void)hipGetLastError();
        grid = cus;
    }
    if (grid < 0) return;
    hipMemsetAsync((char*)d_ws + WS_CTL, 0, CTL_ZERO_BYTES, stream);
    Args a{};
    for (int i = 0; i < 30; ++i) a.in[i] = d_in[i];
    a.out = (float*)d_out; a.ws = (unsigned char*)d_ws;
#ifndef MK_MULTI_LAUNCH
    a.ph_lo = 0; a.ph_hi = NPHASE;
    hipLaunchKernelGGL(mk_fwd, dim3(grid), dim3(NWAVES * 64), LDS_BYTES, stream, a);
#else
    for (int p = 0; p < NPHASE; ++p) { a.ph_lo = p; a.ph_hi = p + 1; hipLaunchKernelGGL(mk_fwd, dim3(grid), dim3(NWAVES * 64), LDS_BYTES, stream, a); }
#endif
}
```

```cpp
#include <hip/hip_runtime.h>
#include <cstdio>
#include <cstdint>

constexpr int BATCH = 16, SEQ = 2048, DM = 1024, NTOK = BATCH * SEQ;
constexpr int RW_COLS = 1792, AT_COLS = 2304, G_COLS = 2048, IN_COLS = 6144;
constexpr int NEXP = 32, DEXP = 512;
constexpr int MAXTILES = 288;
constexpr float NORM_EPS = 1e-6f, GN_EPS = 64e-5f;

#define GAS __attribute__((address_space(1)))
#define LAS __attribute__((address_space(3)))
typedef unsigned short bf16;
typedef unsigned v4u __attribute__((ext_vector_type(4)));
typedef unsigned v2u __attribute__((ext_vector_type(2)));
typedef float f32x4 __attribute__((ext_vector_type(4)));
typedef float f32x2 __attribute__((ext_vector_type(2)));
typedef float f32x16 __attribute__((ext_vector_type(16)));
typedef short bf16x8 __attribute__((ext_vector_type(8)));
typedef __bf16 bf16x2_t __attribute__((ext_vector_type(2)));
typedef GAS unsigned gu32;
#define RLX_AGENT __ATOMIC_RELAXED, __HIP_MEMORY_SCOPE_AGENT
#define LDS_WAIT() asm volatile("s_waitcnt lgkmcnt(0)" ::: "memory")
#define VM_WAIT() asm volatile("s_waitcnt vmcnt(0)" ::: "memory")
#define DI __device__ __forceinline__
#ifdef PROBE_VARIANT
#define VAR(b) (F.variant & (b))
#else
#define VAR(b) 0
#endif
#define LAUNDER(x) asm volatile("" : "+v"(x))

DI unsigned pk2(float lo, float hi) { f32x2 v = {lo, hi}; bf16x2_t b = __builtin_convertvector(v, bf16x2_t); return __builtin_bit_cast(unsigned, b); }
DI float bflo(unsigned u) { return __builtin_bit_cast(float, u << 16); }
DI float bfhi(unsigned u) { return __builtin_bit_cast(float, u & 0xffff0000u); }
DI float sigmoidf_(float x) { return __builtin_amdgcn_rcpf(1.f + __builtin_amdgcn_exp2f(-1.44269504f * x)); }
DI float wave_sum(float v) {
#pragma unroll
    for (int o = 1; o < 64; o <<= 1) v += __shfl_xor(v, o);
    return v;
}
DI int crow(int reg, int h) { return (reg & 3) + 8 * (reg >> 2) + 4 * h; }
#define MFMA32(a, b, c) __builtin_amdgcn_mfma_f32_32x32x16_bf16((a), (b), (c), 0, 0, 0)

constexpr size_t MiB = 1u << 20;
constexpr size_t WS_CTL = 0, CTL_ZERO_BYTES = 1 * MiB;
constexpr size_t WS_WIN_T = 1 * MiB;
constexpr size_t WS_WR_T = 13 * MiB;
constexpr size_t WS_WA_T = 14 * MiB;
constexpr size_t WS_WOUT_T = 15 * MiB;
constexpr size_t WS_GUP_T = 17 * MiB;
constexpr size_t WS_RT_HI = 17 * MiB + 256 * 1024;
constexpr size_t WS_RT_LO = 17 * MiB + 384 * 1024;
constexpr size_t WS_WUP_T = 17 * MiB + 512 * 1024;
constexpr size_t WS_AUP_T = 17 * MiB + 640 * 1024;
constexpr size_t RG_A = 18 * MiB, RG_B = 82 * MiB, RG_C = 194 * MiB, RG_D = 338 * MiB, RG_E = 466 * MiB, WS_END = 512 * MiB;
constexpr size_t WS_HB = RG_A;
constexpr size_t WS_PR = RG_B;
constexpr size_t WS_PT = RG_C;
constexpr size_t WS_G = RG_D;
constexpr size_t WS_OG = RG_A;
constexpr size_t WS_LSE = RG_A + 48 * MiB;
constexpr size_t WS_YA = RG_E;
constexpr size_t WS_BSUM = RG_E + 16 * MiB;
constexpr size_t WS_WKV = RG_C;
constexpr size_t WS_YR = RG_A;
constexpr size_t WS_Z1 = RG_C;
constexpr size_t WS_Z = RG_C + 64 * MiB;
constexpr size_t WS_H2 = RG_B;
constexpr size_t WS_LTOK = RG_E + 20 * MiB;
constexpr size_t WS_LW = RG_E + 24 * MiB;
constexpr size_t WS_ROWTOK = RG_E + 28 * MiB;
constexpr size_t WS_ROWW = RG_E + 29 * MiB;
constexpr size_t WS_WGU_T = RG_D;
constexpr size_t WS_WD_T = RG_D + 64 * MiB;
constexpr size_t WS_XG = RG_C;
constexpr size_t WS_HH = RG_B;
constexpr size_t WS_YB = RG_C;
constexpr size_t WS_INV = RG_E + 30 * MiB;
constexpr int CW_BAR = 4096;
constexpr int CW_CNT = 32768;

constexpr int RING_BYTES = 155648;
constexpr int MISC_OFF = RING_BYTES + 320;
constexpr int TAB_OFF = RING_BYTES + 1024;
constexpr int LDS_BYTES = 163840;
constexpr int NWAVES = 8;

namespace pg8 {
constexpr int BM = 256, BK = 64, HALF = 128, HTB = HALF * BK * 2, STAGE_BYTES = 8 * HTB, NXCD = 8, WGM = 8;
__host__ __device__ __forceinline__ int lds_byte(int r, int c) { const int st = (r >> 4) * 2 + (c >> 5), rr = r & 15, cc = c & 31, ob = rr * 64 + cc * 2; return st * 1024 + (ob ^ (((ob >> 9) & 1) << 5)); }
__host__ __device__ __forceinline__ void stage_rc(int b, int& R, int& C) { const int st = b / 1024, sb = b % 1024, swz = sb ^ (((sb >> 9) & 1) << 5); R = (st >> 1) * 16 + swz / 64; C = (st & 1) * 32 + (swz % 64) / 2; }
__host__ __device__ __forceinline__ int perm32(int rho) { const int n = rho >> 4, i = rho & 15; return 8 * (i >> 2) + 4 * n + (i & 3); }

struct Unit { int pm, pn, e; };
struct Gemm { const bf16* A; const bf16* Bt; int K; size_t bgroup; };

struct StaticOrder {
    int nM, nN, nwg, G, c;
    __device__ void init(int M, int N, int G_, int c_) { nM = M / BM; nN = N / BM; nwg = nM * nN; G = G_; c = c_; }
    __device__ bool next(int i, Unit& u) const {
        const long L = (long)i * G + c; if (L >= nwg) return false;
        int wgid = (int)L; { const int q = nwg / NXCD, r = nwg % NXCD, xcd = wgid % NXCD, off = wgid / NXCD; wgid = (xcd < r ? xcd * (q + 1) : r * (q + 1) + (xcd - r) * q) + off; }
        const int nig = WGM * nN, gid = wgid / nig, fm = gid * WGM, gsz = (nM - fm) < WGM ? (nM - fm) : WGM;
        u.pm = fm + ((wgid % nig) % gsz); u.pn = (wgid % nig) / gsz; u.e = 0; return true;
    }
};
struct GroupedOrder {
    const LAS int* tstart; int nT, G, c;
    __device__ bool next(int i, Unit& u) const {
        const int L = i * G + c; if (L >= nT * 4) return false;
        u.pm = L >> 2; u.pn = L & 3; int e = 0;
        for (int k = 1; k < NEXP; ++k) e += (tstart[k] <= u.pm) ? 1 : 0;
        u.e = e; return true;
    }
};

template <class Epi, class Sched, bool ALIGN_EPI = false, bool SP2 = false>
__device__ __forceinline__ void gemm_phase(LAS unsigned char* lds, const Gemm g, const Sched& S, const Epi& E) {
    const int tid = threadIdx.x, wid = __builtin_amdgcn_readfirstlane(tid >> 6), lane = tid & 63, wr = wid >> 2, wc = wid & 3, fr = lane & 15, fq = lane >> 4;
    const int K = g.K, nt = K / BK;
    unsigned voffA[2], voffB[2];
#pragma unroll
    for (int i = 0; i < 2; ++i) { int R, C; stage_rc(tid * 16 + i * 8192, R, C); const int Rb = Epi::PERM ? ((R & ~31) + perm32(R & 31)) : R;
        voffA[i] = (unsigned)(R * K + C) * 2u; voffB[i] = (unsigned)(Rb * K + C) * 2u; }
    const size_t kstep = (size_t)(BK * 2);
    const size_t hstep = (size_t)HALF * K * 2;
    const size_t tstep = 2 * hstep;
    const unsigned ldsw = (unsigned)wid * 1024u;
    const int aoff = lds_byte(wr * 64 + fr, fq * 8), boff = lds_byte(wc * 32 + fr, fq * 8);
#define PG8_SA(b, h) (((b) * 2 + (h)) * HTB)
#define PG8_SB(b, h) ((4 + (b) * 2 + (h)) * HTB)
#define PG8_STAGE(bufoff, gbase, voff) do { _Pragma("unroll") for (int _i = 0; _i < 2; ++_i) \
        __builtin_amdgcn_global_load_lds((const unsigned*)((const char*)(gbase) + (voff)[_i]), (LAS unsigned*)(lds + (bufoff) + ldsw + _i * 8192), 16, 0, 0); } while (0)
#define PG8_LDA(dst, b, h) do { _Pragma("unroll") for (int m = 0; m < 4; ++m) _Pragma("unroll") for (int k = 0; k < 2; ++k) dst[m][k] = *(const LAS bf16x8*)(lds + PG8_SA(b, h) + aoff + m * 2048 + k * 1024); } while (0)
#define PG8_LDB(dst, b, h) do { _Pragma("unroll") for (int n = 0; n < 2; ++n) _Pragma("unroll") for (int k = 0; k < 2; ++k) dst[n][k] = *(const LAS bf16x8*)(lds + PG8_SB(b, h) + boff + n * 2048 + k * 1024); } while (0)
#define PG8_MMA(ai, bj, At, Bt) do { __builtin_amdgcn_s_setprio(1); _Pragma("unroll") for (int m = 0; m < 4; ++m) _Pragma("unroll") for (int n = 0; n < 2; ++n) _Pragma("unroll") for (int k = 0; k < 2; ++k) \
        acc[ai][bj][m][n] = __builtin_amdgcn_mfma_f32_16x16x32_bf16(Bt[n][k], At[m][k], acc[ai][bj][m][n], 0, 0, 0); __builtin_amdgcn_s_setprio(0); } while (0)
#define PG8_WAIT_V(n) asm volatile("s_waitcnt vmcnt(" #n ")" ::: "memory")
#define PG8_WAIT_L(n) asm volatile("s_waitcnt lgkmcnt(" #n ")" ::: "memory")
#define PG8_BAR __builtin_amdgcn_s_barrier()
#define PG8_SCHED __builtin_amdgcn_sched_barrier(0)
    Unit cur, nxt; int ui = 0;
    if (!S.next(0, cur)) return;
    f32x4 acc[2][2][4][2];
#pragma unroll
    for (int a = 0; a < 2; ++a)
#pragma unroll
        for (int b = 0; b < 2; ++b)
#pragma unroll
            for (int m = 0; m < 4; ++m)
#pragma unroll
                for (int n = 0; n < 2; ++n) acc[a][b][m][n] = (f32x4){0.f, 0.f, 0.f, 0.f};
    bf16x8 At[4][2], B0[2][2], B1[2][2];
    const char* cA = (const char*)g.A + (size_t)cur.pm * tstep; const char* cB = (const char*)g.Bt + (size_t)cur.e * g.bgroup + (size_t)cur.pn * tstep;
    if constexpr (SP2) {
        PG8_STAGE(PG8_SB(0, 0), cB, voffB); PG8_STAGE(PG8_SB(0, 1), cB + hstep, voffB); PG8_STAGE(PG8_SA(0, 0), cA, voffA); PG8_STAGE(PG8_SA(0, 1), cA + hstep, voffA);
        if (wr == 1) PG8_BAR;
        PG8_WAIT_V(2); PG8_BAR;
        PG8_STAGE(PG8_SB(1, 0), cB + kstep, voffB); PG8_STAGE(PG8_SA(1, 0), cA + kstep, voffA); PG8_STAGE(PG8_SB(1, 1), cB + hstep + kstep, voffB);
        PG8_WAIT_V(6); PG8_BAR;
    } else {
        PG8_STAGE(PG8_SB(0, 0), cB, voffB); PG8_STAGE(PG8_SA(0, 0), cA, voffA); PG8_STAGE(PG8_SB(0, 1), cB + hstep, voffB); PG8_STAGE(PG8_SA(0, 1), cA + hstep, voffA);
        if (wr == 1) PG8_BAR;
        PG8_WAIT_V(4); PG8_BAR;
        PG8_STAGE(PG8_SB(1, 0), cB + kstep, voffB); PG8_STAGE(PG8_SA(1, 0), cA + kstep, voffA); PG8_STAGE(PG8_SB(1, 1), cB + hstep + kstep, voffB);
        PG8_WAIT_V(6); PG8_BAR;
    }
    for (;;) {
        const bool has_next = S.next(ui + 1, nxt);
        const char* nA = has_next ? (const char*)g.A + (size_t)nxt.pm * tstep : cA; const char* nB = has_next ? (const char*)g.Bt + (size_t)nxt.e * g.bgroup + (size_t)nxt.pn * tstep : cB;
        for (int t = 0; t < nt; t += 2) {
            const bool last = (t == nt - 2);
            const char* a1 = cA + (size_t)(t + 1) * kstep;
            const char* a2 = last ? nA : cA + (size_t)(t + 2) * kstep; const char* b2 = last ? nB : cB + (size_t)(t + 2) * kstep;
            const char* a3 = a2 + kstep; const char* b3 = b2 + kstep;
            if constexpr (SP2) {
            PG8_LDB(B0, 0, 0); PG8_LDB(B1, 0, 1); PG8_SCHED; PG8_LDA(At, 0, 0); PG8_STAGE(PG8_SA(1, 1), a1 + hstep, voffA);
            PG8_WAIT_V(8); PG8_WAIT_L(0); PG8_BAR; PG8_MMA(0, 0, At, B0); PG8_MMA(0, 1, At, B1); PG8_BAR; PG8_SCHED;
            PG8_LDA(At, 0, 1); PG8_STAGE(PG8_SB(0, 0), b2, voffB); PG8_STAGE(PG8_SB(0, 1), b2 + hstep, voffB); PG8_STAGE(PG8_SA(0, 0), a2, voffA);
            PG8_WAIT_V(8); PG8_WAIT_L(0); PG8_BAR; PG8_MMA(1, 0, At, B0); PG8_MMA(1, 1, At, B1); PG8_BAR; PG8_SCHED;
            PG8_LDB(B0, 1, 0); PG8_LDB(B1, 1, 1); PG8_SCHED; PG8_LDA(At, 1, 0); PG8_STAGE(PG8_SA(0, 1), a2 + hstep, voffA);
            PG8_WAIT_V(8); PG8_WAIT_L(0); PG8_BAR; PG8_MMA(0, 0, At, B0); PG8_MMA(0, 1, At, B1); PG8_BAR; PG8_SCHED;
            PG8_LDA(At, 1, 1); PG8_STAGE(PG8_SB(1, 0), b3, voffB); PG8_STAGE(PG8_SB(1, 1), b3 + hstep, voffB); PG8_STAGE(PG8_SA(1, 0), a3, voffA);
            PG8_WAIT_V(8); PG8_WAIT_L(0); PG8_BAR; PG8_MMA(1, 0, At, B0); PG8_MMA(1, 1, At, B1); PG8_BAR; PG8_SCHED;
            } else {
            PG8_LDB(B0, 0, 0); PG8_SCHED; PG8_LDA(At, 0, 0); PG8_STAGE(PG8_SA(1, 1), a1 + hstep, voffA);
            PG8_WAIT_L(8); PG8_BAR; PG8_WAIT_L(0); PG8_MMA(0, 0, At, B0); PG8_BAR; PG8_SCHED;
            PG8_LDB(B1, 0, 1); PG8_STAGE(PG8_SB(0, 0), b2, voffB);
            PG8_BAR; PG8_WAIT_L(0); PG8_MMA(0, 1, At, B1); PG8_BAR;
            PG8_LDA(At, 0, 1); PG8_STAGE(PG8_SA(0, 0), a2, voffA);
            PG8_BAR; PG8_WAIT_L(0); PG8_MMA(1, 0, At, B0); PG8_BAR; PG8_SCHED;
            PG8_STAGE(PG8_SB(0, 1), b2 + hstep, voffB);
            PG8_WAIT_V(6); PG8_BAR; PG8_MMA(1, 1, At, B1); PG8_BAR;
            PG8_LDB(B0, 1, 0); PG8_SCHED; PG8_LDA(At, 1, 0); PG8_STAGE(PG8_SA(0, 1), a2 + hstep, voffA);
            PG8_WAIT_L(8); PG8_BAR; PG8_WAIT_L(0); PG8_MMA(0, 0, At, B0); PG8_BAR; PG8_SCHED;
            PG8_LDB(B1, 1, 1); PG8_STAGE(PG8_SB(1, 0), b3, voffB);
            PG8_BAR; PG8_WAIT_L(0); PG8_MMA(0, 1, At, B1); PG8_BAR;
            PG8_LDA(At, 1, 1); PG8_STAGE(PG8_SA(1, 0), a3, voffA);
            PG8_BAR; PG8_WAIT_L(0); PG8_MMA(1, 0, At, B0); PG8_BAR; PG8_SCHED;
            PG8_STAGE(PG8_SB(1, 1), b3 + hstep, voffB);
            PG8_WAIT_V(6); PG8_BAR; PG8_MMA(1, 1, At, B1); PG8_BAR;
            }
        }
        if constexpr (ALIGN_EPI) { if (wr == 0) PG8_BAR; }
        E(acc, cur, wr, wc, fr, fq);
        if (!has_next) break;
#pragma unroll
        for (int a = 0; a < 2; ++a)
#pragma unroll
            for (int b = 0; b < 2; ++b)
#pragma unroll
                for (int m = 0; m < 4; ++m)
#pragma unroll
                    for (int n = 0; n < 2; ++n) acc[a][b][m][n] = (f32x4){0.f, 0.f, 0.f, 0.f};
        cur = nxt; cA = nA; cB = nB; ++ui;
        if constexpr (ALIGN_EPI) { if (wr == 1) PG8_BAR; }
    }
    PG8_WAIT_V(0);
    if constexpr (!ALIGN_EPI) { if (wr == 0) PG8_BAR; }
    PG8_BAR;
#undef PG8_SA
#undef PG8_SB
#undef PG8_STAGE
#undef PG8_LDA
#undef PG8_LDB
#undef PG8_MMA
#undef PG8_WAIT_V
#undef PG8_WAIT_L
#undef PG8_BAR
#undef PG8_SCHED
}

struct EpiIn {
    static constexpr bool PERM = true;
    bf16* PR; bf16* PT; bf16* G; const float* bmerge;
    __device__ __forceinline__ void operator()(const f32x4 (&acc)[2][2][4][2], const Unit& u, int wr, int wc, int fr, int fq) const {
        const int row0 = u.pm * BM + wr * 64 + fr; const int pn = u.pn;
        bf16* base; int ldc, colt;
        if (pn < 7) { base = PR; ldc = RW_COLS; colt = pn * BM; } else if (pn < 16) { base = PT; ldc = AT_COLS; colt = (pn - 7) * BM; } else { base = G; ldc = G_COLS; colt = (pn - 16) * BM; }
        const bool gate = pn >= 16;
        const int col0 = colt + wc * 32 + 8 * fq;
        f32x4 bv[2][2];
#pragma unroll
        for (int bj = 0; bj < 2; ++bj)
#pragma unroll
            for (int n = 0; n < 2; ++n) bv[bj][n] = gate ? *(const f32x4*)(bmerge + col0 + bj * HALF + 4 * n) : (f32x4){0.f, 0.f, 0.f, 0.f};
#pragma unroll
        for (int ai = 0; ai < 2; ++ai)
#pragma unroll
            for (int m = 0; m < 4; ++m) { bf16* rowp = base + (size_t)(row0 + ai * HALF + m * 16) * ldc + col0;
#pragma unroll
                for (int bj = 0; bj < 2; ++bj) { f32x4 v0 = acc[ai][bj][m][0] + bv[bj][0], v1 = acc[ai][bj][m][1] + bv[bj][1];
                    if (gate) {
#pragma unroll
                        for (int j = 0; j < 4; ++j) { v0[j] = sigmoidf_(v0[j]); v1[j] = sigmoidf_(v1[j]); } }
                    v4u w; w.x = pk2(v0[0], v0[1]); w.y = pk2(v0[2], v0[3]); w.z = pk2(v1[0], v1[1]); w.w = pk2(v1[2], v1[3]);
                    *(v4u*)(rowp + bj * HALF) = w; } }
    }
};
template <int MODE> struct EpiMix {
    static constexpr bool PERM = true;
    const bf16* G; const bf16* Zin; bf16* Zout;
    __device__ __forceinline__ void operator()(const f32x4 (&acc)[2][2][4][2], const Unit& u, int wr, int wc, int fr, int fq) const {
        const int row0 = u.pm * BM + wr * 64 + fr, col0 = u.pn * BM + wc * 32 + 8 * fq;
#pragma unroll
        for (int ai = 0; ai < 2; ++ai)
#pragma unroll
            for (int m = 0; m < 4; ++m) { const size_t r = (size_t)(row0 + ai * HALF + m * 16);
#pragma unroll
                for (int bj = 0; bj < 2; ++bj) {
                    const int c = col0 + bj * HALF;
                    const v4u gv = *(const v4u*)(G + r * G_COLS + MODE * DM + c);
                    f32x4 v0 = acc[ai][bj][m][0], v1 = acc[ai][bj][m][1];
                    v0[0] *= bflo(gv.x); v0[1] *= bfhi(gv.x); v0[2] *= bflo(gv.y); v0[3] *= bfhi(gv.y);
                    v1[0] *= bflo(gv.z); v1[1] *= bfhi(gv.z); v1[2] *= bflo(gv.w); v1[3] *= bfhi(gv.w);
                    if (MODE == 1) { const v4u zv = *(const v4u*)(Zin + r * DM + c);
                        v0[0] += bflo(zv.x); v0[1] += bfhi(zv.x); v0[2] += bflo(zv.y); v0[3] += bfhi(zv.y);
                        v1[0] += bflo(zv.z); v1[1] += bfhi(zv.z); v1[2] += bflo(zv.w); v1[3] += bfhi(zv.w); }
                    v4u w; w.x = pk2(v0[0], v0[1]); w.y = pk2(v0[2], v0[3]); w.z = pk2(v1[0], v1[1]); w.w = pk2(v1[2], v1[3]);
                    *(v4u*)(Zout + r * DM + c) = w; } }
    }
};
struct EpiRes {
    static constexpr bool PERM = false;
    const float* X; float* O;
    __device__ __forceinline__ void operator()(const f32x4 (&acc)[2][2][4][2], const Unit& u, int wr, int wc, int fr, int fq) const {
        const int row0 = u.pm * BM + wr * 64 + fr, col0 = u.pn * BM + wc * 32 + 4 * fq;
#pragma unroll
        for (int ai = 0; ai < 2; ++ai)
#pragma unroll
            for (int m = 0; m < 4; ++m) { const size_t off = (size_t)(row0 + ai * HALF + m * 16) * DM + col0;
#pragma unroll
                for (int bj = 0; bj < 2; ++bj)
#pragma unroll
                    for (int n = 0; n < 2; ++n) { const f32x4 xv = *(const f32x4*)(X + off + bj * HALF + n * 16); *(f32x4*)(O + off + bj * HALF + n * 16) = xv + acc[ai][bj][m][n]; } }
    }
};
struct EpiSwiglu {
    static constexpr bool PERM = false;
    bf16* H;
    __device__ __forceinline__ void operator()(const f32x4 (&acc)[2][2][4][2], const Unit& u, int wr, int wc, int fr, int fq) const {
        const int row0 = u.pm * BM + wr * 64 + fr, col0 = u.pn * 128 + wc * 16 + 4 * fq;
#pragma unroll
        for (int ai = 0; ai < 2; ++ai)
#pragma unroll
            for (int m = 0; m < 4; ++m) { bf16* rowp = H + (size_t)(row0 + ai * HALF + m * 16) * DEXP + col0;
#pragma unroll
                for (int bj = 0; bj < 2; ++bj) { const f32x4 gt = acc[ai][bj][m][0], up = acc[ai][bj][m][1]; f32x4 o;
#pragma unroll
                    for (int j = 0; j < 4; ++j) o[j] = gt[j] * sigmoidf_(gt[j]) * up[j];
                    v2u w; w.x = pk2(o[0], o[1]); w.y = pk2(o[2], o[3]);
                    *(v2u*)(rowp + bj * 64) = w; } }
    }
};
struct EpiStoreY {
    static constexpr bool PERM = true;
    const float* roww; bf16* Y;
    __device__ __forceinline__ void operator()(const f32x4 (&acc)[2][2][4][2], const Unit& u, int wr, int wc, int fr, int fq) const {
        const int row0 = u.pm * BM + wr * 64 + fr, col0 = u.pn * BM + wc * 32 + 8 * fq;
#pragma unroll
        for (int ai = 0; ai < 2; ++ai)
#pragma unroll
            for (int m = 0; m < 4; ++m) { const int r = row0 + ai * HALF + m * 16; const float w = roww[r]; bf16* rowp = Y + (size_t)r * DM + col0;
#pragma unroll
                for (int bj = 0; bj < 2; ++bj) { const f32x4 v0 = acc[ai][bj][m][0] * w, v1 = acc[ai][bj][m][1] * w;
                    v4u o; o.x = pk2(v0[0], v0[1]); o.y = pk2(v0[2], v0[3]); o.z = pk2(v1[0], v1[1]); o.w = pk2(v1[2], v1[3]);
                    *(v4u*)(rowp + bj * HALF) = o; } }
    }
};
}

#define XB_TMO      128
#define XB_XCNT(j)  (256  + 64 * (j))
#define XB_XSUB(j)  (1280 + 64 * (j))
#define XB_XGEN(j)  (2304 + 64 * (j))
#define XB_TOP      3328
#define XB_TOPGEN   3392
#define XCD_BAR_WORDS 3456
#define XB_SPIN_CAP (1u << 18)
__device__ __forceinline__ unsigned xb_ld(unsigned* p)              { return __hip_atomic_load(p, __ATOMIC_RELAXED, __HIP_MEMORY_SCOPE_AGENT); }
__device__ __forceinline__ unsigned xb_add(unsigned* p, unsigned v) { return __hip_atomic_fetch_add(p, v, __ATOMIC_RELAXED, __HIP_MEMORY_SCOPE_AGENT); }
__device__ __forceinline__ unsigned xb_xcc_id() { return (unsigned)__builtin_amdgcn_s_getreg((3 << 11) | 20) & 0xFu; }
#define XB_SPIN(cond, bar) do { unsigned _sp = 0; while (cond) { __builtin_amdgcn_s_sleep(1); \
    if ((++_sp & 255u) == 0u) { if (xb_ld(&(bar)[XB_TMO])) break; if (_sp > XB_SPIN_CAP) { atomicAdd(&(bar)[XB_TMO], 1u); break; } } } } while (0)
struct XcdBarrier { unsigned* bar; unsigned x; volatile LAS unsigned* st; };
__device__ __forceinline__ XcdBarrier xcd_barrier_post(unsigned* bar, volatile LAS unsigned* st) {
    XcdBarrier b; b.bar = bar; b.x = xb_xcc_id(); b.st = st;
    if (threadIdx.x == 0) (void)xb_add(&bar[XB_XCNT(b.x)], 1u);
    return b;
}
__device__ __forceinline__ void xcd_barrier_complete(unsigned* bar, unsigned x, unsigned& nloc, unsigned& nx) {
    const unsigned G = gridDim.x * gridDim.y * gridDim.z;
    unsigned sum, cnt, mine, sp = 0u;
    for (;;) {
        sum = 0u; cnt = 0u; mine = 0u;
#pragma unroll
        for (unsigned j = 0; j < 16; ++j) { const unsigned c = xb_ld(&bar[XB_XCNT(j)]); sum += c; cnt += (c > 0u) ? 1u : 0u; mine = (j == x) ? c : mine; }
        if (sum == G) break;
        __builtin_amdgcn_s_sleep(1);
        if ((++sp & 255u) == 0u) { if (xb_ld(&bar[XB_TMO])) break; if (sp > XB_SPIN_CAP) { atomicAdd(&bar[XB_TMO], 1u); break; } }
    }
    nloc = mine > 0u ? mine : 1u; nx = cnt > 0u ? cnt : 1u;
}
__device__ __forceinline__ void xcd_barrier(const XcdBarrier& b) {
    asm volatile("s_waitcnt vmcnt(0)" ::: "memory");
    __syncthreads();
    if (threadIdx.x == 0) {
        unsigned* bar = b.bar;
        __builtin_amdgcn_s_waitcnt(0);
        unsigned nloc = b.st[0], nx = b.st[1];
        if (nloc == 0u) { xcd_barrier_complete(bar, b.x, nloc, nx); b.st[0] = nloc; b.st[1] = nx; }
        const unsigned old = xb_add(&bar[XB_XSUB(b.x)], 1u);
        const unsigned gen = old / nloc;
        if (old + 1u == (gen + 1u) * nloc) {
            __builtin_amdgcn_fence(__ATOMIC_RELEASE, "agent");
            asm volatile("s_waitcnt vmcnt(0)" ::: "memory");
            const unsigned og = xb_add(&bar[XB_TOP], 1u);
            const unsigned tg = og / nx;
            if (og + 1u == (tg + 1u) * nx) xb_add(&bar[XB_TOPGEN], 1u);
            else XB_SPIN(xb_ld(&bar[XB_TOPGEN]) == tg, bar);
            __builtin_amdgcn_fence(__ATOMIC_ACQUIRE, "agent");
            xb_add(&bar[XB_XGEN(b.x)], 1u);
            asm volatile("s_waitcnt vmcnt(0)" ::: "memory");
        } else {
            XB_SPIN(xb_ld(&bar[XB_XGEN(b.x)]) == gen, bar);
            __builtin_amdgcn_fence(__ATOMIC_ACQUIRE, "agent");
            asm volatile("s_waitcnt vmcnt(0)" ::: "memory");
        }
    }
    __syncthreads();
}

struct Args { const void* in[30]; float* out; unsigned char* ws; int ph_lo, ph_hi, li, variant; };
struct Frame {
    LAS unsigned char* lds; volatile LAS unsigned* MISC;
    int tid, lane, wave, G, bid, variant;
    unsigned char* ws;
};
enum { I_X = 0, I_POS, I_N1G, I_WIN, I_MUP, I_MUN, I_WD0, I_WDUP, I_AG0, I_AGUP, I_GUP, I_KK, I_KA, I_RK, I_GNW, I_GNB, I_WROUT, I_QNG, I_KNG, I_WAOUT, I_BMERGE, I_WOUT,
       I_N2G, I_WRG, I_BRG, I_WRE, I_BRE, I_WGATE, I_WUP, I_WDOWN };

template <class RowMap>
DI void transpose_item(const float* W, int K, int N, bf16* WT, const RowMap& rm, LAS float* scr, int item, int lane) {
    const int nblk = N / 32, kb = item / nblk, nb = item % nblk, k0 = 64 * kb, n0 = 32 * nb;
#pragma unroll 8
    for (int i = 0; i < 32; ++i) { const int kk = 2 * i + (lane >> 5); scr[kk * 33 + (lane & 31)] = W[(size_t)(k0 + kk) * N + n0 + (lane & 31)]; }
    LDS_WAIT(); asm volatile("" ::: "memory");
    const int c = lane & 7;
#pragma unroll
    for (int j = 0; j < 4; ++j) { const int n = (lane >> 3) + 8 * j; const LAS float* s = scr + (8 * c) * 33 + n;
        v4u o; o.x = pk2(s[0 * 33], s[1 * 33]); o.y = pk2(s[2 * 33], s[3 * 33]); o.z = pk2(s[4 * 33], s[5 * 33]); o.w = pk2(s[6 * 33], s[7 * 33]);
        *(GAS v4u*)(WT + (size_t)rm(n0 + n) * K + k0 + 8 * c) = o; }
    LDS_WAIT(); asm volatile("" ::: "memory");
}
struct RmId { DI int operator()(int n) const { return n; } };
struct RmGate { DI int operator()(int n) const { return 32 * (n >> 4) + (n & 15); } };
struct RmUp { DI int operator()(int n) const { return 32 * (n >> 4) + 16 + (n & 15); } };

DI void p0_prologue(Frame& F, const Args& a) {
    LAS float* scr = (LAS float*)(F.lds + F.wave * 16384);
    const int gw = F.bid * NWAVES + F.wave, NGW = F.G * NWAVES;
    unsigned char* ws = F.ws;
    constexpr int I_IN = (DM / 64) * (IN_COLS / 32), I_R = (512 / 64) * (DM / 32), I_A = (256 / 64) * (DM / 32), I_O = (DM / 64) * (DM / 32), I_G = (128 / 64) * (512 / 32), I_L = 512 / 32;
    constexpr int NITEMS = I_IN + I_R + I_A + I_O + I_G + 4 * I_L;
    for (int it = gw; it < NITEMS; it += NGW) {
        int r = it;
        if (r < I_IN) { transpose_item((const float*)a.in[I_WIN], DM, IN_COLS, (bf16*)(ws + WS_WIN_T), RmId(), scr, r, F.lane); continue; } r -= I_IN;
        if (r < I_R) { transpose_item((const float*)a.in[I_WROUT], 512, DM, (bf16*)(ws + WS_WR_T), RmId(), scr, r, F.lane); continue; } r -= I_R;
        if (r < I_A) { transpose_item((const float*)a.in[I_WAOUT], 256, DM, (bf16*)(ws + WS_WA_T), RmId(), scr, r, F.lane); continue; } r -= I_A;
        if (r < I_O) { transpose_item((const float*)a.in[I_WOUT], DM, DM, (bf16*)(ws + WS_WOUT_T), RmId(), scr, r, F.lane); continue; } r -= I_O;
        if (r < I_G) { transpose_item((const float*)a.in[I_GUP], 128, 512, (bf16*)(ws + WS_GUP_T), RmId(), scr, r, F.lane); continue; } r -= I_G;
        { const int d = r / I_L, rr = r % I_L;
          if (d < 2) transpose_item((const float*)a.in[I_WDUP] + (size_t)d * 64 * 512, 64, 512, (bf16*)(ws + WS_WUP_T) + (size_t)d * 512 * 64, RmId(), scr, rr, F.lane);
          else transpose_item((const float*)a.in[I_AGUP] + (size_t)(d - 2) * 64 * 512, 64, 512, (bf16*)(ws + WS_AUP_T) + (size_t)(d - 2) * 512 * 64, RmId(), scr, rr, F.lane); }
    }
    { const float* g2 = (const float*)a.in[I_N2G]; const float* wre = (const float*)a.in[I_WRE]; const float* wrg = (const float*)a.in[I_WRG];
      bf16* hi = (bf16*)(ws + WS_RT_HI); bf16* lo = (bf16*)(ws + WS_RT_LO);
      for (int i = F.bid * 512 + F.tid; i < 64 * DM; i += F.G * 512) { const int n = i / DM, k = i % DM;
          float v = 0.f; if (n < 32) v = g2[k] * wre[k * 32 + n]; else if (n < 36) v = g2[k] * wrg[k * 4 + (n - 32)];
          const unsigned h = pk2(v, 0.f) & 0xffffu; const float hf = bflo(h); hi[i] = (bf16)h; lo[i] = (bf16)(pk2(v - hf, 0.f) & 0xffffu); } }
    { const float* x = (const float*)a.in[I_X]; const float* g1 = (const float*)a.in[I_N1G]; bf16* hb = (bf16*)(ws + WS_HB);
      f32x4 gv[4];
#pragma unroll
      for (int j = 0; j < 4; ++j) gv[j] = ((const f32x4*)g1)[F.lane + 64 * j];
      for (int m = gw; m < NTOK; m += NGW) {
          const GAS f32x4* xr = (const GAS f32x4*)(x + (size_t)m * DM) + F.lane; f32x4 v[4]; float s = 0.f;
#pragma unroll
          for (int j = 0; j < 4; ++j) { v[j] = xr[64 * j]; s += (v[j].x * v[j].x + v[j].y * v[j].y) + (v[j].z * v[j].z + v[j].w * v[j].w); }
          const float rstd = 1.f / sqrtf(wave_sum(s) * (1.f / DM) + NORM_EPS);
          GAS v2u* o8 = (GAS v2u*)(hb + (size_t)m * DM) + F.lane;
#pragma unroll
          for (int j = 0; j < 4; ++j) { v2u w; w.x = pk2(v[j].x * rstd * gv[j].x, v[j].y * rstd * gv[j].y); w.y = pk2(v[j].z * rstd * gv[j].z, v[j].w * rstd * gv[j].w); o8[64 * j] = w; } } }
}

DI void p1b_qkprep(Frame& F, const Args& a) {
    bf16* PT = (bf16*)(F.ws + WS_PT);
    const int* pos = (const int*)a.in[I_POS];
    const int sub = F.lane & 7;
    const f32x4 qg0 = ((const f32x4*)a.in[I_QNG])[2 * sub], qg1 = ((const f32x4*)a.in[I_QNG])[2 * sub + 1];
    const f32x4 kg0 = ((const f32x4*)a.in[I_KNG])[2 * sub], kg1 = ((const f32x4*)a.in[I_KNG])[2 * sub + 1];
    constexpr float IF2PI[8] = {0.15915494309189535f, 0.03086376340470123f, 0.005985185712713705f, 0.001160663641240061f, 0.00022507907903927653f, 4.364795279280289e-05f, 8.464330808241401e-06f, 1.6414262627950345e-06f};
    const int nvec = NTOK * 24, stride = (F.G * 512) >> 3;
    for (int vid0 = (F.bid * 512 + F.tid) >> 3; vid0 < nvec; vid0 += 4 * stride) {
        v4u raw[4]; int pv[4];
#pragma unroll
        for (int u = 0; u < 4; ++u) { const int vid = vid0 + u * stride; if (vid < nvec) { const int tok = vid / 24, v = vid % 24; const bool isq = v < 12; const int head = isq ? v : v - 12;
            raw[u] = *(const v4u*)(PT + (size_t)tok * AT_COLS + (isq ? 0 : 768) + head * 64 + sub * 8); pv[u] = pos[tok]; } else { raw[u] = (v4u){0u, 0u, 0u, 0u}; pv[u] = 0; } }
#pragma unroll
        for (int u = 0; u < 4; ++u) { const int vid = vid0 + u * stride; const bool act = vid < nvec; const int vv = act ? vid : 0;
            const int tok = vv / 24, v = vv % 24; const bool isq = v < 12; const int head = isq ? v : v - 12;
            bf16* p = PT + (size_t)tok * AT_COLS + (isq ? 0 : 768) + head * 64 + sub * 8;
            float y[8] = {bflo(raw[u].x), bfhi(raw[u].x), bflo(raw[u].y), bfhi(raw[u].y), bflo(raw[u].z), bfhi(raw[u].z), bflo(raw[u].w), bfhi(raw[u].w)};
            float ss = 0.f;
#pragma unroll
            for (int j = 0; j < 8; ++j) ss += y[j] * y[j];
            ss += __shfl_xor(ss, 1); ss += __shfl_xor(ss, 2); ss += __shfl_xor(ss, 4);
            const float rstd = 1.f / sqrtf(ss * (1.f / 64.f) + NORM_EPS);
            const f32x4 g0 = isq ? qg0 : kg0, g1 = isq ? qg1 : kg1;
#pragma unroll
            for (int j = 0; j < 4; ++j) { y[j] = y[j] * rstd * g0[j]; y[4 + j] = y[4 + j] * rstd * g1[j]; }
            const float pf = (float)pv[u];
#pragma unroll
            for (int j = 0; j < 8; ++j) {
                const float partner = __shfl_xor(y[j], 1);
                float r = pf * IF2PI[j]; r = r - floorf(r);
                const float sn = __builtin_amdgcn_sinf(r), cs = __builtin_amdgcn_cosf(r);
                const float rot = y[j] * cs + (sub == 0 ? -partner : partner) * sn;
                if (sub < 2) y[j] = rot;
            }
            if (isq) {
#pragma unroll
                for (int j = 0; j < 8; ++j) y[j] *= 0.18033688011112042f;
            }
            v4u o; o.x = pk2(y[0], y[1]); o.y = pk2(y[2], y[3]); o.z = pk2(y[4], y[5]); o.w = pk2(y[6], y[7]);
            if (act) *(v4u*)p = o; }
    }
}

DI void p1c_preshift(Frame& F, const Args& a) {
    if (F.tid >= 448) return;
    const bf16* PR = (const bf16*)(F.ws + WS_PR); bf16* PS = (bf16*)a.out;
    const int rsub = F.tid / 224, cg8 = (F.tid % 224) * 8;
    const float* mup = (const float*)a.in[I_MUP] + cg8; const float* mun = (const float*)a.in[I_MUN] + cg8;
    const f32x4 mp0 = *(const f32x4*)mup, mp1 = *(const f32x4*)(mup + 4), mn0 = *(const f32x4*)mun, mn1 = *(const f32x4*)(mun + 4);
    const int mode = (cg8 >= 1536 && cg8 < 1600) ? 1 : (cg8 >= 1664 ? 2 : 0);
    const int rows_per = NTOK / F.G;
    for (int r0 = F.bid * rows_per + rsub; r0 < (F.bid + 1) * rows_per; r0 += 8) {
        v4u cur[4], prv[4], nxt[4];
#pragma unroll
        for (int u = 0; u < 4; ++u) { const int row = r0 + 2 * u, t = row % SEQ; const bf16* p = PR + (size_t)row * RW_COLS + cg8;
            cur[u] = *(const v4u*)p; prv[u] = *(const v4u*)(p - (t > 0 ? RW_COLS : 0)); nxt[u] = *(const v4u*)(p + (t < SEQ - 1 ? RW_COLS : 0)); }
#pragma unroll
        for (int u = 0; u < 4; ++u) { const int row = r0 + 2 * u, t = row % SEQ; const float fp = t > 0 ? 1.f : 0.f, fn = t < SEQ - 1 ? 1.f : 0.f;
            const unsigned cw[4] = {cur[u].x, cur[u].y, cur[u].z, cur[u].w}, pw[4] = {prv[u].x, prv[u].y, prv[u].z, prv[u].w}, nw[4] = {nxt[u].x, nxt[u].y, nxt[u].z, nxt[u].w};
            float y[8];
#pragma unroll
            for (int j = 0; j < 4; ++j) {
                const float c0 = bflo(cw[j]), c1 = bfhi(cw[j]), p0 = bflo(pw[j]) * fp, p1 = bfhi(pw[j]) * fp, n0 = bflo(nw[j]) * fn, n1 = bfhi(nw[j]) * fn;
                const float m0 = j < 2 ? mp0[2 * j] : mp1[2 * j - 4], m1 = j < 2 ? mp0[2 * j + 1] : mp1[2 * j - 3], q0 = j < 2 ? mn0[2 * j] : mn1[2 * j - 4], q1 = j < 2 ? mn0[2 * j + 1] : mn1[2 * j - 3];
                y[2 * j] = c0 + m0 * (p0 - c0) + q0 * (n0 - c0); y[2 * j + 1] = c1 + m1 * (p1 - c1) + q1 * (n1 - c1); }
            if (mode == 1) {
#pragma unroll
                for (int j = 0; j < 8; ++j) y[j] = 1.f - 2.f * __builtin_amdgcn_rcpf(1.f + __builtin_amdgcn_exp2f(2.88539008f * y[j])); }
            if (mode == 2) {
#pragma unroll
                for (int j = 0; j < 8; ++j) y[j] = sigmoidf_(y[j]); }
            v4u o; o.x = pk2(y[0], y[1]); o.y = pk2(y[2], y[3]); o.z = pk2(y[4], y[5]); o.w = pk2(y[6], y[7]);
            *(v4u*)(PS + (size_t)row * RW_COLS + cg8) = o; }
    }
}

DI bf16x8 pack8(float a0, float a1, float a2, float a3, float a4, float a5, float a6, float a7) {
    v4u p; p.x = pk2(a0, a1); p.y = pk2(a2, a3); p.z = pk2(a4, a5); p.w = pk2(a6, a7); return __builtin_bit_cast(bf16x8, p);
}
DI void attn_unit(Frame& F, int b, int hh, int span) {
    const bf16* PT = (const bf16*)(F.ws + WS_PT); bf16* Og = (bf16*)(F.ws + WS_OG); float* Lse = (float*)(F.ws + WS_LSE); bf16* YA = (bf16*)(F.ws + WS_YA);
    LAS unsigned char* vbuf = F.lds + F.wave * 9216;
    const int lane = F.lane, n = lane & 31, half = lane >> 5;
    const int T0 = span * 512; const size_t rowbase = (size_t)b * SEQ;
    for (int su = F.wave; su < 48; su += 8) {
        const int g = su >> 4, s16 = su & 15, dsh = 2 * g, L = SEQ >> dsh, per_r = 16 >> dsh;
        const int r = s16 / per_r, sb = s16 % per_r, l0 = (T0 >> dsh) + sb * 32, head = 4 * g + hh;
        const int tq = ((l0 + n) << dsh) + r;
        const bf16* qp = PT + (rowbase + tq) * AT_COLS + head * 64 + 8 * half;
        bf16x8 qf[4];
#pragma unroll
        for (int kk = 0; kk < 4; ++kk) qf[kk] = *(const bf16x8*)(qp + 16 * kk);
        f32x16 o0, o1;
#pragma unroll
        for (int i = 0; i < 16; ++i) { o0[i] = 0.f; o1[i] = 0.f; }
        float mrun = -1e30f, lrun = 0.f;
        const int kb_lo = l0 >= 64 ? 0 : (64 - l0) >> 5, kb_hi = min(4, (L + 32 - l0) >> 5);
        bf16x8 kfn[4]; v4u vvn[4];
#define ATT_PRELOAD(kbx) do { const int lk0_ = l0 - 64 + 32 * (kbx); \
            _Pragma("unroll") for (int j = 0; j < 4; ++j) { const int idx = lane + 64 * j, key = idx >> 3, ch = idx & 7; const int tk_ = ((lk0_ + key) << dsh) + r; \
                vvn[j] = *(const v4u*)(PT + (rowbase + tk_) * AT_COLS + 1536 + head * 64 + ch * 8); } \
            const int tk2_ = ((lk0_ + n) << dsh) + r; const bf16* kp_ = PT + (rowbase + tk2_) * AT_COLS + 768 + head * 64 + 8 * half; \
            _Pragma("unroll") for (int kk = 0; kk < 4; ++kk) kfn[kk] = *(const bf16x8*)(kp_ + 16 * kk); } while (0)
        ATT_PRELOAD(kb_lo);
        for (int kb = kb_lo; kb <= kb_hi; ++kb) {
            LAS unsigned char* vb = vbuf + (kb & 1) * 4608;
            bf16x8 kf[4];
#pragma unroll
            for (int j = 0; j < 4; ++j) { const int idx = lane + 64 * j, key = idx >> 3, ch = idx & 7; *(LAS v4u*)(vb + key * 144 + ch * 16) = vvn[j]; kf[j] = kfn[j]; }
            if (kb < kb_hi) ATT_PRELOAD(kb + 1);
            f32x16 s;
#pragma unroll
            for (int i = 0; i < 16; ++i) s[i] = 0.f;
#pragma unroll
            for (int kk = 0; kk < 4; ++kk) s = MFMA32(kf[kk], qf[kk], s);
            if (kb == 0) {
#pragma unroll
                for (int i = 0; i < 16; ++i) if (crow(i, half) < n) s[i] = -1e30f; }
            if (kb == 4) {
#pragma unroll
                for (int i = 0; i < 16; ++i) if (crow(i, half) > n) s[i] = -1e30f; }
            float mx = s[0];
#pragma unroll
            for (int i = 1; i < 16; ++i) mx = fmaxf(mx, s[i]);
            mx = fmaxf(mx, __shfl_xor(mx, 32));
            const float mnew = fmaxf(mrun, mx), alpha = __builtin_amdgcn_exp2f(mrun - mnew); mrun = mnew;
            float ps = 0.f;
#pragma unroll
            for (int i = 0; i < 16; ++i) { s[i] = __builtin_amdgcn_exp2f(s[i] - mnew); ps += s[i]; }
            lrun = lrun * alpha + ps;
#pragma unroll
            for (int i = 0; i < 16; ++i) { o0[i] *= alpha; o1[i] *= alpha; }
            const bf16x8 pf0 = pack8(s[0], s[1], s[2], s[3], s[4], s[5], s[6], s[7]), pf1 = pack8(s[8], s[9], s[10], s[11], s[12], s[13], s[14], s[15]);
#pragma unroll
            for (int g2 = 0; g2 < 2; ++g2) {
                bf16x8 vf0, vf1;
#pragma unroll
                for (int si = 0; si < 8; ++si) { const int key = 16 * g2 + (si & 3) + 8 * (si >> 2) + 4 * half;
                    vf0[si] = *(const LAS short*)(vb + key * 144 + n * 2); vf1[si] = *(const LAS short*)(vb + key * 144 + (n + 32) * 2); }
                o0 = MFMA32(vf0, g2 ? pf1 : pf0, o0); o1 = MFMA32(vf1, g2 ? pf1 : pf0, o1);
            }
        }
#undef ATT_PRELOAD
        const float ltot = lrun + __shfl_xor(lrun, 32), inv = 1.f / ltot;
        bf16* op = Og + ((size_t)g * NTOK + rowbase + tq) * 256 + hh * 64;
#pragma unroll
        for (int q4 = 0; q4 < 4; ++q4) { const int d0 = 8 * q4 + 4 * half;
            v2u w0; w0.x = pk2(o0[4 * q4] * inv, o0[4 * q4 + 1] * inv); w0.y = pk2(o0[4 * q4 + 2] * inv, o0[4 * q4 + 3] * inv); *(v2u*)(op + d0) = w0;
            v2u w1; w1.x = pk2(o1[4 * q4] * inv, o1[4 * q4 + 1] * inv); w1.y = pk2(o1[4 * q4 + 2] * inv, o1[4 * q4 + 3] * inv); *(v2u*)(op + 32 + d0) = w1; }
        if (half == 0) Lse[((size_t)g * NTOK + rowbase + tq) * 4 + hh] = mrun + __builtin_amdgcn_logf(ltot);
    }
    VM_WAIT(); __syncthreads();
    __builtin_amdgcn_fence(__ATOMIC_ACQUIRE, "agent"); VM_WAIT();
    {
        const size_t tok = rowbase + T0 + F.tid;
        const float l0 = Lse[(0 * (size_t)NTOK + tok) * 4 + hh], l1 = Lse[(1 * (size_t)NTOK + tok) * 4 + hh], l2 = Lse[(2 * (size_t)NTOK + tok) * 4 + hh];
        const float mx = fmaxf(l0, fmaxf(l1, l2));
        float a0 = __builtin_amdgcn_exp2f(l0 - mx), a1 = __builtin_amdgcn_exp2f(l1 - mx), a2 = __builtin_amdgcn_exp2f(l2 - mx);
        const float inv = 1.f / (a0 + a1 + a2); a0 *= inv; a1 *= inv; a2 *= inv;
        const bf16* p0 = Og + (0 * (size_t)NTOK + tok) * 256 + hh * 64; const bf16* p1 = Og + (1 * (size_t)NTOK + tok) * 256 + hh * 64; const bf16* p2 = Og + (2 * (size_t)NTOK + tok) * 256 + hh * 64;
        bf16* yo = YA + tok * 256 + hh * 64;
#pragma unroll
        for (int c = 0; c < 8; ++c) { const v4u x0 = *(const v4u*)(p0 + 8 * c), x1 = *(const v4u*)(p1 + 8 * c), x2 = *(const v4u*)(p2 + 8 * c); v4u o;
            o.x = pk2(a0 * bflo(x0.x) + a1 * bflo(x1.x) + a2 * bflo(x2.x), a0 * bfhi(x0.x) + a1 * bfhi(x1.x) + a2 * bfhi(x2.x));
            o.y = pk2(a0 * bflo(x0.y) + a1 * bflo(x1.y) + a2 * bflo(x2.y), a0 * bfhi(x0.y) + a1 * bfhi(x1.y) + a2 * bfhi(x2.y));
            o.z = pk2(a0 * bflo(x0.z) + a1 * bflo(x1.z) + a2 * bflo(x2.z), a0 * bfhi(x0.z) + a1 * bfhi(x1.z) + a2 * bfhi(x2.z));
            o.w = pk2(a0 * bflo(x0.w) + a1 * bflo(x1.w) + a2 * bflo(x2.w), a0 * bfhi(x0.w) + a1 * bfhi(x1.w) + a2 * bfhi(x2.w));
            *(v4u*)(yo + 8 * c) = o; }
    }
    __syncthreads();
}

DI f32x4 ld4bf(const bf16* p) { const v2u u = *(const v2u*)p; return (f32x4){bflo(u.x), bfhi(u.x), bflo(u.y), bfhi(u.y)}; }
DI f32x4 shift4(const bf16* prow, bool hasp, bool hasn, const float* mup, const float* mun, int col) {
    const f32x4 u = ld4bf(prow + col);
    const float mp = hasp ? 1.f : 0.f, mn = hasn ? 1.f : 0.f;
    const f32x4 up = ld4bf(prow + (hasp ? -RW_COLS : 0) + col) * mp, un = ld4bf(prow + (hasn ? RW_COLS : 0) + col) * mn;
    return u + *(const f32x4*)(mup + col) * (up - u) + *(const f32x4*)(mun + col) * (un - u);
}
DI float red8(float v) {
    v += __builtin_bit_cast(float, __builtin_amdgcn_update_dpp(0, __builtin_bit_cast(int, v), 0xB1, 0xF, 0xF, true));
    v += __builtin_bit_cast(float, __builtin_amdgcn_update_dpp(0, __builtin_bit_cast(int, v), 0x4E, 0xF, 0xF, true));
    v += __builtin_bit_cast(float, __builtin_amdgcn_update_dpp(0, __builtin_bit_cast(int, v), 0x141, 0xF, 0xF, true));
    return v;
}
constexpr int SC_CH = 32, SC_NCH = SEQ / SC_CH;
constexpr int FP = 68;
#define SC_BUF(bi, arr) ((LAS float*)F.lds + ((arr) - 1) * (32 * FP))
constexpr int SCL_E2 = 4 * 32 * FP * 4, SCL_CONST = 49152, SCL_IMG = 51200, SCL_IMGSZ = 35072, SCL_MABT = SCL_IMG + 2 * SCL_IMGSZ;
constexpr int IM_AT = 0, IM_RT = 4608, IM_BT = 9216, IM_KT = 14336, IM_VT = 19456, IM_MAK = 24576, IM_NB = 27136, IM_NK = 29696, IM_T = 32256, IM_GC = 34816;
constexpr int SCL_RAW = 131584, RAW_PITCH = 656;
constexpr int P144 = 144, P80 = 80;
#define SC_E2(bi) ((LAS float*)(F.lds + SCL_E2))
#define SC_IMG(ib) (F.lds + SCL_IMG + (ib) * SCL_IMGSZ)
#define SC_CONST ((LAS float*)(F.lds + SCL_CONST))
DI f32x4 up4(v2u u) { return (f32x4){bflo(u.x), bfhi(u.x), bflo(u.y), bfhi(u.y)}; }
template <int KIND> struct PrepRaw { bf16x8 xf[4]; v2u ga[4], gb[4], gc[4]; };
DI void raw_load(Frame& F, const bf16* PS, int b, int h, int dir, int c, v4u (&Rp)[5]) {
    int hl = F.tid - 256; LAUNDER(hl); const int hc = h * 64;
#pragma unroll
    for (int k = 0; k < 5; ++k) { const int pc = hl + 256 * k, tau = pc / 40, s16 = pc % 40, seg = s16 >> 3;
        const int tl = SC_CH * c + tau, t = dir ? (SEQ - 1 - tl) : tl;
        const int col = (seg < 3 ? seg * 512 + hc : (seg == 3 ? 1536 : 1600)) + (s16 & 7) * 8;
        Rp[k] = *(const v4u*)(PS + ((size_t)b * SEQ + t) * RW_COLS + col); }
}
DI void raw_store(Frame& F, const v4u (&Rp)[5]) {
    int hl = F.tid - 256; LAUNDER(hl);
#pragma unroll
    for (int k = 0; k < 5; ++k) { const int pc = hl + 256 * k, tau = pc / 40, s16 = pc % 40; *(LAS v4u*)(F.lds + SCL_RAW + tau * RAW_PITCH + s16 * 16) = Rp[k]; }
}
template <int KIND>
DI void prep_fetch(Frame& F, PrepRaw<KIND>& R) {
    const int q = F.wave - 4, jt = q & 1, lane = F.lane, n = lane & 31, half = lane >> 5;
    const LAS unsigned char* pr = F.lds + SCL_RAW + n * RAW_PITCH;
#pragma unroll
    for (int kk = 0; kk < 4; ++kk) R.xf[kk] = *(const LAS bf16x8*)(pr + (KIND ? 512 : 384) + (16 * kk + 8 * half) * 2);
#pragma unroll
    for (int q4 = 0; q4 < 4; ++q4) { const int j = 32 * jt + 8 * q4 + 4 * half, jo = 32 * (1 - jt) + 8 * q4 + 4 * half;
        R.ga[q4] = *(const LAS v2u*)(pr + (KIND ? 128 : 0) + j * 2);
        R.gb[q4] = *(const LAS v2u*)(pr + (KIND ? 128 + jo * 2 : 256 + j * 2));
        if (KIND) R.gc[q4] = *(const LAS v2u*)(pr + j * 2); }
}
template <int KIND>
DI void prep_compute(Frame& F, int b, int h, int dir, int c, const PrepRaw<KIND>& R, const bf16x8 (&af)[4]) {
    const int q = F.wave - 4, jt = q & 1, lane = F.lane, n = lane & 31, half = lane >> 5, bi = 0;
    const LAS float* cm = SC_CONST;
    f32x16 D;
#pragma unroll
    for (int i = 0; i < 16; ++i) D[i] = 0.f;
    if (KIND == 0) {
#pragma unroll
        for (int kk = 0; kk < 4; ++kk) D = MFMA32(R.xf[kk], af[kk], D);
        const int j = 32 * jt + n; const float w0j = cm[j];
        float e2[16];
#pragma unroll
        for (int i = 0; i < 16; ++i) e2[i] = 0.8750387749f * sigmoidf_(D[i] + w0j);
        float gs[4], ps[4];
#pragma unroll
        for (int g = 0; g < 4; ++g) { gs[g] = (e2[4 * g] + e2[4 * g + 1]) + (e2[4 * g + 2] + e2[4 * g + 3]); ps[g] = __shfl_xor(gs[g], 32); }
        float off = 0.f;
        LAS float* Eb = SC_E2(bi) + j;
#pragma unroll
        for (int g = 0; g < 4; ++g) {
            float run = off + (half ? ps[g] : 0.f);
#pragma unroll
            for (int ii = 0; ii < 4; ++ii) { const int i = 4 * g + ii, tau = 8 * g + 4 * half + ii; run += e2[i]; Eb[tau * FP] = run; }
            off += gs[g] + ps[g];
        }
        LAS unsigned char* vt = SC_IMG(c & 1) + IM_VT;
#pragma unroll
        for (int q4 = 0; q4 < 4; ++q4) { const int jj = 32 * jt + 8 * q4 + 4 * half;
            *(LAS f32x4*)(SC_BUF(bi, 4) + n * FP + jj) = up4(R.ga[q4]);
            const unsigned v01 = R.gb[q4].x, v23 = R.gb[q4].y;
            *(LAS unsigned short*)(vt + (jj + 0) * P80 + n * 2) = (unsigned short)(v01 & 0xffffu);
            *(LAS unsigned short*)(vt + (jj + 1) * P80 + n * 2) = (unsigned short)(v01 >> 16);
            *(LAS unsigned short*)(vt + (jj + 2) * P80 + n * 2) = (unsigned short)(v23 & 0xffffu);
            *(LAS unsigned short*)(vt + (jj + 3) * P80 + n * 2) = (unsigned short)(v23 >> 16); }
    } else {
#pragma unroll
        for (int kk = 0; kk < 4; ++kk) D = MFMA32(af[kk], R.xf[kk], D);
        float ss = 0.f;
#pragma unroll
        for (int q4 = 0; q4 < 4; ++q4) { const int j = 32 * jt + 8 * q4 + 4 * half, jo = 32 * (1 - jt) + 8 * q4 + 4 * half;
            const f32x4 kr = up4(R.ga[q4]) * *(const LAS f32x4*)(cm + 128 + j), ko = up4(R.gb[q4]) * *(const LAS f32x4*)(cm + 128 + jo);
            ss += (kr[0] * kr[0] + kr[1] * kr[1]) + (kr[2] * kr[2] + kr[3] * kr[3]) + (ko[0] * ko[0] + ko[1] * ko[1]) + (ko[2] * ko[2] + ko[3] * ko[3]); }
        ss += __shfl_xor(ss, 32);
        const float inv = __builtin_amdgcn_rcpf(fmaxf(__builtin_amdgcn_sqrtf(ss), 1e-12f));
        float bs = 0.f;
#pragma unroll
        for (int q4 = 0; q4 < 4; ++q4) { const int j = 32 * jt + 8 * q4 + 4 * half;
            const f32x4 az = *(const LAS f32x4*)(cm + 64 + j), kkv = *(const LAS f32x4*)(cm + 128 + j), kav = *(const LAS f32x4*)(cm + 192 + j), rkv = *(const LAS f32x4*)(cm + 256 + j);
            const f32x4 kpr = up4(R.ga[q4]), rr = up4(R.gc[q4]);
            f32x4 av, kk4, kd4;
#pragma unroll
            for (int jj = 0; jj < 4; ++jj) { av[jj] = sigmoidf_(D[4 * q4 + jj] + az[jj]); kk4[jj] = kpr[jj] * kkv[jj] * inv; kd4[jj] = kpr[jj] * (1.f + (av[jj] - 1.f) * kav[jj]); bs += rr[jj] * kd4[jj] * rkv[jj]; }
            *(LAS f32x4*)(SC_BUF(bi, 1) + n * FP + j) = kd4;
            *(LAS f32x4*)(SC_BUF(bi, 2) + n * FP + j) = kk4 * av;
            *(LAS f32x4*)(SC_BUF(bi, 3) + n * FP + j) = -kk4; }
        bs += __shfl_xor(bs, 32);
        const int tl = SC_CH * c + n, t = dir ? (SEQ - 1 - tl) : tl;
        if (half == 0 && !VAR(255)) ((float*)(F.ws + WS_BSUM))[(((size_t)dir * NTOK + (size_t)b * SEQ + t) * 8 + h) * 2 + jt] = bs;
    }
}
DI void scan_consts(Frame& F, const Args& a, int h, int dir) {
    LAS float* cm = SC_CONST; const int i = F.tid - 256, hc = h * 64;
    if (i < 64) { cm[i] = ((const float*)a.in[I_WD0])[dir * 512 + hc + i]; cm[64 + i] = ((const float*)a.in[I_AG0])[dir * 512 + hc + i];
        cm[128 + i] = ((const float*)a.in[I_KK])[hc + i]; cm[192 + i] = ((const float*)a.in[I_KA])[hc + i]; cm[256 + i] = ((const float*)a.in[I_RK])[hc + i]; }
}
#define SC_BARRIER() do { asm volatile("s_waitcnt lgkmcnt(0)" ::: "memory"); __builtin_amdgcn_s_barrier(); asm volatile("" ::: "memory"); } while (0)
DI bf16x8 ld_perm(const LAS unsigned char* row, int ks, int half) {
    const v2u a0 = *(const LAS v2u*)(row + (16 * ks + 4 * half) * 2), a1 = *(const LAS v2u*)(row + (16 * ks + 8 + 4 * half) * 2);
    const v4u r = {a0.x, a0.y, a1.x, a1.y}; return __builtin_bit_cast(bf16x8, r);
}
DI bf16x8 packacc(const f32x16& x, int ks) { return ks ? pack8(x[8], x[9], x[10], x[11], x[12], x[13], x[14], x[15]) : pack8(x[0], x[1], x[2], x[3], x[4], x[5], x[6], x[7]); }
DI bf16x8 frag_scaled(const LAS float* arr, const LAS float* erow, int kk, float sgn, bool ezero) {
    const f32x4 x0 = *(const LAS f32x4*)(arr + 16 * kk), x1 = *(const LAS f32x4*)(arr + 16 * kk + 4);
    f32x4 e0 = *(const LAS f32x4*)(erow + 16 * kk), e1 = *(const LAS f32x4*)(erow + 16 * kk + 4);
    if (ezero) { e0 = (f32x4){0.f, 0.f, 0.f, 0.f}; e1 = e0; }
    float y[8];
#pragma unroll
    for (int j = 0; j < 4; ++j) { y[j] = x0[j] * __builtin_amdgcn_exp2f(sgn * e0[j]); y[4 + j] = x1[j] * __builtin_amdgcn_exp2f(sgn * e1[j]); }
    return pack8(y[0], y[1], y[2], y[3], y[4], y[5], y[6], y[7]);
}
template <bool LO>
DI void scan_build(Frame& F, int p, int role) {
    const int lane = F.lane, n = lane & 31, half = lane >> 5;
    LAS unsigned char* img = SC_IMG(p & 1);
    const LAS float* E = SC_E2(0) + n * FP + 8 * half;
    const LAS float* Eex = SC_E2(0) + (n > 0 ? n - 1 : 0) * FP + 8 * half;
    const LAS float* AAr = SC_BUF(0, 3) + n * FP + 8 * half; const LAS float* Rr = SC_BUF(0, 4) + n * FP + 8 * half;
    const LAS float* BBr = SC_BUF(0, 2) + n * FP + 8 * half; const LAS float* KDr = SC_BUF(0, 1) + n * FP + 8 * half;
    if (LO && role == 0 && VAR(16)) {
    } else if (LO && role == 0) {
        f32x16 z, pacc;
#pragma unroll
        for (int i = 0; i < 16; ++i) z[i] = 0.f;
#pragma unroll
        for (int kk = 0; kk < 4; ++kk) z = MFMA32(frag_scaled(BBr, E, kk, 1.f, false), frag_scaled(AAr, Eex, kk, -1.f, n == 0), z);
#pragma unroll
        for (int i = 0; i < 16; ++i) { const int srow = crow(i, half); z[i] = (srow < n) ? z[i] : 0.f; }
        LAS unsigned char* zi = F.lds + SCL_MABT;
#pragma unroll
        for (int k = 0; k < 4; ++k) {
            LAS unsigned char* zk = zi + k * (32 * P80);
#pragma unroll
            for (int i = 0; i < 16; ++i) *(LAS unsigned short*)(zk + crow(i, half) * P80 + n * 2) = (unsigned short)(pk2(z[i], 0.f) & 0xffffu);
            LDS_WAIT(); asm volatile("" ::: "memory");
            const bf16x8 zb0 = packacc(z, 0), zb1 = packacc(z, 1);
            f32x16 zn;
#pragma unroll
            for (int i = 0; i < 16; ++i) zn[i] = 0.f;
            zn = MFMA32(ld_perm(zk + n * P80, 0, half), zb0, zn); zn = MFMA32(ld_perm(zk + n * P80, 1, half), zb1, zn);
            z = zn;
        }
#pragma unroll
        for (int i = 0; i < 16; ++i) pacc[i] = z[i] + ((crow(i, half) == n) ? 1.f : 0.f);
#pragma unroll
        for (int k = 3; k >= 0; --k) {
            const LAS unsigned char* zk = zi + k * (32 * P80);
            const bf16x8 qb0 = packacc(pacc, 0), qb1 = packacc(pacc, 1);
            pacc = MFMA32(ld_perm(zk + n * P80, 0, half), qb0, pacc); pacc = MFMA32(ld_perm(zk + n * P80, 1, half), qb1, pacc);
        }
#pragma unroll
        for (int g = 0; g < 4; ++g) { v2u w; w.x = pk2(pacc[4 * g], pacc[4 * g + 1]); w.y = pk2(pacc[4 * g + 2], pacc[4 * g + 3]); *(LAS v2u*)(img + IM_T + n * P80 + (8 * g + 4 * half) * 2) = w; }
    } else if (LO && role == 1) {
        ((LAS float*)(img + IM_GC))[lane] = __builtin_amdgcn_exp2f(-(SC_E2(0)[31 * FP + lane]));
    } else if (!LO && VAR(32)) {
    } else if (!LO) {
        bf16x8 fa[4], fb[4];
        if (role == 2 || role == 3) {
#pragma unroll
            for (int kk = 0; kk < 4; ++kk) { fb[kk] = frag_scaled(role == 2 ? AAr : Rr, role == 2 ? Eex : E, kk, -1.f, role == 2 && n == 0);
                *(LAS bf16x8*)(img + (role == 2 ? IM_AT : IM_RT) + n * P144 + (16 * kk + 8 * half) * 2) = fb[kk]; }
#pragma unroll
            for (int kk = 0; kk < 4; ++kk) fa[kk] = frag_scaled(role == 2 ? KDr : BBr, E, kk, 1.f, false);
        } else {
            LAS unsigned char* dst = img + (role == 4 ? IM_BT : IM_KT);
#pragma unroll
            for (int kk = 0; kk < 4; ++kk) { fa[kk] = frag_scaled(role == 4 ? BBr : KDr, E, kk, 1.f, false);
#pragma unroll
                for (int e = 0; e < 8; ++e) *(LAS unsigned short*)(dst + (16 * kk + 8 * half + e) * P80 + n * 2) = (unsigned short)fa[kk][e]; }
            if (role == 5) {
#pragma unroll
                for (int kk = 0; kk < 4; ++kk) fb[kk] = frag_scaled(Rr, E, kk, -1.f, false); }
        }
        if (role != 4) {
            f32x16 x;
#pragma unroll
            for (int i = 0; i < 16; ++i) x[i] = 0.f;
#pragma unroll
            for (int kk = 0; kk < 4; ++kk) x = MFMA32(fa[kk], fb[kk], x);
            LAS unsigned char* gi = img + (role == 2 ? IM_MAK : (role == 3 ? IM_NB : IM_NK));
#pragma unroll
            for (int g = 0; g < 4; ++g) { float m_[4];
#pragma unroll
                for (int e = 0; e < 4; ++e) { const int srow = 8 * g + 4 * half + e; m_[e] = ((role == 2) ? srow < n : srow <= n) ? x[4 * g + e] : 0.f; }
                v2u w_; w_.x = pk2(m_[0], m_[1]); w_.y = pk2(m_[2], m_[3]); *(LAS v2u*)(gi + n * P80 + (8 * g + 4 * half) * 2) = w_; }
        }
    }
}
template <int KIND>
DI void scan_helper(Frame& F, const Args& a, int b, int h, int dir) {
    const bf16* PS = (const bf16*)a.out;
    const int q = F.wave - 4, jt = q & 1, n = F.lane & 31, half = F.lane >> 5, role = F.wave - 2;
    const bf16* WT = (const bf16*)(F.ws + (KIND ? WS_AUP_T : WS_WUP_T)) + ((size_t)dir * 512 + h * 64 + 32 * jt + n) * 64 + 8 * half;
    bf16x8 af[4];
#pragma unroll
    for (int kk = 0; kk < 4; ++kk) af[kk] = *(const bf16x8*)(WT + 16 * kk);
    v4u RR[5]; PrepRaw<KIND> R;
    raw_load(F, PS, b, h, dir, 0, RR); raw_store(F, RR);
    raw_load(F, PS, b, h, dir, 1, RR);
    SC_BARRIER();
    prep_fetch<KIND>(F, R); prep_compute<KIND>(F, b, h, dir, 0, R, af);
    SC_BARRIER();
    raw_store(F, RR);
    scan_build<false>(F, 0, role);
    SC_BARRIER();
#pragma unroll 1
    for (int c = 0; c < SC_NCH; ++c) {
        if (!VAR(8)) raw_load(F, PS, b, h, dir, (c + 2) & (SC_NCH - 1), RR);
        if (c + 1 < SC_NCH && !VAR(4)) { prep_fetch<KIND>(F, R); prep_compute<KIND>(F, b, h, dir, c + 1, R, af); }
        SC_BARRIER();
        if (!VAR(8)) raw_store(F, RR);
        if (c + 1 < SC_NCH && !VAR(2)) scan_build<false>(F, c + 1, role);
        SC_BARRIER();
    }
}
DI void scan_builder_only(Frame& F) {
    const int role = F.wave - 2;
    SC_BARRIER(); SC_BARRIER();
    scan_build<true>(F, 0, role);
    SC_BARRIER();
#pragma unroll 1
    for (int c = 0; c < SC_NCH; ++c) { SC_BARRIER(); if (c + 1 < SC_NCH && !VAR(2)) scan_build<true>(F, c + 1, role); SC_BARRIER(); }
}
DI void scan_sequencer(Frame& F, int b, int h, int dir) {
    const int it = F.wave, lane = F.lane, n = lane & 31, half = lane >> 5;
    f32x16 D0, D1;
#pragma unroll
    for (int i = 0; i < 16; ++i) { D0[i] = 0.f; D1[i] = 0.f; }
    float* wkv = (float*)(F.ws + WS_WKV) + ((size_t)dir * NTOK + (size_t)b * SEQ) * 512 + h * 64 + 32 * it + n;
    SC_BARRIER(); SC_BARRIER(); SC_BARRIER();
#pragma unroll 1
    for (int c = 0; c < SC_NCH; ++c) {
        if (VAR(1)) { SC_BARRIER(); SC_BARRIER(); continue; }
        const LAS unsigned char* img = SC_IMG(c & 1);
        const LAS unsigned char* atr = img + IM_AT + n * P144; const LAS unsigned char* rtr = img + IM_RT + n * P144;
        const LAS unsigned char* vtr = img + IM_VT + (32 * it + n) * P80 + 16 * half;
        const bf16x8 sb00 = packacc(D0, 0), sb01 = packacc(D0, 1), sb10 = packacc(D1, 0), sb11 = packacc(D1, 1);
        const bf16x8 vt0 = *(const LAS bf16x8*)vtr, vt1 = *(const LAS bf16x8*)(vtr + 32);
        f32x16 U, Y;
#pragma unroll
        for (int i = 0; i < 16; ++i) { U[i] = 0.f; Y[i] = 0.f; }
        U = MFMA32(ld_perm(atr, 0, half), sb00, U); Y = MFMA32(ld_perm(rtr, 0, half), sb00, Y);
        U = MFMA32(ld_perm(atr, 1, half), sb01, U); Y = MFMA32(ld_perm(rtr, 1, half), sb01, Y);
        U = MFMA32(ld_perm(atr + 64, 0, half), sb10, U); Y = MFMA32(ld_perm(rtr + 64, 0, half), sb10, Y);
        U = MFMA32(ld_perm(atr + 64, 1, half), sb11, U); Y = MFMA32(ld_perm(rtr + 64, 1, half), sb11, Y);
        { const LAS unsigned char* mk = img + IM_MAK + n * P80 + 16 * half; const LAS unsigned char* nk = img + IM_NK + n * P80 + 16 * half;
          U = MFMA32(*(const LAS bf16x8*)mk, vt0, U); U = MFMA32(*(const LAS bf16x8*)(mk + 32), vt1, U);
          Y = MFMA32(*(const LAS bf16x8*)nk, vt0, Y); Y = MFMA32(*(const LAS bf16x8*)(nk + 32), vt1, Y); }
        f32x16 SA;
#pragma unroll
        for (int i = 0; i < 16; ++i) SA[i] = 0.f;
        { const LAS unsigned char* tr = img + IM_T + n * P80; const bf16x8 ub0 = packacc(U, 0), ub1 = packacc(U, 1);
          SA = MFMA32(ld_perm(tr, 0, half), ub0, SA); SA = MFMA32(ld_perm(tr, 1, half), ub1, SA); }
        const bf16x8 sab0 = packacc(SA, 0), sab1 = packacc(SA, 1);
        { const LAS unsigned char* nb = img + IM_NB + n * P80; Y = MFMA32(ld_perm(nb, 0, half), sab0, Y); Y = MFMA32(ld_perm(nb, 1, half), sab1, Y); }
        { const int tl0 = SC_CH * c;
#pragma unroll
          for (int i = 0; i < 16; ++i) { const int tl = tl0 + crow(i, half), t = dir ? (SEQ - 1 - tl) : tl; if (!VAR(255)) wkv[(size_t)t * 512] = Y[i]; } }
        { const LAS unsigned char* b0 = img + IM_BT + n * P80; const LAS unsigned char* k0 = img + IM_KT + n * P80 + 16 * half;
          D0 = MFMA32(ld_perm(b0, 0, half), sab0, D0); D1 = MFMA32(ld_perm(b0 + 32 * P80, 0, half), sab0, D1);
          D0 = MFMA32(ld_perm(b0, 1, half), sab1, D0); D1 = MFMA32(ld_perm(b0 + 32 * P80, 1, half), sab1, D1);
          D0 = MFMA32(*(const LAS bf16x8*)k0, vt0, D0); D1 = MFMA32(*(const LAS bf16x8*)(k0 + 32 * P80), vt0, D1);
          D0 = MFMA32(*(const LAS bf16x8*)(k0 + 32), vt1, D0); D1 = MFMA32(*(const LAS bf16x8*)(k0 + 32 * P80 + 32), vt1, D1);
          const LAS float* gc = (const LAS float*)(img + IM_GC) + 4 * half;
#pragma unroll
          for (int g = 0; g < 4; ++g) { const f32x4 g0 = *(const LAS f32x4*)(gc + 8 * g), g1 = *(const LAS f32x4*)(gc + 32 + 8 * g);
#pragma unroll
              for (int e = 0; e < 4; ++e) { D0[4 * g + e] *= g0[e]; D1[4 * g + e] *= g1[e]; } } }
        SC_BARRIER(); SC_BARRIER();
    }
}
DI void scan_unit(Frame& F, const Args& a, int b, int h, int dir) {
    if (F.wave >= 4) { scan_consts(F, a, h, dir); LDS_WAIT(); }
    __syncthreads();
    if (F.wave < 2) scan_sequencer(F, b, h, dir);
    else if (F.wave < 4) scan_builder_only(F);
    else if ((F.wave - 4) >> 1) scan_helper<1>(F, a, b, h, dir);
    else scan_helper<0>(F, a, b, h, dir);
}

DI void post_consts(Frame& F, const Args& a) {
    LAS float* cm = (LAS float*)F.lds;
    cm[F.tid] = ((const float*)a.in[I_GNW])[F.tid]; cm[512 + F.tid] = ((const float*)a.in[I_GNB])[F.tid];
    LDS_WAIT(); __syncthreads();
}
DI void post_item(Frame& F, const bf16* PS, int item) {
    const int tile = item >> 3, h = item & 7, hc = h * 64;
    const int lane = F.lane, n = lane & 31; int half = lane >> 5; LAUNDER(half);
    const bf16* GT = (const bf16*)(F.ws + WS_GUP_T);
    const float* WKV = (const float*)(F.ws + WS_WKV); const float* BS = (const float*)(F.ws + WS_BSUM); bf16* YR = (bf16*)(F.ws + WS_YR);
    const LAS float* cm = (const LAS float*)F.lds;
    const size_t tok = (size_t)tile * 32 + n;
    const bf16* pr = PS + tok * RW_COLS;
    bf16x8 bfr[8];
#pragma unroll
    for (int kk = 0; kk < 8; ++kk) bfr[kk] = *(const bf16x8*)(pr + 1664 + 16 * kk + 8 * half);
    f32x4 x[2][4]; v2u vr[2][4];
#pragma unroll
    for (int ct = 0; ct < 2; ++ct)
#pragma unroll
        for (int q4 = 0; q4 < 4; ++q4) { const int c = hc + 32 * ct + 8 * q4 + 4 * half;
            x[ct][q4] = *(const f32x4*)(WKV + tok * 512 + c) + *(const f32x4*)(WKV + ((size_t)NTOK + tok) * 512 + c);
            vr[ct][q4] = *(const v2u*)(pr + 1024 + c); }
    const f32x2 b0 = *(const f32x2*)(BS + (tok * 8 + h) * 2), b1 = *(const f32x2*)(BS + (((size_t)NTOK + tok) * 8 + h) * 2);
    f32x16 g0, g1;
#pragma unroll
    for (int i = 0; i < 16; ++i) { g0[i] = 0.f; g1[i] = 0.f; }
    const bf16* gp = GT + (size_t)(hc + n) * 128 + 8 * half;
#pragma unroll
    for (int kk = 0; kk < 8; ++kk) { g0 = MFMA32(*(const bf16x8*)(gp + 16 * kk), bfr[kk], g0); g1 = MFMA32(*(const bf16x8*)(gp + 32 * 128 + 16 * kk), bfr[kk], g1); }
    float sm = 0.f;
#pragma unroll
    for (int ct = 0; ct < 2; ++ct)
#pragma unroll
        for (int q4 = 0; q4 < 4; ++q4) sm += (x[ct][q4][0] + x[ct][q4][1]) + (x[ct][q4][2] + x[ct][q4][3]);
    sm += __shfl_xor(sm, 32);
    const float mean = sm * (1.f / 64.f); float vs = 0.f;
#pragma unroll
    for (int ct = 0; ct < 2; ++ct)
#pragma unroll
        for (int q4 = 0; q4 < 4; ++q4) { const f32x4 d = x[ct][q4] - mean; vs += (d[0] * d[0] + d[1] * d[1]) + (d[2] * d[2] + d[3] * d[3]); }
    vs += __shfl_xor(vs, 32);
    const float rstd = 1.f / sqrtf(vs * (1.f / 64.f) + GN_EPS);
    const float bsum = (b0.x + b0.y) + (b1.x + b1.y);
#pragma unroll
    for (int ct = 0; ct < 2; ++ct)
#pragma unroll
        for (int q4 = 0; q4 < 4; ++q4) { const int c = hc + 32 * ct + 8 * q4 + 4 * half;
            const f32x4 y = (x[ct][q4] - mean) * rstd * *(const LAS f32x4*)(cm + c) + *(const LAS f32x4*)(cm + 512 + c) + up4(vr[ct][q4]) * bsum;
            f32x4 gg; if (ct == 0) gg = (f32x4){g0[4 * q4], g0[4 * q4 + 1], g0[4 * q4 + 2], g0[4 * q4 + 3]}; else gg = (f32x4){g1[4 * q4], g1[4 * q4 + 1], g1[4 * q4 + 2], g1[4 * q4 + 3]};
            const f32x4 o = y * gg; v2u w; w.x = pk2(o[0], o[1]); w.y = pk2(o[2], o[3]);
            *(v2u*)(YR + tok * 512 + c) = w; }
}

DI void p5_router_tile(Frame& F, const Args& a, int tile) {
    const int lane = F.lane, n = lane & 31, half = lane >> 5;
    const size_t tok = (size_t)tile * 32 + n;
    const float* xr = a.out + tok * DM + 8 * half;
    const bf16* RH = (const bf16*)(F.ws + WS_RT_HI) + (size_t)n * DM + 8 * half; const bf16* RL = (const bf16*)(F.ws + WS_RT_LO) + (size_t)n * DM + 8 * half;
    f32x16 d0, d1;
#pragma unroll
    for (int i = 0; i < 16; ++i) { d0[i] = 0.f; d1[i] = 0.f; }
    float ss = 0.f;
#pragma unroll 4
    for (int kk = 0; kk < 64; ++kk) {
        const f32x4 xa = *(const f32x4*)(xr + 16 * kk), xb = *(const f32x4*)(xr + 16 * kk + 4);
        ss += (xa[0] * xa[0] + xa[1] * xa[1]) + (xa[2] * xa[2] + xa[3] * xa[3]) + (xb[0] * xb[0] + xb[1] * xb[1]) + (xb[2] * xb[2] + xb[3] * xb[3]);
        v4u hp; hp.x = pk2(xa[0], xa[1]); hp.y = pk2(xa[2], xa[3]); hp.z = pk2(xb[0], xb[1]); hp.w = pk2(xb[2], xb[3]);
        v4u lp; lp.x = pk2(xa[0] - bflo(hp.x), xa[1] - bfhi(hp.x)); lp.y = pk2(xa[2] - bflo(hp.y), xa[3] - bfhi(hp.y)); lp.z = pk2(xb[0] - bflo(hp.z), xb[1] - bfhi(hp.z)); lp.w = pk2(xb[2] - bflo(hp.w), xb[3] - bfhi(hp.w));
        const bf16x8 bh = __builtin_bit_cast(bf16x8, hp), bl = __builtin_bit_cast(bf16x8, lp);
        const bf16x8 ah0 = *(const bf16x8*)(RH + 16 * kk), ah1 = *(const bf16x8*)(RH + 32 * DM + 16 * kk), al0 = *(const bf16x8*)(RL + 16 * kk), al1 = *(const bf16x8*)(RL + 32 * DM + 16 * kk);
        d0 = MFMA32(ah0, bh, d0); d0 = MFMA32(ah0, bl, d0); d0 = MFMA32(al0, bh, d0);
        d1 = MFMA32(ah1, bh, d1); d1 = MFMA32(ah1, bl, d1); d1 = MFMA32(al1, bh, d1);
    }
    ss += __shfl_xor(ss, 32);
    const float rstd = 1.f / sqrtf(ss * (1.f / DM) + NORM_EPS);
    const float* brg = (const float*)a.in[I_BRG]; const float* bre = (const float*)a.in[I_BRE];
    float gl[4];
#pragma unroll
    for (int j = 0; j < 4; ++j) gl[j] = __shfl(d1[j] * rstd + brg[j], n);
    int grp = 0; float gmax = gl[0];
#pragma unroll
    for (int j = 1; j < 4; ++j) if (gl[j] > gmax) { gmax = gl[j]; grp = j; }
    float gsum = 0.f;
#pragma unroll
    for (int j = 0; j < 4; ++j) gsum += __expf(gl[j] - gmax);
    const float grp_p = 1.f / gsum;
    const f32x4 bv = *(const f32x4*)(bre + 8 * grp + 4 * half);
    float cv[4];
#pragma unroll
    for (int j = 0; j < 4; ++j) { float v = d0[j]; v = grp == 1 ? d0[4 + j] : v; v = grp == 2 ? d0[8 + j] : v; v = grp == 3 ? d0[12 + j] : v; cv[j] = v * rstd + bv[j]; }
    float m1v = cv[0]; int m1i = 0;
#pragma unroll
    for (int j = 1; j < 4; ++j) if (cv[j] > m1v) { m1v = cv[j]; m1i = j; }
    float m2v = -3.0e38f; int m2i = 0;
#pragma unroll
    for (int j = 0; j < 4; ++j) if (j != m1i && cv[j] > m2v) { m2v = cv[j]; m2i = j; }
    m1i += 4 * half; m2i += 4 * half;
    const float t1v = __shfl_xor(m1v, 32), t2v = __shfl_xor(m2v, 32); const int t1i = __shfl_xor(m1i, 32), t2i = __shfl_xor(m2i, 32);
    auto better = [](float av, int ai, float bv_, int bi) { return av > bv_ || (av == bv_ && ai < bi); };
    float top1v, top2v; int top1i, top2i;
    if (better(m1v, m1i, t1v, t1i)) { top1v = m1v; top1i = m1i; if (better(m2v, m2i, t1v, t1i)) { top2v = m2v; top2i = m2i; } else { top2v = t1v; top2i = t1i; } }
    else { top1v = t1v; top1i = t1i; if (better(m1v, m1i, t2v, t2i)) { top2v = m1v; top2i = m1i; } else { top2v = t2v; top2i = t2i; } }
    const float w0 = grp_p / (1.f + __expf(top2v - top1v)), w1 = grp_p - w0;
    const int mye = 8 * grp + (half ? top2i : top1i); const float myw = half ? w1 : w0;
    unsigned long long mymask = 0ull; int cnt_l = 0;
    for (int e = 0; e < NEXP; ++e) { const unsigned long long m = __ballot(mye == e); if (mye == e) mymask = m; if (lane == e) cnt_l = __popcll(m); }
    int base_l = 0;
    if (lane < NEXP && cnt_l > 0) base_l = (int)__hip_atomic_fetch_add((unsigned*)(F.ws + WS_CTL) + CW_CNT + 64 * lane, (unsigned)cnt_l, RLX_AGENT);
    const int mybase = __shfl(base_l, mye);
    const int pos = mybase + __popcll(mymask & ((1ull << lane) - 1ull));
    ((int*)(F.ws + WS_LTOK))[(size_t)mye * NTOK + pos] = (int)tok * 2 + half;
    ((float*)(F.ws + WS_LW))[(size_t)mye * NTOK + pos] = myw;
    const float* g2 = (const float*)a.in[I_N2G] + 8 * half; bf16* h2 = (bf16*)(F.ws + WS_H2) + tok * DM + 8 * half;
#pragma unroll 4
    for (int kk = 0; kk < 64; ++kk) {
        const f32x4 xa = *(const f32x4*)(xr + 16 * kk) * rstd * *(const f32x4*)(g2 + 16 * kk), xb = *(const f32x4*)(xr + 16 * kk + 4) * rstd * *(const f32x4*)(g2 + 16 * kk + 4);
        v4u o; o.x = pk2(xa[0], xa[1]); o.y = pk2(xa[2], xa[3]); o.z = pk2(xb[0], xb[1]); o.w = pk2(xb[2], xb[3]);
        *(v4u*)(h2 + 16 * kk) = o; }
}
DI void p5_phase(Frame& F, const Args& a) {
    const int gw = F.bid * NWAVES + F.wave, NGW = F.G * NWAVES;
    for (int tile = gw; tile < NTOK / 32; tile += NGW) p5_router_tile(F, a, tile);
    if (F.bid == 0 && F.tid < 128) ((v4u*)((bf16*)(F.ws + WS_H2) + (size_t)NTOK * DM))[F.tid] = (v4u){0u, 0u, 0u, 0u};
    LAS float* scr = (LAS float*)(F.lds + F.wave * 16384);
    constexpr int IPE = 256;
    for (int it = gw; it < NEXP * 3 * IPE; it += NGW) {
        const int e = it / (3 * IPE), r = it % (3 * IPE), which = r / IPE, item = r % IPE;
        if (which == 0) transpose_item((const float*)a.in[I_WGATE] + (size_t)e * DM * DEXP, DM, DEXP, (bf16*)(F.ws + WS_WGU_T) + (size_t)e * DM * DM, RmGate(), scr, item, F.lane);
        else if (which == 1) transpose_item((const float*)a.in[I_WUP] + (size_t)e * DM * DEXP, DM, DEXP, (bf16*)(F.ws + WS_WGU_T) + (size_t)e * DM * DM, RmUp(), scr, item, F.lane);
        else transpose_item((const float*)a.in[I_WDOWN] + (size_t)e * DEXP * DM, DEXP, DM, (bf16*)(F.ws + WS_WD_T) + (size_t)e * DM * DEXP, RmId(), scr, item, F.lane);
    }
}
DI int moe_table(Frame& F) {
    LAS int* tab = (LAS int*)(F.lds + TAB_OFF);
    if (F.tid == 0) { int acc = 0;
        for (int e = 0; e < NEXP; ++e) { const int c = (int)__hip_atomic_load((unsigned*)(F.ws + WS_CTL) + CW_CNT + 64 * e, RLX_AGENT); tab[e] = acc; tab[33 + e] = c; acc += (c + 255) >> 8; }
        tab[32] = acc; }
    __syncthreads();
    return tab[32];
}
DI void p6_gather(Frame& F) {
    const int nT = moe_table(F);
    const LAS int* tab = (const LAS int*)(F.lds + TAB_OFF);
    const bf16* h2 = (const bf16*)(F.ws + WS_H2); bf16* Xg = (bf16*)(F.ws + WS_XG);
    const int* ltok = (const int*)(F.ws + WS_LTOK); const float* lw = (const float*)(F.ws + WS_LW);
    const int nrows = nT * 256, rstride = F.G * NWAVES;
    for (int R0 = F.bid * NWAVES + F.wave; R0 < nrows; R0 += 4 * rstride) {
        int tk[4], kq[4]; float wv[4];
#pragma unroll
        for (int u = 0; u < 4; ++u) { const int R = R0 + u * rstride; tk[u] = -1; kq[u] = 0; wv[u] = 0.f;
            if (R < nrows) { const int tile = R >> 8; int e = 0;
                for (int k = 1; k < NEXP; ++k) e += (tab[k] <= tile) ? 1 : 0;
                const int slot = R - tab[e] * 256;
                if (slot < tab[33 + e]) { const int t2 = ltok[(size_t)e * NTOK + slot]; tk[u] = t2 >> 1; kq[u] = t2 & 1; wv[u] = lw[(size_t)e * NTOK + slot]; } } }
        v4u d0[4], d1[4];
#pragma unroll
        for (int u = 0; u < 4; ++u) { const v4u* src = (const v4u*)(h2 + (size_t)(tk[u] < 0 ? NTOK : tk[u]) * DM); d0[u] = src[F.lane]; d1[u] = src[F.lane + 64]; }
#pragma unroll
        for (int u = 0; u < 4; ++u) { const int R = R0 + u * rstride; if (R < nrows) { v4u* dst = (v4u*)(Xg + (size_t)R * DM); dst[F.lane] = d0[u]; dst[F.lane + 64] = d1[u];
            if (F.lane == 0) { ((float*)(F.ws + WS_ROWW))[R] = wv[u]; if (tk[u] >= 0) ((int*)(F.ws + WS_INV))[tk[u] * 2 + kq[u]] = R; } } }
    }
}

__global__ void __launch_bounds__(NWAVES * 64, 2) mk_fwd(Args args) {
    extern __shared__ __attribute__((aligned(16))) unsigned char lds[];
    Frame F;
    F.lds = (LAS unsigned char*)lds; F.MISC = (volatile LAS unsigned*)(F.lds + MISC_OFF);
    F.tid = threadIdx.x; F.lane = F.tid & 63; F.wave = __builtin_amdgcn_readfirstlane(F.tid >> 6); F.G = gridDim.x; F.bid = blockIdx.x; F.ws = args.ws; F.variant = args.variant;
    for (int u = F.tid; u < (LDS_BYTES - RING_BYTES) / 4; u += NWAVES * 64) ((LAS unsigned*)(F.lds + RING_BYTES))[u] = 0u;
    __syncthreads();
    const int lo = args.ph_lo, hi = args.ph_hi;
    const bool multi = (hi - lo) > 1;
    XcdBarrier bar; bar.bar = (unsigned*)(args.ws + WS_CTL) + CW_BAR + args.li * XCD_BAR_WORDS; bar.x = 0; bar.st = nullptr;
    if (multi) bar = xcd_barrier_post((unsigned*)(args.ws + WS_CTL) + CW_BAR + args.li * XCD_BAR_WORDS, F.MISC + 8);
#ifndef PH_MASK
#define PH_MASK 0xFFFFFFFFu
#endif
#define IN(k) ((((PH_MASK) >> (k)) & 1u) && lo <= (k) && (k) < hi)
#define SEAM(k) do { if (IN(k) && IN((k) + 1)) xcd_barrier(bar); } while (0)
    unsigned char* ws = args.ws;

    if (IN(0)) { p0_prologue(F, args); } SEAM(0);
    if (IN(1)) {
        pg8::Gemm g{(const bf16*)(ws + WS_HB), (const bf16*)(ws + WS_WIN_T), DM, 0}; pg8::StaticOrder S; S.init(NTOK, IN_COLS, F.G, F.bid);
        pg8::EpiIn E{(bf16*)(ws + WS_PR), (bf16*)(ws + WS_PT), (bf16*)(ws + WS_G), (const float*)args.in[I_BMERGE]};
        pg8::gemm_phase<pg8::EpiIn, pg8::StaticOrder, true, true>(F.lds, g, S, E);
    } SEAM(1);
    if (IN(2)) { p1b_qkprep(F, args); p1c_preshift(F, args); } SEAM(2);
    if (IN(3)) { for (int u = F.bid; u < 256; u += F.G) attn_unit(F, u >> 4, (u >> 2) & 3, u & 3); } SEAM(3);
    if (IN(4)) { for (int u = F.bid; u < 256; u += F.G) scan_unit(F, args, u >> 4, (u >> 1) & 7, u & 1); } SEAM(4);
    if (IN(5)) { post_consts(F, args);
#pragma unroll 1
        for (int item = F.bid * NWAVES + F.wave; item < NTOK / 32 * 8; item += F.G * NWAVES) post_item(F, (const bf16*)args.out, item); } SEAM(5);
    if (IN(6)) {
        pg8::Gemm g{(const bf16*)(ws + WS_YR), (const bf16*)(ws + WS_WR_T), 512, 0}; pg8::StaticOrder S; S.init(NTOK, DM, F.G, F.bid);
        pg8::EpiMix<0> E{(const bf16*)(ws + WS_G), nullptr, (bf16*)(ws + WS_Z1)};
        pg8::gemm_phase<pg8::EpiMix<0>, pg8::StaticOrder, true, true>(F.lds, g, S, E);
    } SEAM(6);
    if (IN(7)) {
        pg8::Gemm g{(const bf16*)(ws + WS_YA), (const bf16*)(ws + WS_WA_T), 256, 0}; pg8::StaticOrder S; S.init(NTOK, DM, F.G, F.bid);
        pg8::EpiMix<1> E{(const bf16*)(ws + WS_G), (const bf16*)(ws + WS_Z1), (bf16*)(ws + WS_Z)};
        pg8::gemm_phase<pg8::EpiMix<1>, pg8::StaticOrder, true, true>(F.lds, g, S, E);
    } SEAM(7);
    if (IN(8)) {
        pg8::Gemm g{(const bf16*)(ws + WS_Z), (const bf16*)(ws + WS_WOUT_T), DM, 0}; pg8::StaticOrder S; S.init(NTOK, DM, F.G, F.bid);
        pg8::EpiRes E{(const float*)args.in[I_X], args.out};
        pg8::gemm_phase<pg8::EpiRes, pg8::StaticOrder, true, true>(F.lds, g, S, E);
    } SEAM(8);
    if (IN(9)) { p5_phase(F, args); } SEAM(9);
    if (IN(10)) { p6_gather(F); } SEAM(10);
    if (IN(11)) {
        const int nT = moe_table(F);
        pg8::Gemm g{(const bf16*)(ws + WS_XG), (const bf16*)(ws + WS_WGU_T), DM, (size_t)DM * DM * 2}; pg8::GroupedOrder S{(const LAS int*)(F.lds + TAB_OFF), nT, F.G, F.bid};
        pg8::EpiSwiglu E{(bf16*)(ws + WS_HH)};
        pg8::gemm_phase<pg8::EpiSwiglu, pg8::GroupedOrder, true, true>(F.lds, g, S, E);
    } SEAM(11);
    if (IN(12)) {
        const int nT = moe_table(F);
        pg8::Gemm g{(const bf16*)(ws + WS_HH), (const bf16*)(ws + WS_WD_T), DEXP, (size_t)DM * DEXP * 2}; pg8::GroupedOrder S{(const LAS int*)(F.lds + TAB_OFF), nT, F.G, F.bid};
        pg8::EpiStoreY E{(const float*)(ws + WS_ROWW), (bf16*)(ws + WS_YB)};
        pg8::gemm_phase<pg8::EpiStoreY, pg8::GroupedOrder, true, true>(F.lds, g, S, E);
    } SEAM(12);
    if (IN(13)) {
        const int* inv = (const int*)(ws + WS_INV); const bf16* Y = (const bf16*)(ws + WS_YB);
        const int tstride = F.G * NWAVES;
        for (int tok0 = F.bid * NWAVES + F.wave; tok0 < NTOK; tok0 += 4 * tstride) {
            int r0[4], r1[4];
#pragma unroll
            for (int u = 0; u < 4; ++u) { const int tok = tok0 + u * tstride; r0[u] = inv[tok * 2]; r1[u] = inv[tok * 2 + 1]; }
#pragma unroll
            for (int u = 0; u < 4; ++u) { const int tok = tok0 + u * tstride;
                f32x4* o = (f32x4*)(args.out + (size_t)tok * DM) + F.lane; const v2u* y0 = (const v2u*)(Y + (size_t)r0[u] * DM) + F.lane; const v2u* y1 = (const v2u*)(Y + (size_t)r1[u] * DM) + F.lane;
                f32x4 v[4]; v2u a0[4], a1[4];
#pragma unroll
                for (int j = 0; j < 4; ++j) { v[j] = o[64 * j]; a0[j] = y0[64 * j]; a1[j] = y1[64 * j]; }
#pragma unroll
                for (int j = 0; j < 4; ++j) { v[j][0] += bflo(a0[j].x) + bflo(a1[j].x); v[j][1] += bfhi(a0[j].x) + bfhi(a1[j].x); v[j][2] += bflo(a0[j].y) + bflo(a1[j].y); v[j][3] += bfhi(a0[j].y) + bfhi(a1[j].y); o[64 * j] = v[j]; } }
        }
    }
#undef IN
#undef SEAM
}

constexpr int NPHASE = 14;
extern "C" void kernel_launch(void* const* d_in, const int* in_sizes, int n_in, void* d_out, int out_size, void* d_ws, size_t ws_size, hipStream_t stream) {
    static int grid = 0;
    if (grid == 0) {
        if (n_in != 30 || ws_size < WS_END) { fprintf(stderr, "kernel_launch: need 30 inputs and >= %zu bytes of workspace (got %d, %zu)\n", (size_t)WS_END, n_in, ws_size); grid = -1; return; }
        int dev = 0, cus = 0;
        if (hipGetDevice(&dev) != hipSuccess || hipDeviceGetAttribute(&cus, hipDeviceAttributeMultiprocessorCount, dev) != hipSuccess) { grid = -1; return; }
        if (hipFuncSetAttribute((const void*)mk_fwd, hipFuncAttributeMaxDynamicSharedMemorySize, LDS_BYTES) != hipSuccess) { fprintf(stderr, "kernel_launch: hipFuncSetAttribute failed\n"); grid = -1; return; }
        int per_cu = 0;
        if (hipOccupancyMaxActiveBlocksPerMultiprocessor(&per_cu, (const void*)mk_fwd, NWAVES * 64, LDS_BYTES) != hipSuccess || per_cu < 1) fprintf(stderr, "kernel_launch: occupancy query reports %d\n", per_cu);
        (void)hipGetLastError();
        grid = cus;
    }
    if (grid < 0) return;
    hipMemsetAsync((char*)d_ws + WS_CTL, 0, CTL_ZERO_BYTES, stream);
    Args a{};
    for (int i = 0; i < 30; ++i) a.in[i] = d_in[i];
    a.out = (float*)d_out; a.ws = (unsigned char*)d_ws;
#if defined(PROBE_REPEAT)
#ifdef PROBE_VARIANT
#define PROBE_VARIANT_V PROBE_VARIANT
#else
#define PROBE_VARIANT_V 0
#endif
    { const int k = PROBE_REPEAT; int li = 0;
      const int cuts[5][2] = {{0, k}, {k, k + 1}, {k, k + 1}, {k + 1, NPHASE}, {0, 0}};
      for (int i = 0; i < 4; ++i) { if (cuts[i][1] <= cuts[i][0]) continue; a.ph_lo = cuts[i][0]; a.ph_hi = cuts[i][1]; a.li = li++; a.variant = (i == 2) ? PROBE_VARIANT_V : 0; hipLaunchKernelGGL(mk_fwd, dim3(grid), dim3(NWAVES * 64), LDS_BYTES, stream, a); } }
#elif !defined(MK_MULTI_LAUNCH)
    a.ph_lo = 0; a.ph_hi = NPHASE; a.li = 0;
    hipLaunchKernelGGL(mk_fwd, dim3(grid), dim3(NWAVES * 64), LDS_BYTES, stream, a);
#else
    for (int p = 0; p < NPHASE; ++p) { a.ph_lo = p; a.ph_hi = p + 1; a.li = 0; hipLaunchKernelGGL(mk_fwd, dim3(grid), dim3(NWAVES * 64), LDS_BYTES, stream, a); }
#endif
}
```

```cpp
#include <hip/hip_runtime.h>
#include <cstdio>
#include <cstdint>

constexpr int BATCH = 16, SEQ = 2048, DM = 1024, NTOK = BATCH * SEQ;
constexpr int RW_COLS = 1792, AT_COLS = 2304, G_COLS = 2048, IN_COLS = 6144;
constexpr int NEXP = 32, DEXP = 512;
constexpr int MAXTILES = 288;
constexpr float NORM_EPS = 1e-6f, GN_EPS = 64e-5f;

#define GAS __attribute__((address_space(1)))
#define LAS __attribute__((address_space(3)))
typedef unsigned short bf16;
typedef unsigned v4u __attribute__((ext_vector_type(4)));
typedef unsigned v2u __attribute__((ext_vector_type(2)));
typedef float f32x4 __attribute__((ext_vector_type(4)));
typedef float f32x2 __attribute__((ext_vector_type(2)));
typedef float f32x16 __attribute__((ext_vector_type(16)));
typedef short bf16x8 __attribute__((ext_vector_type(8)));
typedef __bf16 bf16x2_t __attribute__((ext_vector_type(2)));
typedef GAS unsigned gu32;
#define RLX_AGENT __ATOMIC_RELAXED, __HIP_MEMORY_SCOPE_AGENT
#define LDS_WAIT() asm volatile("s_waitcnt lgkmcnt(0)" ::: "memory")
#define VM_WAIT() asm volatile("s_waitcnt vmcnt(0)" ::: "memory")
#define DI __device__ __forceinline__
#ifdef PROBE_VARIANT
#define VAR(b) (F.variant & (b))
#else
#define VAR(b) 0
#endif
#define LAUNDER(x) asm volatile("" : "+v"(x))

DI unsigned pk2(float lo, float hi) { f32x2 v = {lo, hi}; bf16x2_t b = __builtin_convertvector(v, bf16x2_t); return __builtin_bit_cast(unsigned, b); }
DI float bflo(unsigned u) { return __builtin_bit_cast(float, u << 16); }
DI float bfhi(unsigned u) { return __builtin_bit_cast(float, u & 0xffff0000u); }
DI float sigmoidf_(float x) { return __builtin_amdgcn_rcpf(1.f + __builtin_amdgcn_exp2f(-1.44269504f * x)); }
DI float wave_sum(float v) {
#pragma unroll
    for (int o = 1; o < 64; o <<= 1) v += __shfl_xor(v, o);
    return v;
}
DI int crow(int reg, int h) { return (reg & 3) + 8 * (reg >> 2) + 4 * h; }
#define MFMA32(a, b, c) __builtin_amdgcn_mfma_f32_32x32x16_bf16((a), (b), (c), 0, 0, 0)

constexpr size_t MiB = 1u << 20;
constexpr size_t WS_CTL = 0, CTL_ZERO_BYTES = 1 * MiB;
constexpr size_t WS_WIN_T = 1 * MiB;
constexpr size_t WS_WR_T = 13 * MiB;
constexpr size_t WS_WA_T = 14 * MiB;
constexpr size_t WS_WOUT_T = 15 * MiB;
constexpr size_t WS_GUP_T = 17 * MiB;
constexpr size_t WS_RT_HI = 17 * MiB + 256 * 1024;
constexpr size_t WS_RT_LO = 17 * MiB + 384 * 1024;
constexpr size_t WS_WUP_T = 17 * MiB + 512 * 1024;
constexpr size_t WS_AUP_T = 17 * MiB + 640 * 1024;
constexpr size_t RG_A = 18 * MiB, RG_B = 82 * MiB, RG_C = 194 * MiB, RG_D = 338 * MiB, RG_E = 466 * MiB, WS_END = 512 * MiB;
constexpr size_t WS_HB = RG_A;
constexpr size_t WS_PR = RG_B;
constexpr size_t WS_PT = RG_C;
constexpr size_t WS_G = RG_D;
constexpr size_t WS_OG = RG_A;
constexpr size_t WS_LSE = RG_A + 48 * MiB;
constexpr size_t WS_YA = RG_E;
constexpr size_t WS_BSUM = RG_E + 16 * MiB;
constexpr size_t WS_WKV = RG_C;
constexpr size_t WS_YR = RG_A;
constexpr int YC_COLS = 768;
constexpr size_t WS_X1 = RG_A;
constexpr size_t WS_Z1 = RG_C;
constexpr size_t WS_Z = RG_C + 64 * MiB;
constexpr size_t WS_H2 = RG_B;
constexpr size_t WS_LTOK = RG_E + 20 * MiB;
constexpr size_t WS_LW = RG_E + 24 * MiB;
constexpr size_t WS_ROWTOK = RG_E + 28 * MiB;
constexpr size_t WS_ROWW = RG_E + 29 * MiB;
constexpr size_t WS_WGU_T = RG_D;
constexpr size_t WS_WD_T = RG_D + 64 * MiB;
constexpr size_t WS_XG = RG_C;
constexpr size_t WS_HH = RG_B;
constexpr size_t WS_YB = RG_C;
constexpr size_t WS_INV = RG_E + 30 * MiB;
constexpr int CW_BAR = 4096;
constexpr int CW_CNT = 32768;

constexpr int RING_BYTES = 155648;
constexpr int MISC_OFF = RING_BYTES + 320;
constexpr int TAB_OFF = RING_BYTES + 1024;
constexpr int LDS_BYTES = 163840;
constexpr int NWAVES = 8;

namespace pg8 {
constexpr int BM = 256, BK = 64, HALF = 128, HTB = HALF * BK * 2, STAGE_BYTES = 8 * HTB, NXCD = 8, WGM = 8;
__host__ __device__ __forceinline__ int lds_byte(int r, int c) { const int st = (r >> 4) * 2 + (c >> 5), rr = r & 15, cc = c & 31, ob = rr * 64 + cc * 2; return st * 1024 + (ob ^ (((ob >> 9) & 1) << 5)); }
__host__ __device__ __forceinline__ void stage_rc(int b, int& R, int& C) { const int st = b / 1024, sb = b % 1024, swz = sb ^ (((sb >> 9) & 1) << 5); R = (st >> 1) * 16 + swz / 64; C = (st & 1) * 32 + (swz % 64) / 2; }
__host__ __device__ __forceinline__ int perm32(int rho) { const int n = rho >> 4, i = rho & 15; return 8 * (i >> 2) + 4 * n + (i & 3); }

struct Unit { int pm, pn, e; };
struct Gemm { const bf16* A; const bf16* Bt; int K; size_t bgroup; };

struct StaticOrder {
    int nM, nN, nwg, G, c;
    __device__ void init(int M, int N, int G_, int c_) { nM = M / BM; nN = N / BM; nwg = nM * nN; G = G_; c = c_; }
    __device__ bool next(int i, Unit& u) const {
        const long L = (long)i * G + c; if (L >= nwg) return false;
        int wgid = (int)L; { const int q = nwg / NXCD, r = nwg % NXCD, xcd = wgid % NXCD, off = wgid / NXCD; wgid = (xcd < r ? xcd * (q + 1) : r * (q + 1) + (xcd - r) * q) + off; }
        const int nig = WGM * nN, gid = wgid / nig, fm = gid * WGM, gsz = (nM - fm) < WGM ? (nM - fm) : WGM;
        u.pm = fm + ((wgid % nig) % gsz); u.pn = (wgid % nig) / gsz; u.e = 0; return true;
    }
};
struct GroupedOrder {
    const LAS int* tstart; int nT, G, c;
    __device__ bool next(int i, Unit& u) const {
        const int L = i * G + c; if (L >= nT * 4) return false;
        u.pm = L >> 2; u.pn = L & 3; int e = 0;
        for (int k = 1; k < NEXP; ++k) e += (tstart[k] <= u.pm) ? 1 : 0;
        u.e = e; return true;
    }
};

template <class Epi, class Sched, bool ALIGN_EPI = false, bool SP2 = false>
__device__ __forceinline__ void gemm_phase(LAS unsigned char* lds, const Gemm g, const Sched& S, const Epi& E) {
    const int tid = threadIdx.x, wid = __builtin_amdgcn_readfirstlane(tid >> 6), lane = tid & 63, wr = wid >> 2, wc = wid & 3, fr = lane & 15, fq = lane >> 4;
    const int K = g.K, nt = K / BK;
    unsigned voffA[2], voffB[2];
#pragma unroll
    for (int i = 0; i < 2; ++i) { int R, C; stage_rc(tid * 16 + i * 8192, R, C); const int Rb = Epi::PERM ? ((R & ~31) + perm32(R & 31)) : R;
        voffA[i] = (unsigned)(R * K + C) * 2u; voffB[i] = (unsigned)(Rb * K + C) * 2u; }
    const size_t kstep = (size_t)(BK * 2);
    const size_t hstep = (size_t)HALF * K * 2;
    const size_t tstep = 2 * hstep;
    const unsigned ldsw = (unsigned)wid * 1024u;
    const int aoff = lds_byte(wr * 64 + fr, fq * 8), boff = lds_byte(wc * 32 + fr, fq * 8);
#define PG8_SA(b, h) (((b) * 2 + (h)) * HTB)
#define PG8_SB(b, h) ((4 + (b) * 2 + (h)) * HTB)
#define PG8_STAGE(bufoff, gbase, voff) do { _Pragma("unroll") for (int _i = 0; _i < 2; ++_i) \
        __builtin_amdgcn_global_load_lds((const unsigned*)((const char*)(gbase) + (voff)[_i]), (LAS unsigned*)(lds + (bufoff) + ldsw + _i * 8192), 16, 0, 0); } while (0)
#define PG8_LDA(dst, b, h) do { _Pragma("unroll") for (int m = 0; m < 4; ++m) _Pragma("unroll") for (int k = 0; k < 2; ++k) dst[m][k] = *(const LAS bf16x8*)(lds + PG8_SA(b, h) + aoff + m * 2048 + k * 1024); } while (0)
#define PG8_LDB(dst, b, h) do { _Pragma("unroll") for (int n = 0; n < 2; ++n) _Pragma("unroll") for (int k = 0; k < 2; ++k) dst[n][k] = *(const LAS bf16x8*)(lds + PG8_SB(b, h) + boff + n * 2048 + k * 1024); } while (0)
#define PG8_MMA(ai, bj, At, Bt) do { __builtin_amdgcn_s_setprio(1); _Pragma("unroll") for (int m = 0; m < 4; ++m) _Pragma("unroll") for (int n = 0; n < 2; ++n) _Pragma("unroll") for (int k = 0; k < 2; ++k) \
        acc[ai][bj][m][n] = __builtin_amdgcn_mfma_f32_16x16x32_bf16(Bt[n][k], At[m][k], acc[ai][bj][m][n], 0, 0, 0); __builtin_amdgcn_s_setprio(0); } while (0)
#define PG8_WAIT_V(n) asm volatile("s_waitcnt vmcnt(" #n ")" ::: "memory")
#define PG8_WAIT_L(n) asm volatile("s_waitcnt lgkmcnt(" #n ")" ::: "memory")
#define PG8_BAR __builtin_amdgcn_s_barrier()
#define PG8_SCHED __builtin_amdgcn_sched_barrier(0)
    Unit cur, nxt; int ui = 0;
    if (!S.next(0, cur)) return;
    f32x4 acc[2][2][4][2];
#pragma unroll
    for (int a = 0; a < 2; ++a)
#pragma unroll
        for (int b = 0; b < 2; ++b)
#pragma unroll
            for (int m = 0; m < 4; ++m)
#pragma unroll
                for (int n = 0; n < 2; ++n) acc[a][b][m][n] = (f32x4){0.f, 0.f, 0.f, 0.f};
    bf16x8 At[4][2], B0[2][2], B1[2][2];
    const char* cA = (const char*)g.A + (size_t)cur.pm * tstep; const char* cB = (const char*)g.Bt + (size_t)cur.e * g.bgroup + (size_t)cur.pn * tstep;
    if constexpr (SP2) {
        PG8_STAGE(PG8_SB(0, 0), cB, voffB); PG8_STAGE(PG8_SB(0, 1), cB + hstep, voffB); PG8_STAGE(PG8_SA(0, 0), cA, voffA); PG8_STAGE(PG8_SA(0, 1), cA + hstep, voffA);
        if (wr == 1) PG8_BAR;
        PG8_WAIT_V(2); PG8_BAR;
        PG8_STAGE(PG8_SB(1, 0), cB + kstep, voffB); PG8_STAGE(PG8_SA(1, 0), cA + kstep, voffA); PG8_STAGE(PG8_SB(1, 1), cB + hstep + kstep, voffB);
        PG8_WAIT_V(6); PG8_BAR;
    } else {
        PG8_STAGE(PG8_SB(0, 0), cB, voffB); PG8_STAGE(PG8_SA(0, 0), cA, voffA); PG8_STAGE(PG8_SB(0, 1), cB + hstep, voffB); PG8_STAGE(PG8_SA(0, 1), cA + hstep, voffA);
        if (wr == 1) PG8_BAR;
        PG8_WAIT_V(4); PG8_BAR;
        PG8_STAGE(PG8_SB(1, 0), cB + kstep, voffB); PG8_STAGE(PG8_SA(1, 0), cA + kstep, voffA); PG8_STAGE(PG8_SB(1, 1), cB + hstep + kstep, voffB);
        PG8_WAIT_V(6); PG8_BAR;
    }
    for (;;) {
        const bool has_next = S.next(ui + 1, nxt);
        const char* nA = has_next ? (const char*)g.A + (size_t)nxt.pm * tstep : cA; const char* nB = has_next ? (const char*)g.Bt + (size_t)nxt.e * g.bgroup + (size_t)nxt.pn * tstep : cB;
        for (int t = 0; t < nt; t += 2) {
            if constexpr (Epi::MID_T >= 0) { if (t == Epi::MID_T) E.mid(acc, cur, wr, wc, fr, fq); }
            const bool last = (t == nt - 2);
            const char* a1 = cA + (size_t)(t + 1) * kstep;
            const char* a2 = last ? nA : cA + (size_t)(t + 2) * kstep; const char* b2 = last ? nB : cB + (size_t)(t + 2) * kstep;
            const char* a3 = a2 + kstep; const char* b3 = b2 + kstep;
            if constexpr (SP2) {
            PG8_LDB(B0, 0, 0); PG8_LDB(B1, 0, 1); PG8_SCHED; PG8_LDA(At, 0, 0); PG8_STAGE(PG8_SA(1, 1), a1 + hstep, voffA);
            PG8_WAIT_V(8); PG8_WAIT_L(0); PG8_BAR; PG8_MMA(0, 0, At, B0); PG8_MMA(0, 1, At, B1); PG8_BAR; PG8_SCHED;
            PG8_LDA(At, 0, 1); PG8_STAGE(PG8_SB(0, 0), b2, voffB); PG8_STAGE(PG8_SB(0, 1), b2 + hstep, voffB); PG8_STAGE(PG8_SA(0, 0), a2, voffA);
            PG8_WAIT_V(8); PG8_WAIT_L(0); PG8_BAR; PG8_MMA(1, 0, At, B0); PG8_MMA(1, 1, At, B1); PG8_BAR; PG8_SCHED;
            PG8_LDB(B0, 1, 0); PG8_LDB(B1, 1, 1); PG8_SCHED; PG8_LDA(At, 1, 0); PG8_STAGE(PG8_SA(0, 1), a2 + hstep, voffA);
            PG8_WAIT_V(8); PG8_WAIT_L(0); PG8_BAR; PG8_MMA(0, 0, At, B0); PG8_MMA(0, 1, At, B1); PG8_BAR; PG8_SCHED;
            PG8_LDA(At, 1, 1); PG8_STAGE(PG8_SB(1, 0), b3, voffB); PG8_STAGE(PG8_SB(1, 1), b3 + hstep, voffB); PG8_STAGE(PG8_SA(1, 0), a3, voffA);
            PG8_WAIT_V(8); PG8_WAIT_L(0); PG8_BAR; PG8_MMA(1, 0, At, B0); PG8_MMA(1, 1, At, B1); PG8_BAR; PG8_SCHED;
            } else {
            PG8_LDB(B0, 0, 0); PG8_SCHED; PG8_LDA(At, 0, 0); PG8_STAGE(PG8_SA(1, 1), a1 + hstep, voffA);
            PG8_WAIT_L(8); PG8_BAR; PG8_WAIT_L(0); PG8_MMA(0, 0, At, B0); PG8_BAR; PG8_SCHED;
            PG8_LDB(B1, 0, 1); PG8_STAGE(PG8_SB(0, 0), b2, voffB);
            PG8_BAR; PG8_WAIT_L(0); PG8_MMA(0, 1, At, B1); PG8_BAR;
            PG8_LDA(At, 0, 1); PG8_STAGE(PG8_SA(0, 0), a2, voffA);
            PG8_BAR; PG8_WAIT_L(0); PG8_MMA(1, 0, At, B0); PG8_BAR; PG8_SCHED;
            PG8_STAGE(PG8_SB(0, 1), b2 + hstep, voffB);
            PG8_WAIT_V(6); PG8_BAR; PG8_MMA(1, 1, At, B1); PG8_BAR;
            PG8_LDB(B0, 1, 0); PG8_SCHED; PG8_LDA(At, 1, 0); PG8_STAGE(PG8_SA(0, 1), a2 + hstep, voffA);
            PG8_WAIT_L(8); PG8_BAR; PG8_WAIT_L(0); PG8_MMA(0, 0, At, B0); PG8_BAR; PG8_SCHED;
            PG8_LDB(B1, 1, 1); PG8_STAGE(PG8_SB(1, 0), b3, voffB);
            PG8_BAR; PG8_WAIT_L(0); PG8_MMA(0, 1, At, B1); PG8_BAR;
            PG8_LDA(At, 1, 1); PG8_STAGE(PG8_SA(1, 0), a3, voffA);
            PG8_BAR; PG8_WAIT_L(0); PG8_MMA(1, 0, At, B0); PG8_BAR; PG8_SCHED;
            PG8_STAGE(PG8_SB(1, 1), b3 + hstep, voffB);
            PG8_WAIT_V(6); PG8_BAR; PG8_MMA(1, 1, At, B1); PG8_BAR;
            }
        }
        if constexpr (ALIGN_EPI) { if (wr == 0) PG8_BAR; }
        E(acc, cur, wr, wc, fr, fq);
        if (!has_next) break;
#pragma unroll
        for (int a = 0; a < 2; ++a)
#pragma unroll
            for (int b = 0; b < 2; ++b)
#pragma unroll
                for (int m = 0; m < 4; ++m)
#pragma unroll
                    for (int n = 0; n < 2; ++n) acc[a][b][m][n] = (f32x4){0.f, 0.f, 0.f, 0.f};
        cur = nxt; cA = nA; cB = nB; ++ui;
        if constexpr (ALIGN_EPI) { if (wr == 1) PG8_BAR; }
    }
    PG8_WAIT_V(0);
    if constexpr (!ALIGN_EPI) { if (wr == 0) PG8_BAR; }
    PG8_BAR;
#undef PG8_SA
#undef PG8_SB
#undef PG8_STAGE
#undef PG8_LDA
#undef PG8_LDB
#undef PG8_MMA
#undef PG8_WAIT_V
#undef PG8_WAIT_L
#undef PG8_BAR
#undef PG8_SCHED
}

struct EpiIn {
    static constexpr bool PERM = true; static constexpr int MID_T = -1;
    bf16* PR; bf16* PT; bf16* G; const float* bmerge;
    __device__ __forceinline__ void operator()(const f32x4 (&acc)[2][2][4][2], const Unit& u, int wr, int wc, int fr, int fq) const {
        const int row0 = u.pm * BM + wr * 64 + fr; const int pn = u.pn;
        bf16* base; int ldc, colt;
        if (pn < 7) { base = PR; ldc = RW_COLS; colt = pn * BM; } else if (pn < 16) { base = PT; ldc = AT_COLS; colt = (pn - 7) * BM; } else { base = G; ldc = G_COLS; colt = (pn - 16) * BM; }
        const bool gate = pn >= 16;
        const int col0 = colt + wc * 32 + 8 * fq;
        f32x4 bv[2][2];
#pragma unroll
        for (int bj = 0; bj < 2; ++bj)
#pragma unroll
            for (int n = 0; n < 2; ++n) bv[bj][n] = gate ? *(const f32x4*)(bmerge + col0 + bj * HALF + 4 * n) : (f32x4){0.f, 0.f, 0.f, 0.f};
#pragma unroll
        for (int ai = 0; ai < 2; ++ai)
#pragma unroll
            for (int m = 0; m < 4; ++m) { bf16* rowp = base + (size_t)(row0 + ai * HALF + m * 16) * ldc + col0;
#pragma unroll
                for (int bj = 0; bj < 2; ++bj) { f32x4 v0 = acc[ai][bj][m][0] + bv[bj][0], v1 = acc[ai][bj][m][1] + bv[bj][1];
                    if (gate) {
#pragma unroll
                        for (int j = 0; j < 4; ++j) { v0[j] = sigmoidf_(v0[j]); v1[j] = sigmoidf_(v1[j]); } }
                    v4u w; w.x = pk2(v0[0], v0[1]); w.y = pk2(v0[2], v0[3]); w.z = pk2(v1[0], v1[1]); w.w = pk2(v1[2], v1[3]);
                    *(v4u*)(rowp + bj * HALF) = w; } }
    }
};
struct EpiMix2 {
    static constexpr bool PERM = true; static constexpr int MID_T = 8;
    const bf16* G; bf16* Zout;
    __device__ __forceinline__ void mid(f32x4 (&acc)[2][2][4][2], const Unit& u, int wr, int wc, int fr, int fq) const {
        int row0 = u.pm * BM + wr * 64 + fr; LAUNDER(row0); const int col0 = u.pn * BM + wc * 32 + 8 * fq;
#pragma unroll
        for (int ai = 0; ai < 2; ++ai)
#pragma unroll
            for (int m = 0; m < 4; ++m) { const size_t r = (size_t)(row0 + ai * HALF + m * 16);
#pragma unroll
                for (int bj = 0; bj < 2; ++bj) { const int c = col0 + bj * HALF;
                    const v4u ga = *(const v4u*)(G + r * G_COLS + c), gb = *(const v4u*)(G + r * G_COLS + DM + c);
                    acc[ai][bj][m][0][0] *= bflo(ga.x) * __builtin_amdgcn_rcpf(bflo(gb.x)); acc[ai][bj][m][0][1] *= bfhi(ga.x) * __builtin_amdgcn_rcpf(bfhi(gb.x));
                    acc[ai][bj][m][0][2] *= bflo(ga.y) * __builtin_amdgcn_rcpf(bflo(gb.y)); acc[ai][bj][m][0][3] *= bfhi(ga.y) * __builtin_amdgcn_rcpf(bfhi(gb.y));
                    acc[ai][bj][m][1][0] *= bflo(ga.z) * __builtin_amdgcn_rcpf(bflo(gb.z)); acc[ai][bj][m][1][1] *= bfhi(ga.z) * __builtin_amdgcn_rcpf(bfhi(gb.z));
                    acc[ai][bj][m][1][2] *= bflo(ga.w) * __builtin_amdgcn_rcpf(bflo(gb.w)); acc[ai][bj][m][1][3] *= bfhi(ga.w) * __builtin_amdgcn_rcpf(bfhi(gb.w));
                    __builtin_amdgcn_sched_barrier(0); } }
    }
    __device__ __forceinline__ void operator()(const f32x4 (&acc)[2][2][4][2], const Unit& u, int wr, int wc, int fr, int fq) const {
        const int row0 = u.pm * BM + wr * 64 + fr, col0 = u.pn * BM + wc * 32 + 8 * fq;
#pragma unroll
        for (int ai = 0; ai < 2; ++ai)
#pragma unroll
            for (int m = 0; m < 4; ++m) { const size_t r = (size_t)(row0 + ai * HALF + m * 16);
#pragma unroll
                for (int bj = 0; bj < 2; ++bj) { const int c = col0 + bj * HALF;
                    const v4u gv = *(const v4u*)(G + r * G_COLS + DM + c);
                    const f32x4 v0 = acc[ai][bj][m][0], v1 = acc[ai][bj][m][1];
                    v4u w; w.x = pk2(v0[0] * bflo(gv.x), v0[1] * bfhi(gv.x)); w.y = pk2(v0[2] * bflo(gv.y), v0[3] * bfhi(gv.y));
                    w.z = pk2(v1[0] * bflo(gv.z), v1[1] * bfhi(gv.z)); w.w = pk2(v1[2] * bflo(gv.w), v1[3] * bfhi(gv.w));
                    *(v4u*)(Zout + r * DM + c) = w; } }
    }
};
struct EpiRes {
    static constexpr bool PERM = true; static constexpr int MID_T = -1;
    const float* X; bf16* O;
    __device__ __forceinline__ void operator()(const f32x4 (&acc)[2][2][4][2], const Unit& u, int wr, int wc, int fr, int fq) const {
        const int row0 = u.pm * BM + wr * 64 + fr, col0 = u.pn * BM + wc * 32 + 8 * fq;
#pragma unroll
        for (int ai = 0; ai < 2; ++ai)
#pragma unroll
            for (int m = 0; m < 4; ++m) { const size_t off = (size_t)(row0 + ai * HALF + m * 16) * DM + col0;
#pragma unroll
                for (int bj = 0; bj < 2; ++bj) { const f32x4 x0 = *(const f32x4*)(X + off + bj * HALF) + acc[ai][bj][m][0], x1 = *(const f32x4*)(X + off + bj * HALF + 4) + acc[ai][bj][m][1];
                    v4u w; w.x = pk2(x0[0], x0[1]); w.y = pk2(x0[2], x0[3]); w.z = pk2(x1[0], x1[1]); w.w = pk2(x1[2], x1[3]);
                    *(v4u*)(O + off + bj * HALF) = w; } }
    }
};
struct EpiSwiglu {
    static constexpr bool PERM = false; static constexpr int MID_T = -1;
    bf16* H;
    __device__ __forceinline__ void operator()(const f32x4 (&acc)[2][2][4][2], const Unit& u, int wr, int wc, int fr, int fq) const {
        const int row0 = u.pm * BM + wr * 64 + fr, col0 = u.pn * 128 + wc * 16 + 4 * fq;
#pragma unroll
        for (int ai = 0; ai < 2; ++ai)
#pragma unroll
            for (int m = 0; m < 4; ++m) { bf16* rowp = H + (size_t)(row0 + ai * HALF + m * 16) * DEXP + col0;
#pragma unroll
                for (int bj = 0; bj < 2; ++bj) { const f32x4 gt = acc[ai][bj][m][0], up = acc[ai][bj][m][1]; f32x4 o;
#pragma unroll
                    for (int j = 0; j < 4; ++j) o[j] = gt[j] * sigmoidf_(gt[j]) * up[j];
                    v2u w; w.x = pk2(o[0], o[1]); w.y = pk2(o[2], o[3]);
                    *(v2u*)(rowp + bj * 64) = w; } }
    }
};
struct EpiStoreY {
    static constexpr bool PERM = true; static constexpr int MID_T = -1;
    const float* roww; bf16* Y;
    __device__ __forceinline__ void operator()(const f32x4 (&acc)[2][2][4][2], const Unit& u, int wr, int wc, int fr, int fq) const {
        const int row0 = u.pm * BM + wr * 64 + fr, col0 = u.pn * BM + wc * 32 + 8 * fq;
#pragma unroll
        for (int ai = 0; ai < 2; ++ai)
#pragma unroll
            for (int m = 0; m < 4; ++m) { const int r = row0 + ai * HALF + m * 16; const float w = roww[r]; bf16* rowp = Y + (size_t)r * DM + col0;
#pragma unroll
                for (int bj = 0; bj < 2; ++bj) { const f32x4 v0 = acc[ai][bj][m][0] * w, v1 = acc[ai][bj][m][1] * w;
                    v4u o; o.x = pk2(v0[0], v0[1]); o.y = pk2(v0[2], v0[3]); o.z = pk2(v1[0], v1[1]); o.w = pk2(v1[2], v1[3]);
                    *(v4u*)(rowp + bj * HALF) = o; } }
    }
};
}

#define XB_TMO      128
#define XB_XCNT(j)  (256  + 64 * (j))
#define XB_XSUB(j)  (1280 + 64 * (j))
#define XB_XGEN(j)  (2304 + 64 * (j))
#define XB_TOP      3328
#define XB_TOPGEN   3392
#define XCD_BAR_WORDS 3456
#define XB_SPIN_CAP (1u << 18)
__device__ __forceinline__ unsigned xb_ld(unsigned* p)              { return __hip_atomic_load(p, __ATOMIC_RELAXED, __HIP_MEMORY_SCOPE_AGENT); }
__device__ __forceinline__ unsigned xb_add(unsigned* p, unsigned v) { return __hip_atomic_fetch_add(p, v, __ATOMIC_RELAXED, __HIP_MEMORY_SCOPE_AGENT); }
__device__ __forceinline__ unsigned xb_xcc_id() { return (unsigned)__builtin_amdgcn_s_getreg((3 << 11) | 20) & 0xFu; }
#define XB_SPIN(cond, bar) do { unsigned _sp = 0; while (cond) { __builtin_amdgcn_s_sleep(1); \
    if ((++_sp & 255u) == 0u) { if (xb_ld(&(bar)[XB_TMO])) break; if (_sp > XB_SPIN_CAP) { atomicAdd(&(bar)[XB_TMO], 1u); break; } } } } while (0)
struct XcdBarrier { unsigned* bar; unsigned x; volatile LAS unsigned* st; };
__device__ __forceinline__ XcdBarrier xcd_barrier_post(unsigned* bar, volatile LAS unsigned* st) {
    XcdBarrier b; b.bar = bar; b.x = xb_xcc_id(); b.st = st;
    if (threadIdx.x == 0) (void)xb_add(&bar[XB_XCNT(b.x)], 1u);
    return b;
}
__device__ __forceinline__ void xcd_barrier_complete(unsigned* bar, unsigned x, unsigned& nloc, unsigned& nx) {
    const unsigned G = gridDim.x * gridDim.y * gridDim.z;
    unsigned sum, cnt, mine, sp = 0u;
    for (;;) {
        sum = 0u; cnt = 0u; mine = 0u;
#pragma unroll
        for (unsigned j = 0; j < 16; ++j) { const unsigned c = xb_ld(&bar[XB_XCNT(j)]); sum += c; cnt += (c > 0u) ? 1u : 0u; mine = (j == x) ? c : mine; }
        if (sum == G) break;
        __builtin_amdgcn_s_sleep(1);
        if ((++sp & 255u) == 0u) { if (xb_ld(&bar[XB_TMO])) break; if (sp > XB_SPIN_CAP) { atomicAdd(&bar[XB_TMO], 1u); break; } }
    }
    nloc = mine > 0u ? mine : 1u; nx = cnt > 0u ? cnt : 1u;
}
__device__ __forceinline__ void xcd_barrier(const XcdBarrier& b) {
    asm volatile("s_waitcnt vmcnt(0)" ::: "memory");
    __syncthreads();
    if (threadIdx.x == 0) {
        unsigned* bar = b.bar;
        __builtin_amdgcn_s_waitcnt(0);
        unsigned nloc = b.st[0], nx = b.st[1];
        if (nloc == 0u) { xcd_barrier_complete(bar, b.x, nloc, nx); b.st[0] = nloc; b.st[1] = nx; }
        const unsigned old = xb_add(&bar[XB_XSUB(b.x)], 1u);
        const unsigned gen = old / nloc;
        if (old + 1u == (gen + 1u) * nloc) {
            __builtin_amdgcn_fence(__ATOMIC_RELEASE, "agent");
            asm volatile("s_waitcnt vmcnt(0)" ::: "memory");
            const unsigned og = xb_add(&bar[XB_TOP], 1u);
            const unsigned tg = og / nx;
            if (og + 1u == (tg + 1u) * nx) xb_add(&bar[XB_TOPGEN], 1u);
            else XB_SPIN(xb_ld(&bar[XB_TOPGEN]) == tg, bar);
            __builtin_amdgcn_fence(__ATOMIC_ACQUIRE, "agent");
            xb_add(&bar[XB_XGEN(b.x)], 1u);
            asm volatile("s_waitcnt vmcnt(0)" ::: "memory");
        } else {
            XB_SPIN(xb_ld(&bar[XB_XGEN(b.x)]) == gen, bar);
            __builtin_amdgcn_fence(__ATOMIC_ACQUIRE, "agent");
            asm volatile("s_waitcnt vmcnt(0)" ::: "memory");
        }
    }
    __syncthreads();
}

struct Args { const void* in[30]; float* out; unsigned char* ws; int ph_lo, ph_hi, li, variant; };
struct Frame {
    LAS unsigned char* lds; volatile LAS unsigned* MISC;
    int tid, lane, wave, G, bid, variant;
    unsigned char* ws;
};
enum { I_X = 0, I_POS, I_N1G, I_WIN, I_MUP, I_MUN, I_WD0, I_WDUP, I_AG0, I_AGUP, I_GUP, I_KK, I_KA, I_RK, I_GNW, I_GNB, I_WROUT, I_QNG, I_KNG, I_WAOUT, I_BMERGE, I_WOUT,
       I_N2G, I_WRG, I_BRG, I_WRE, I_BRE, I_WGATE, I_WUP, I_WDOWN };

template <class RowMap>
DI void transpose_item(const float* W, int K, int N, bf16* WT, const RowMap& rm, LAS float* scr, int item, int lane, int ldk = 0, int koff = 0) {
    if (ldk == 0) ldk = K;
    const int nblk = N / 32, kb = item / nblk, nb = item % nblk, k0 = 64 * kb, n0 = 32 * nb;
#pragma unroll 8
    for (int i = 0; i < 32; ++i) { const int kk = 2 * i + (lane >> 5); scr[kk * 33 + (lane & 31)] = W[(size_t)(k0 + kk) * N + n0 + (lane & 31)]; }
    LDS_WAIT(); asm volatile("" ::: "memory");
    const int c = lane & 7;
#pragma unroll
    for (int j = 0; j < 4; ++j) { const int n = (lane >> 3) + 8 * j; const LAS float* s = scr + (8 * c) * 33 + n;
        v4u o; o.x = pk2(s[0 * 33], s[1 * 33]); o.y = pk2(s[2 * 33], s[3 * 33]); o.z = pk2(s[4 * 33], s[5 * 33]); o.w = pk2(s[6 * 33], s[7 * 33]);
        *(GAS v4u*)(WT + (size_t)rm(n0 + n) * ldk + koff + k0 + 8 * c) = o; }
    LDS_WAIT(); asm volatile("" ::: "memory");
}
struct RmId { DI int operator()(int n) const { return n; } };
struct RmGate { DI int operator()(int n) const { return 32 * (n >> 4) + (n & 15); } };
struct RmUp { DI int operator()(int n) const { return 32 * (n >> 4) + 16 + (n & 15); } };

DI void p0_prologue(Frame& F, const Args& a) {
    LAS float* scr = (LAS float*)(F.lds + F.wave * 16384);
    const int gw = F.bid * NWAVES + F.wave, NGW = F.G * NWAVES;
    unsigned char* ws = F.ws;
    constexpr int I_IN = (DM / 64) * (IN_COLS / 32), I_R = (512 / 64) * (DM / 32), I_A = (256 / 64) * (DM / 32), I_O = (DM / 64) * (DM / 32), I_G = (128 / 64) * (512 / 32), I_L = 512 / 32;
    constexpr int NITEMS = I_IN + I_R + I_A + I_O + I_G + 4 * I_L;
    for (int it = gw; it < NITEMS; it += NGW) {
        int r = it;
        if (r < I_IN) { transpose_item((const float*)a.in[I_WIN], DM, IN_COLS, (bf16*)(ws + WS_WIN_T), RmId(), scr, r, F.lane); continue; } r -= I_IN;
        if (r < I_R) { transpose_item((const float*)a.in[I_WROUT], 512, DM, (bf16*)(ws + WS_WR_T), RmId(), scr, r, F.lane, YC_COLS, 0); continue; } r -= I_R;
        if (r < I_A) { transpose_item((const float*)a.in[I_WAOUT], 256, DM, (bf16*)(ws + WS_WR_T), RmId(), scr, r, F.lane, YC_COLS, 512); continue; } r -= I_A;
        if (r < I_O) { transpose_item((const float*)a.in[I_WOUT], DM, DM, (bf16*)(ws + WS_WOUT_T), RmId(), scr, r, F.lane); continue; } r -= I_O;
        if (r < I_G) { transpose_item((const float*)a.in[I_GUP], 128, 512, (bf16*)(ws + WS_GUP_T), RmId(), scr, r, F.lane); continue; } r -= I_G;
        { const int d = r / I_L, rr = r % I_L;
          if (d < 2) transpose_item((const float*)a.in[I_WDUP] + (size_t)d * 64 * 512, 64, 512, (bf16*)(ws + WS_WUP_T) + (size_t)d * 512 * 64, RmId(), scr, rr, F.lane);
          else transpose_item((const float*)a.in[I_AGUP] + (size_t)(d - 2) * 64 * 512, 64, 512, (bf16*)(ws + WS_AUP_T) + (size_t)(d - 2) * 512 * 64, RmId(), scr, rr, F.lane); }
    }
    { const float* g2 = (const float*)a.in[I_N2G]; const float* wre = (const float*)a.in[I_WRE]; const float* wrg = (const float*)a.in[I_WRG];
      bf16* hi = (bf16*)(ws + WS_RT_HI); bf16* lo = (bf16*)(ws + WS_RT_LO);
      for (int i = F.bid * 512 + F.tid; i < 64 * DM; i += F.G * 512) { const int n = i / DM, k = i % DM;
          float v = 0.f; if (n < 32) v = g2[k] * wre[k * 32 + n]; else if (n < 36) v = g2[k] * wrg[k * 4 + (n - 32)];
          const unsigned h = pk2(v, 0.f) & 0xffffu; const float hf = bflo(h); hi[i] = (bf16)h; lo[i] = (bf16)(pk2(v - hf, 0.f) & 0xffffu); } }
    { const float* x = (const float*)a.in[I_X]; const float* g1 = (const float*)a.in[I_N1G]; bf16* hb = (bf16*)(ws + WS_HB);
      f32x4 gv[4];
#pragma unroll
      for (int j = 0; j < 4; ++j) gv[j] = ((const f32x4*)g1)[F.lane + 64 * j];
      for (int m = gw; m < NTOK; m += NGW) {
          const GAS f32x4* xr = (const GAS f32x4*)(x + (size_t)m * DM) + F.lane; f32x4 v[4]; float s = 0.f;
#pragma unroll
          for (int j = 0; j < 4; ++j) { v[j] = xr[64 * j]; s += (v[j].x * v[j].x + v[j].y * v[j].y) + (v[j].z * v[j].z + v[j].w * v[j].w); }
          const float rstd = 1.f / sqrtf(wave_sum(s) * (1.f / DM) + NORM_EPS);
          GAS v2u* o8 = (GAS v2u*)(hb + (size_t)m * DM) + F.lane;
#pragma unroll
          for (int j = 0; j < 4; ++j) { v2u w; w.x = pk2(v[j].x * rstd * gv[j].x, v[j].y * rstd * gv[j].y); w.y = pk2(v[j].z * rstd * gv[j].z, v[j].w * rstd * gv[j].w); o8[64 * j] = w; } } }
}

DI void p1b_qkprep(Frame& F, const Args& a) {
    bf16* PT = (bf16*)(F.ws + WS_PT);
    const int* pos = (const int*)a.in[I_POS];
    const int sub = F.lane & 7;
    const f32x4 qg0 = ((const f32x4*)a.in[I_QNG])[2 * sub], qg1 = ((const f32x4*)a.in[I_QNG])[2 * sub + 1];
    const f32x4 kg0 = ((const f32x4*)a.in[I_KNG])[2 * sub], kg1 = ((const f32x4*)a.in[I_KNG])[2 * sub + 1];
    constexpr float IF2PI[8] = {0.15915494309189535f, 0.03086376340470123f, 0.005985185712713705f, 0.001160663641240061f, 0.00022507907903927653f, 4.364795279280289e-05f, 8.464330808241401e-06f, 1.6414262627950345e-06f};
    const int nvec = NTOK * 24, stride = (F.G * 512) >> 3;
    for (int vid0 = (F.bid * 512 + F.tid) >> 3; vid0 < nvec; vid0 += 4 * stride) {
        v4u raw[4]; int pv[4];
#pragma unroll
        for (int u = 0; u < 4; ++u) { const int vid = vid0 + u * stride; if (vid < nvec) { const int tok = vid / 24, v = vid % 24; const bool isq = v < 12; const int head = isq ? v : v - 12;
            raw[u] = *(const v4u*)(PT + (size_t)tok * AT_COLS + (isq ? 0 : 768) + head * 64 + sub * 8); pv[u] = pos[tok]; } else { raw[u] = (v4u){0u, 0u, 0u, 0u}; pv[u] = 0; } }
#pragma unroll
        for (int u = 0; u < 4; ++u) { const int vid = vid0 + u * stride; const bool act = vid < nvec; const int vv = act ? vid : 0;
            const int tok = vv / 24, v = vv % 24; const bool isq = v < 12; const int head = isq ? v : v - 12;
            bf16* p = PT + (size_t)tok * AT_COLS + (isq ? 0 : 768) + head * 64 + sub * 8;
            float y[8] = {bflo(raw[u].x), bfhi(raw[u].x), bflo(raw[u].y), bfhi(raw[u].y), bflo(raw[u].z), bfhi(raw[u].z), bflo(raw[u].w), bfhi(raw[u].w)};
            float ss = 0.f;
#pragma unroll
            for (int j = 0; j < 8; ++j) ss += y[j] * y[j];
            ss += __shfl_xor(ss, 1); ss += __shfl_xor(ss, 2); ss += __shfl_xor(ss, 4);
            const float rstd = 1.f / sqrtf(ss * (1.f / 64.f) + NORM_EPS);
            const f32x4 g0 = isq ? qg0 : kg0, g1 = isq ? qg1 : kg1;
#pragma unroll
            for (int j = 0; j < 4; ++j) { y[j] = y[j] * rstd * g0[j]; y[4 + j] = y[4 + j] * rstd * g1[j]; }
            const float pf = (float)pv[u];
#pragma unroll
            for (int j = 0; j < 8; ++j) {
                const float partner = __shfl_xor(y[j], 1);
                float r = pf * IF2PI[j]; r = r - floorf(r);
                const float sn = __builtin_amdgcn_sinf(r), cs = __builtin_amdgcn_cosf(r);
                const float rot = y[j] * cs + (sub == 0 ? -partner : partner) * sn;
                if (sub < 2) y[j] = rot;
            }
            if (isq) {
#pragma unroll
                for (int j = 0; j < 8; ++j) y[j] *= 0.18033688011112042f;
            }
            v4u o; o.x = pk2(y[0], y[1]); o.y = pk2(y[2], y[3]); o.z = pk2(y[4], y[5]); o.w = pk2(y[6], y[7]);
            if (act && !VAR(64)) *(v4u*)p = o; }
    }
}

DI void p1c_preshift(Frame& F, const Args& a) {
    if (F.tid >= 448) return;
    const bf16* PR = (const bf16*)(F.ws + WS_PR); bf16* PS = (bf16*)a.out;
    const int rsub = F.tid / 224, cg8 = (F.tid % 224) * 8;
    const float* mup = (const float*)a.in[I_MUP] + cg8; const float* mun = (const float*)a.in[I_MUN] + cg8;
    const f32x4 mp0 = *(const f32x4*)mup, mp1 = *(const f32x4*)(mup + 4), mn0 = *(const f32x4*)mun, mn1 = *(const f32x4*)(mun + 4);
    const int mode = (cg8 >= 1536 && cg8 < 1600) ? 1 : (cg8 >= 1664 ? 2 : 0);
    const int rows_per = NTOK / F.G;
    for (int r0 = F.bid * rows_per + rsub; r0 < (F.bid + 1) * rows_per; r0 += 8) {
        v4u cur[4], prv[4], nxt[4];
#pragma unroll
        for (int u = 0; u < 4; ++u) { const int row = r0 + 2 * u, t = row % SEQ; const bf16* p = PR + (size_t)row * RW_COLS + cg8;
            cur[u] = *(const v4u*)p; prv[u] = *(const v4u*)(p - (t > 0 ? RW_COLS : 0)); nxt[u] = *(const v4u*)(p + (t < SEQ - 1 ? RW_COLS : 0)); }
#pragma unroll
        for (int u = 0; u < 4; ++u) { const int row = r0 + 2 * u, t = row % SEQ; const float fp = t > 0 ? 1.f : 0.f, fn = t < SEQ - 1 ? 1.f : 0.f;
            const unsigned cw[4] = {cur[u].x, cur[u].y, cur[u].z, cur[u].w}, pw[4] = {prv[u].x, prv[u].y, prv[u].z, prv[u].w}, nw[4] = {nxt[u].x, nxt[u].y, nxt[u].z, nxt[u].w};
            float y[8];
#pragma unroll
            for (int j = 0; j < 4; ++j) {
                const float c0 = bflo(cw[j]), c1 = bfhi(cw[j]), p0 = bflo(pw[j]) * fp, p1 = bfhi(pw[j]) * fp, n0 = bflo(nw[j]) * fn, n1 = bfhi(nw[j]) * fn;
                const float m0 = j < 2 ? mp0[2 * j] : mp1[2 * j - 4], m1 = j < 2 ? mp0[2 * j + 1] : mp1[2 * j - 3], q0 = j < 2 ? mn0[2 * j] : mn1[2 * j - 4], q1 = j < 2 ? mn0[2 * j + 1] : mn1[2 * j - 3];
                y[2 * j] = c0 + m0 * (p0 - c0) + q0 * (n0 - c0); y[2 * j + 1] = c1 + m1 * (p1 - c1) + q1 * (n1 - c1); }
            if (mode == 1) {
#pragma unroll
                for (int j = 0; j < 8; ++j) y[j] = 1.f - 2.f * __builtin_amdgcn_rcpf(1.f + __builtin_amdgcn_exp2f(2.88539008f * y[j])); }
            if (mode == 2) {
#pragma unroll
                for (int j = 0; j < 8; ++j) y[j] = sigmoidf_(y[j]); }
            v4u o; o.x = pk2(y[0], y[1]); o.y = pk2(y[2], y[3]); o.z = pk2(y[4], y[5]); o.w = pk2(y[6], y[7]);
            if (!VAR(64)) *(v4u*)(PS + (size_t)row * RW_COLS + cg8) = o; }
    }
}

DI bf16x8 pack8(float a0, float a1, float a2, float a3, float a4, float a5, float a6, float a7) {
    v4u p; p.x = pk2(a0, a1); p.y = pk2(a2, a3); p.z = pk2(a4, a5); p.w = pk2(a6, a7); return __builtin_bit_cast(bf16x8, p);
}
DI void attn_unit(Frame& F, int b, int hh, int span) {
    const bf16* PT = (const bf16*)(F.ws + WS_PT); bf16* Og = (bf16*)(F.ws + WS_OG); float* Lse = (float*)(F.ws + WS_LSE); bf16* YA = (bf16*)(F.ws + WS_YA);
    LAS unsigned char* vbuf = F.lds + F.wave * 9216;
    const int lane = F.lane, n = lane & 31, half = lane >> 5;
    const int T0 = span * 512; const size_t rowbase = (size_t)b * SEQ;
    for (int su = F.wave; su < 48; su += 8) {
        const int g = su >> 4, s16 = su & 15, dsh = 2 * g, L = SEQ >> dsh, per_r = 16 >> dsh;
        const int r = s16 / per_r, sb = s16 % per_r, l0 = (T0 >> dsh) + sb * 32, head = 4 * g + hh;
        const int tq = ((l0 + n) << dsh) + r;
        const bf16* qp = PT + (rowbase + tq) * AT_COLS + head * 64 + 8 * half;
        bf16x8 qf[4];
#pragma unroll
        for (int kk = 0; kk < 4; ++kk) qf[kk] = *(const bf16x8*)(qp + 16 * kk);
        f32x16 o0, o1;
#pragma unroll
        for (int i = 0; i < 16; ++i) { o0[i] = 0.f; o1[i] = 0.f; }
        float mrun = -1e30f, lrun = 0.f;
        const int kb_lo = l0 >= 64 ? 0 : (64 - l0) >> 5, kb_hi = min(4, (L + 32 - l0) >> 5);
        bf16x8 kfn[4]; v4u vvn[4];
#define ATT_PRELOAD(kbx) do { const int lk0_ = l0 - 64 + 32 * (kbx); \
            _Pragma("unroll") for (int j = 0; j < 4; ++j) { const int idx = lane + 64 * j, key = idx >> 3, ch = idx & 7; const int tk_ = ((lk0_ + key) << dsh) + r; \
                vvn[j] = *(const v4u*)(PT + (rowbase + tk_) * AT_COLS + 1536 + head * 64 + ch * 8); } \
            const int tk2_ = ((lk0_ + n) << dsh) + r; const bf16* kp_ = PT + (rowbase + tk2_) * AT_COLS + 768 + head * 64 + 8 * half; \
            _Pragma("unroll") for (int kk = 0; kk < 4; ++kk) kfn[kk] = *(const bf16x8*)(kp_ + 16 * kk); } while (0)
        ATT_PRELOAD(kb_lo);
        for (int kb = kb_lo; kb <= kb_hi; ++kb) {
            LAS unsigned char* vb = vbuf + (kb & 1) * 4608;
            bf16x8 kf[4];
#pragma unroll
            for (int j = 0; j < 4; ++j) { const int idx = lane + 64 * j, key = idx >> 3, ch = idx & 7; *(LAS v4u*)(vb + key * 144 + ch * 16) = vvn[j]; kf[j] = kfn[j]; }
            if (kb < kb_hi) ATT_PRELOAD(kb + 1);
            f32x16 s;
#pragma unroll
            for (int i = 0; i < 16; ++i) s[i] = 0.f;
#pragma unroll
            for (int kk = 0; kk < 4; ++kk) s = MFMA32(kf[kk], qf[kk], s);
            if (kb == 0) {
#pragma unroll
                for (int i = 0; i < 16; ++i) if (crow(i, half) < n) s[i] = -1e30f; }
            if (kb == 4) {
#pragma unroll
                for (int i = 0; i < 16; ++i) if (crow(i, half) > n) s[i] = -1e30f; }
            float mx = s[0];
#pragma unroll
            for (int i = 1; i < 16; ++i) mx = fmaxf(mx, s[i]);
            mx = fmaxf(mx, __shfl_xor(mx, 32));
            const float mnew = fmaxf(mrun, mx), alpha = __builtin_amdgcn_exp2f(mrun - mnew); mrun = mnew;
            float ps = 0.f;
#pragma unroll
            for (int i = 0; i < 16; ++i) { s[i] = __builtin_amdgcn_exp2f(s[i] - mnew); ps += s[i]; }
            lrun = lrun * alpha + ps;
#pragma unroll
            for (int i = 0; i < 16; ++i) { o0[i] *= alpha; o1[i] *= alpha; }
            const bf16x8 pf0 = pack8(s[0], s[1], s[2], s[3], s[4], s[5], s[6], s[7]), pf1 = pack8(s[8], s[9], s[10], s[11], s[12], s[13], s[14], s[15]);
#pragma unroll
            for (int g2 = 0; g2 < 2; ++g2) {
                bf16x8 vf0, vf1;
#pragma unroll
                for (int si = 0; si < 8; ++si) { const int key = 16 * g2 + (si & 3) + 8 * (si >> 2) + 4 * half;
                    vf0[si] = *(const LAS short*)(vb + key * 144 + n * 2); vf1[si] = *(const LAS short*)(vb + key * 144 + (n + 32) * 2); }
                o0 = MFMA32(vf0, g2 ? pf1 : pf0, o0); o1 = MFMA32(vf1, g2 ? pf1 : pf0, o1);
            }
        }
#undef ATT_PRELOAD
        const float ltot = lrun + __shfl_xor(lrun, 32), inv = 1.f / ltot;
        bf16* op = Og + ((size_t)g * NTOK + rowbase + tq) * 256 + hh * 64;
#pragma unroll
        for (int q4 = 0; q4 < 4; ++q4) { const int d0 = 8 * q4 + 4 * half;
            v2u w0; w0.x = pk2(o0[4 * q4] * inv, o0[4 * q4 + 1] * inv); w0.y = pk2(o0[4 * q4 + 2] * inv, o0[4 * q4 + 3] * inv); *(v2u*)(op + d0) = w0;
            v2u w1; w1.x = pk2(o1[4 * q4] * inv, o1[4 * q4 + 1] * inv); w1.y = pk2(o1[4 * q4 + 2] * inv, o1[4 * q4 + 3] * inv); *(v2u*)(op + 32 + d0) = w1; }
        if (half == 0) Lse[((size_t)g * NTOK + rowbase + tq) * 4 + hh] = mrun + __builtin_amdgcn_logf(ltot);
    }
    VM_WAIT(); __syncthreads();
    __builtin_amdgcn_fence(__ATOMIC_ACQUIRE, "agent"); VM_WAIT();
    {
        const size_t tok = rowbase + T0 + F.tid;
        const float l0 = Lse[(0 * (size_t)NTOK + tok) * 4 + hh], l1 = Lse[(1 * (size_t)NTOK + tok) * 4 + hh], l2 = Lse[(2 * (size_t)NTOK + tok) * 4 + hh];
        const float mx = fmaxf(l0, fmaxf(l1, l2));
        float a0 = __builtin_amdgcn_exp2f(l0 - mx), a1 = __builtin_amdgcn_exp2f(l1 - mx), a2 = __builtin_amdgcn_exp2f(l2 - mx);
        const float inv = 1.f / (a0 + a1 + a2); a0 *= inv; a1 *= inv; a2 *= inv;
        const bf16* p0 = Og + (0 * (size_t)NTOK + tok) * 256 + hh * 64; const bf16* p1 = Og + (1 * (size_t)NTOK + tok) * 256 + hh * 64; const bf16* p2 = Og + (2 * (size_t)NTOK + tok) * 256 + hh * 64;
        bf16* yo = YA + tok * 256 + hh * 64;
#pragma unroll
        for (int c = 0; c < 8; ++c) { const v4u x0 = *(const v4u*)(p0 + 8 * c), x1 = *(const v4u*)(p1 + 8 * c), x2 = *(const v4u*)(p2 + 8 * c); v4u o;
            o.x = pk2(a0 * bflo(x0.x) + a1 * bflo(x1.x) + a2 * bflo(x2.x), a0 * bfhi(x0.x) + a1 * bfhi(x1.x) + a2 * bfhi(x2.x));
            o.y = pk2(a0 * bflo(x0.y) + a1 * bflo(x1.y) + a2 * bflo(x2.y), a0 * bfhi(x0.y) + a1 * bfhi(x1.y) + a2 * bfhi(x2.y));
            o.z = pk2(a0 * bflo(x0.z) + a1 * bflo(x1.z) + a2 * bflo(x2.z), a0 * bfhi(x0.z) + a1 * bfhi(x1.z) + a2 * bfhi(x2.z));
            o.w = pk2(a0 * bflo(x0.w) + a1 * bflo(x1.w) + a2 * bflo(x2.w), a0 * bfhi(x0.w) + a1 * bfhi(x1.w) + a2 * bfhi(x2.w));
            *(v4u*)(yo + 8 * c) = o; }
    }
    __syncthreads();
}

DI f32x4 ld4bf(const bf16* p) { const v2u u = *(const v2u*)p; return (f32x4){bflo(u.x), bfhi(u.x), bflo(u.y), bfhi(u.y)}; }
DI f32x4 shift4(const bf16* prow, bool hasp, bool hasn, const float* mup, const float* mun, int col) {
    const f32x4 u = ld4bf(prow + col);
    const float mp = hasp ? 1.f : 0.f, mn = hasn ? 1.f : 0.f;
    const f32x4 up = ld4bf(prow + (hasp ? -RW_COLS : 0) + col) * mp, un = ld4bf(prow + (hasn ? RW_COLS : 0) + col) * mn;
    return u + *(const f32x4*)(mup + col) * (up - u) + *(const f32x4*)(mun + col) * (un - u);
}
DI float red8(float v) {
    v += __builtin_bit_cast(float, __builtin_amdgcn_update_dpp(0, __builtin_bit_cast(int, v), 0xB1, 0xF, 0xF, true));
    v += __builtin_bit_cast(float, __builtin_amdgcn_update_dpp(0, __builtin_bit_cast(int, v), 0x4E, 0xF, 0xF, true));
    v += __builtin_bit_cast(float, __builtin_amdgcn_update_dpp(0, __builtin_bit_cast(int, v), 0x141, 0xF, 0xF, true));
    return v;
}
constexpr int SC_CH = 32, SC_NCH = SEQ / SC_CH;
constexpr int FP = 68, ARR_SZ = 32 * 144, ARRBUF_SZ = 5 * ARR_SZ + 32 * FP * 4;
#define SC_ARR(ab, arr) (F.lds + (ab) * ARRBUF_SZ + (arr) * ARR_SZ)
#define SC_E2(ab) ((LAS float*)(F.lds + (ab) * ARRBUF_SZ + 5 * ARR_SZ))
constexpr int SCL_CONST = 2 * ARRBUF_SZ, SCL_IMG = 65536, SCL_IMGSZ = 35072, SCL_MABT = SCL_IMG + 2 * SCL_IMGSZ;
constexpr int IM_AT = 0, IM_RT = 4608, IM_BT = 9216, IM_KT = 14336, IM_VT = 19456, IM_MAK = 24576, IM_NB = 27136, IM_NK = 29696, IM_T = 32256, IM_GC = 34816;
constexpr int P144 = 144, P80 = 80;
#define SC_IMG(ib) (F.lds + SCL_IMG + (ib) * SCL_IMGSZ)
#define SC_CONST ((LAS float*)(F.lds + SCL_CONST))
DI f32x4 up4(v2u u) { return (f32x4){bflo(u.x), bfhi(u.x), bflo(u.y), bfhi(u.y)}; }
template <int KIND> struct PrepRaw { bf16x8 xf[4]; v2u ga[4], gb[4], gc[4]; };
template <int KIND>
DI void prep_load(Frame& F, const bf16* PS, int b, int h, int dir, int c, PrepRaw<KIND>& R) {
    const int q = F.wave - 4, jt = q & 1, lane = F.lane, n = lane & 31, half = lane >> 5;
    const int tl = SC_CH * c + n, t = dir ? (SEQ - 1 - tl) : tl, hc = h * 64;
    const bf16* pr = PS + ((size_t)b * SEQ + t) * RW_COLS;
#pragma unroll
    for (int kk = 0; kk < 4; ++kk) R.xf[kk] = *(const bf16x8*)(pr + (KIND ? 1600 : 1536) + 16 * kk + 8 * half);
#pragma unroll
    for (int q4 = 0; q4 < 4; ++q4) { const int j = 32 * jt + 8 * q4 + 4 * half, jo = 32 * (1 - jt) + 8 * q4 + 4 * half;
        R.ga[q4] = *(const v2u*)(pr + (KIND ? 512 : 0) + hc + j);
        R.gb[q4] = *(const v2u*)(pr + (KIND ? 512 + hc + jo : 1024 + hc + j));
        if (KIND) R.gc[q4] = *(const v2u*)(pr + hc + j); }
}
template <int KIND>
DI void prep_compute(Frame& F, int b, int h, int dir, int c, const PrepRaw<KIND>& R, const bf16x8 (&af)[4]) {
    const int q = F.wave - 4, jt = q & 1, lane = F.lane, n = lane & 31, half = lane >> 5, ab = c & 1;
    const LAS float* cm = SC_CONST;
    f32x16 D;
#pragma unroll
    for (int i = 0; i < 16; ++i) D[i] = 0.f;
    if (KIND == 0) {
#pragma unroll
        for (int kk = 0; kk < 4; ++kk) D = MFMA32(R.xf[kk], af[kk], D);
        const int j = 32 * jt + n; const float w0j = cm[j];
        float e2[16];
#pragma unroll
        for (int i = 0; i < 16; ++i) e2[i] = 0.8750387749f * sigmoidf_(D[i] + w0j);
        float gs[4], ps[4];
#pragma unroll
        for (int g = 0; g < 4; ++g) { gs[g] = (e2[4 * g] + e2[4 * g + 1]) + (e2[4 * g + 2] + e2[4 * g + 3]); ps[g] = __shfl_xor(gs[g], 32); }
        float off = 0.f;
        LAS float* Eb = SC_E2(ab) + j;
#pragma unroll
        for (int g = 0; g < 4; ++g) {
            float run = off + (half ? ps[g] : 0.f);
#pragma unroll
            for (int ii = 0; ii < 4; ++ii) { const int i = 4 * g + ii, tau = 8 * g + 4 * half + ii; run += e2[i]; Eb[tau * FP] = run; }
            off += gs[g] + ps[g];
        }
#pragma unroll
        for (int q4 = 0; q4 < 4; ++q4) { const int jj = 32 * jt + 8 * q4 + 4 * half;
            *(LAS v2u*)(SC_ARR(ab, 3) + n * P144 + jj * 2) = R.ga[q4];
            *(LAS v2u*)(SC_ARR(ab, 4) + n * P144 + jj * 2) = R.gb[q4]; }
    } else {
#pragma unroll
        for (int kk = 0; kk < 4; ++kk) D = MFMA32(af[kk], R.xf[kk], D);
        float ss = 0.f;
#pragma unroll
        for (int q4 = 0; q4 < 4; ++q4) { const int j = 32 * jt + 8 * q4 + 4 * half, jo = 32 * (1 - jt) + 8 * q4 + 4 * half;
            const f32x4 kr = up4(R.ga[q4]) * *(const LAS f32x4*)(cm + 128 + j), ko = up4(R.gb[q4]) * *(const LAS f32x4*)(cm + 128 + jo);
            ss += (kr[0] * kr[0] + kr[1] * kr[1]) + (kr[2] * kr[2] + kr[3] * kr[3]) + (ko[0] * ko[0] + ko[1] * ko[1]) + (ko[2] * ko[2] + ko[3] * ko[3]); }
        ss += __shfl_xor(ss, 32);
        const float inv = __builtin_amdgcn_rcpf(fmaxf(__builtin_amdgcn_sqrtf(ss), 1e-12f));
        float bs = 0.f;
#pragma unroll
        for (int q4 = 0; q4 < 4; ++q4) { const int j = 32 * jt + 8 * q4 + 4 * half;
            const f32x4 az = *(const LAS f32x4*)(cm + 64 + j), kkv = *(const LAS f32x4*)(cm + 128 + j), kav = *(const LAS f32x4*)(cm + 192 + j), rkv = *(const LAS f32x4*)(cm + 256 + j);
            const f32x4 kpr = up4(R.ga[q4]), rr = up4(R.gc[q4]);
            f32x4 av, kk4, kd4;
#pragma unroll
            for (int jj = 0; jj < 4; ++jj) { av[jj] = sigmoidf_(D[4 * q4 + jj] + az[jj]); kk4[jj] = kpr[jj] * kkv[jj] * inv; kd4[jj] = kpr[jj] * (1.f + (av[jj] - 1.f) * kav[jj]); bs += rr[jj] * kd4[jj] * rkv[jj]; }
            v2u w; w.x = pk2(kd4[0], kd4[1]); w.y = pk2(kd4[2], kd4[3]); *(LAS v2u*)(SC_ARR(ab, 0) + n * P144 + j * 2) = w;
            w.x = pk2(kk4[0] * av[0], kk4[1] * av[1]); w.y = pk2(kk4[2] * av[2], kk4[3] * av[3]); *(LAS v2u*)(SC_ARR(ab, 1) + n * P144 + j * 2) = w;
            w.x = pk2(-kk4[0], -kk4[1]); w.y = pk2(-kk4[2], -kk4[3]); *(LAS v2u*)(SC_ARR(ab, 2) + n * P144 + j * 2) = w; }
        bs += __shfl_xor(bs, 32);
        const int tl = SC_CH * c + n, t = dir ? (SEQ - 1 - tl) : tl;
        if (half == 0 && !VAR(255)) ((float*)(F.ws + WS_BSUM))[(((size_t)dir * NTOK + (size_t)b * SEQ + t) * 8 + h) * 2 + jt] = bs;
    }
}
DI void scan_consts(Frame& F, const Args& a, int h, int dir) {
    LAS float* cm = SC_CONST; const int i = F.tid - 256, hc = h * 64;
    if (i < 64) { cm[i] = ((const float*)a.in[I_WD0])[dir * 512 + hc + i]; cm[64 + i] = ((const float*)a.in[I_AG0])[dir * 512 + hc + i];
        cm[128 + i] = ((const float*)a.in[I_KK])[hc + i]; cm[192 + i] = ((const float*)a.in[I_KA])[hc + i]; cm[256 + i] = ((const float*)a.in[I_RK])[hc + i]; }
}
#define SC_BARRIER() do { asm volatile("s_waitcnt lgkmcnt(0)" ::: "memory"); __builtin_amdgcn_s_barrier(); asm volatile("" ::: "memory"); } while (0)
DI bf16x8 ld_perm(const LAS unsigned char* row, int ks, int half) {
    const v2u a0 = *(const LAS v2u*)(row + (16 * ks + 4 * half) * 2), a1 = *(const LAS v2u*)(row + (16 * ks + 8 + 4 * half) * 2);
    const v4u r = {a0.x, a0.y, a1.x, a1.y}; return __builtin_bit_cast(bf16x8, r);
}
DI bf16x8 packacc(const f32x16& x, int ks) { return ks ? pack8(x[8], x[9], x[10], x[11], x[12], x[13], x[14], x[15]) : pack8(x[0], x[1], x[2], x[3], x[4], x[5], x[6], x[7]); }
DI bf16x8 frag_scaled(const LAS unsigned char* arow, const LAS float* erow, int kk, float sgn, bool ezero) {
    const v4u xr = *(const LAS v4u*)(arow + 32 * kk);
    f32x4 e0 = *(const LAS f32x4*)(erow + 16 * kk), e1 = *(const LAS f32x4*)(erow + 16 * kk + 4);
    if (ezero) { e0 = (f32x4){0.f, 0.f, 0.f, 0.f}; e1 = e0; }
    const float x[8] = {bflo(xr.x), bfhi(xr.x), bflo(xr.y), bfhi(xr.y), bflo(xr.z), bfhi(xr.z), bflo(xr.w), bfhi(xr.w)};
    float y[8];
#pragma unroll
    for (int j = 0; j < 4; ++j) { y[j] = x[j] * __builtin_amdgcn_exp2f(sgn * e0[j]); y[4 + j] = x[4 + j] * __builtin_amdgcn_exp2f(sgn * e1[j]); }
    return pack8(y[0], y[1], y[2], y[3], y[4], y[5], y[6], y[7]);
}
template <bool LO>
DI void scan_build(Frame& F, int p, int bw) {
    int lane = F.lane; LAUNDER(lane); const int n = lane & 31, half = lane >> 5, ab = p & 1;
    LAS unsigned char* img = SC_IMG(p & 1);
    const LAS float* E = SC_E2(ab) + n * FP + 8 * half;
    const LAS float* Eex = SC_E2(ab) + (n > 0 ? n - 1 : 0) * FP + 8 * half;
    const LAS unsigned char* KDr = SC_ARR(ab, 0) + n * P144 + 16 * half; const LAS unsigned char* BBr = SC_ARR(ab, 1) + n * P144 + 16 * half;
    const LAS unsigned char* AAr = SC_ARR(ab, 2) + n * P144 + 16 * half; const LAS unsigned char* Rr = SC_ARR(ab, 3) + n * P144 + 16 * half;
    if (LO && bw == 2) {
        if (VAR(16)) return;
        f32x16 z, pacc;
#pragma unroll
        for (int i = 0; i < 16; ++i) z[i] = 0.f;
#pragma unroll
        for (int kk = 0; kk < 4; ++kk) z = MFMA32(frag_scaled(BBr, E, kk, 1.f, false), frag_scaled(AAr, Eex, kk, -1.f, n == 0), z);
#pragma unroll
        for (int i = 0; i < 16; ++i) { const int srow = crow(i, half); z[i] = (srow < n) ? z[i] : 0.f; }
        LAS unsigned char* zi = F.lds + SCL_MABT;
#pragma unroll
        for (int k = 0; k < 4; ++k) {
            LAS unsigned char* zk = zi + k * (32 * P80);
#pragma unroll
            for (int i = 0; i < 16; ++i) *(LAS unsigned short*)(zk + crow(i, half) * P80 + n * 2) = (unsigned short)(pk2(z[i], 0.f) & 0xffffu);
            LDS_WAIT(); asm volatile("" ::: "memory");
            const bf16x8 zb0 = packacc(z, 0), zb1 = packacc(z, 1);
            f32x16 zn;
#pragma unroll
            for (int i = 0; i < 16; ++i) zn[i] = 0.f;
            zn = MFMA32(ld_perm(zk + n * P80, 0, half), zb0, zn); zn = MFMA32(ld_perm(zk + n * P80, 1, half), zb1, zn);
            z = zn;
        }
#pragma unroll
        for (int i = 0; i < 16; ++i) pacc[i] = z[i] + ((crow(i, half) == n) ? 1.f : 0.f);
#pragma unroll
        for (int k = 3; k >= 0; --k) {
            const LAS unsigned char* zk = zi + k * (32 * P80);
            const bf16x8 qb0 = packacc(pacc, 0), qb1 = packacc(pacc, 1);
            pacc = MFMA32(ld_perm(zk + n * P80, 0, half), qb0, pacc); pacc = MFMA32(ld_perm(zk + n * P80, 1, half), qb1, pacc);
        }
#pragma unroll
        for (int g = 0; g < 4; ++g) { v2u w; w.x = pk2(pacc[4 * g], pacc[4 * g + 1]); w.y = pk2(pacc[4 * g + 2], pacc[4 * g + 3]); *(LAS v2u*)(img + IM_T + n * P80 + (8 * g + 4 * half) * 2) = w; }
    } else if (LO && bw == 3) {
        if (VAR(32)) return;
#pragma unroll
        for (int kk = 0; kk < 4; ++kk) { const bf16x8 f = frag_scaled(BBr, E, kk, 1.f, false);
            const v4u vr = *(const LAS v4u*)(SC_ARR(ab, 4) + n * P144 + 16 * half + 32 * kk); const bf16x8 vf = __builtin_bit_cast(bf16x8, vr);
#pragma unroll
            for (int e = 0; e < 8; ++e) { *(LAS unsigned short*)(img + IM_BT + (16 * kk + 8 * half + e) * P80 + n * 2) = (unsigned short)f[e];
                *(LAS unsigned short*)(img + IM_VT + (16 * kk + 8 * half + e) * P80 + n * 2) = (unsigned short)vf[e]; } }
        ((LAS float*)(img + IM_GC))[lane] = __builtin_amdgcn_exp2f(-(SC_E2(ab)[31 * FP + lane]));
    } else if (!LO && bw <= 6) {
        if (VAR(32)) return;
        bf16x8 fa[4], fb[4];
        if (bw == 4 || bw == 5) {
#pragma unroll
            for (int kk = 0; kk < 4; ++kk) { fb[kk] = frag_scaled(bw == 4 ? AAr : Rr, bw == 4 ? Eex : E, kk, -1.f, bw == 4 && n == 0);
                *(LAS bf16x8*)(img + (bw == 4 ? IM_AT : IM_RT) + n * P144 + (16 * kk + 8 * half) * 2) = fb[kk]; }
#pragma unroll
            for (int kk = 0; kk < 4; ++kk) fa[kk] = frag_scaled(bw == 4 ? KDr : BBr, E, kk, 1.f, false);
        } else {
#pragma unroll
            for (int kk = 0; kk < 4; ++kk) { fa[kk] = frag_scaled(KDr, E, kk, 1.f, false);
#pragma unroll
                for (int e = 0; e < 8; ++e) *(LAS unsigned short*)(img + IM_KT + (16 * kk + 8 * half + e) * P80 + n * 2) = (unsigned short)fa[kk][e]; }
#pragma unroll
            for (int kk = 0; kk < 4; ++kk) fb[kk] = frag_scaled(Rr, E, kk, -1.f, false);
        }
        f32x16 x;
#pragma unroll
        for (int i = 0; i < 16; ++i) x[i] = 0.f;
#pragma unroll
        for (int kk = 0; kk < 4; ++kk) x = MFMA32(fa[kk], fb[kk], x);
        LAS unsigned char* gi = img + (bw == 4 ? IM_MAK : (bw == 5 ? IM_NB : IM_NK));
#pragma unroll
        for (int g = 0; g < 4; ++g) { float m_[4];
#pragma unroll
            for (int e = 0; e < 4; ++e) { const int srow = 8 * g + 4 * half + e; m_[e] = ((bw == 4) ? srow < n : srow <= n) ? x[4 * g + e] : 0.f; }
            v2u w_; w_.x = pk2(m_[0], m_[1]); w_.y = pk2(m_[2], m_[3]); *(LAS v2u*)(gi + n * P80 + (8 * g + 4 * half) * 2) = w_; }
    }
}
template <int KIND>
DI void scan_helper(Frame& F, const Args& a, int b, int h, int dir) {
    const bf16* PS = (const bf16*)a.out;
    const int q = F.wave - 4, jt = q & 1, n = F.lane & 31, half = F.lane >> 5;
    const bf16* WT = (const bf16*)(F.ws + (KIND ? WS_AUP_T : WS_WUP_T)) + ((size_t)dir * 512 + h * 64 + 32 * jt + n) * 64 + 8 * half;
    bf16x8 af[4];
#pragma unroll
    for (int kk = 0; kk < 4; ++kk) af[kk] = *(const bf16x8*)(WT + 16 * kk);
    PrepRaw<KIND> Ra, Rb;
    prep_load<KIND>(F, PS, b, h, dir, 0, Ra);
    prep_load<KIND>(F, PS, b, h, dir, 1, Rb);
    prep_compute<KIND>(F, b, h, dir, 0, Ra, af);
    prep_load<KIND>(F, PS, b, h, dir, 2, Ra);
    SC_BARRIER();
    prep_compute<KIND>(F, b, h, dir, 1, Rb, af);
    prep_load<KIND>(F, PS, b, h, dir, 3, Rb);
    SC_BARRIER();
#pragma unroll 1
    for (int s2 = 0; s2 < SC_NCH; s2 += 2) {
        if (s2 + 2 < SC_NCH && !VAR(4)) prep_compute<KIND>(F, b, h, dir, s2 + 2, Ra, af);
        if (!VAR(8)) prep_load<KIND>(F, PS, b, h, dir, (s2 + 4) & (SC_NCH - 1), Ra);
        SC_BARRIER();
        if (s2 + 3 < SC_NCH && !VAR(4)) prep_compute<KIND>(F, b, h, dir, s2 + 3, Rb, af);
        if (!VAR(8)) prep_load<KIND>(F, PS, b, h, dir, (s2 + 5) & (SC_NCH - 1), Rb);
        SC_BARRIER();
    }
}
DI void scan_builder_only(Frame& F) {
    SC_BARRIER();
    scan_build<true>(F, 0, F.wave); if (F.wave == 3) scan_build<false>(F, 0, 6);
    SC_BARRIER();
#pragma unroll 1
    for (int s = 0; s < SC_NCH; ++s) { if (s + 1 < SC_NCH && !VAR(2)) { scan_build<true>(F, s + 1, F.wave); if (F.wave == 3) scan_build<false>(F, s + 1, 6); } SC_BARRIER(); }
}
DI void scan_sequencer(Frame& F, int b, int h, int dir) {
    const int it = F.wave, lane = F.lane, n = lane & 31, half = lane >> 5;
    f32x16 D0, D1;
#pragma unroll
    for (int i = 0; i < 16; ++i) { D0[i] = 0.f; D1[i] = 0.f; }
    bf16* wkv = (bf16*)(F.ws + WS_WKV) + ((size_t)dir * NTOK + (size_t)b * SEQ) * 512 + h * 64 + 32 * it + n;
    SC_BARRIER();
    scan_build<false>(F, 0, 4 + it);
    SC_BARRIER();
#pragma unroll 1
    for (int c = 0; c < SC_NCH; ++c) {
        if (VAR(1)) { if (c + 1 < SC_NCH && !VAR(2)) scan_build<false>(F, c + 1, 4 + it); SC_BARRIER(); continue; }
        const LAS unsigned char* img = SC_IMG(c & 1);
        const LAS unsigned char* atr = img + IM_AT + n * P144; const LAS unsigned char* rtr = img + IM_RT + n * P144;
        const LAS unsigned char* vtr = img + IM_VT + (32 * it + n) * P80 + 16 * half;
        const bf16x8 sb00 = packacc(D0, 0), sb01 = packacc(D0, 1), sb10 = packacc(D1, 0), sb11 = packacc(D1, 1);
        const bf16x8 vt0 = *(const LAS bf16x8*)vtr, vt1 = *(const LAS bf16x8*)(vtr + 32);
        f32x16 U, Y;
#pragma unroll
        for (int i = 0; i < 16; ++i) { U[i] = 0.f; Y[i] = 0.f; }
        U = MFMA32(ld_perm(atr, 0, half), sb00, U); Y = MFMA32(ld_perm(rtr, 0, half), sb00, Y);
        U = MFMA32(ld_perm(atr, 1, half), sb01, U); Y = MFMA32(ld_perm(rtr, 1, half), sb01, Y);
        U = MFMA32(ld_perm(atr + 64, 0, half), sb10, U); Y = MFMA32(ld_perm(rtr + 64, 0, half), sb10, Y);
        U = MFMA32(ld_perm(atr + 64, 1, half), sb11, U); Y = MFMA32(ld_perm(rtr + 64, 1, half), sb11, Y);
        { const LAS unsigned char* mk = img + IM_MAK + n * P80 + 16 * half; const LAS unsigned char* nk = img + IM_NK + n * P80 + 16 * half;
          U = MFMA32(*(const LAS bf16x8*)mk, vt0, U); U = MFMA32(*(const LAS bf16x8*)(mk + 32), vt1, U);
          Y = MFMA32(*(const LAS bf16x8*)nk, vt0, Y); Y = MFMA32(*(const LAS bf16x8*)(nk + 32), vt1, Y); }
        f32x16 SA;
#pragma unroll
        for (int i = 0; i < 16; ++i) SA[i] = 0.f;
        { const LAS unsigned char* tr = img + IM_T + n * P80; const bf16x8 ub0 = packacc(U, 0), ub1 = packacc(U, 1);
          SA = MFMA32(ld_perm(tr, 0, half), ub0, SA); SA = MFMA32(ld_perm(tr, 1, half), ub1, SA); }
        const bf16x8 sab0 = packacc(SA, 0), sab1 = packacc(SA, 1);
        { const LAS unsigned char* nb = img + IM_NB + n * P80; Y = MFMA32(ld_perm(nb, 0, half), sab0, Y); Y = MFMA32(ld_perm(nb, 1, half), sab1, Y); }
        { const int tl0 = SC_CH * c;
#pragma unroll
          for (int i = 0; i < 16; ++i) { const int tl = tl0 + crow(i, half), t = dir ? (SEQ - 1 - tl) : tl; if (!VAR(255)) wkv[(size_t)t * 512] = (bf16)(pk2(Y[i], 0.f) & 0xffffu); } }
        { const LAS unsigned char* b0 = img + IM_BT + n * P80; const LAS unsigned char* k0 = img + IM_KT + n * P80 + 16 * half;
          D0 = MFMA32(ld_perm(b0, 0, half), sab0, D0); D1 = MFMA32(ld_perm(b0 + 32 * P80, 0, half), sab0, D1);
          D0 = MFMA32(ld_perm(b0, 1, half), sab1, D0); D1 = MFMA32(ld_perm(b0 + 32 * P80, 1, half), sab1, D1);
          D0 = MFMA32(*(const LAS bf16x8*)k0, vt0, D0); D1 = MFMA32(*(const LAS bf16x8*)(k0 + 32 * P80), vt0, D1);
          D0 = MFMA32(*(const LAS bf16x8*)(k0 + 32), vt1, D0); D1 = MFMA32(*(const LAS bf16x8*)(k0 + 32 * P80 + 32), vt1, D1);
          const LAS float* gc = (const LAS float*)(img + IM_GC) + 4 * half;
#pragma unroll
          for (int g = 0; g < 4; ++g) { const f32x4 g0 = *(const LAS f32x4*)(gc + 8 * g), g1 = *(const LAS f32x4*)(gc + 32 + 8 * g);
#pragma unroll
              for (int e = 0; e < 4; ++e) { D0[4 * g + e] *= g0[e]; D1[4 * g + e] *= g1[e]; } } }
        if (c + 1 < SC_NCH && !VAR(2)) scan_build<false>(F, c + 1, 4 + it);
        SC_BARRIER();
    }
}
DI void scan_unit(Frame& F, const Args& a, int b, int h, int dir) {
    if (F.wave >= 4) { scan_consts(F, a, h, dir); LDS_WAIT(); }
    __syncthreads();
    if (F.wave < 2) scan_sequencer(F, b, h, dir);
    else if (F.wave < 4) scan_builder_only(F);
    else if ((F.wave - 4) >> 1) scan_helper<1>(F, a, b, h, dir);
    else scan_helper<0>(F, a, b, h, dir);
}

DI void post_consts(Frame& F, const Args& a) {
    LAS float* cm = (LAS float*)F.lds;
    cm[F.tid] = ((const float*)a.in[I_GNW])[F.tid]; cm[512 + F.tid] = ((const float*)a.in[I_GNB])[F.tid];
    LDS_WAIT(); __syncthreads();
}
DI void post_item(Frame& F, const bf16* PS, int item) {
    const int tile = item >> 3, h = item & 7, hc = h * 64;
    const int lane = F.lane, n = lane & 31; int half = lane >> 5; LAUNDER(half);
    const bf16* GT = (const bf16*)(F.ws + WS_GUP_T);
    const bf16* WKV = (const bf16*)(F.ws + WS_WKV); const float* BS = (const float*)(F.ws + WS_BSUM); bf16* YR = (bf16*)(F.ws + WS_YR);
    const LAS float* cm = (const LAS float*)F.lds;
    const size_t tok = (size_t)tile * 32 + n;
    const bf16* pr = PS + tok * RW_COLS;
    bf16x8 bfr[8];
#pragma unroll
    for (int kk = 0; kk < 8; ++kk) bfr[kk] = *(const bf16x8*)(pr + 1664 + 16 * kk + 8 * half);
    f32x4 x[2][4]; v2u vr[2][4];
#pragma unroll
    for (int ct = 0; ct < 2; ++ct)
#pragma unroll
        for (int q4 = 0; q4 < 4; ++q4) { const int c = hc + 32 * ct + 8 * q4 + 4 * half;
            x[ct][q4] = up4(*(const v2u*)(WKV + tok * 512 + c)) + up4(*(const v2u*)(WKV + ((size_t)NTOK + tok) * 512 + c));
            vr[ct][q4] = *(const v2u*)(pr + 1024 + c); }
    const f32x2 b0 = *(const f32x2*)(BS + (tok * 8 + h) * 2), b1 = *(const f32x2*)(BS + (((size_t)NTOK + tok) * 8 + h) * 2);
    f32x16 g0, g1;
#pragma unroll
    for (int i = 0; i < 16; ++i) { g0[i] = 0.f; g1[i] = 0.f; }
    const bf16* gp = GT + (size_t)(hc + n) * 128 + 8 * half;
#pragma unroll
    for (int kk = 0; kk < 8; ++kk) { g0 = MFMA32(*(const bf16x8*)(gp + 16 * kk), bfr[kk], g0); g1 = MFMA32(*(const bf16x8*)(gp + 32 * 128 + 16 * kk), bfr[kk], g1); }
    float sm = 0.f;
#pragma unroll
    for (int ct = 0; ct < 2; ++ct)
#pragma unroll
        for (int q4 = 0; q4 < 4; ++q4) sm += (x[ct][q4][0] + x[ct][q4][1]) + (x[ct][q4][2] + x[ct][q4][3]);
    sm += __shfl_xor(sm, 32);
    const float mean = sm * (1.f / 64.f); float vs = 0.f;
#pragma unroll
    for (int ct = 0; ct < 2; ++ct)
#pragma unroll
        for (int q4 = 0; q4 < 4; ++q4) { const f32x4 d = x[ct][q4] - mean; vs += (d[0] * d[0] + d[1] * d[1]) + (d[2] * d[2] + d[3] * d[3]); }
    vs += __shfl_xor(vs, 32);
    const float rstd = 1.f / sqrtf(vs * (1.f / 64.f) + GN_EPS);
    const float bsum = (b0.x + b0.y) + (b1.x + b1.y);
#pragma unroll
    for (int ct = 0; ct < 2; ++ct)
#pragma unroll
        for (int q4 = 0; q4 < 4; ++q4) { const int c = hc + 32 * ct + 8 * q4 + 4 * half;
            const f32x4 y = (x[ct][q4] - mean) * rstd * *(const LAS f32x4*)(cm + c) + *(const LAS f32x4*)(cm + 512 + c) + up4(vr[ct][q4]) * bsum;
            f32x4 gg; if (ct == 0) gg = (f32x4){g0[4 * q4], g0[4 * q4 + 1], g0[4 * q4 + 2], g0[4 * q4 + 3]}; else gg = (f32x4){g1[4 * q4], g1[4 * q4 + 1], g1[4 * q4 + 2], g1[4 * q4 + 3]};
            const f32x4 o = y * gg; v2u w; w.x = pk2(o[0], o[1]); w.y = pk2(o[2], o[3]);
            *(v2u*)(YR + tok * YC_COLS + c) = w; }
    if (h < 4) {
        const bf16* ya = (const bf16*)(F.ws + WS_YA) + tok * 256 + h * 64 + 32 * half; bf16* yc = YR + tok * YC_COLS + 512 + h * 64 + 32 * half;
#pragma unroll
        for (int e = 0; e < 4; ++e) *(v4u*)(yc + 8 * e) = *(const v4u*)(ya + 8 * e); }
}

DI void p5_router_tile(Frame& F, const Args& a, int tile) {
    const int lane = F.lane, n = lane & 31, half = lane >> 5;
    const size_t tok = (size_t)tile * 32 + n;
    const bf16* xr = (const bf16*)(F.ws + WS_X1) + tok * DM + 8 * half;
    const bf16* RH = (const bf16*)(F.ws + WS_RT_HI) + (size_t)n * DM + 8 * half; const bf16* RL = (const bf16*)(F.ws + WS_RT_LO) + (size_t)n * DM + 8 * half;
    f32x16 d0, d1;
#pragma unroll
    for (int i = 0; i < 16; ++i) { d0[i] = 0.f; d1[i] = 0.f; }
    float ss = 0.f;
#pragma unroll 8
    for (int kk = 0; kk < 64; ++kk) {
        const v4u xv = *(const v4u*)(xr + 16 * kk);
        const float x8[8] = {bflo(xv.x), bfhi(xv.x), bflo(xv.y), bfhi(xv.y), bflo(xv.z), bfhi(xv.z), bflo(xv.w), bfhi(xv.w)};
#pragma unroll
        for (int j = 0; j < 8; ++j) ss += x8[j] * x8[j];
        const bf16x8 bh = __builtin_bit_cast(bf16x8, xv);
        const bf16x8 ah0 = *(const bf16x8*)(RH + 16 * kk), ah1 = *(const bf16x8*)(RH + 32 * DM + 16 * kk), al0 = *(const bf16x8*)(RL + 16 * kk), al1 = *(const bf16x8*)(RL + 32 * DM + 16 * kk);
        d0 = MFMA32(ah0, bh, d0); d0 = MFMA32(al0, bh, d0);
        d1 = MFMA32(ah1, bh, d1); d1 = MFMA32(al1, bh, d1);
    }
    ss += __shfl_xor(ss, 32);
    const float rstd = 1.f / sqrtf(ss * (1.f / DM) + NORM_EPS);
    const float* brg = (const float*)a.in[I_BRG]; const float* bre = (const float*)a.in[I_BRE];
    float gl[4];
#pragma unroll
    for (int j = 0; j < 4; ++j) gl[j] = __shfl(d1[j] * rstd + brg[j], n);
    int grp = 0; float gmax = gl[0];
#pragma unroll
    for (int j = 1; j < 4; ++j) if (gl[j] > gmax) { gmax = gl[j]; grp = j; }
    float gsum = 0.f;
#pragma unroll
    for (int j = 0; j < 4; ++j) gsum += __expf(gl[j] - gmax);
    const float grp_p = 1.f / gsum;
    const f32x4 bv = *(const f32x4*)(bre + 8 * grp + 4 * half);
    float cv[4];
#pragma unroll
    for (int j = 0; j < 4; ++j) { float v = d0[j]; v = grp == 1 ? d0[4 + j] : v; v = grp == 2 ? d0[8 + j] : v; v = grp == 3 ? d0[12 + j] : v; cv[j] = v * rstd + bv[j]; }
    float m1v = cv[0]; int m1i = 0;
#pragma unroll
    for (int j = 1; j < 4; ++j) if (cv[j] > m1v) { m1v = cv[j]; m1i = j; }
    float m2v = -3.0e38f; int m2i = 0;
#pragma unroll
    for (int j = 0; j < 4; ++j) if (j != m1i && cv[j] > m2v) { m2v = cv[j]; m2i = j; }
    m1i += 4 * half; m2i += 4 * half;
    const float t1v = __shfl_xor(m1v, 32), t2v = __shfl_xor(m2v, 32); const int t1i = __shfl_xor(m1i, 32), t2i = __shfl_xor(m2i, 32);
    auto better = [](float av, int ai, float bv_, int bi) { return av > bv_ || (av == bv_ && ai < bi); };
    float top1v, top2v; int top1i, top2i;
    if (better(m1v, m1i, t1v, t1i)) { top1v = m1v; top1i = m1i; if (better(m2v, m2i, t1v, t1i)) { top2v = m2v; top2i = m2i; } else { top2v = t1v; top2i = t1i; } }
    else { top1v = t1v; top1i = t1i; if (better(m1v, m1i, t2v, t2i)) { top2v = m1v; top2i = m1i; } else { top2v = t2v; top2i = t2i; } }
    const float w0 = grp_p / (1.f + __expf(top2v - top1v)), w1 = grp_p - w0;
    const int mye = 8 * grp + (half ? top2i : top1i); const float myw = half ? w1 : w0;
    unsigned long long mymask = 0ull; int cnt_l = 0;
    for (int e = 0; e < NEXP; ++e) { const unsigned long long m = __ballot(mye == e); if (mye == e) mymask = m; if (lane == e) cnt_l = __popcll(m); }
    int base_l = 0;
    if (lane < NEXP && cnt_l > 0 && !VAR(64)) base_l = (int)__hip_atomic_fetch_add((unsigned*)(F.ws + WS_CTL) + CW_CNT + 64 * lane, (unsigned)cnt_l, RLX_AGENT);
    const int mybase = __shfl(base_l, mye);
    const int pos = mybase + __popcll(mymask & ((1ull << lane) - 1ull));
    if (!VAR(64)) { ((int*)(F.ws + WS_LTOK))[(size_t)mye * NTOK + pos] = (int)tok * 2 + half;
    ((float*)(F.ws + WS_LW))[(size_t)mye * NTOK + pos] = myw; }
    const float* g2 = (const float*)a.in[I_N2G] + 8 * half; bf16* h2 = (bf16*)(F.ws + WS_H2) + tok * DM + 8 * half;
#pragma unroll 8
    for (int kk = 0; kk < 64; ++kk) {
        const v4u xv = *(const v4u*)(xr + 16 * kk); const f32x4 ga = *(const f32x4*)(g2 + 16 * kk) * rstd, gb = *(const f32x4*)(g2 + 16 * kk + 4) * rstd;
        v4u o; o.x = pk2(bflo(xv.x) * ga[0], bfhi(xv.x) * ga[1]); o.y = pk2(bflo(xv.y) * ga[2], bfhi(xv.y) * ga[3]); o.z = pk2(bflo(xv.z) * gb[0], bfhi(xv.z) * gb[1]); o.w = pk2(bflo(xv.w) * gb[2], bfhi(xv.w) * gb[3]);
        if (!VAR(64)) *(v4u*)(h2 + 16 * kk) = o; }
}
DI void p5_phase(Frame& F, const Args& a) {
    const int gw = F.bid * NWAVES + F.wave, NGW = F.G * NWAVES;
    if (!VAR(256)) for (int tile = F.wave * F.G + F.bid; tile < NTOK / 32; tile += NGW) p5_router_tile(F, a, tile);
    if (F.bid == 0 && F.tid < 128) ((v4u*)((bf16*)(F.ws + WS_H2) + (size_t)NTOK * DM))[F.tid] = (v4u){0u, 0u, 0u, 0u};
    LAS float* scr = (LAS float*)(F.lds + F.wave * 16384);
    constexpr int IPE = 256;
    if (!VAR(128)) for (int it = gw; it < NEXP * 3 * IPE; it += NGW) {
        const int e = it / (3 * IPE), r = it % (3 * IPE), which = r / IPE, item = r % IPE;
        if (which == 0) transpose_item((const float*)a.in[I_WGATE] + (size_t)e * DM * DEXP, DM, DEXP, (bf16*)(F.ws + WS_WGU_T) + (size_t)e * DM * DM, RmGate(), scr, item, F.lane);
        else if (which == 1) transpose_item((const float*)a.in[I_WUP] + (size_t)e * DM * DEXP, DM, DEXP, (bf16*)(F.ws + WS_WGU_T) + (size_t)e * DM * DM, RmUp(), scr, item, F.lane);
        else transpose_item((const float*)a.in[I_WDOWN] + (size_t)e * DEXP * DM, DEXP, DM, (bf16*)(F.ws + WS_WD_T) + (size_t)e * DM * DEXP, RmId(), scr, item, F.lane);
    }
}
DI int moe_table(Frame& F) {
    LAS int* tab = (LAS int*)(F.lds + TAB_OFF);
    if (F.tid == 0) { int acc = 0;
        for (int e = 0; e < NEXP; ++e) { const int c = (int)__hip_atomic_load((unsigned*)(F.ws + WS_CTL) + CW_CNT + 64 * e, RLX_AGENT); tab[e] = acc; tab[33 + e] = c; acc += (c + 255) >> 8; }
        tab[32] = acc; }
    __syncthreads();
    return tab[32];
}
DI void p6_gather(Frame& F) {
    const int nT = moe_table(F);
    const LAS int* tab = (const LAS int*)(F.lds + TAB_OFF);
    const bf16* h2 = (const bf16*)(F.ws + WS_H2); bf16* Xg = (bf16*)(F.ws + WS_XG);
    const int* ltok = (const int*)(F.ws + WS_LTOK); const float* lw = (const float*)(F.ws + WS_LW);
    const int nrows = nT * 256, rstride = F.G * NWAVES;
    for (int R0 = F.bid * NWAVES + F.wave; R0 < nrows; R0 += 4 * rstride) {
        int tk[4], kq[4]; float wv[4];
#pragma unroll
        for (int u = 0; u < 4; ++u) { const int R = R0 + u * rstride; tk[u] = -1; kq[u] = 0; wv[u] = 0.f;
            if (R < nrows) { const int tile = R >> 8; int e = 0;
                for (int k = 1; k < NEXP; ++k) e += (tab[k] <= tile) ? 1 : 0;
                const int slot = R - tab[e] * 256;
                if (slot < tab[33 + e]) { const int t2 = ltok[(size_t)e * NTOK + slot]; tk[u] = t2 >> 1; kq[u] = t2 & 1; wv[u] = lw[(size_t)e * NTOK + slot]; } } }
        v4u d0[4], d1[4];
#pragma unroll
        for (int u = 0; u < 4; ++u) { const v4u* src = (const v4u*)(h2 + (size_t)(tk[u] < 0 ? NTOK : tk[u]) * DM); d0[u] = src[F.lane]; d1[u] = src[F.lane + 64]; }
#pragma unroll
        for (int u = 0; u < 4; ++u) { const int R = R0 + u * rstride; if (R < nrows) { v4u* dst = (v4u*)(Xg + (size_t)R * DM); dst[F.lane] = d0[u]; dst[F.lane + 64] = d1[u];
            if (F.lane == 0) { ((float*)(F.ws + WS_ROWW))[R] = wv[u]; if (tk[u] >= 0) ((int*)(F.ws + WS_INV))[tk[u] * 2 + kq[u]] = R; } } }
    }
}

__global__ void __launch_bounds__(NWAVES * 64, 2) mk_fwd(Args args) {
    extern __shared__ __attribute__((aligned(16))) unsigned char lds[];
    Frame F;
    F.lds = (LAS unsigned char*)lds; F.MISC = (volatile LAS unsigned*)(F.lds + MISC_OFF);
    F.tid = threadIdx.x; F.lane = F.tid & 63; F.wave = __builtin_amdgcn_readfirstlane(F.tid >> 6); F.G = gridDim.x; F.bid = blockIdx.x; F.ws = args.ws; F.variant = args.variant;
    for (int u = F.tid; u < (LDS_BYTES - RING_BYTES) / 4; u += NWAVES * 64) ((LAS unsigned*)(F.lds + RING_BYTES))[u] = 0u;
    __syncthreads();
    const int lo = args.ph_lo, hi = args.ph_hi;
    const bool multi = (hi - lo) > 1;
    XcdBarrier bar; bar.bar = (unsigned*)(args.ws + WS_CTL) + CW_BAR + args.li * XCD_BAR_WORDS; bar.x = 0; bar.st = nullptr;
    if (multi) bar = xcd_barrier_post((unsigned*)(args.ws + WS_CTL) + CW_BAR + args.li * XCD_BAR_WORDS, F.MISC + 8);
#ifndef PH_MASK
#define PH_MASK 0xFFFFFFFFu
#endif
#define REFRESH() do { F.lane = (int)__builtin_amdgcn_mbcnt_hi(~0u, __builtin_amdgcn_mbcnt_lo(~0u, 0u)); F.tid = F.wave * 64 + F.lane; } while (0)
#define IN(k) ((((PH_MASK) >> (k)) & 1u) && lo <= (k) && (k) < hi)
#define SEAM(k) do { if (IN(k) && IN((k) + 1)) xcd_barrier(bar); } while (0)
    unsigned char* ws = args.ws;

    if (IN(0)) { REFRESH(); p0_prologue(F, args); } SEAM(0);
    if (IN(1)) { REFRESH();
        pg8::Gemm g{(const bf16*)(ws + WS_HB), (const bf16*)(ws + WS_WIN_T), DM, 0}; pg8::StaticOrder S; S.init(NTOK, IN_COLS, F.G, F.bid);
        pg8::EpiIn E{(bf16*)(ws + WS_PR), (bf16*)(ws + WS_PT), (bf16*)(ws + WS_G), (const float*)args.in[I_BMERGE]};
        pg8::gemm_phase<pg8::EpiIn, pg8::StaticOrder, true, true>(F.lds, g, S, E);
    } SEAM(1);
    if (IN(2)) { REFRESH(); if (!VAR(128)) p1b_qkprep(F, args); if (!VAR(256)) p1c_preshift(F, args); } SEAM(2);
    if (IN(3)) { REFRESH(); for (int u = F.bid; u < 256; u += F.G) attn_unit(F, u >> 4, (u >> 2) & 3, u & 3); } SEAM(3);
    if (IN(4)) { REFRESH(); for (int u = F.bid; u < 256; u += F.G) scan_unit(F, args, u >> 4, (u >> 1) & 7, u & 1); } SEAM(4);
    if (IN(5)) { REFRESH(); post_consts(F, args);
#pragma unroll 1
        for (int item = F.bid * NWAVES + F.wave; item < NTOK / 32 * 8; item += F.G * NWAVES) post_item(F, (const bf16*)args.out, item); } SEAM(5);
    if (IN(6)) { REFRESH();
        pg8::Gemm g{(const bf16*)(ws + WS_YR), (const bf16*)(ws + WS_WR_T), YC_COLS, 0}; pg8::StaticOrder S; S.init(NTOK, DM, F.G, F.bid);
        pg8::EpiMix2 E{(const bf16*)(ws + WS_G), (bf16*)(ws + WS_Z)};
        pg8::gemm_phase<pg8::EpiMix2, pg8::StaticOrder, true, true>(F.lds, g, S, E);
    } SEAM(6);
    if (IN(8)) { REFRESH();
        pg8::Gemm g{(const bf16*)(ws + WS_Z), (const bf16*)(ws + WS_WOUT_T), DM, 0}; pg8::StaticOrder S; S.init(NTOK, DM, F.G, F.bid);
        pg8::EpiRes E{(const float*)args.in[I_X], (bf16*)(ws + WS_X1)};
        pg8::gemm_phase<pg8::EpiRes, pg8::StaticOrder, true, true>(F.lds, g, S, E);
    } SEAM(8);
    if (IN(9)) { REFRESH(); p5_phase(F, args); } SEAM(9);
    if (IN(10)) { REFRESH(); p6_gather(F); } SEAM(10);
    if (IN(11)) { REFRESH();
        const int nT = moe_table(F);
        pg8::Gemm g{(const bf16*)(ws + WS_XG), (const bf16*)(ws + WS_WGU_T), DM, (size_t)DM * DM * 2}; pg8::GroupedOrder S{(const LAS int*)(F.lds + TAB_OFF), nT, F.G, F.bid};
        pg8::EpiSwiglu E{(bf16*)(ws + WS_HH)};
        pg8::gemm_phase<pg8::EpiSwiglu, pg8::GroupedOrder, true, true>(F.lds, g, S, E);
    } SEAM(11);
    if (IN(12)) { REFRESH();
        const int nT = moe_table(F);
        pg8::Gemm g{(const bf16*)(ws + WS_HH), (const bf16*)(ws + WS_WD_T), DEXP, (size_t)DM * DEXP * 2}; pg8::GroupedOrder S{(const LAS int*)(F.lds + TAB_OFF), nT, F.G, F.bid};
        pg8::EpiStoreY E{(const float*)(ws + WS_ROWW), (bf16*)(ws + WS_YB)};
        pg8::gemm_phase<pg8::EpiStoreY, pg8::GroupedOrder, true, true>(F.lds, g, S, E);
    } SEAM(12);
    if (IN(13)) { REFRESH();
        const int* inv = (const int*)(ws + WS_INV); const bf16* Y = (const bf16*)(ws + WS_YB);
        const int tstride = F.G * NWAVES;
        for (int tok0 = F.bid * NWAVES + F.wave; tok0 < NTOK; tok0 += 4 * tstride) {
            int r0[4], r1[4];
#pragma unroll
            for (int u = 0; u < 4; ++u) { const int tok = tok0 + u * tstride; r0[u] = inv[tok * 2]; r1[u] = inv[tok * 2 + 1]; }
#pragma unroll
            for (int u = 0; u < 4; ++u) { const int tok = tok0 + u * tstride;
                f32x4* o = (f32x4*)(args.out + (size_t)tok * DM) + F.lane; const v2u* xb = (const v2u*)((const bf16*)(ws + WS_X1) + (size_t)tok * DM) + F.lane;
                const v2u* y0 = (const v2u*)(Y + (size_t)r0[u] * DM) + F.lane; const v2u* y1 = (const v2u*)(Y + (size_t)r1[u] * DM) + F.lane;
                v2u xv[4], a0[4], a1[4];
#pragma unroll
                for (int j = 0; j < 4; ++j) { xv[j] = xb[64 * j]; a0[j] = y0[64 * j]; a1[j] = y1[64 * j]; }
#pragma unroll
                for (int j = 0; j < 4; ++j) { f32x4 v; v[0] = bflo(xv[j].x) + bflo(a0[j].x) + bflo(a1[j].x); v[1] = bfhi(xv[j].x) + bfhi(a0[j].x) + bfhi(a1[j].x); v[2] = bflo(xv[j].y) + bflo(a0[j].y) + bflo(a1[j].y); v[3] = bfhi(xv[j].y) + bfhi(a0[j].y) + bfhi(a1[j].y); if (!VAR(64)) o[64 * j] = v; } }
        }
    }
#undef IN
#undef SEAM
}

constexpr int NPHASE = 14;
extern "C" void kernel_launch(void* const* d_in, const int* in_sizes, int n_in, void* d_out, int out_size, void* d_ws, size_t ws_size, hipStream_t stream) {
    static int grid = 0;
    if (grid == 0) {
        if (n_in != 30 || ws_size < WS_END) { fprintf(stderr, "kernel_launch: need 30 inputs and >= %zu bytes of workspace (got %d, %zu)\n", (size_t)WS_END, n_in, ws_size); grid = -1; return; }
        int dev = 0, cus = 0;
        if (hipGetDevice(&dev) != hipSuccess || hipDeviceGetAttribute(&cus, hipDeviceAttributeMultiprocessorCount, dev) != hipSuccess) { grid = -1; return; }
        if (hipFuncSetAttribute((const void*)mk_fwd, hipFuncAttributeMaxDynamicSharedMemorySize, LDS_BYTES) != hipSuccess) { fprintf(stderr, "kernel_launch: hipFuncSetAttribute failed\n"); grid = -1; return; }
        int per_cu = 0;
        if (hipOccupancyMaxActiveBlocksPerMultiprocessor(&per_cu, (const void*)mk_fwd, NWAVES * 64, LDS_BYTES) != hipSuccess || per_cu < 1) fprintf(stderr, "kernel_launch: occupancy query reports %d\n", per_cu);
        (void)hipGetLastError();
        grid = cus;
    }
    if (grid < 0) return;
    hipMemsetAsync((char*)d_ws + WS_CTL, 0, CTL_ZERO_BYTES, stream);
    Args a{};
    for (int i = 0; i < 30; ++i) a.in[i] = d_in[i];
    a.out = (float*)d_out; a.ws = (unsigned char*)d_ws;
#if defined(PROBE_REPEAT)
#ifdef PROBE_VARIANT
#define PROBE_VARIANT_V PROBE_VARIANT
#else
#define PROBE_VARIANT_V 0
#endif
    { const int k = PROBE_REPEAT; int li = 0;
      const int cuts[5][2] = {{0, k}, {k, k + 1}, {k, k + 1}, {k + 1, NPHASE}, {0, 0}};
      for (int i = 0; i < 4; ++i) { if (cuts[i][1] <= cuts[i][0]) continue; a.ph_lo = cuts[i][0]; a.ph_hi = cuts[i][1]; a.li = li++; a.variant = (i == 2) ? PROBE_VARIANT_V : 0; hipLaunchKernelGGL(mk_fwd, dim3(grid), dim3(NWAVES * 64), LDS_BYTES, stream, a); } }
#elif !defined(MK_MULTI_LAUNCH)
    a.ph_lo = 0; a.ph_hi = NPHASE; a.li = 0;
    hipLaunchKernelGGL(mk_fwd, dim3(grid), dim3(NWAVES * 64), LDS_BYTES, stream, a);
#else
    for (int p = 0; p < NPHASE; ++p) { a.ph_lo = p; a.ph_hi = p + 1; a.li = 0; hipLaunchKernelGGL(mk_fwd, dim3(grid), dim3(NWAVES * 64), LDS_BYTES, stream, a); }
#endif
}
```

```cpp
#include <hip/hip_runtime.h>
#include <cstdio>
#include <cstdint>

constexpr int BATCH = 16, SEQ = 2048, DM = 1024, NTOK = BATCH * SEQ;
constexpr int RW_COLS = 1792, AT_COLS = 2304, G_COLS = 2048, IN_COLS = 6144;
constexpr int NEXP = 32, DEXP = 512;
constexpr int MAXTILES = 288;
constexpr float NORM_EPS = 1e-6f, GN_EPS = 64e-5f;

#define GAS __attribute__((address_space(1)))
#define LAS __attribute__((address_space(3)))
typedef unsigned short bf16;
typedef unsigned v4u __attribute__((ext_vector_type(4)));
typedef unsigned v2u __attribute__((ext_vector_type(2)));
typedef float f32x4 __attribute__((ext_vector_type(4)));
typedef float f32x2 __attribute__((ext_vector_type(2)));
typedef float f32x16 __attribute__((ext_vector_type(16)));
typedef short bf16x8 __attribute__((ext_vector_type(8)));
typedef __bf16 bf16x2_t __attribute__((ext_vector_type(2)));
typedef GAS unsigned gu32;
#define RLX_AGENT __ATOMIC_RELAXED, __HIP_MEMORY_SCOPE_AGENT
#define LDS_WAIT() asm volatile("s_waitcnt lgkmcnt(0)" ::: "memory")
#define VM_WAIT() asm volatile("s_waitcnt vmcnt(0)" ::: "memory")
#define DI __device__ __forceinline__
#ifdef PROBE_VARIANT
#define VAR(b) (F.variant & (b))
#else
#define VAR(b) 0
#endif
#define LAUNDER(x) asm volatile("" : "+v"(x))

DI unsigned pk2(float lo, float hi) { f32x2 v = {lo, hi}; bf16x2_t b = __builtin_convertvector(v, bf16x2_t); return __builtin_bit_cast(unsigned, b); }
DI float bflo(unsigned u) { return __builtin_bit_cast(float, u << 16); }
DI float bfhi(unsigned u) { return __builtin_bit_cast(float, u & 0xffff0000u); }
DI float sigmoidf_(float x) { return __builtin_amdgcn_rcpf(1.f + __builtin_amdgcn_exp2f(-1.44269504f * x)); }
DI float wave_sum(float v) {
#pragma unroll
    for (int o = 1; o < 64; o <<= 1) v += __shfl_xor(v, o);
    return v;
}
DI int crow(int reg, int h) { return (reg & 3) + 8 * (reg >> 2) + 4 * h; }
#define MFMA32(a, b, c) __builtin_amdgcn_mfma_f32_32x32x16_bf16((a), (b), (c), 0, 0, 0)

constexpr size_t MiB = 1u << 20;
constexpr size_t WS_CTL = 0, CTL_ZERO_BYTES = 1 * MiB;
constexpr size_t WS_WIN_T = 1 * MiB;
constexpr size_t WS_WR_T = 13 * MiB;
constexpr size_t WS_WA_T = 14 * MiB;
constexpr size_t WS_WOUT_T = 15 * MiB;
constexpr size_t WS_GUP_T = 17 * MiB;
constexpr size_t WS_RT_HI = 17 * MiB + 256 * 1024;
constexpr size_t WS_RT_LO = 17 * MiB + 384 * 1024;
constexpr size_t WS_WUP_T = 17 * MiB + 512 * 1024;
constexpr size_t WS_AUP_T = 17 * MiB + 640 * 1024;
constexpr size_t RG_A = 18 * MiB, RG_B = 82 * MiB, RG_C = 194 * MiB, RG_D = 338 * MiB, RG_E = 466 * MiB, WS_END = 512 * MiB;
constexpr size_t WS_HB = RG_A;
constexpr size_t WS_PR = RG_B;
constexpr size_t WS_PT = RG_C;
constexpr size_t WS_G = RG_D;
constexpr size_t WS_OG = RG_A;
constexpr size_t WS_LSE = RG_A + 48 * MiB;
constexpr size_t WS_YA = RG_E;
constexpr size_t WS_BSUM = RG_E + 16 * MiB;
constexpr size_t WS_WKV = RG_C;
constexpr size_t WS_YR = RG_A;
constexpr int YC_COLS = 768;
constexpr size_t WS_X1 = RG_A;
constexpr size_t WS_Z1 = RG_C;
constexpr size_t WS_Z = RG_C + 64 * MiB;
constexpr size_t WS_H2 = RG_B;
constexpr size_t WS_LTOK = RG_E + 20 * MiB;
constexpr size_t WS_LW = RG_E + 24 * MiB;
constexpr size_t WS_ROWTOK = RG_E + 28 * MiB;
constexpr size_t WS_ROWW = RG_E + 29 * MiB;
constexpr size_t WS_WGU_T = RG_D;
constexpr size_t WS_WD_T = 434 * MiB;
constexpr size_t WS_XG = RG_C;
constexpr size_t WS_HH = RG_C;
constexpr size_t WS_YB = RG_C + 72 * MiB;
constexpr size_t WS_INV = RG_E + 30 * MiB;
constexpr int CW_BAR = 4096;
constexpr int CW_CNT = 32768;

constexpr int RING_BYTES = 155648;
constexpr int MISC_OFF = RING_BYTES + 320;
constexpr int TAB_OFF = RING_BYTES + 1024;
constexpr int LDS_BYTES = 163840;
constexpr int NWAVES = 8;

namespace pg8 {
constexpr int BM = 256, BK = 64, HALF = 128, HTB = HALF * BK * 2, STAGE_BYTES = 8 * HTB, NXCD = 8, WGM = 8;
__host__ __device__ __forceinline__ int lds_byte(int r, int c) { const int st = (r >> 4) * 2 + (c >> 5), rr = r & 15, cc = c & 31, ob = rr * 64 + cc * 2; return st * 1024 + (ob ^ (((ob >> 9) & 1) << 5)); }
__host__ __device__ __forceinline__ void stage_rc(int b, int& R, int& C) { const int st = b / 1024, sb = b % 1024, swz = sb ^ (((sb >> 9) & 1) << 5); R = (st >> 1) * 16 + swz / 64; C = (st & 1) * 32 + (swz % 64) / 2; }
__host__ __device__ __forceinline__ int perm32(int rho) { const int n = rho >> 4, i = rho & 15; return 8 * (i >> 2) + 4 * n + (i & 3); }

struct Unit { int pm, pn, e; };
struct Gemm { const bf16* A; const bf16* Bt; int K; size_t bgroup; const int* ltok; const LAS int* tab; };

struct StaticOrder {
    int nM, nN, nwg, G, c;
    __device__ void init(int M, int N, int G_, int c_) { nM = M / BM; nN = N / BM; nwg = nM * nN; G = G_; c = c_; }
    __device__ bool next(int i, Unit& u) const {
        const long L = (long)i * G + c; if (L >= nwg) return false;
        int wgid = (int)L; { const int q = nwg / NXCD, r = nwg % NXCD, xcd = wgid % NXCD, off = wgid / NXCD; wgid = (xcd < r ? xcd * (q + 1) : r * (q + 1) + (xcd - r) * q) + off; }
        const int nig = WGM * nN, gid = wgid / nig, fm = gid * WGM, gsz = (nM - fm) < WGM ? (nM - fm) : WGM;
        u.pm = fm + ((wgid % nig) % gsz); u.pn = (wgid % nig) / gsz; u.e = 0; return true;
    }
};
struct GroupedOrder {
    const LAS int* tstart; int nT, G, c;
    __device__ bool next(int i, Unit& u) const {
        const int L = i * G + c; if (L >= nT * 4) return false;
        u.pm = L >> 2; u.pn = L & 3; int e = 0;
        for (int k = 1; k < NEXP; ++k) e += (tstart[k] <= u.pm) ? 1 : 0;
        u.e = e; return true;
    }
};

template <class Epi, class Sched, bool ALIGN_EPI = false, bool SP2 = false, bool GATHER = false>
__device__ __forceinline__ void gemm_phase(LAS unsigned char* lds, const Gemm g, const Sched& S, const Epi& E) {
    const int tid = threadIdx.x, wid = __builtin_amdgcn_readfirstlane(tid >> 6), lane = tid & 63, wr = wid >> 2, wc = wid & 3, fr = lane & 15, fq = lane >> 4;
    const int K = g.K, nt = K / BK;
    unsigned voffA[2], voffB[2];
#pragma unroll
    for (int i = 0; i < 2; ++i) { int R, C; stage_rc(tid * 16 + i * 8192, R, C); const int Rb = Epi::PERM ? ((R & ~31) + perm32(R & 31)) : R;
        voffA[i] = (unsigned)(R * K + C) * 2u; voffB[i] = (unsigned)(Rb * K + C) * 2u; }
    const size_t kstep = (size_t)(BK * 2);
    const size_t hstep = (size_t)HALF * K * 2;
    const size_t tstep = 2 * hstep;
    const unsigned ldsw = (unsigned)wid * 1024u;
    const int aoff = lds_byte(wr * 64 + fr, fq * 8), boff = lds_byte(wc * 32 + fr, fq * 8);
    const size_t hstepA = GATHER ? 0 : hstep;
    unsigned voffGc[2][2], voffGn[2][2];
#define PG8_GOFF(dst, un) do { if constexpr (GATHER) { _Pragma("unroll") for (int _h = 0; _h < 2; ++_h) _Pragma("unroll") for (int _i = 0; _i < 2; ++_i) { int R_, C_; stage_rc(tid * 16 + _i * 8192, R_, C_); \
        const int slot_ = ((un).pm - g.tab[(un).e]) * 256 + _h * 128 + R_; const int tok_ = slot_ < g.tab[33 + (un).e] ? (g.ltok[(size_t)(un).e * NTOK + slot_] >> 1) : NTOK; \
        dst[_h][_i] = (unsigned)(tok_ * K + C_) * 2u; } } } while (0)
#define PG8_VA(sel, h) (GATHER ? ((sel) ? voffGn[h] : voffGc[h]) : voffA)
#define PG8_SA(b, h) (((b) * 2 + (h)) * HTB)
#define PG8_SB(b, h) ((4 + (b) * 2 + (h)) * HTB)
#define PG8_STAGE(bufoff, gbase, voff) do { _Pragma("unroll") for (int _i = 0; _i < 2; ++_i) \
        __builtin_amdgcn_global_load_lds((const unsigned*)((const char*)(gbase) + (voff)[_i]), (LAS unsigned*)(lds + (bufoff) + ldsw + _i * 8192), 16, 0, 0); } while (0)
#define PG8_LDA(dst, b, h) do { _Pragma("unroll") for (int m = 0; m < 4; ++m) _Pragma("unroll") for (int k = 0; k < 2; ++k) dst[m][k] = *(const LAS bf16x8*)(lds + PG8_SA(b, h) + aoff + m * 2048 + k * 1024); } while (0)
#define PG8_LDB(dst, b, h) do { _Pragma("unroll") for (int n = 0; n < 2; ++n) _Pragma("unroll") for (int k = 0; k < 2; ++k) dst[n][k] = *(const LAS bf16x8*)(lds + PG8_SB(b, h) + boff + n * 2048 + k * 1024); } while (0)
#define PG8_MMA(ai, bj, At, Bt) do { __builtin_amdgcn_s_setprio(1); _Pragma("unroll") for (int m = 0; m < 4; ++m) _Pragma("unroll") for (int n = 0; n < 2; ++n) _Pragma("unroll") for (int k = 0; k < 2; ++k) \
        acc[ai][bj][m][n] = __builtin_amdgcn_mfma_f32_16x16x32_bf16(Bt[n][k], At[m][k], acc[ai][bj][m][n], 0, 0, 0); __builtin_amdgcn_s_setprio(0); } while (0)
#define PG8_WAIT_V(n) asm volatile("s_waitcnt vmcnt(" #n ")" ::: "memory")
#define PG8_WAIT_L(n) asm volatile("s_waitcnt lgkmcnt(" #n ")" ::: "memory")
#define PG8_BAR __builtin_amdgcn_s_barrier()
#define PG8_SCHED __builtin_amdgcn_sched_barrier(0)
    Unit cur, nxt; int ui = 0;
    if (!S.next(0, cur)) return;
    f32x4 acc[2][2][4][2];
#pragma unroll
    for (int a = 0; a < 2; ++a)
#pragma unroll
        for (int b = 0; b < 2; ++b)
#pragma unroll
            for (int m = 0; m < 4; ++m)
#pragma unroll
                for (int n = 0; n < 2; ++n) acc[a][b][m][n] = (f32x4){0.f, 0.f, 0.f, 0.f};
    bf16x8 At[4][2], B0[2][2], B1[2][2];
    const char* cA = (const char*)g.A + (GATHER ? 0 : (size_t)cur.pm * tstep); const char* cB = (const char*)g.Bt + (size_t)cur.e * g.bgroup + (size_t)cur.pn * tstep;
    PG8_GOFF(voffGc, cur);
    if constexpr (SP2) {
        PG8_STAGE(PG8_SB(0, 0), cB, voffB); PG8_STAGE(PG8_SB(0, 1), cB + hstep, voffB); PG8_STAGE(PG8_SA(0, 0), cA, PG8_VA(false, 0)); PG8_STAGE(PG8_SA(0, 1), cA + hstepA, PG8_VA(false, 1));
        if (wr == 1) PG8_BAR;
        PG8_WAIT_V(2); PG8_BAR;
        PG8_STAGE(PG8_SB(1, 0), cB + kstep, voffB); PG8_STAGE(PG8_SA(1, 0), cA + kstep, PG8_VA(false, 0)); PG8_STAGE(PG8_SB(1, 1), cB + hstep + kstep, voffB);
        PG8_WAIT_V(6); PG8_BAR;
    } else {
        PG8_STAGE(PG8_SB(0, 0), cB, voffB); PG8_STAGE(PG8_SA(0, 0), cA, PG8_VA(false, 0)); PG8_STAGE(PG8_SB(0, 1), cB + hstep, voffB); PG8_STAGE(PG8_SA(0, 1), cA + hstepA, PG8_VA(false, 1));
        if (wr == 1) PG8_BAR;
        PG8_WAIT_V(4); PG8_BAR;
        PG8_STAGE(PG8_SB(1, 0), cB + kstep, voffB); PG8_STAGE(PG8_SA(1, 0), cA + kstep, PG8_VA(false, 0)); PG8_STAGE(PG8_SB(1, 1), cB + hstep + kstep, voffB);
        PG8_WAIT_V(6); PG8_BAR;
    }
    for (;;) {
        const bool has_next = S.next(ui + 1, nxt);
        const char* nA = has_next ? (const char*)g.A + (GATHER ? 0 : (size_t)nxt.pm * tstep) : cA;
        if (has_next) PG8_GOFF(voffGn, nxt); const char* nB = has_next ? (const char*)g.Bt + (size_t)nxt.e * g.bgroup + (size_t)nxt.pn * tstep : cB;
        for (int t = 0; t < nt; t += 2) {
            if constexpr (Epi::MID_T >= 0) { if (t == Epi::MID_T) E.mid(acc, cur, wr, wc, fr, fq); }
            const bool last = (t == nt - 2); const bool seln = last && has_next;
            const char* a1 = cA + (size_t)(t + 1) * kstep;
            const char* a2 = last ? nA : cA + (size_t)(t + 2) * kstep; const char* b2 = last ? nB : cB + (size_t)(t + 2) * kstep;
            const char* a3 = a2 + kstep; const char* b3 = b2 + kstep;
            if constexpr (SP2) {
            PG8_LDB(B0, 0, 0); PG8_LDB(B1, 0, 1); PG8_SCHED; PG8_LDA(At, 0, 0); PG8_STAGE(PG8_SA(1, 1), a1 + hstepA, PG8_VA(false, 1));
            PG8_WAIT_V(8); PG8_WAIT_L(0); PG8_BAR; PG8_MMA(0, 0, At, B0); PG8_MMA(0, 1, At, B1); PG8_BAR; PG8_SCHED;
            PG8_LDA(At, 0, 1); PG8_STAGE(PG8_SB(0, 0), b2, voffB); PG8_STAGE(PG8_SB(0, 1), b2 + hstep, voffB); PG8_STAGE(PG8_SA(0, 0), a2, PG8_VA(seln, 0));
            PG8_WAIT_V(8); PG8_WAIT_L(0); PG8_BAR; PG8_MMA(1, 0, At, B0); PG8_MMA(1, 1, At, B1); PG8_BAR; PG8_SCHED;
            PG8_LDB(B0, 1, 0); PG8_LDB(B1, 1, 1); PG8_SCHED; PG8_LDA(At, 1, 0); PG8_STAGE(PG8_SA(0, 1), a2 + hstepA, PG8_VA(seln, 1));
            PG8_WAIT_V(8); PG8_WAIT_L(0); PG8_BAR; PG8_MMA(0, 0, At, B0); PG8_MMA(0, 1, At, B1); PG8_BAR; PG8_SCHED;
            PG8_LDA(At, 1, 1); PG8_STAGE(PG8_SB(1, 0), b3, voffB); PG8_STAGE(PG8_SB(1, 1), b3 + hstep, voffB); PG8_STAGE(PG8_SA(1, 0), a3, PG8_VA(seln, 0));
            PG8_WAIT_V(8); PG8_WAIT_L(0); PG8_BAR; PG8_MMA(1, 0, At, B0); PG8_MMA(1, 1, At, B1); PG8_BAR; PG8_SCHED;
            } else {
            PG8_LDB(B0, 0, 0); PG8_SCHED; PG8_LDA(At, 0, 0); PG8_STAGE(PG8_SA(1, 1), a1 + hstepA, PG8_VA(false, 1));
            PG8_WAIT_L(8); PG8_BAR; PG8_WAIT_L(0); PG8_MMA(0, 0, At, B0); PG8_BAR; PG8_SCHED;
            PG8_LDB(B1, 0, 1); PG8_STAGE(PG8_SB(0, 0), b2, voffB);
            PG8_BAR; PG8_WAIT_L(0); PG8_MMA(0, 1, At, B1); PG8_BAR;
            PG8_LDA(At, 0, 1); PG8_STAGE(PG8_SA(0, 0), a2, PG8_VA(seln, 0));
            PG8_BAR; PG8_WAIT_L(0); PG8_MMA(1, 0, At, B0); PG8_BAR; PG8_SCHED;
            PG8_STAGE(PG8_SB(0, 1), b2 + hstep, voffB);
            PG8_WAIT_V(6); PG8_BAR; PG8_MMA(1, 1, At, B1); PG8_BAR;
            PG8_LDB(B0, 1, 0); PG8_SCHED; PG8_LDA(At, 1, 0); PG8_STAGE(PG8_SA(0, 1), a2 + hstepA, PG8_VA(seln, 1));
            PG8_WAIT_L(8); PG8_BAR; PG8_WAIT_L(0); PG8_MMA(0, 0, At, B0); PG8_BAR; PG8_SCHED;
            PG8_LDB(B1, 1, 1); PG8_STAGE(PG8_SB(1, 0), b3, voffB);
            PG8_BAR; PG8_WAIT_L(0); PG8_MMA(0, 1, At, B1); PG8_BAR;
            PG8_LDA(At, 1, 1); PG8_STAGE(PG8_SA(1, 0), a3, PG8_VA(seln, 0));
            PG8_BAR; PG8_WAIT_L(0); PG8_MMA(1, 0, At, B0); PG8_BAR; PG8_SCHED;
            PG8_STAGE(PG8_SB(1, 1), b3 + hstep, voffB);
            PG8_WAIT_V(6); PG8_BAR; PG8_MMA(1, 1, At, B1); PG8_BAR;
            }
        }
        if constexpr (ALIGN_EPI) { if (wr == 0) PG8_BAR; }
        E(acc, cur, wr, wc, fr, fq);
        if (!has_next) break;
#pragma unroll
        for (int a = 0; a < 2; ++a)
#pragma unroll
            for (int b = 0; b < 2; ++b)
#pragma unroll
                for (int m = 0; m < 4; ++m)
#pragma unroll
                    for (int n = 0; n < 2; ++n) acc[a][b][m][n] = (f32x4){0.f, 0.f, 0.f, 0.f};
        cur = nxt; cA = nA; cB = nB; ++ui;
        if constexpr (GATHER) { voffGc[0][0] = voffGn[0][0]; voffGc[0][1] = voffGn[0][1]; voffGc[1][0] = voffGn[1][0]; voffGc[1][1] = voffGn[1][1]; }
        if constexpr (ALIGN_EPI) { if (wr == 1) PG8_BAR; }
    }
    PG8_WAIT_V(0);
    if constexpr (!ALIGN_EPI) { if (wr == 0) PG8_BAR; }
    PG8_BAR;
#undef PG8_SA
#undef PG8_GOFF
#undef PG8_VA
#undef PG8_SB
#undef PG8_STAGE
#undef PG8_LDA
#undef PG8_LDB
#undef PG8_MMA
#undef PG8_WAIT_V
#undef PG8_WAIT_L
#undef PG8_BAR
#undef PG8_SCHED
}

struct EpiIn {
    static constexpr bool PERM = true; static constexpr int MID_T = -1;
    bf16* PR; bf16* PT; bf16* G; const float* bmerge;
    __device__ __forceinline__ void operator()(const f32x4 (&acc)[2][2][4][2], const Unit& u, int wr, int wc, int fr, int fq) const {
        const int row0 = u.pm * BM + wr * 64 + fr; const int pn = u.pn;
        bf16* base; int ldc, colt;
        if (pn < 7) { base = PR; ldc = RW_COLS; colt = pn * BM; } else if (pn < 16) { base = PT; ldc = AT_COLS; colt = (pn - 7) * BM; } else { base = G; ldc = G_COLS; colt = (pn - 16) * BM; }
        const bool gate = pn >= 16;
        const int col0 = colt + wc * 32 + 8 * fq;
        f32x4 bv[2][2];
#pragma unroll
        for (int bj = 0; bj < 2; ++bj)
#pragma unroll
            for (int n = 0; n < 2; ++n) bv[bj][n] = gate ? *(const f32x4*)(bmerge + col0 + bj * HALF + 4 * n) : (f32x4){0.f, 0.f, 0.f, 0.f};
#pragma unroll
        for (int ai = 0; ai < 2; ++ai)
#pragma unroll
            for (int m = 0; m < 4; ++m) { bf16* rowp = base + (size_t)(row0 + ai * HALF + m * 16) * ldc + col0;
#pragma unroll
                for (int bj = 0; bj < 2; ++bj) { f32x4 v0 = acc[ai][bj][m][0] + bv[bj][0], v1 = acc[ai][bj][m][1] + bv[bj][1];
                    if (gate) {
#pragma unroll
                        for (int j = 0; j < 4; ++j) { v0[j] = sigmoidf_(v0[j]); v1[j] = sigmoidf_(v1[j]); } }
                    v4u w; w.x = pk2(v0[0], v0[1]); w.y = pk2(v0[2], v0[3]); w.z = pk2(v1[0], v1[1]); w.w = pk2(v1[2], v1[3]);
                    *(v4u*)(rowp + bj * HALF) = w; } }
    }
};
struct EpiMix2 {
    static constexpr bool PERM = true; static constexpr int MID_T = 8;
    const bf16* G; bf16* Zout;
    __device__ __forceinline__ void mid(f32x4 (&acc)[2][2][4][2], const Unit& u, int wr, int wc, int fr, int fq) const {
        int row0 = u.pm * BM + wr * 64 + fr; LAUNDER(row0); const int col0 = u.pn * BM + wc * 32 + 8 * fq;
#pragma unroll
        for (int ai = 0; ai < 2; ++ai)
#pragma unroll
            for (int m = 0; m < 4; ++m) { const size_t r = (size_t)(row0 + ai * HALF + m * 16);
#pragma unroll
                for (int bj = 0; bj < 2; ++bj) { const int c = col0 + bj * HALF;
                    const v4u ga = *(const v4u*)(G + r * G_COLS + c), gb = *(const v4u*)(G + r * G_COLS + DM + c);
                    acc[ai][bj][m][0][0] *= bflo(ga.x) * __builtin_amdgcn_rcpf(bflo(gb.x)); acc[ai][bj][m][0][1] *= bfhi(ga.x) * __builtin_amdgcn_rcpf(bfhi(gb.x));
                    acc[ai][bj][m][0][2] *= bflo(ga.y) * __builtin_amdgcn_rcpf(bflo(gb.y)); acc[ai][bj][m][0][3] *= bfhi(ga.y) * __builtin_amdgcn_rcpf(bfhi(gb.y));
                    acc[ai][bj][m][1][0] *= bflo(ga.z) * __builtin_amdgcn_rcpf(bflo(gb.z)); acc[ai][bj][m][1][1] *= bfhi(ga.z) * __builtin_amdgcn_rcpf(bfhi(gb.z));
                    acc[ai][bj][m][1][2] *= bflo(ga.w) * __builtin_amdgcn_rcpf(bflo(gb.w)); acc[ai][bj][m][1][3] *= bfhi(ga.w) * __builtin_amdgcn_rcpf(bfhi(gb.w));
                    __builtin_amdgcn_sched_barrier(0); } }
    }
    __device__ __forceinline__ void operator()(const f32x4 (&acc)[2][2][4][2], const Unit& u, int wr, int wc, int fr, int fq) const {
        const int row0 = u.pm * BM + wr * 64 + fr, col0 = u.pn * BM + wc * 32 + 8 * fq;
#pragma unroll
        for (int ai = 0; ai < 2; ++ai)
#pragma unroll
            for (int m = 0; m < 4; ++m) { const size_t r = (size_t)(row0 + ai * HALF + m * 16);
#pragma unroll
                for (int bj = 0; bj < 2; ++bj) { const int c = col0 + bj * HALF;
                    const v4u gv = *(const v4u*)(G + r * G_COLS + DM + c);
                    const f32x4 v0 = acc[ai][bj][m][0], v1 = acc[ai][bj][m][1];
                    v4u w; w.x = pk2(v0[0] * bflo(gv.x), v0[1] * bfhi(gv.x)); w.y = pk2(v0[2] * bflo(gv.y), v0[3] * bfhi(gv.y));
                    w.z = pk2(v1[0] * bflo(gv.z), v1[1] * bfhi(gv.z)); w.w = pk2(v1[2] * bflo(gv.w), v1[3] * bfhi(gv.w));
                    *(v4u*)(Zout + r * DM + c) = w; } }
    }
};
struct EpiRes {
    static constexpr bool PERM = true; static constexpr int MID_T = -1;
    const float* X; bf16* O;
    __device__ __forceinline__ void operator()(const f32x4 (&acc)[2][2][4][2], const Unit& u, int wr, int wc, int fr, int fq) const {
        const int row0 = u.pm * BM + wr * 64 + fr, col0 = u.pn * BM + wc * 32 + 8 * fq;
#pragma unroll
        for (int ai = 0; ai < 2; ++ai)
#pragma unroll
            for (int m = 0; m < 4; ++m) { const size_t off = (size_t)(row0 + ai * HALF + m * 16) * DM + col0;
#pragma unroll
                for (int bj = 0; bj < 2; ++bj) { const f32x4 x0 = *(const f32x4*)(X + off + bj * HALF) + acc[ai][bj][m][0], x1 = *(const f32x4*)(X + off + bj * HALF + 4) + acc[ai][bj][m][1];
                    v4u w; w.x = pk2(x0[0], x0[1]); w.y = pk2(x0[2], x0[3]); w.z = pk2(x1[0], x1[1]); w.w = pk2(x1[2], x1[3]);
                    *(v4u*)(O + off + bj * HALF) = w; } }
    }
};
struct EpiSwiglu {
    static constexpr bool PERM = false; static constexpr int MID_T = -1;
    bf16* H;
    __device__ __forceinline__ void operator()(const f32x4 (&acc)[2][2][4][2], const Unit& u, int wr, int wc, int fr, int fq) const {
        const int row0 = u.pm * BM + wr * 64 + fr, col0 = u.pn * 128 + wc * 16 + 4 * fq;
#pragma unroll
        for (int ai = 0; ai < 2; ++ai)
#pragma unroll
            for (int m = 0; m < 4; ++m) { bf16* rowp = H + (size_t)(row0 + ai * HALF + m * 16) * DEXP + col0;
#pragma unroll
                for (int bj = 0; bj < 2; ++bj) { const f32x4 gt = acc[ai][bj][m][0], up = acc[ai][bj][m][1]; f32x4 o;
#pragma unroll
                    for (int j = 0; j < 4; ++j) o[j] = gt[j] * sigmoidf_(gt[j]) * up[j];
                    v2u w; w.x = pk2(o[0], o[1]); w.y = pk2(o[2], o[3]);
                    *(v2u*)(rowp + bj * 64) = w; } }
    }
};
struct EpiStoreY {
    static constexpr bool PERM = true; static constexpr int MID_T = -1;
    const int* ltok; const float* lw; const LAS int* tab; int* inv; bf16* Y;
    __device__ __forceinline__ void operator()(const f32x4 (&acc)[2][2][4][2], const Unit& u, int wr, int wc, int fr, int fq) const {
        const int rl0 = wr * 64 + fr, col0 = u.pn * BM + wc * 32 + 8 * fq, slot0 = (u.pm - tab[u.e]) * 256, cnt = tab[33 + u.e];
#pragma unroll
        for (int ai = 0; ai < 2; ++ai)
#pragma unroll
            for (int m = 0; m < 4; ++m) { const int rl = rl0 + ai * HALF + m * 16, slot = slot0 + rl, r = u.pm * BM + rl; const bool ok = slot < cnt;
                const int t2 = ok ? ltok[(size_t)u.e * NTOK + slot] : -1; const float w = ok ? lw[(size_t)u.e * NTOK + slot] : 0.f;
                if (ok && u.pn == 0 && wc == 0 && fq == 0) inv[t2] = r;
                bf16* rowp = Y + (size_t)r * DM + col0;
#pragma unroll
                for (int bj = 0; bj < 2; ++bj) { const f32x4 v0 = acc[ai][bj][m][0] * w, v1 = acc[ai][bj][m][1] * w;
                    v4u o; o.x = pk2(v0[0], v0[1]); o.y = pk2(v0[2], v0[3]); o.z = pk2(v1[0], v1[1]); o.w = pk2(v1[2], v1[3]);
                    *(v4u*)(rowp + bj * HALF) = o; } }
    }
};
}

#define XB_TMO      128
#define XB_XCNT(j)  (256  + 64 * (j))
#define XB_XSUB(j)  (1280 + 64 * (j))
#define XB_XGEN(j)  (2304 + 64 * (j))
#define XB_TOP      3328
#define XB_TOPGEN   3392
#define XCD_BAR_WORDS 3456
#define XB_SPIN_CAP (1u << 18)
__device__ __forceinline__ unsigned xb_ld(unsigned* p)              { return __hip_atomic_load(p, __ATOMIC_RELAXED, __HIP_MEMORY_SCOPE_AGENT); }
__device__ __forceinline__ unsigned xb_add(unsigned* p, unsigned v) { return __hip_atomic_fetch_add(p, v, __ATOMIC_RELAXED, __HIP_MEMORY_SCOPE_AGENT); }
__device__ __forceinline__ unsigned xb_xcc_id() { return (unsigned)__builtin_amdgcn_s_getreg((3 << 11) | 20) & 0xFu; }
#define XB_SPIN(cond, bar) do { unsigned _sp = 0; while (cond) { __builtin_amdgcn_s_sleep(1); \
    if ((++_sp & 255u) == 0u) { if (xb_ld(&(bar)[XB_TMO])) break; if (_sp > XB_SPIN_CAP) { atomicAdd(&(bar)[XB_TMO], 1u); break; } } } } while (0)
struct XcdBarrier { unsigned* bar; unsigned x; volatile LAS unsigned* st; };
__device__ __forceinline__ XcdBarrier xcd_barrier_post(unsigned* bar, volatile LAS unsigned* st) {
    XcdBarrier b; b.bar = bar; b.x = xb_xcc_id(); b.st = st;
    if (threadIdx.x == 0) (void)xb_add(&bar[XB_XCNT(b.x)], 1u);
    return b;
}
__device__ __forceinline__ void xcd_barrier_complete(unsigned* bar, unsigned x, unsigned& nloc, unsigned& nx) {
    const unsigned G = gridDim.x * gridDim.y * gridDim.z;
    unsigned sum, cnt, mine, sp = 0u;
    for (;;) {
        sum = 0u; cnt = 0u; mine = 0u;
#pragma unroll
        for (unsigned j = 0; j < 16; ++j) { const unsigned c = xb_ld(&bar[XB_XCNT(j)]); sum += c; cnt += (c > 0u) ? 1u : 0u; mine = (j == x) ? c : mine; }
        if (sum == G) break;
        __builtin_amdgcn_s_sleep(1);
        if ((++sp & 255u) == 0u) { if (xb_ld(&bar[XB_TMO])) break; if (sp > XB_SPIN_CAP) { atomicAdd(&bar[XB_TMO], 1u); break; } }
    }
    nloc = mine > 0u ? mine : 1u; nx = cnt > 0u ? cnt : 1u;
}
__device__ __forceinline__ void xcd_barrier(const XcdBarrier& b) {
    asm volatile("s_waitcnt vmcnt(0)" ::: "memory");
    __syncthreads();
    if (threadIdx.x == 0) {
        unsigned* bar = b.bar;
        __builtin_amdgcn_s_waitcnt(0);
        unsigned nloc = b.st[0], nx = b.st[1];
        if (nloc == 0u) { xcd_barrier_complete(bar, b.x, nloc, nx); b.st[0] = nloc; b.st[1] = nx; }
        const unsigned old = xb_add(&bar[XB_XSUB(b.x)], 1u);
        const unsigned gen = old / nloc;
        if (old + 1u == (gen + 1u) * nloc) {
            __builtin_amdgcn_fence(__ATOMIC_RELEASE, "agent");
            asm volatile("s_waitcnt vmcnt(0)" ::: "memory");
            const unsigned og = xb_add(&bar[XB_TOP], 1u);
            const unsigned tg = og / nx;
            if (og + 1u == (tg + 1u) * nx) xb_add(&bar[XB_TOPGEN], 1u);
            else XB_SPIN(xb_ld(&bar[XB_TOPGEN]) == tg, bar);
            __builtin_amdgcn_fence(__ATOMIC_ACQUIRE, "agent");
            xb_add(&bar[XB_XGEN(b.x)], 1u);
            asm volatile("s_waitcnt vmcnt(0)" ::: "memory");
        } else {
            XB_SPIN(xb_ld(&bar[XB_XGEN(b.x)]) == gen, bar);
            __builtin_amdgcn_fence(__ATOMIC_ACQUIRE, "agent");
            asm volatile("s_waitcnt vmcnt(0)" ::: "memory");
        }
    }
    __syncthreads();
}

struct Args { const void* in[30]; float* out; unsigned char* ws; int ph_lo, ph_hi, li, variant; };
struct Frame {
    LAS unsigned char* lds; volatile LAS unsigned* MISC;
    int tid, lane, wave, G, bid, variant;
    unsigned char* ws;
};
enum { I_X = 0, I_POS, I_N1G, I_WIN, I_MUP, I_MUN, I_WD0, I_WDUP, I_AG0, I_AGUP, I_GUP, I_KK, I_KA, I_RK, I_GNW, I_GNB, I_WROUT, I_QNG, I_KNG, I_WAOUT, I_BMERGE, I_WOUT,
       I_N2G, I_WRG, I_BRG, I_WRE, I_BRE, I_WGATE, I_WUP, I_WDOWN };

template <class RowMap>
DI void transpose_item(const float* W, int K, int N, bf16* WT, const RowMap& rm, LAS float* scr, int item, int lane, int ldk = 0, int koff = 0) {
    if (ldk == 0) ldk = K;
    const int nblk = N / 32, kb = item / nblk, nb = item % nblk, k0 = 64 * kb, n0 = 32 * nb;
#pragma unroll 8
    for (int i = 0; i < 32; ++i) { const int kk = 2 * i + (lane >> 5); scr[kk * 33 + (lane & 31)] = W[(size_t)(k0 + kk) * N + n0 + (lane & 31)]; }
    LDS_WAIT(); asm volatile("" ::: "memory");
    const int c = lane & 7;
#pragma unroll
    for (int j = 0; j < 4; ++j) { const int n = (lane >> 3) + 8 * j; const LAS float* s = scr + (8 * c) * 33 + n;
        v4u o; o.x = pk2(s[0 * 33], s[1 * 33]); o.y = pk2(s[2 * 33], s[3 * 33]); o.z = pk2(s[4 * 33], s[5 * 33]); o.w = pk2(s[6 * 33], s[7 * 33]);
        *(GAS v4u*)(WT + (size_t)rm(n0 + n) * ldk + koff + k0 + 8 * c) = o; }
    LDS_WAIT(); asm volatile("" ::: "memory");
}
struct RmId { DI int operator()(int n) const { return n; } };
struct RmGate { DI int operator()(int n) const { return 32 * (n >> 4) + (n & 15); } };
struct RmUp { DI int operator()(int n) const { return 32 * (n >> 4) + 16 + (n & 15); } };

DI void p0_prologue(Frame& F, const Args& a) {
    LAS float* scr = (LAS float*)(F.lds + F.wave * 16384);
    const int gw = F.bid * NWAVES + F.wave, NGW = F.G * NWAVES;
    unsigned char* ws = F.ws;
    constexpr int I_IN = (DM / 64) * (IN_COLS / 32), I_R = (512 / 64) * (DM / 32), I_A = (256 / 64) * (DM / 32), I_O = (DM / 64) * (DM / 32), I_G = (128 / 64) * (512 / 32), I_L = 512 / 32;
    constexpr int NITEMS = I_IN + I_R + I_A + I_O + I_G + 4 * I_L;
    for (int it = gw; it < NITEMS; it += NGW) {
        int r = it;
        if (r < I_IN) { transpose_item((const float*)a.in[I_WIN], DM, IN_COLS, (bf16*)(ws + WS_WIN_T), RmId(), scr, r, F.lane); continue; } r -= I_IN;
        if (r < I_R) { transpose_item((const float*)a.in[I_WROUT], 512, DM, (bf16*)(ws + WS_WR_T), RmId(), scr, r, F.lane, YC_COLS, 0); continue; } r -= I_R;
        if (r < I_A) { transpose_item((const float*)a.in[I_WAOUT], 256, DM, (bf16*)(ws + WS_WR_T), RmId(), scr, r, F.lane, YC_COLS, 512); continue; } r -= I_A;
        if (r < I_O) { transpose_item((const float*)a.in[I_WOUT], DM, DM, (bf16*)(ws + WS_WOUT_T), RmId(), scr, r, F.lane); continue; } r -= I_O;
        if (r < I_G) { transpose_item((const float*)a.in[I_GUP], 128, 512, (bf16*)(ws + WS_GUP_T), RmId(), scr, r, F.lane); continue; } r -= I_G;
        { const int d = r / I_L, rr = r % I_L;
          if (d < 2) transpose_item((const float*)a.in[I_WDUP] + (size_t)d * 64 * 512, 64, 512, (bf16*)(ws + WS_WUP_T) + (size_t)d * 512 * 64, RmId(), scr, rr, F.lane);
          else transpose_item((const float*)a.in[I_AGUP] + (size_t)(d - 2) * 64 * 512, 64, 512, (bf16*)(ws + WS_AUP_T) + (size_t)(d - 2) * 512 * 64, RmId(), scr, rr, F.lane); }
    }
    { const float* g2 = (const float*)a.in[I_N2G]; const float* wre = (const float*)a.in[I_WRE]; const float* wrg = (const float*)a.in[I_WRG];
      bf16* hi = (bf16*)(ws + WS_RT_HI); bf16* lo = (bf16*)(ws + WS_RT_LO);
      for (int i = F.bid * 512 + F.tid; i < 64 * DM; i += F.G * 512) { const int n = i / DM, k = i % DM;
          float v = 0.f; if (n < 32) v = g2[k] * wre[k * 32 + n]; else if (n < 36) v = g2[k] * wrg[k * 4 + (n - 32)];
          const unsigned h = pk2(v, 0.f) & 0xffffu; const float hf = bflo(h); hi[i] = (bf16)h; lo[i] = (bf16)(pk2(v - hf, 0.f) & 0xffffu); } }
    { const float* x = (const float*)a.in[I_X]; const float* g1 = (const float*)a.in[I_N1G]; bf16* hb = (bf16*)(ws + WS_HB);
      f32x4 gv[4];
#pragma unroll
      for (int j = 0; j < 4; ++j) gv[j] = ((const f32x4*)g1)[F.lane + 64 * j];
      for (int m = gw; m < NTOK; m += NGW) {
          const GAS f32x4* xr = (const GAS f32x4*)(x + (size_t)m * DM) + F.lane; f32x4 v[4]; float s = 0.f;
#pragma unroll
          for (int j = 0; j < 4; ++j) { v[j] = xr[64 * j]; s += (v[j].x * v[j].x + v[j].y * v[j].y) + (v[j].z * v[j].z + v[j].w * v[j].w); }
          const float rstd = 1.f / sqrtf(wave_sum(s) * (1.f / DM) + NORM_EPS);
          GAS v2u* o8 = (GAS v2u*)(hb + (size_t)m * DM) + F.lane;
#pragma unroll
          for (int j = 0; j < 4; ++j) { v2u w; w.x = pk2(v[j].x * rstd * gv[j].x, v[j].y * rstd * gv[j].y); w.y = pk2(v[j].z * rstd * gv[j].z, v[j].w * rstd * gv[j].w); o8[64 * j] = w; } } }
}

DI void p1b_qkprep(Frame& F, const Args& a) {
    bf16* PT = (bf16*)(F.ws + WS_PT);
    const int* pos = (const int*)a.in[I_POS];
    const int sub = F.lane & 7;
    const f32x4 qg0 = ((const f32x4*)a.in[I_QNG])[2 * sub], qg1 = ((const f32x4*)a.in[I_QNG])[2 * sub + 1];
    const f32x4 kg0 = ((const f32x4*)a.in[I_KNG])[2 * sub], kg1 = ((const f32x4*)a.in[I_KNG])[2 * sub + 1];
    constexpr float IF2PI[8] = {0.15915494309189535f, 0.03086376340470123f, 0.005985185712713705f, 0.001160663641240061f, 0.00022507907903927653f, 4.364795279280289e-05f, 8.464330808241401e-06f, 1.6414262627950345e-06f};
    const int nvec = NTOK * 24, stride = (F.G * 512) >> 3;
    for (int vid0 = (F.bid * 512 + F.tid) >> 3; vid0 < nvec; vid0 += 4 * stride) {
        v4u raw[4]; int pv[4];
#pragma unroll
        for (int u = 0; u < 4; ++u) { const int vid = vid0 + u * stride; if (vid < nvec) { const int tok = vid / 24, v = vid % 24; const bool isq = v < 12; const int head = isq ? v : v - 12;
            raw[u] = *(const v4u*)(PT + (size_t)tok * AT_COLS + (isq ? 0 : 768) + head * 64 + sub * 8); pv[u] = pos[tok]; } else { raw[u] = (v4u){0u, 0u, 0u, 0u}; pv[u] = 0; } }
#pragma unroll
        for (int u = 0; u < 4; ++u) { const int vid = vid0 + u * stride; const bool act = vid < nvec; const int vv = act ? vid : 0;
            const int tok = vv / 24, v = vv % 24; const bool isq = v < 12; const int head = isq ? v : v - 12;
            bf16* p = PT + (size_t)tok * AT_COLS + (isq ? 0 : 768) + head * 64 + sub * 8;
            float y[8] = {bflo(raw[u].x), bfhi(raw[u].x), bflo(raw[u].y), bfhi(raw[u].y), bflo(raw[u].z), bfhi(raw[u].z), bflo(raw[u].w), bfhi(raw[u].w)};
            float ss = 0.f;
#pragma unroll
            for (int j = 0; j < 8; ++j) ss += y[j] * y[j];
            ss += __shfl_xor(ss, 1); ss += __shfl_xor(ss, 2); ss += __shfl_xor(ss, 4);
            const float rstd = 1.f / sqrtf(ss * (1.f / 64.f) + NORM_EPS);
            const f32x4 g0 = isq ? qg0 : kg0, g1 = isq ? qg1 : kg1;
#pragma unroll
            for (int j = 0; j < 4; ++j) { y[j] = y[j] * rstd * g0[j]; y[4 + j] = y[4 + j] * rstd * g1[j]; }
            const float pf = (float)pv[u];
#pragma unroll
            for (int j = 0; j < 8; ++j) {
                const float partner = __shfl_xor(y[j], 1);
                float r = pf * IF2PI[j]; r = r - floorf(r);
                const float sn = __builtin_amdgcn_sinf(r), cs = __builtin_amdgcn_cosf(r);
                const float rot = y[j] * cs + (sub == 0 ? -partner : partner) * sn;
                if (sub < 2) y[j] = rot;
            }
            if (isq) {
#pragma unroll
                for (int j = 0; j < 8; ++j) y[j] *= 0.18033688011112042f;
            }
            v4u o; o.x = pk2(y[0], y[1]); o.y = pk2(y[2], y[3]); o.z = pk2(y[4], y[5]); o.w = pk2(y[6], y[7]);
            if (act && !VAR(64)) *(v4u*)p = o; }
    }
}

DI void p1c_preshift(Frame& F, const Args& a) {
    if (F.tid >= 448) return;
    const bf16* PR = (const bf16*)(F.ws + WS_PR); bf16* PS = (bf16*)a.out;
    const int rsub = F.tid / 224, cg8 = (F.tid % 224) * 8;
    const float* mup = (const float*)a.in[I_MUP] + cg8; const float* mun = (const float*)a.in[I_MUN] + cg8;
    const f32x4 mp0 = *(const f32x4*)mup, mp1 = *(const f32x4*)(mup + 4), mn0 = *(const f32x4*)mun, mn1 = *(const f32x4*)(mun + 4);
    const int mode = (cg8 >= 1536 && cg8 < 1600) ? 1 : (cg8 >= 1664 ? 2 : 0);
    const int rows_per = NTOK / F.G;
    for (int r0 = F.bid * rows_per + rsub; r0 < (F.bid + 1) * rows_per; r0 += 8) {
        v4u cur[4], prv[4], nxt[4];
#pragma unroll
        for (int u = 0; u < 4; ++u) { const int row = r0 + 2 * u, t = row % SEQ; const bf16* p = PR + (size_t)row * RW_COLS + cg8;
            cur[u] = *(const v4u*)p; prv[u] = *(const v4u*)(p - (t > 0 ? RW_COLS : 0)); nxt[u] = *(const v4u*)(p + (t < SEQ - 1 ? RW_COLS : 0)); }
#pragma unroll
        for (int u = 0; u < 4; ++u) { const int row = r0 + 2 * u, t = row % SEQ; const float fp = t > 0 ? 1.f : 0.f, fn = t < SEQ - 1 ? 1.f : 0.f;
            const unsigned cw[4] = {cur[u].x, cur[u].y, cur[u].z, cur[u].w}, pw[4] = {prv[u].x, prv[u].y, prv[u].z, prv[u].w}, nw[4] = {nxt[u].x, nxt[u].y, nxt[u].z, nxt[u].w};
            float y[8];
#pragma unroll
            for (int j = 0; j < 4; ++j) {
                const float c0 = bflo(cw[j]), c1 = bfhi(cw[j]), p0 = bflo(pw[j]) * fp, p1 = bfhi(pw[j]) * fp, n0 = bflo(nw[j]) * fn, n1 = bfhi(nw[j]) * fn;
                const float m0 = j < 2 ? mp0[2 * j] : mp1[2 * j - 4], m1 = j < 2 ? mp0[2 * j + 1] : mp1[2 * j - 3], q0 = j < 2 ? mn0[2 * j] : mn1[2 * j - 4], q1 = j < 2 ? mn0[2 * j + 1] : mn1[2 * j - 3];
                y[2 * j] = c0 + m0 * (p0 - c0) + q0 * (n0 - c0); y[2 * j + 1] = c1 + m1 * (p1 - c1) + q1 * (n1 - c1); }
            if (mode == 1) {
#pragma unroll
                for (int j = 0; j < 8; ++j) y[j] = 1.f - 2.f * __builtin_amdgcn_rcpf(1.f + __builtin_amdgcn_exp2f(2.88539008f * y[j])); }
            if (mode == 2) {
#pragma unroll
                for (int j = 0; j < 8; ++j) y[j] = sigmoidf_(y[j]); }
            v4u o; o.x = pk2(y[0], y[1]); o.y = pk2(y[2], y[3]); o.z = pk2(y[4], y[5]); o.w = pk2(y[6], y[7]);
            if (!VAR(64)) *(v4u*)(PS + (size_t)row * RW_COLS + cg8) = o; }
    }
}

DI bf16x8 pack8(float a0, float a1, float a2, float a3, float a4, float a5, float a6, float a7) {
    v4u p; p.x = pk2(a0, a1); p.y = pk2(a2, a3); p.z = pk2(a4, a5); p.w = pk2(a6, a7); return __builtin_bit_cast(bf16x8, p);
}
DI void attn_unit(Frame& F, int b, int hh, int span) {
    const bf16* PT = (const bf16*)(F.ws + WS_PT); bf16* Og = (bf16*)(F.ws + WS_OG); float* Lse = (float*)(F.ws + WS_LSE); bf16* YA = (bf16*)(F.ws + WS_YA);
    LAS unsigned char* vbuf = F.lds + F.wave * 9216;
    const int lane = F.lane, n = lane & 31, half = lane >> 5;
    const int T0 = span * 512; const size_t rowbase = (size_t)b * SEQ;
    for (int su = F.wave; su < 48; su += 8) {
        const int g = su >> 4, s16 = su & 15, dsh = 2 * g, L = SEQ >> dsh, per_r = 16 >> dsh;
        const int r = s16 / per_r, sb = s16 % per_r, l0 = (T0 >> dsh) + sb * 32, head = 4 * g + hh;
        const int tq = ((l0 + n) << dsh) + r;
        const bf16* qp = PT + (rowbase + tq) * AT_COLS + head * 64 + 8 * half;
        bf16x8 qf[4];
#pragma unroll
        for (int kk = 0; kk < 4; ++kk) qf[kk] = *(const bf16x8*)(qp + 16 * kk);
        f32x16 o0, o1;
#pragma unroll
        for (int i = 0; i < 16; ++i) { o0[i] = 0.f; o1[i] = 0.f; }
        float mrun = -1e30f, lrun = 0.f;
        const int kb_lo = l0 >= 64 ? 0 : (64 - l0) >> 5, kb_hi = min(4, (L + 32 - l0) >> 5);
        bf16x8 kfn[4]; v4u vvn[4];
#define ATT_PRELOAD(kbx) do { const int lk0_ = l0 - 64 + 32 * (kbx); \
            _Pragma("unroll") for (int j = 0; j < 4; ++j) { const int idx = lane + 64 * j, key = idx >> 3, ch = idx & 7; const int tk_ = ((lk0_ + key) << dsh) + r; \
                vvn[j] = *(const v4u*)(PT + (rowbase + tk_) * AT_COLS + 1536 + head * 64 + ch * 8); } \
            const int tk2_ = ((lk0_ + n) << dsh) + r; const bf16* kp_ = PT + (rowbase + tk2_) * AT_COLS + 768 + head * 64 + 8 * half; \
            _Pragma("unroll") for (int kk = 0; kk < 4; ++kk) kfn[kk] = *(const bf16x8*)(kp_ + 16 * kk); } while (0)
        ATT_PRELOAD(kb_lo);
        for (int kb = kb_lo; kb <= kb_hi; ++kb) {
            LAS unsigned char* vb = vbuf + (kb & 1) * 4608;
            bf16x8 kf[4];
#pragma unroll
            for (int j = 0; j < 4; ++j) { const int idx = lane + 64 * j, key = idx >> 3, ch = idx & 7; *(LAS v4u*)(vb + key * 144 + ch * 16) = vvn[j]; kf[j] = kfn[j]; }
            if (kb < kb_hi) ATT_PRELOAD(kb + 1);
            f32x16 s;
#pragma unroll
            for (int i = 0; i < 16; ++i) s[i] = 0.f;
#pragma unroll
            for (int kk = 0; kk < 4; ++kk) s = MFMA32(kf[kk], qf[kk], s);
            if (kb == 0) {
#pragma unroll
                for (int i = 0; i < 16; ++i) if (crow(i, half) < n) s[i] = -1e30f; }
            if (kb == 4) {
#pragma unroll
                for (int i = 0; i < 16; ++i) if (crow(i, half) > n) s[i] = -1e30f; }
            float mx = s[0];
#pragma unroll
            for (int i = 1; i < 16; ++i) mx = fmaxf(mx, s[i]);
            mx = fmaxf(mx, __shfl_xor(mx, 32));
            const float mnew = fmaxf(mrun, mx), alpha = __builtin_amdgcn_exp2f(mrun - mnew); mrun = mnew;
            float ps = 0.f;
#pragma unroll
            for (int i = 0; i < 16; ++i) { s[i] = __builtin_amdgcn_exp2f(s[i] - mnew); ps += s[i]; }
            lrun = lrun * alpha + ps;
#pragma unroll
            for (int i = 0; i < 16; ++i) { o0[i] *= alpha; o1[i] *= alpha; }
            const bf16x8 pf0 = pack8(s[0], s[1], s[2], s[3], s[4], s[5], s[6], s[7]), pf1 = pack8(s[8], s[9], s[10], s[11], s[12], s[13], s[14], s[15]);
#pragma unroll
            for (int g2 = 0; g2 < 2; ++g2) {
                bf16x8 vf0, vf1;
#pragma unroll
                for (int si = 0; si < 8; ++si) { const int key = 16 * g2 + (si & 3) + 8 * (si >> 2) + 4 * half;
                    vf0[si] = *(const LAS short*)(vb + key * 144 + n * 2); vf1[si] = *(const LAS short*)(vb + key * 144 + (n + 32) * 2); }
                o0 = MFMA32(vf0, g2 ? pf1 : pf0, o0); o1 = MFMA32(vf1, g2 ? pf1 : pf0, o1);
            }
        }
#undef ATT_PRELOAD
        const float ltot = lrun + __shfl_xor(lrun, 32), inv = 1.f / ltot;
        bf16* op = Og + ((size_t)g * NTOK + rowbase + tq) * 256 + hh * 64;
#pragma unroll
        for (int q4 = 0; q4 < 4; ++q4) { const int d0 = 8 * q4 + 4 * half;
            v2u w0; w0.x = pk2(o0[4 * q4] * inv, o0[4 * q4 + 1] * inv); w0.y = pk2(o0[4 * q4 + 2] * inv, o0[4 * q4 + 3] * inv); *(v2u*)(op + d0) = w0;
            v2u w1; w1.x = pk2(o1[4 * q4] * inv, o1[4 * q4 + 1] * inv); w1.y = pk2(o1[4 * q4 + 2] * inv, o1[4 * q4 + 3] * inv); *(v2u*)(op + 32 + d0) = w1; }
        if (half == 0) Lse[((size_t)g * NTOK + rowbase + tq) * 4 + hh] = mrun + __builtin_amdgcn_logf(ltot);
    }
    VM_WAIT(); __syncthreads();
    __builtin_amdgcn_fence(__ATOMIC_ACQUIRE, "agent"); VM_WAIT();
    {
        const size_t tok = rowbase + T0 + F.tid;
        const float l0 = Lse[(0 * (size_t)NTOK + tok) * 4 + hh], l1 = Lse[(1 * (size_t)NTOK + tok) * 4 + hh], l2 = Lse[(2 * (size_t)NTOK + tok) * 4 + hh];
        const float mx = fmaxf(l0, fmaxf(l1, l2));
        float a0 = __builtin_amdgcn_exp2f(l0 - mx), a1 = __builtin_amdgcn_exp2f(l1 - mx), a2 = __builtin_amdgcn_exp2f(l2 - mx);
        const float inv = 1.f / (a0 + a1 + a2); a0 *= inv; a1 *= inv; a2 *= inv;
        const bf16* p0 = Og + (0 * (size_t)NTOK + tok) * 256 + hh * 64; const bf16* p1 = Og + (1 * (size_t)NTOK + tok) * 256 + hh * 64; const bf16* p2 = Og + (2 * (size_t)NTOK + tok) * 256 + hh * 64;
        bf16* yo = YA + tok * 256 + hh * 64;
#pragma unroll
        for (int c = 0; c < 8; ++c) { const v4u x0 = *(const v4u*)(p0 + 8 * c), x1 = *(const v4u*)(p1 + 8 * c), x2 = *(const v4u*)(p2 + 8 * c); v4u o;
            o.x = pk2(a0 * bflo(x0.x) + a1 * bflo(x1.x) + a2 * bflo(x2.x), a0 * bfhi(x0.x) + a1 * bfhi(x1.x) + a2 * bfhi(x2.x));
            o.y = pk2(a0 * bflo(x0.y) + a1 * bflo(x1.y) + a2 * bflo(x2.y), a0 * bfhi(x0.y) + a1 * bfhi(x1.y) + a2 * bfhi(x2.y));
            o.z = pk2(a0 * bflo(x0.z) + a1 * bflo(x1.z) + a2 * bflo(x2.z), a0 * bfhi(x0.z) + a1 * bfhi(x1.z) + a2 * bfhi(x2.z));
            o.w = pk2(a0 * bflo(x0.w) + a1 * bflo(x1.w) + a2 * bflo(x2.w), a0 * bfhi(x0.w) + a1 * bfhi(x1.w) + a2 * bfhi(x2.w));
            *(v4u*)(yo + 8 * c) = o; }
    }
    __syncthreads();
}

DI f32x4 ld4bf(const bf16* p) { const v2u u = *(const v2u*)p; return (f32x4){bflo(u.x), bfhi(u.x), bflo(u.y), bfhi(u.y)}; }
DI f32x4 shift4(const bf16* prow, bool hasp, bool hasn, const float* mup, const float* mun, int col) {
    const f32x4 u = ld4bf(prow + col);
    const float mp = hasp ? 1.f : 0.f, mn = hasn ? 1.f : 0.f;
    const f32x4 up = ld4bf(prow + (hasp ? -RW_COLS : 0) + col) * mp, un = ld4bf(prow + (hasn ? RW_COLS : 0) + col) * mn;
    return u + *(const f32x4*)(mup + col) * (up - u) + *(const f32x4*)(mun + col) * (un - u);
}
DI float red8(float v) {
    v += __builtin_bit_cast(float, __builtin_amdgcn_update_dpp(0, __builtin_bit_cast(int, v), 0xB1, 0xF, 0xF, true));
    v += __builtin_bit_cast(float, __builtin_amdgcn_update_dpp(0, __builtin_bit_cast(int, v), 0x4E, 0xF, 0xF, true));
    v += __builtin_bit_cast(float, __builtin_amdgcn_update_dpp(0, __builtin_bit_cast(int, v), 0x141, 0xF, 0xF, true));
    return v;
}
constexpr int SC_CH = 32, SC_NCH = SEQ / SC_CH;
constexpr int FP = 68, ARR_SZ = 32 * 144, ARRBUF_SZ = 5 * ARR_SZ + 32 * FP * 4;
#define SC_ARR(ab, arr) (F.lds + (ab) * ARRBUF_SZ + (arr) * ARR_SZ)
#define SC_E2(ab) ((LAS float*)(F.lds + (ab) * ARRBUF_SZ + 5 * ARR_SZ))
constexpr int SCL_CONST = 2 * ARRBUF_SZ, SCL_IMG = 65536, SCL_IMGSZ = 35072, SCL_MABT = SCL_IMG + 2 * SCL_IMGSZ;
constexpr int IM_AT = 0, IM_RT = 4608, IM_BT = 9216, IM_KT = 14336, IM_VT = 19456, IM_MAK = 24576, IM_NB = 27136, IM_NK = 29696, IM_T = 32256, IM_GC = 34816;
constexpr int P144 = 144, P80 = 80;
#define SC_IMG(ib) (F.lds + SCL_IMG + (ib) * SCL_IMGSZ)
#define SC_CONST ((LAS float*)(F.lds + SCL_CONST))
DI f32x4 up4(v2u u) { return (f32x4){bflo(u.x), bfhi(u.x), bflo(u.y), bfhi(u.y)}; }
template <int KIND> struct PrepRaw { bf16x8 xf[4]; v2u ga[4], gb[4], gc[4]; };
template <int KIND>
DI void prep_load(Frame& F, const bf16* PS, int b, int h, int dir, int c, PrepRaw<KIND>& R) {
    const int q = F.wave - 4, jt = q & 1, lane = F.lane, n = lane & 31, half = lane >> 5;
    const int tl = SC_CH * c + n, t = dir ? (SEQ - 1 - tl) : tl, hc = h * 64;
    const bf16* pr = PS + ((size_t)b * SEQ + t) * RW_COLS;
#pragma unroll
    for (int kk = 0; kk < 4; ++kk) R.xf[kk] = *(const bf16x8*)(pr + (KIND ? 1600 : 1536) + 16 * kk + 8 * half);
#pragma unroll
    for (int q4 = 0; q4 < 4; ++q4) { const int j = 32 * jt + 8 * q4 + 4 * half, jo = 32 * (1 - jt) + 8 * q4 + 4 * half;
        R.ga[q4] = *(const v2u*)(pr + (KIND ? 512 : 0) + hc + j);
        R.gb[q4] = *(const v2u*)(pr + (KIND ? 512 + hc + jo : 1024 + hc + j));
        if (KIND) R.gc[q4] = *(const v2u*)(pr + hc + j); }
}
template <int KIND>
DI void prep_compute(Frame& F, int b, int h, int dir, int c, const PrepRaw<KIND>& R, const bf16x8 (&af)[4]) {
    const int q = F.wave - 4, jt = q & 1, lane = F.lane, n = lane & 31, half = lane >> 5, ab = c & 1;
    const LAS float* cm = SC_CONST;
    f32x16 D;
#pragma unroll
    for (int i = 0; i < 16; ++i) D[i] = 0.f;
    if (KIND == 0) {
#pragma unroll
        for (int kk = 0; kk < 4; ++kk) D = MFMA32(R.xf[kk], af[kk], D);
        const int j = 32 * jt + n; const float w0j = cm[j];
        float e2[16];
#pragma unroll
        for (int i = 0; i < 16; ++i) e2[i] = 0.8750387749f * sigmoidf_(D[i] + w0j);
        float gs[4], ps[4];
#pragma unroll
        for (int g = 0; g < 4; ++g) { gs[g] = (e2[4 * g] + e2[4 * g + 1]) + (e2[4 * g + 2] + e2[4 * g + 3]); ps[g] = __shfl_xor(gs[g], 32); }
        float off = 0.f;
        LAS float* Eb = SC_E2(ab) + j;
#pragma unroll
        for (int g = 0; g < 4; ++g) {
            float run = off + (half ? ps[g] : 0.f);
#pragma unroll
            for (int ii = 0; ii < 4; ++ii) { const int i = 4 * g + ii, tau = 8 * g + 4 * half + ii; run += e2[i]; Eb[tau * FP] = run; }
            off += gs[g] + ps[g];
        }
#pragma unroll
        for (int q4 = 0; q4 < 4; ++q4) { const int jj = 32 * jt + 8 * q4 + 4 * half;
            *(LAS v2u*)(SC_ARR(ab, 3) + n * P144 + jj * 2) = R.ga[q4];
            *(LAS v2u*)(SC_ARR(ab, 4) + n * P144 + jj * 2) = R.gb[q4]; }
    } else {
#pragma unroll
        for (int kk = 0; kk < 4; ++kk) D = MFMA32(af[kk], R.xf[kk], D);
        float ss = 0.f;
#pragma unroll
        for (int q4 = 0; q4 < 4; ++q4) { const int j = 32 * jt + 8 * q4 + 4 * half, jo = 32 * (1 - jt) + 8 * q4 + 4 * half;
            const f32x4 kr = up4(R.ga[q4]) * *(const LAS f32x4*)(cm + 128 + j), ko = up4(R.gb[q4]) * *(const LAS f32x4*)(cm + 128 + jo);
            ss += (kr[0] * kr[0] + kr[1] * kr[1]) + (kr[2] * kr[2] + kr[3] * kr[3]) + (ko[0] * ko[0] + ko[1] * ko[1]) + (ko[2] * ko[2] + ko[3] * ko[3]); }
        ss += __shfl_xor(ss, 32);
        const float inv = __builtin_amdgcn_rcpf(fmaxf(__builtin_amdgcn_sqrtf(ss), 1e-12f));
        float bs = 0.f;
#pragma unroll
        for (int q4 = 0; q4 < 4; ++q4) { const int j = 32 * jt + 8 * q4 + 4 * half;
            const f32x4 az = *(const LAS f32x4*)(cm + 64 + j), kkv = *(const LAS f32x4*)(cm + 128 + j), kav = *(const LAS f32x4*)(cm + 192 + j), rkv = *(const LAS f32x4*)(cm + 256 + j);
            const f32x4 kpr = up4(R.ga[q4]), rr = up4(R.gc[q4]);
            f32x4 av, kk4, kd4;
#pragma unroll
            for (int jj = 0; jj < 4; ++jj) { av[jj] = sigmoidf_(D[4 * q4 + jj] + az[jj]); kk4[jj] = kpr[jj] * kkv[jj] * inv; kd4[jj] = kpr[jj] * (1.f + (av[jj] - 1.f) * kav[jj]); bs += rr[jj] * kd4[jj] * rkv[jj]; }
            v2u w; w.x = pk2(kd4[0], kd4[1]); w.y = pk2(kd4[2], kd4[3]); *(LAS v2u*)(SC_ARR(ab, 0) + n * P144 + j * 2) = w;
            w.x = pk2(kk4[0] * av[0], kk4[1] * av[1]); w.y = pk2(kk4[2] * av[2], kk4[3] * av[3]); *(LAS v2u*)(SC_ARR(ab, 1) + n * P144 + j * 2) = w;
            w.x = pk2(-kk4[0], -kk4[1]); w.y = pk2(-kk4[2], -kk4[3]); *(LAS v2u*)(SC_ARR(ab, 2) + n * P144 + j * 2) = w; }
        bs += __shfl_xor(bs, 32);
        const int tl = SC_CH * c + n, t = dir ? (SEQ - 1 - tl) : tl;
        if (half == 0 && !VAR(255)) ((float*)(F.ws + WS_BSUM))[(((size_t)dir * NTOK + (size_t)b * SEQ + t) * 8 + h) * 2 + jt] = bs;
    }
}
DI void scan_consts(Frame& F, const Args& a, int h, int dir) {
    LAS float* cm = SC_CONST; const int i = F.tid - 256, hc = h * 64;
    if (i < 64) { cm[i] = ((const float*)a.in[I_WD0])[dir * 512 + hc + i]; cm[64 + i] = ((const float*)a.in[I_AG0])[dir * 512 + hc + i];
        cm[128 + i] = ((const float*)a.in[I_KK])[hc + i]; cm[192 + i] = ((const float*)a.in[I_KA])[hc + i]; cm[256 + i] = ((const float*)a.in[I_RK])[hc + i]; }
}
#define SC_BARRIER() do { asm volatile("s_waitcnt lgkmcnt(0)" ::: "memory"); __builtin_amdgcn_s_barrier(); asm volatile("" ::: "memory"); } while (0)
DI bf16x8 ld_perm(const LAS unsigned char* row, int ks, int half) {
    const v2u a0 = *(const LAS v2u*)(row + (16 * ks + 4 * half) * 2), a1 = *(const LAS v2u*)(row + (16 * ks + 8 + 4 * half) * 2);
    const v4u r = {a0.x, a0.y, a1.x, a1.y}; return __builtin_bit_cast(bf16x8, r);
}
DI bf16x8 packacc(const f32x16& x, int ks) { return ks ? pack8(x[8], x[9], x[10], x[11], x[12], x[13], x[14], x[15]) : pack8(x[0], x[1], x[2], x[3], x[4], x[5], x[6], x[7]); }
DI bf16x8 frag_scaled(const LAS unsigned char* arow, const LAS float* erow, int kk, float sgn, bool ezero) {
    const v4u xr = *(const LAS v4u*)(arow + 32 * kk);
    f32x4 e0 = *(const LAS f32x4*)(erow + 16 * kk), e1 = *(const LAS f32x4*)(erow + 16 * kk + 4);
    if (ezero) { e0 = (f32x4){0.f, 0.f, 0.f, 0.f}; e1 = e0; }
    const float x[8] = {bflo(xr.x), bfhi(xr.x), bflo(xr.y), bfhi(xr.y), bflo(xr.z), bfhi(xr.z), bflo(xr.w), bfhi(xr.w)};
    float y[8];
#pragma unroll
    for (int j = 0; j < 4; ++j) { y[j] = x[j] * __builtin_amdgcn_exp2f(sgn * e0[j]); y[4 + j] = x[4 + j] * __builtin_amdgcn_exp2f(sgn * e1[j]); }
    return pack8(y[0], y[1], y[2], y[3], y[4], y[5], y[6], y[7]);
}
template <bool LO>
DI void scan_build(Frame& F, int p, int bw) {
    int lane = F.lane; LAUNDER(lane); const int n = lane & 31, half = lane >> 5, ab = p & 1;
    LAS unsigned char* img = SC_IMG(p & 1);
    const LAS float* E = SC_E2(ab) + n * FP + 8 * half;
    const LAS float* Eex = SC_E2(ab) + (n > 0 ? n - 1 : 0) * FP + 8 * half;
    const LAS unsigned char* KDr = SC_ARR(ab, 0) + n * P144 + 16 * half; const LAS unsigned char* BBr = SC_ARR(ab, 1) + n * P144 + 16 * half;
    const LAS unsigned char* AAr = SC_ARR(ab, 2) + n * P144 + 16 * half; const LAS unsigned char* Rr = SC_ARR(ab, 3) + n * P144 + 16 * half;
    if (LO && bw == 2) {
        if (VAR(16)) return;
        f32x16 z, pacc;
#pragma unroll
        for (int i = 0; i < 16; ++i) z[i] = 0.f;
#pragma unroll
        for (int kk = 0; kk < 4; ++kk) z = MFMA32(frag_scaled(BBr, E, kk, 1.f, false), frag_scaled(AAr, Eex, kk, -1.f, n == 0), z);
#pragma unroll
        for (int i = 0; i < 16; ++i) { const int srow = crow(i, half); z[i] = (srow < n) ? z[i] : 0.f; }
        LAS unsigned char* zi = F.lds + SCL_MABT;
#pragma unroll
        for (int k = 0; k < 4; ++k) {
            LAS unsigned char* zk = zi + k * (32 * P80);
#pragma unroll
            for (int i = 0; i < 16; ++i) *(LAS unsigned short*)(zk + crow(i, half) * P80 + n * 2) = (unsigned short)(pk2(z[i], 0.f) & 0xffffu);
            LDS_WAIT(); asm volatile("" ::: "memory");
            const bf16x8 zb0 = packacc(z, 0), zb1 = packacc(z, 1);
            f32x16 zn;
#pragma unroll
            for (int i = 0; i < 16; ++i) zn[i] = 0.f;
            zn = MFMA32(ld_perm(zk + n * P80, 0, half), zb0, zn); zn = MFMA32(ld_perm(zk + n * P80, 1, half), zb1, zn);
            z = zn;
        }
#pragma unroll
        for (int i = 0; i < 16; ++i) pacc[i] = z[i] + ((crow(i, half) == n) ? 1.f : 0.f);
#pragma unroll
        for (int k = 3; k >= 0; --k) {
            const LAS unsigned char* zk = zi + k * (32 * P80);
            const bf16x8 qb0 = packacc(pacc, 0), qb1 = packacc(pacc, 1);
            pacc = MFMA32(ld_perm(zk + n * P80, 0, half), qb0, pacc); pacc = MFMA32(ld_perm(zk + n * P80, 1, half), qb1, pacc);
        }
#pragma unroll
        for (int g = 0; g < 4; ++g) { v2u w; w.x = pk2(pacc[4 * g], pacc[4 * g + 1]); w.y = pk2(pacc[4 * g + 2], pacc[4 * g + 3]); *(LAS v2u*)(img + IM_T + n * P80 + (8 * g + 4 * half) * 2) = w; }
    } else if (LO && bw == 3) {
        if (VAR(32)) return;
#pragma unroll
        for (int kk = 0; kk < 4; ++kk) { const bf16x8 f = frag_scaled(BBr, E, kk, 1.f, false);
            const v4u vr = *(const LAS v4u*)(SC_ARR(ab, 4) + n * P144 + 16 * half + 32 * kk); const bf16x8 vf = __builtin_bit_cast(bf16x8, vr);
#pragma unroll
            for (int e = 0; e < 8; ++e) { *(LAS unsigned short*)(img + IM_BT + (16 * kk + 8 * half + e) * P80 + n * 2) = (unsigned short)f[e];
                *(LAS unsigned short*)(img + IM_VT + (16 * kk + 8 * half + e) * P80 + n * 2) = (unsigned short)vf[e]; } }
        ((LAS float*)(img + IM_GC))[lane] = __builtin_amdgcn_exp2f(-(SC_E2(ab)[31 * FP + lane]));
    } else if (!LO && bw <= 6) {
        if (VAR(32)) return;
        bf16x8 fa[4], fb[4];
        if (bw == 4 || bw == 5) {
#pragma unroll
            for (int kk = 0; kk < 4; ++kk) { fb[kk] = frag_scaled(bw == 4 ? AAr : Rr, bw == 4 ? Eex : E, kk, -1.f, bw == 4 && n == 0);
                *(LAS bf16x8*)(img + (bw == 4 ? IM_AT : IM_RT) + n * P144 + (16 * kk + 8 * half) * 2) = fb[kk]; }
#pragma unroll
            for (int kk = 0; kk < 4; ++kk) fa[kk] = frag_scaled(bw == 4 ? KDr : BBr, E, kk, 1.f, false);
        } else {
#pragma unroll
            for (int kk = 0; kk < 4; ++kk) { fa[kk] = frag_scaled(KDr, E, kk, 1.f, false);
#pragma unroll
                for (int e = 0; e < 8; ++e) *(LAS unsigned short*)(img + IM_KT + (16 * kk + 8 * half + e) * P80 + n * 2) = (unsigned short)fa[kk][e]; }
#pragma unroll
            for (int kk = 0; kk < 4; ++kk) fb[kk] = frag_scaled(Rr, E, kk, -1.f, false);
        }
        f32x16 x;
#pragma unroll
        for (int i = 0; i < 16; ++i) x[i] = 0.f;
#pragma unroll
        for (int kk = 0; kk < 4; ++kk) x = MFMA32(fa[kk], fb[kk], x);
        LAS unsigned char* gi = img + (bw == 4 ? IM_MAK : (bw == 5 ? IM_NB : IM_NK));
#pragma unroll
        for (int g = 0; g < 4; ++g) { float m_[4];
#pragma unroll
            for (int e = 0; e < 4; ++e) { const int srow = 8 * g + 4 * half + e; m_[e] = ((bw == 4) ? srow < n : srow <= n) ? x[4 * g + e] : 0.f; }
            v2u w_; w_.x = pk2(m_[0], m_[1]); w_.y = pk2(m_[2], m_[3]); *(LAS v2u*)(gi + n * P80 + (8 * g + 4 * half) * 2) = w_; }
    }
}
template <int KIND>
DI void scan_helper(Frame& F, const Args& a, int b, int h, int dir) {
    const bf16* PS = (const bf16*)a.out;
    const int q = F.wave - 4, jt = q & 1, n = F.lane & 31, half = F.lane >> 5;
    const bf16* WT = (const bf16*)(F.ws + (KIND ? WS_AUP_T : WS_WUP_T)) + ((size_t)dir * 512 + h * 64 + 32 * jt + n) * 64 + 8 * half;
    bf16x8 af[4];
#pragma unroll
    for (int kk = 0; kk < 4; ++kk) af[kk] = *(const bf16x8*)(WT + 16 * kk);
    PrepRaw<KIND> Ra, Rb;
    prep_load<KIND>(F, PS, b, h, dir, 0, Ra);
    prep_load<KIND>(F, PS, b, h, dir, 1, Rb);
    prep_compute<KIND>(F, b, h, dir, 0, Ra, af);
    prep_load<KIND>(F, PS, b, h, dir, 2, Ra);
    SC_BARRIER();
    prep_compute<KIND>(F, b, h, dir, 1, Rb, af);
    prep_load<KIND>(F, PS, b, h, dir, 3, Rb);
    SC_BARRIER();
#pragma unroll 1
    for (int s2 = 0; s2 < SC_NCH; s2 += 2) {
        if (s2 + 2 < SC_NCH && !VAR(4)) prep_compute<KIND>(F, b, h, dir, s2 + 2, Ra, af);
        if (!VAR(8)) prep_load<KIND>(F, PS, b, h, dir, (s2 + 4) & (SC_NCH - 1), Ra);
        SC_BARRIER();
        if (s2 + 3 < SC_NCH && !VAR(4)) prep_compute<KIND>(F, b, h, dir, s2 + 3, Rb, af);
        if (!VAR(8)) prep_load<KIND>(F, PS, b, h, dir, (s2 + 5) & (SC_NCH - 1), Rb);
        SC_BARRIER();
    }
}
DI void scan_builder_only(Frame& F) {
    SC_BARRIER();
    scan_build<true>(F, 0, F.wave); if (F.wave == 3) scan_build<false>(F, 0, 6);
    SC_BARRIER();
#pragma unroll 1
    for (int s = 0; s < SC_NCH; ++s) { if (s + 1 < SC_NCH && !VAR(2)) { scan_build<true>(F, s + 1, F.wave); if (F.wave == 3) scan_build<false>(F, s + 1, 6); } SC_BARRIER(); }
}
DI void scan_sequencer(Frame& F, int b, int h, int dir) {
    const int it = F.wave, lane = F.lane, n = lane & 31, half = lane >> 5;
    f32x16 D0, D1;
#pragma unroll
    for (int i = 0; i < 16; ++i) { D0[i] = 0.f; D1[i] = 0.f; }
    bf16* wkv = (bf16*)(F.ws + WS_WKV) + ((size_t)dir * NTOK + (size_t)b * SEQ) * 512 + h * 64 + 32 * it + n;
    SC_BARRIER();
    scan_build<false>(F, 0, 4 + it);
    SC_BARRIER();
#pragma unroll 1
    for (int c = 0; c < SC_NCH; ++c) {
        if (VAR(1)) { if (c + 1 < SC_NCH && !VAR(2)) scan_build<false>(F, c + 1, 4 + it); SC_BARRIER(); continue; }
        const LAS unsigned char* img = SC_IMG(c & 1);
        const LAS unsigned char* atr = img + IM_AT + n * P144; const LAS unsigned char* rtr = img + IM_RT + n * P144;
        const LAS unsigned char* vtr = img + IM_VT + (32 * it + n) * P80 + 16 * half;
        const bf16x8 sb00 = packacc(D0, 0), sb01 = packacc(D0, 1), sb10 = packacc(D1, 0), sb11 = packacc(D1, 1);
        const bf16x8 vt0 = *(const LAS bf16x8*)vtr, vt1 = *(const LAS bf16x8*)(vtr + 32);
        f32x16 U, Y;
#pragma unroll
        for (int i = 0; i < 16; ++i) { U[i] = 0.f; Y[i] = 0.f; }
        U = MFMA32(ld_perm(atr, 0, half), sb00, U); Y = MFMA32(ld_perm(rtr, 0, half), sb00, Y);
        U = MFMA32(ld_perm(atr, 1, half), sb01, U); Y = MFMA32(ld_perm(rtr, 1, half), sb01, Y);
        U = MFMA32(ld_perm(atr + 64, 0, half), sb10, U); Y = MFMA32(ld_perm(rtr + 64, 0, half), sb10, Y);
        U = MFMA32(ld_perm(atr + 64, 1, half), sb11, U); Y = MFMA32(ld_perm(rtr + 64, 1, half), sb11, Y);
        { const LAS unsigned char* mk = img + IM_MAK + n * P80 + 16 * half; const LAS unsigned char* nk = img + IM_NK + n * P80 + 16 * half;
          U = MFMA32(*(const LAS bf16x8*)mk, vt0, U); U = MFMA32(*(const LAS bf16x8*)(mk + 32), vt1, U);
          Y = MFMA32(*(const LAS bf16x8*)nk, vt0, Y); Y = MFMA32(*(const LAS bf16x8*)(nk + 32), vt1, Y); }
        f32x16 SA;
#pragma unroll
        for (int i = 0; i < 16; ++i) SA[i] = 0.f;
        { const LAS unsigned char* tr = img + IM_T + n * P80; const bf16x8 ub0 = packacc(U, 0), ub1 = packacc(U, 1);
          SA = MFMA32(ld_perm(tr, 0, half), ub0, SA); SA = MFMA32(ld_perm(tr, 1, half), ub1, SA); }
        const bf16x8 sab0 = packacc(SA, 0), sab1 = packacc(SA, 1);
        { const LAS unsigned char* nb = img + IM_NB + n * P80; Y = MFMA32(ld_perm(nb, 0, half), sab0, Y); Y = MFMA32(ld_perm(nb, 1, half), sab1, Y); }
        { const int tl0 = SC_CH * c;
#pragma unroll
          for (int i = 0; i < 16; ++i) { const int tl = tl0 + crow(i, half), t = dir ? (SEQ - 1 - tl) : tl; if (!VAR(255)) wkv[(size_t)t * 512] = (bf16)(pk2(Y[i], 0.f) & 0xffffu); } }
        { const LAS unsigned char* b0 = img + IM_BT + n * P80; const LAS unsigned char* k0 = img + IM_KT + n * P80 + 16 * half;
          D0 = MFMA32(ld_perm(b0, 0, half), sab0, D0); D1 = MFMA32(ld_perm(b0 + 32 * P80, 0, half), sab0, D1);
          D0 = MFMA32(ld_perm(b0, 1, half), sab1, D0); D1 = MFMA32(ld_perm(b0 + 32 * P80, 1, half), sab1, D1);
          D0 = MFMA32(*(const LAS bf16x8*)k0, vt0, D0); D1 = MFMA32(*(const LAS bf16x8*)(k0 + 32 * P80), vt0, D1);
          D0 = MFMA32(*(const LAS bf16x8*)(k0 + 32), vt1, D0); D1 = MFMA32(*(const LAS bf16x8*)(k0 + 32 * P80 + 32), vt1, D1);
          const LAS float* gc = (const LAS float*)(img + IM_GC) + 4 * half;
#pragma unroll
          for (int g = 0; g < 4; ++g) { const f32x4 g0 = *(const LAS f32x4*)(gc + 8 * g), g1 = *(const LAS f32x4*)(gc + 32 + 8 * g);
#pragma unroll
              for (int e = 0; e < 4; ++e) { D0[4 * g + e] *= g0[e]; D1[4 * g + e] *= g1[e]; } } }
        if (c + 1 < SC_NCH && !VAR(2)) scan_build<false>(F, c + 1, 4 + it);
        SC_BARRIER();
    }
}
DI void scan_unit(Frame& F, const Args& a, int b, int h, int dir) {
    if (F.wave >= 4) { scan_consts(F, a, h, dir); LDS_WAIT(); }
    __syncthreads();
    if (F.wave < 2) scan_sequencer(F, b, h, dir);
    else if (F.wave < 4) scan_builder_only(F);
    else if ((F.wave - 4) >> 1) scan_helper<1>(F, a, b, h, dir);
    else scan_helper<0>(F, a, b, h, dir);
}

DI void post_consts(Frame& F, const Args& a) {
    LAS float* cm = (LAS float*)F.lds;
    cm[F.tid] = ((const float*)a.in[I_GNW])[F.tid]; cm[512 + F.tid] = ((const float*)a.in[I_GNB])[F.tid];
    LDS_WAIT(); __syncthreads();
}
DI void post_item(Frame& F, const bf16* PS, int item) {
    const int tile = item >> 3, h = item & 7, hc = h * 64;
    const int lane = F.lane, n = lane & 31; int half = lane >> 5; LAUNDER(half);
    const bf16* GT = (const bf16*)(F.ws + WS_GUP_T);
    const bf16* WKV = (const bf16*)(F.ws + WS_WKV); const float* BS = (const float*)(F.ws + WS_BSUM); bf16* YR = (bf16*)(F.ws + WS_YR);
    const LAS float* cm = (const LAS float*)F.lds;
    const size_t tok = (size_t)tile * 32 + n;
    const bf16* pr = PS + tok * RW_COLS;
    bf16x8 bfr[8];
#pragma unroll
    for (int kk = 0; kk < 8; ++kk) bfr[kk] = *(const bf16x8*)(pr + 1664 + 16 * kk + 8 * half);
    f32x4 x[2][4]; v2u vr[2][4];
#pragma unroll
    for (int ct = 0; ct < 2; ++ct)
#pragma unroll
        for (int q4 = 0; q4 < 4; ++q4) { const int c = hc + 32 * ct + 8 * q4 + 4 * half;
            x[ct][q4] = up4(*(const v2u*)(WKV + tok * 512 + c)) + up4(*(const v2u*)(WKV + ((size_t)NTOK + tok) * 512 + c));
            vr[ct][q4] = *(const v2u*)(pr + 1024 + c); }
    const f32x2 b0 = *(const f32x2*)(BS + (tok * 8 + h) * 2), b1 = *(const f32x2*)(BS + (((size_t)NTOK + tok) * 8 + h) * 2);
    f32x16 g0, g1;
#pragma unroll
    for (int i = 0; i < 16; ++i) { g0[i] = 0.f; g1[i] = 0.f; }
    const bf16* gp = GT + (size_t)(hc + n) * 128 + 8 * half;
#pragma unroll
    for (int kk = 0; kk < 8; ++kk) { g0 = MFMA32(*(const bf16x8*)(gp + 16 * kk), bfr[kk], g0); g1 = MFMA32(*(const bf16x8*)(gp + 32 * 128 + 16 * kk), bfr[kk], g1); }
    float sm = 0.f;
#pragma unroll
    for (int ct = 0; ct < 2; ++ct)
#pragma unroll
        for (int q4 = 0; q4 < 4; ++q4) sm += (x[ct][q4][0] + x[ct][q4][1]) + (x[ct][q4][2] + x[ct][q4][3]);
    sm += __shfl_xor(sm, 32);
    const float mean = sm * (1.f / 64.f); float vs = 0.f;
#pragma unroll
    for (int ct = 0; ct < 2; ++ct)
#pragma unroll
        for (int q4 = 0; q4 < 4; ++q4) { const f32x4 d = x[ct][q4] - mean; vs += (d[0] * d[0] + d[1] * d[1]) + (d[2] * d[2] + d[3] * d[3]); }
    vs += __shfl_xor(vs, 32);
    const float rstd = 1.f / sqrtf(vs * (1.f / 64.f) + GN_EPS);
    const float bsum = (b0.x + b0.y) + (b1.x + b1.y);
#pragma unroll
    for (int ct = 0; ct < 2; ++ct)
#pragma unroll
        for (int q4 = 0; q4 < 4; ++q4) { const int c = hc + 32 * ct + 8 * q4 + 4 * half;
            const f32x4 y = (x[ct][q4] - mean) * rstd * *(const LAS f32x4*)(cm + c) + *(const LAS f32x4*)(cm + 512 + c) + up4(vr[ct][q4]) * bsum;
            f32x4 gg; if (ct == 0) gg = (f32x4){g0[4 * q4], g0[4 * q4 + 1], g0[4 * q4 + 2], g0[4 * q4 + 3]}; else gg = (f32x4){g1[4 * q4], g1[4 * q4 + 1], g1[4 * q4 + 2], g1[4 * q4 + 3]};
            const f32x4 o = y * gg; v2u w; w.x = pk2(o[0], o[1]); w.y = pk2(o[2], o[3]);
            *(v2u*)(YR + tok * YC_COLS + c) = w; }
    if (h < 4) {
        const bf16* ya = (const bf16*)(F.ws + WS_YA) + tok * 256 + h * 64 + 32 * half; bf16* yc = YR + tok * YC_COLS + 512 + h * 64 + 32 * half;
#pragma unroll
        for (int e = 0; e < 4; ++e) *(v4u*)(yc + 8 * e) = *(const v4u*)(ya + 8 * e); }
}

DI void p5_router_tile(Frame& F, const Args& a, int tile) {
    const int lane = F.lane, n = lane & 31, half = lane >> 5;
    const size_t tok = (size_t)tile * 32 + n;
    const bf16* xr = (const bf16*)(F.ws + WS_X1) + tok * DM + 8 * half;
    const bf16* RH = (const bf16*)(F.ws + WS_RT_HI) + (size_t)n * DM + 8 * half; const bf16* RL = (const bf16*)(F.ws + WS_RT_LO) + (size_t)n * DM + 8 * half;
    f32x16 d0, d1;
#pragma unroll
    for (int i = 0; i < 16; ++i) { d0[i] = 0.f; d1[i] = 0.f; }
    float ss = 0.f;
#pragma unroll 8
    for (int kk = 0; kk < 64; ++kk) {
        const v4u xv = *(const v4u*)(xr + 16 * kk);
        const float x8[8] = {bflo(xv.x), bfhi(xv.x), bflo(xv.y), bfhi(xv.y), bflo(xv.z), bfhi(xv.z), bflo(xv.w), bfhi(xv.w)};
#pragma unroll
        for (int j = 0; j < 8; ++j) ss += x8[j] * x8[j];
        const bf16x8 bh = __builtin_bit_cast(bf16x8, xv);
        const bf16x8 ah0 = *(const bf16x8*)(RH + 16 * kk), ah1 = *(const bf16x8*)(RH + 32 * DM + 16 * kk), al0 = *(const bf16x8*)(RL + 16 * kk), al1 = *(const bf16x8*)(RL + 32 * DM + 16 * kk);
        d0 = MFMA32(ah0, bh, d0); d0 = MFMA32(al0, bh, d0);
        d1 = MFMA32(ah1, bh, d1); d1 = MFMA32(al1, bh, d1);
    }
    ss += __shfl_xor(ss, 32);
    const float rstd = 1.f / sqrtf(ss * (1.f / DM) + NORM_EPS);
    const float* brg = (const float*)a.in[I_BRG]; const float* bre = (const float*)a.in[I_BRE];
    float gl[4];
#pragma unroll
    for (int j = 0; j < 4; ++j) gl[j] = __shfl(d1[j] * rstd + brg[j], n);
    int grp = 0; float gmax = gl[0];
#pragma unroll
    for (int j = 1; j < 4; ++j) if (gl[j] > gmax) { gmax = gl[j]; grp = j; }
    float gsum = 0.f;
#pragma unroll
    for (int j = 0; j < 4; ++j) gsum += __expf(gl[j] - gmax);
    const float grp_p = 1.f / gsum;
    const f32x4 bv = *(const f32x4*)(bre + 8 * grp + 4 * half);
    float cv[4];
#pragma unroll
    for (int j = 0; j < 4; ++j) { float v = d0[j]; v = grp == 1 ? d0[4 + j] : v; v = grp == 2 ? d0[8 + j] : v; v = grp == 3 ? d0[12 + j] : v; cv[j] = v * rstd + bv[j]; }
    float m1v = cv[0]; int m1i = 0;
#pragma unroll
    for (int j = 1; j < 4; ++j) if (cv[j] > m1v) { m1v = cv[j]; m1i = j; }
    float m2v = -3.0e38f; int m2i = 0;
#pragma unroll
    for (int j = 0; j < 4; ++j) if (j != m1i && cv[j] > m2v) { m2v = cv[j]; m2i = j; }
    m1i += 4 * half; m2i += 4 * half;
    const float t1v = __shfl_xor(m1v, 32), t2v = __shfl_xor(m2v, 32); const int t1i = __shfl_xor(m1i, 32), t2i = __shfl_xor(m2i, 32);
    auto better = [](float av, int ai, float bv_, int bi) { return av > bv_ || (av == bv_ && ai < bi); };
    float top1v, top2v; int top1i, top2i;
    if (better(m1v, m1i, t1v, t1i)) { top1v = m1v; top1i = m1i; if (better(m2v, m2i, t1v, t1i)) { top2v = m2v; top2i = m2i; } else { top2v = t1v; top2i = t1i; } }
    else { top1v = t1v; top1i = t1i; if (better(m1v, m1i, t2v, t2i)) { top2v = m1v; top2i = m1i; } else { top2v = t2v; top2i = t2i; } }
    const float w0 = grp_p / (1.f + __expf(top2v - top1v)), w1 = grp_p - w0;
    const int mye = 8 * grp + (half ? top2i : top1i); const float myw = half ? w1 : w0;
    unsigned long long mymask = 0ull; int cnt_l = 0;
    for (int e = 0; e < NEXP; ++e) { const unsigned long long m = __ballot(mye == e); if (mye == e) mymask = m; if (lane == e) cnt_l = __popcll(m); }
    int base_l = 0;
    if (lane < NEXP && cnt_l > 0 && !VAR(64)) base_l = (int)__hip_atomic_fetch_add((unsigned*)(F.ws + WS_CTL) + CW_CNT + 64 * lane, (unsigned)cnt_l, RLX_AGENT);
    const int mybase = __shfl(base_l, mye);
    const int pos = mybase + __popcll(mymask & ((1ull << lane) - 1ull));
    if (!VAR(64)) { ((int*)(F.ws + WS_LTOK))[(size_t)mye * NTOK + pos] = (int)tok * 2 + half;
    ((float*)(F.ws + WS_LW))[(size_t)mye * NTOK + pos] = myw; }
    const float* g2 = (const float*)a.in[I_N2G] + 8 * half; bf16* h2 = (bf16*)(F.ws + WS_H2) + tok * DM + 8 * half;
#pragma unroll 8
    for (int kk = 0; kk < 64; ++kk) {
        const v4u xv = *(const v4u*)(xr + 16 * kk); const f32x4 ga = *(const f32x4*)(g2 + 16 * kk) * rstd, gb = *(const f32x4*)(g2 + 16 * kk + 4) * rstd;
        v4u o; o.x = pk2(bflo(xv.x) * ga[0], bfhi(xv.x) * ga[1]); o.y = pk2(bflo(xv.y) * ga[2], bfhi(xv.y) * ga[3]); o.z = pk2(bflo(xv.z) * gb[0], bfhi(xv.z) * gb[1]); o.w = pk2(bflo(xv.w) * gb[2], bfhi(xv.w) * gb[3]);
        if (!VAR(64)) *(v4u*)(h2 + 16 * kk) = o; }
}
DI void p5_phase(Frame& F, const Args& a) {
    const int gw = F.bid * NWAVES + F.wave, NGW = F.G * NWAVES;
    if (!VAR(256)) for (int tile = F.wave * F.G + F.bid; tile < NTOK / 32; tile += NGW) p5_router_tile(F, a, tile);
    if (F.bid == 0 && F.tid < 128) ((v4u*)((bf16*)(F.ws + WS_H2) + (size_t)NTOK * DM))[F.tid] = (v4u){0u, 0u, 0u, 0u};
    LAS float* scr = (LAS float*)(F.lds + F.wave * 16384);
    constexpr int IPE = 256;
    if (!VAR(128)) for (int it = gw; it < NEXP * 3 * IPE; it += NGW) {
        const int e = it / (3 * IPE), r = it % (3 * IPE), which = r / IPE, item = r % IPE;
        if (which == 0) transpose_item((const float*)a.in[I_WGATE] + (size_t)e * DM * DEXP, DM, DEXP, (bf16*)(F.ws + WS_WGU_T) + (size_t)e * DM * DM, RmGate(), scr, item, F.lane);
        else if (which == 1) transpose_item((const float*)a.in[I_WUP] + (size_t)e * DM * DEXP, DM, DEXP, (bf16*)(F.ws + WS_WGU_T) + (size_t)e * DM * DM, RmUp(), scr, item, F.lane);
        else transpose_item((const float*)a.in[I_WDOWN] + (size_t)e * DEXP * DM, DEXP, DM, (bf16*)(F.ws + WS_WD_T) + (size_t)e * DM * DEXP, RmId(), scr, item, F.lane);
    }
}
DI int moe_table(Frame& F) {
    LAS int* tab = (LAS int*)(F.lds + TAB_OFF);
    if (F.tid == 0) { int acc = 0;
        for (int e = 0; e < NEXP; ++e) { const int c = (int)__hip_atomic_load((unsigned*)(F.ws + WS_CTL) + CW_CNT + 64 * e, RLX_AGENT); tab[e] = acc; tab[33 + e] = c; acc += (c + 255) >> 8; }
        tab[32] = acc; }
    __syncthreads();
    return tab[32];
}
DI void p6_gather(Frame& F) {
    const int nT = moe_table(F);
    const LAS int* tab = (const LAS int*)(F.lds + TAB_OFF);
    const bf16* h2 = (const bf16*)(F.ws + WS_H2); bf16* Xg = (bf16*)(F.ws + WS_XG);
    const int* ltok = (const int*)(F.ws + WS_LTOK); const float* lw = (const float*)(F.ws + WS_LW);
    const int nrows = nT * 256, rstride = F.G * NWAVES;
    for (int R0 = F.bid * NWAVES + F.wave; R0 < nrows; R0 += 4 * rstride) {
        int tk[4], kq[4]; float wv[4];
#pragma unroll
        for (int u = 0; u < 4; ++u) { const int R = R0 + u * rstride; tk[u] = -1; kq[u] = 0; wv[u] = 0.f;
            if (R < nrows) { const int tile = R >> 8; int e = 0;
                for (int k = 1; k < NEXP; ++k) e += (tab[k] <= tile) ? 1 : 0;
                const int slot = R - tab[e] * 256;
                if (slot < tab[33 + e]) { const int t2 = ltok[(size_t)e * NTOK + slot]; tk[u] = t2 >> 1; kq[u] = t2 & 1; wv[u] = lw[(size_t)e * NTOK + slot]; } } }
        v4u d0[4], d1[4];
#pragma unroll
        for (int u = 0; u < 4; ++u) { const v4u* src = (const v4u*)(h2 + (size_t)(tk[u] < 0 ? NTOK : tk[u]) * DM); d0[u] = src[F.lane]; d1[u] = src[F.lane + 64]; }
#pragma unroll
        for (int u = 0; u < 4; ++u) { const int R = R0 + u * rstride; if (R < nrows) { v4u* dst = (v4u*)(Xg + (size_t)R * DM); dst[F.lane] = d0[u]; dst[F.lane + 64] = d1[u];
            if (F.lane == 0) { ((float*)(F.ws + WS_ROWW))[R] = wv[u]; if (tk[u] >= 0) ((int*)(F.ws + WS_INV))[tk[u] * 2 + kq[u]] = R; } } }
    }
}

__global__ void __launch_bounds__(NWAVES * 64, 2) mk_fwd(Args args) {
    extern __shared__ __attribute__((aligned(16))) unsigned char lds[];
    Frame F;
    F.lds = (LAS unsigned char*)lds; F.MISC = (volatile LAS unsigned*)(F.lds + MISC_OFF);
    F.tid = threadIdx.x; F.lane = F.tid & 63; F.wave = __builtin_amdgcn_readfirstlane(F.tid >> 6); F.G = gridDim.x; F.bid = blockIdx.x; F.ws = args.ws; F.variant = args.variant;
    for (int u = F.tid; u < (LDS_BYTES - RING_BYTES) / 4; u += NWAVES * 64) ((LAS unsigned*)(F.lds + RING_BYTES))[u] = 0u;
    __syncthreads();
    const int lo = args.ph_lo, hi = args.ph_hi;
    const bool multi = (hi - lo) > 1;
    XcdBarrier bar; bar.bar = (unsigned*)(args.ws + WS_CTL) + CW_BAR + args.li * XCD_BAR_WORDS; bar.x = 0; bar.st = nullptr;
    if (multi) bar = xcd_barrier_post((unsigned*)(args.ws + WS_CTL) + CW_BAR + args.li * XCD_BAR_WORDS, F.MISC + 8);
#ifndef PH_MASK
#define PH_MASK 0xFFFFFFFFu
#endif
#define REFRESH() do { F.lane = (int)__builtin_amdgcn_mbcnt_hi(~0u, __builtin_amdgcn_mbcnt_lo(~0u, 0u)); F.tid = F.wave * 64 + F.lane; } while (0)
#define IN(k) ((((PH_MASK) >> (k)) & 1u) && lo <= (k) && (k) < hi)
#define SEAM(k) do { if (IN(k) && IN((k) + 1)) xcd_barrier(bar); } while (0)
    unsigned char* ws = args.ws;

    if (IN(0)) { REFRESH(); p0_prologue(F, args); } SEAM(0);
    if (IN(1)) { REFRESH();
        pg8::Gemm g{(const bf16*)(ws + WS_HB), (const bf16*)(ws + WS_WIN_T), DM, 0, nullptr, nullptr}; pg8::StaticOrder S; S.init(NTOK, IN_COLS, F.G, F.bid);
        pg8::EpiIn E{(bf16*)(ws + WS_PR), (bf16*)(ws + WS_PT), (bf16*)(ws + WS_G), (const float*)args.in[I_BMERGE]};
        pg8::gemm_phase<pg8::EpiIn, pg8::StaticOrder, true, true>(F.lds, g, S, E);
    } SEAM(1);
    if (IN(2)) { REFRESH(); if (!VAR(128)) p1b_qkprep(F, args); if (!VAR(256)) p1c_preshift(F, args); } SEAM(2);
    if (IN(3)) { REFRESH(); for (int u = F.bid; u < 256; u += F.G) attn_unit(F, u >> 4, (u >> 2) & 3, u & 3); } SEAM(3);
    if (IN(4)) { REFRESH(); for (int u = F.bid; u < 256; u += F.G) scan_unit(F, args, u >> 4, (u >> 1) & 7, u & 1); } SEAM(4);
    if (IN(5)) { REFRESH(); post_consts(F, args);
#pragma unroll 1
        for (int item = F.bid * NWAVES + F.wave; item < NTOK / 32 * 8; item += F.G * NWAVES) post_item(F, (const bf16*)args.out, item); } SEAM(5);
    if (IN(6)) { REFRESH();
        pg8::Gemm g{(const bf16*)(ws + WS_YR), (const bf16*)(ws + WS_WR_T), YC_COLS, 0, nullptr, nullptr}; pg8::StaticOrder S; S.init(NTOK, DM, F.G, F.bid);
        pg8::EpiMix2 E{(const bf16*)(ws + WS_G), (bf16*)(ws + WS_Z)};
        pg8::gemm_phase<pg8::EpiMix2, pg8::StaticOrder, true, true>(F.lds, g, S, E);
    } SEAM(6);
    if (IN(8)) { REFRESH();
        pg8::Gemm g{(const bf16*)(ws + WS_Z), (const bf16*)(ws + WS_WOUT_T), DM, 0, nullptr, nullptr}; pg8::StaticOrder S; S.init(NTOK, DM, F.G, F.bid);
        pg8::EpiRes E{(const float*)args.in[I_X], (bf16*)(ws + WS_X1)};
        pg8::gemm_phase<pg8::EpiRes, pg8::StaticOrder, true, true>(F.lds, g, S, E);
    } SEAM(8);
    if (IN(9)) { REFRESH(); p5_phase(F, args); } SEAM(9);
    if (IN(11)) { REFRESH();
        const int nT = moe_table(F);
        pg8::Gemm g{(const bf16*)(ws + WS_H2), (const bf16*)(ws + WS_WGU_T), DM, (size_t)DM * DM * 2, (const int*)(ws + WS_LTOK), (const LAS int*)(F.lds + TAB_OFF)}; pg8::GroupedOrder S{(const LAS int*)(F.lds + TAB_OFF), nT, F.G, F.bid};
        pg8::EpiSwiglu E{(bf16*)(ws + WS_HH)};
        pg8::gemm_phase<pg8::EpiSwiglu, pg8::GroupedOrder, true, true, true>(F.lds, g, S, E);
    } SEAM(11);
    if (IN(12)) { REFRESH();
        const int nT = moe_table(F);
        pg8::Gemm g{(const bf16*)(ws + WS_HH), (const bf16*)(ws + WS_WD_T), DEXP, (size_t)DM * DEXP * 2, nullptr, nullptr}; pg8::GroupedOrder S{(const LAS int*)(F.lds + TAB_OFF), nT, F.G, F.bid};
        pg8::EpiStoreY E{(const int*)(ws + WS_LTOK), (const float*)(ws + WS_LW), (const LAS int*)(F.lds + TAB_OFF), (int*)(ws + WS_INV), (bf16*)(ws + WS_YB)};
        pg8::gemm_phase<pg8::EpiStoreY, pg8::GroupedOrder, true, true>(F.lds, g, S, E);
    } SEAM(12);
    if (IN(13)) { REFRESH();
        const int* inv = (const int*)(ws + WS_INV); const bf16* Y = (const bf16*)(ws + WS_YB);
        const int tstride = F.G * NWAVES;
        for (int tok0 = F.bid * NWAVES + F.wave; tok0 < NTOK; tok0 += 4 * tstride) {
            int r0[4], r1[4];
#pragma unroll
            for (int u = 0; u < 4; ++u) { const int tok = tok0 + u * tstride; r0[u] = inv[tok * 2]; r1[u] = inv[tok * 2 + 1]; }
#pragma unroll
            for (int u = 0; u < 4; ++u) { const int tok = tok0 + u * tstride;
                f32x4* o = (f32x4*)(args.out + (size_t)tok * DM) + F.lane; const v2u* xb = (const v2u*)((const bf16*)(ws + WS_X1) + (size_t)tok * DM) + F.lane;
                const v2u* y0 = (const v2u*)(Y + (size_t)r0[u] * DM) + F.lane; const v2u* y1 = (const v2u*)(Y + (size_t)r1[u] * DM) + F.lane;
                v2u xv[4], a0[4], a1[4];
#pragma unroll
                for (int j = 0; j < 4; ++j) { xv[j] = xb[64 * j]; a0[j] = y0[64 * j]; a1[j] = y1[64 * j]; }
#pragma unroll
                for (int j = 0; j < 4; ++j) { f32x4 v; v[0] = bflo(xv[j].x) + bflo(a0[j].x) + bflo(a1[j].x); v[1] = bfhi(xv[j].x) + bfhi(a0[j].x) + bfhi(a1[j].x); v[2] = bflo(xv[j].y) + bflo(a0[j].y) + bflo(a1[j].y); v[3] = bfhi(xv[j].y) + bfhi(a0[j].y) + bfhi(a1[j].y); if (!VAR(64)) o[64 * j] = v; } }
        }
    }
#undef IN
#undef SEAM
}

constexpr int NPHASE = 14;
extern "C" void kernel_launch(void* const* d_in, const int* in_sizes, int n_in, void* d_out, int out_size, void* d_ws, size_t ws_size, hipStream_t stream) {
    static int grid = 0;
    if (grid == 0) {
        if (n_in != 30 || ws_size < WS_END) { fprintf(stderr, "kernel_launch: need 30 inputs and >= %zu bytes of workspace (got %d, %zu)\n", (size_t)WS_END, n_in, ws_size); grid = -1; return; }
        int dev = 0, cus = 0;
        if (hipGetDevice(&dev) != hipSuccess || hipDeviceGetAttribute(&cus, hipDeviceAttributeMultiprocessorCount, dev) != hipSuccess) { grid = -1; return; }
        if (hipFuncSetAttribute((const void*)mk_fwd, hipFuncAttributeMaxDynamicSharedMemorySize, LDS_BYTES) != hipSuccess) { fprintf(stderr, "kernel_launch: hipFuncSetAttribute failed\n"); grid = -1; return; }
        int per_cu = 0;
        if (hipOccupancyMaxActiveBlocksPerMultiprocessor(&per_cu, (const void*)mk_fwd, NWAVES * 64, LDS_BYTES) != hipSuccess || per_cu < 1) fprintf(stderr, "kernel_launch: occupancy query reports %d\n", per_cu);
        (void)hipGetLastError();
        grid = cus;
    }
    if (grid < 0) return;
    hipMemsetAsync((char*)d_ws + WS_CTL, 0, CTL_ZERO_BYTES, stream);
    Args a{};
    for (int i = 0; i < 30; ++i) a.in[i] = d_in[i];
    a.out = (float*)d_out; a.ws = (unsigned char*)d_ws;
#if defined(PROBE_REPEAT)
#ifdef PROBE_VARIANT
#define PROBE_VARIANT_V PROBE_VARIANT
#else
#define PROBE_VARIANT_V 0
#endif
    { const int k = PROBE_REPEAT; int li = 0;
      const int cuts[5][2] = {{0, k}, {k, k + 1}, {k, k + 1}, {k + 1, NPHASE}, {0, 0}};
      for (int i = 0; i < 4; ++i) { if (cuts[i][1] <= cuts[i][0]) continue; a.ph_lo = cuts[i][0]; a.ph_hi = cuts[i][1]; a.li = li++; a.variant = (i == 2) ? PROBE_VARIANT_V : 0; hipLaunchKernelGGL(mk_fwd, dim3(grid), dim3(NWAVES * 64), LDS_BYTES, stream, a); } }
#elif !defined(MK_MULTI_LAUNCH)
    a.ph_lo = 0; a.ph_hi = NPHASE; a.li = 0;
    hipLaunchKernelGGL(mk_fwd, dim3(grid), dim3(NWAVES * 64), LDS_BYTES, stream, a);
#else
    for (int p = 0; p < NPHASE; ++p) { a.ph_lo = p; a.ph_hi = p + 1; a.li = 0; hipLaunchKernelGGL(mk_fwd, dim3(grid), dim3(NWAVES * 64), LDS_BYTES, stream, a); }
#endif
}
```

```cpp
#include <hip/hip_runtime.h>
#include <cstdio>
#include <cstdint>

constexpr int BATCH = 16, SEQ = 2048, DM = 1024, NTOK = BATCH * SEQ;
constexpr int RW_COLS = 1792, AT_COLS = 2304, G_COLS = 2048, IN_COLS = 6144;
constexpr int NEXP = 32, DEXP = 512;
constexpr int MAXTILES = 288;
constexpr float NORM_EPS = 1e-6f, GN_EPS = 64e-5f;

#define GAS __attribute__((address_space(1)))
#define LAS __attribute__((address_space(3)))
typedef unsigned short bf16;
typedef unsigned v4u __attribute__((ext_vector_type(4)));
typedef unsigned v2u __attribute__((ext_vector_type(2)));
typedef float f32x4 __attribute__((ext_vector_type(4)));
typedef float f32x2 __attribute__((ext_vector_type(2)));
typedef float f32x16 __attribute__((ext_vector_type(16)));
typedef short bf16x8 __attribute__((ext_vector_type(8)));
typedef __bf16 bf16x2_t __attribute__((ext_vector_type(2)));
typedef GAS unsigned gu32;
#define RLX_AGENT __ATOMIC_RELAXED, __HIP_MEMORY_SCOPE_AGENT
#define LDS_WAIT() asm volatile("s_waitcnt lgkmcnt(0)" ::: "memory")
#define VM_WAIT() asm volatile("s_waitcnt vmcnt(0)" ::: "memory")
#define DI __device__ __forceinline__
#ifdef PROBE_VARIANT
#define VAR(b) (F.variant & (b))
#else
#define VAR(b) 0
#endif
#define LAUNDER(x) asm volatile("" : "+v"(x))

DI unsigned pk2(float lo, float hi) { f32x2 v = {lo, hi}; bf16x2_t b = __builtin_convertvector(v, bf16x2_t); return __builtin_bit_cast(unsigned, b); }
DI float bflo(unsigned u) { return __builtin_bit_cast(float, u << 16); }
DI float bfhi(unsigned u) { return __builtin_bit_cast(float, u & 0xffff0000u); }
DI float sigmoidf_(float x) { return __builtin_amdgcn_rcpf(1.f + __builtin_amdgcn_exp2f(-1.44269504f * x)); }
DI float wave_sum(float v) {
#pragma unroll
    for (int o = 1; o < 64; o <<= 1) v += __shfl_xor(v, o);
    return v;
}
DI int crow(int reg, int h) { return (reg & 3) + 8 * (reg >> 2) + 4 * h; }
#define MFMA32(a, b, c) __builtin_amdgcn_mfma_f32_32x32x16_bf16((a), (b), (c), 0, 0, 0)

constexpr size_t MiB = 1u << 20;
constexpr size_t WS_CTL = 0, CTL_ZERO_BYTES = 1 * MiB;
constexpr size_t WS_WIN_T = 1 * MiB;
constexpr size_t WS_WR_T = 13 * MiB;
constexpr size_t WS_WA_T = 14 * MiB;
constexpr size_t WS_WOUT_T = 15 * MiB;
constexpr size_t WS_GUP_T = 17 * MiB;
constexpr size_t WS_RT_HI = 17 * MiB + 256 * 1024;
constexpr size_t WS_RT_LO = 17 * MiB + 384 * 1024;
constexpr size_t WS_WUP_T = 17 * MiB + 512 * 1024;
constexpr size_t WS_AUP_T = 17 * MiB + 640 * 1024;
constexpr size_t RG_A = 18 * MiB, RG_B = 82 * MiB, RG_C = 194 * MiB, RG_D = 338 * MiB, RG_E = 466 * MiB, WS_END = 512 * MiB;
constexpr size_t WS_HB = RG_A;
constexpr size_t WS_PR = RG_B;
constexpr size_t WS_PT = RG_C;
constexpr size_t WS_G = RG_D;
constexpr size_t WS_OG = RG_A;
constexpr size_t WS_LSE = RG_A + 48 * MiB;
constexpr size_t WS_YA = RG_E;
constexpr size_t WS_BSUM = RG_E + 16 * MiB;
constexpr size_t WS_WKV = RG_C;
constexpr size_t WS_YR = RG_A;
constexpr int YC_COLS = 768;
constexpr size_t WS_X1 = RG_A;
constexpr size_t WS_Z1 = RG_C;
constexpr size_t WS_Z = RG_C + 64 * MiB;
constexpr size_t WS_H2 = RG_B;
constexpr size_t WS_LTOK = RG_E + 20 * MiB;
constexpr size_t WS_LW = RG_E + 24 * MiB;
constexpr size_t WS_ROWTOK = RG_E + 28 * MiB;
constexpr size_t WS_ROWW = RG_E + 29 * MiB;
constexpr size_t WS_WGU_T = RG_D;
constexpr size_t WS_WD_T = 434 * MiB;
constexpr size_t WS_XG = RG_C;
constexpr size_t WS_HH = RG_C;
constexpr size_t WS_YB = RG_C + 72 * MiB;
constexpr size_t WS_LR = RG_E + 34 * MiB;
constexpr size_t WS_INV = RG_E + 30 * MiB;
constexpr int CW_BAR = 4096;
constexpr int CW_CNT = 32768;

constexpr int RING_BYTES = 155648;
constexpr int MISC_OFF = RING_BYTES + 320;
constexpr int TAB_OFF = RING_BYTES + 1024;
constexpr int LDS_BYTES = 163840;
constexpr int NWAVES = 8;

namespace pg8 {
constexpr int BM = 256, BK = 64, HALF = 128, HTB = HALF * BK * 2, STAGE_BYTES = 8 * HTB, NXCD = 8, WGM = 8;
__host__ __device__ __forceinline__ int lds_byte(int r, int c) { const int st = (r >> 4) * 2 + (c >> 5), rr = r & 15, cc = c & 31, ob = rr * 64 + cc * 2; return st * 1024 + (ob ^ (((ob >> 9) & 1) << 5)); }
__host__ __device__ __forceinline__ void stage_rc(int b, int& R, int& C) { const int st = b / 1024, sb = b % 1024, swz = sb ^ (((sb >> 9) & 1) << 5); R = (st >> 1) * 16 + swz / 64; C = (st & 1) * 32 + (swz % 64) / 2; }
__host__ __device__ __forceinline__ int perm32(int rho) { const int n = rho >> 4, i = rho & 15; return 8 * (i >> 2) + 4 * n + (i & 3); }

struct Unit { int pm, pn, e; };
struct Gemm { const bf16* A; const bf16* Bt; int K; size_t bgroup; const int* ltok; const LAS int* tab; };

struct StaticOrder {
    int nM, nN, nwg, G, c;
    __device__ void init(int M, int N, int G_, int c_) { nM = M / BM; nN = N / BM; nwg = nM * nN; G = G_; c = c_; }
    __device__ bool next(int i, Unit& u) const {
        const long L = (long)i * G + c; if (L >= nwg) return false;
        int wgid = (int)L; { const int q = nwg / NXCD, r = nwg % NXCD, xcd = wgid % NXCD, off = wgid / NXCD; wgid = (xcd < r ? xcd * (q + 1) : r * (q + 1) + (xcd - r) * q) + off; }
        const int nig = WGM * nN, gid = wgid / nig, fm = gid * WGM, gsz = (nM - fm) < WGM ? (nM - fm) : WGM;
        u.pm = fm + ((wgid % nig) % gsz); u.pn = (wgid % nig) / gsz; u.e = 0; return true;
    }
};
struct GroupedOrder {
    const LAS int* tstart; int nT, G, c;
    __device__ bool next(int i, Unit& u) const {
        const int L = i * G + c; if (L >= nT * 4) return false;
        u.pm = L >> 2; u.pn = L & 3; int e = 0;
        for (int k = 1; k < NEXP; ++k) e += (tstart[k] <= u.pm) ? 1 : 0;
        u.e = e; return true;
    }
};

template <class Epi, class Sched, bool ALIGN_EPI = false, bool SP2 = false, bool GATHER = false>
__device__ __forceinline__ void gemm_phase(LAS unsigned char* lds, const Gemm g, const Sched& S, const Epi& E) {
    const int tid = threadIdx.x, wid = __builtin_amdgcn_readfirstlane(tid >> 6), lane = tid & 63, wr = wid >> 2, wc = wid & 3, fr = lane & 15, fq = lane >> 4;
    const int K = g.K, nt = K / BK;
    unsigned voffA[2], voffB[2];
#pragma unroll
    for (int i = 0; i < 2; ++i) { int R, C; stage_rc(tid * 16 + i * 8192, R, C); const int Rb = Epi::PERM ? ((R & ~31) + perm32(R & 31)) : R;
        voffA[i] = (unsigned)(R * K + C) * 2u; voffB[i] = (unsigned)(Rb * K + C) * 2u; }
    const size_t kstep = (size_t)(BK * 2);
    const size_t hstep = (size_t)HALF * K * 2;
    const size_t tstep = 2 * hstep;
    const unsigned ldsw = (unsigned)wid * 1024u;
    const int aoff = lds_byte(wr * 64 + fr, fq * 8), boff = lds_byte(wc * 32 + fr, fq * 8);
    const size_t hstepA = GATHER ? 0 : hstep;
    unsigned voffGc[2][2], voffGn[2][2];
#define PG8_GOFF(dst, un) do { if constexpr (GATHER) { _Pragma("unroll") for (int _h = 0; _h < 2; ++_h) _Pragma("unroll") for (int _i = 0; _i < 2; ++_i) { int R_, C_; stage_rc(tid * 16 + _i * 8192, R_, C_); \
        const int slot_ = ((un).pm - g.tab[(un).e]) * 256 + _h * 128 + R_; const int tok_ = slot_ < g.tab[33 + (un).e] ? (g.ltok[(size_t)(un).e * NTOK + slot_] >> 1) : NTOK; \
        dst[_h][_i] = (unsigned)(tok_ * K + C_) * 2u; } } } while (0)
#define PG8_VA(sel, h) (GATHER ? ((sel) ? voffGn[h] : voffGc[h]) : voffA)
#define PG8_SA(b, h) (((b) * 2 + (h)) * HTB)
#define PG8_SB(b, h) ((4 + (b) * 2 + (h)) * HTB)
#define PG8_STAGE(bufoff, gbase, voff) do { _Pragma("unroll") for (int _i = 0; _i < 2; ++_i) \
        __builtin_amdgcn_global_load_lds((const unsigned*)((const char*)(gbase) + (voff)[_i]), (LAS unsigned*)(lds + (bufoff) + ldsw + _i * 8192), 16, 0, 0); } while (0)
#define PG8_LDA(dst, b, h) do { _Pragma("unroll") for (int m = 0; m < 4; ++m) _Pragma("unroll") for (int k = 0; k < 2; ++k) dst[m][k] = *(const LAS bf16x8*)(lds + PG8_SA(b, h) + aoff + m * 2048 + k * 1024); } while (0)
#define PG8_LDB(dst, b, h) do { _Pragma("unroll") for (int n = 0; n < 2; ++n) _Pragma("unroll") for (int k = 0; k < 2; ++k) dst[n][k] = *(const LAS bf16x8*)(lds + PG8_SB(b, h) + boff + n * 2048 + k * 1024); } while (0)
#define PG8_MMA(ai, bj, At, Bt) do { __builtin_amdgcn_s_setprio(1); _Pragma("unroll") for (int m = 0; m < 4; ++m) _Pragma("unroll") for (int n = 0; n < 2; ++n) _Pragma("unroll") for (int k = 0; k < 2; ++k) \
        acc[ai][bj][m][n] = __builtin_amdgcn_mfma_f32_16x16x32_bf16(Bt[n][k], At[m][k], acc[ai][bj][m][n], 0, 0, 0); __builtin_amdgcn_s_setprio(0); } while (0)
#define PG8_WAIT_V(n) asm volatile("s_waitcnt vmcnt(" #n ")" ::: "memory")
#define PG8_WAIT_L(n) asm volatile("s_waitcnt lgkmcnt(" #n ")" ::: "memory")
#define PG8_BAR __builtin_amdgcn_s_barrier()
#define PG8_SCHED __builtin_amdgcn_sched_barrier(0)
    Unit cur, nxt; int ui = 0;
    if (!S.next(0, cur)) return;
    f32x4 acc[2][2][4][2];
#pragma unroll
    for (int a = 0; a < 2; ++a)
#pragma unroll
        for (int b = 0; b < 2; ++b)
#pragma unroll
            for (int m = 0; m < 4; ++m)
#pragma unroll
                for (int n = 0; n < 2; ++n) acc[a][b][m][n] = (f32x4){0.f, 0.f, 0.f, 0.f};
    bf16x8 At[4][2], B0[2][2], B1[2][2];
    const char* cA = (const char*)g.A + (GATHER ? 0 : (size_t)cur.pm * tstep); const char* cB = (const char*)g.Bt + (size_t)cur.e * g.bgroup + (size_t)cur.pn * tstep;
    PG8_GOFF(voffGc, cur);
    if constexpr (SP2) {
        PG8_STAGE(PG8_SB(0, 0), cB, voffB); PG8_STAGE(PG8_SB(0, 1), cB + hstep, voffB); PG8_STAGE(PG8_SA(0, 0), cA, PG8_VA(false, 0)); PG8_STAGE(PG8_SA(0, 1), cA + hstepA, PG8_VA(false, 1));
        if (wr == 1) PG8_BAR;
        PG8_WAIT_V(2); PG8_BAR;
        PG8_STAGE(PG8_SB(1, 0), cB + kstep, voffB); PG8_STAGE(PG8_SA(1, 0), cA + kstep, PG8_VA(false, 0)); PG8_STAGE(PG8_SB(1, 1), cB + hstep + kstep, voffB);
        PG8_WAIT_V(6); PG8_BAR;
    } else {
        PG8_STAGE(PG8_SB(0, 0), cB, voffB); PG8_STAGE(PG8_SA(0, 0), cA, PG8_VA(false, 0)); PG8_STAGE(PG8_SB(0, 1), cB + hstep, voffB); PG8_STAGE(PG8_SA(0, 1), cA + hstepA, PG8_VA(false, 1));
        if (wr == 1) PG8_BAR;
        PG8_WAIT_V(4); PG8_BAR;
        PG8_STAGE(PG8_SB(1, 0), cB + kstep, voffB); PG8_STAGE(PG8_SA(1, 0), cA + kstep, PG8_VA(false, 0)); PG8_STAGE(PG8_SB(1, 1), cB + hstep + kstep, voffB);
        PG8_WAIT_V(6); PG8_BAR;
    }
    for (;;) {
        const bool has_next = S.next(ui + 1, nxt);
        const char* nA = has_next ? (const char*)g.A + (GATHER ? 0 : (size_t)nxt.pm * tstep) : cA;
        if (has_next) PG8_GOFF(voffGn, nxt); const char* nB = has_next ? (const char*)g.Bt + (size_t)nxt.e * g.bgroup + (size_t)nxt.pn * tstep : cB;
        for (int t = 0; t < nt; t += 2) {
            if constexpr (Epi::MID_T >= 0) { if (t == Epi::MID_T) E.mid(acc, cur, wr, wc, fr, fq); }
            const bool last = (t == nt - 2); const bool seln = last && has_next;
            const char* a1 = cA + (size_t)(t + 1) * kstep;
            const char* a2 = last ? nA : cA + (size_t)(t + 2) * kstep; const char* b2 = last ? nB : cB + (size_t)(t + 2) * kstep;
            const char* a3 = a2 + kstep; const char* b3 = b2 + kstep;
            if constexpr (SP2) {
            PG8_LDB(B0, 0, 0); PG8_LDB(B1, 0, 1); PG8_SCHED; PG8_LDA(At, 0, 0); PG8_STAGE(PG8_SA(1, 1), a1 + hstepA, PG8_VA(false, 1));
            PG8_WAIT_V(8); PG8_WAIT_L(0); PG8_BAR; PG8_MMA(0, 0, At, B0); PG8_MMA(0, 1, At, B1); PG8_BAR; PG8_SCHED;
            PG8_LDA(At, 0, 1); PG8_STAGE(PG8_SB(0, 0), b2, voffB); PG8_STAGE(PG8_SB(0, 1), b2 + hstep, voffB); PG8_STAGE(PG8_SA(0, 0), a2, PG8_VA(seln, 0));
            PG8_WAIT_V(8); PG8_WAIT_L(0); PG8_BAR; PG8_MMA(1, 0, At, B0); PG8_MMA(1, 1, At, B1); PG8_BAR; PG8_SCHED;
            PG8_LDB(B0, 1, 0); PG8_LDB(B1, 1, 1); PG8_SCHED; PG8_LDA(At, 1, 0); PG8_STAGE(PG8_SA(0, 1), a2 + hstepA, PG8_VA(seln, 1));
            PG8_WAIT_V(8); PG8_WAIT_L(0); PG8_BAR; PG8_MMA(0, 0, At, B0); PG8_MMA(0, 1, At, B1); PG8_BAR; PG8_SCHED;
            PG8_LDA(At, 1, 1); PG8_STAGE(PG8_SB(1, 0), b3, voffB); PG8_STAGE(PG8_SB(1, 1), b3 + hstep, voffB); PG8_STAGE(PG8_SA(1, 0), a3, PG8_VA(seln, 0));
            PG8_WAIT_V(8); PG8_WAIT_L(0); PG8_BAR; PG8_MMA(1, 0, At, B0); PG8_MMA(1, 1, At, B1); PG8_BAR; PG8_SCHED;
            } else {
            PG8_LDB(B0, 0, 0); PG8_SCHED; PG8_LDA(At, 0, 0); PG8_STAGE(PG8_SA(1, 1), a1 + hstepA, PG8_VA(false, 1));
            PG8_WAIT_L(8); PG8_BAR; PG8_WAIT_L(0); PG8_MMA(0, 0, At, B0); PG8_BAR; PG8_SCHED;
            PG8_LDB(B1, 0, 1); PG8_STAGE(PG8_SB(0, 0), b2, voffB);
            PG8_BAR; PG8_WAIT_L(0); PG8_MMA(0, 1, At, B1); PG8_BAR;
            PG8_LDA(At, 0, 1); PG8_STAGE(PG8_SA(0, 0), a2, PG8_VA(seln, 0));
            PG8_BAR; PG8_WAIT_L(0); PG8_MMA(1, 0, At, B0); PG8_BAR; PG8_SCHED;
            PG8_STAGE(PG8_SB(0, 1), b2 + hstep, voffB);
            PG8_WAIT_V(6); PG8_BAR; PG8_MMA(1, 1, At, B1); PG8_BAR;
            PG8_LDB(B0, 1, 0); PG8_SCHED; PG8_LDA(At, 1, 0); PG8_STAGE(PG8_SA(0, 1), a2 + hstepA, PG8_VA(seln, 1));
            PG8_WAIT_L(8); PG8_BAR; PG8_WAIT_L(0); PG8_MMA(0, 0, At, B0); PG8_BAR; PG8_SCHED;
            PG8_LDB(B1, 1, 1); PG8_STAGE(PG8_SB(1, 0), b3, voffB);
            PG8_BAR; PG8_WAIT_L(0); PG8_MMA(0, 1, At, B1); PG8_BAR;
            PG8_LDA(At, 1, 1); PG8_STAGE(PG8_SA(1, 0), a3, PG8_VA(seln, 0));
            PG8_BAR; PG8_WAIT_L(0); PG8_MMA(1, 0, At, B0); PG8_BAR; PG8_SCHED;
            PG8_STAGE(PG8_SB(1, 1), b3 + hstep, voffB);
            PG8_WAIT_V(6); PG8_BAR; PG8_MMA(1, 1, At, B1); PG8_BAR;
            }
        }
        if constexpr (ALIGN_EPI) { if (wr == 0) PG8_BAR; }
        E(acc, cur, wr, wc, fr, fq);
        if (!has_next) break;
#pragma unroll
        for (int a = 0; a < 2; ++a)
#pragma unroll
            for (int b = 0; b < 2; ++b)
#pragma unroll
                for (int m = 0; m < 4; ++m)
#pragma unroll
                    for (int n = 0; n < 2; ++n) acc[a][b][m][n] = (f32x4){0.f, 0.f, 0.f, 0.f};
        cur = nxt; cA = nA; cB = nB; ++ui;
        if constexpr (GATHER) { voffGc[0][0] = voffGn[0][0]; voffGc[0][1] = voffGn[0][1]; voffGc[1][0] = voffGn[1][0]; voffGc[1][1] = voffGn[1][1]; }
        if constexpr (ALIGN_EPI) { if (wr == 1) PG8_BAR; }
    }
    PG8_WAIT_V(0);
    if constexpr (!ALIGN_EPI) { if (wr == 0) PG8_BAR; }
    PG8_BAR;
#undef PG8_SA
#undef PG8_GOFF
#undef PG8_VA
#undef PG8_SB
#undef PG8_STAGE
#undef PG8_LDA
#undef PG8_LDB
#undef PG8_MMA
#undef PG8_WAIT_V
#undef PG8_WAIT_L
#undef PG8_BAR
#undef PG8_SCHED
}

struct EpiIn {
    static constexpr bool PERM = true; static constexpr int MID_T = -1;
    bf16* PR; bf16* PT; bf16* G; const float* bmerge;
    __device__ __forceinline__ void operator()(const f32x4 (&acc)[2][2][4][2], const Unit& u, int wr, int wc, int fr, int fq) const {
        const int row0 = u.pm * BM + wr * 64 + fr; const int pn = u.pn;
        bf16* base; int ldc, colt;
        if (pn < 7) { base = PR; ldc = RW_COLS; colt = pn * BM; } else if (pn < 16) { base = PT; ldc = AT_COLS; colt = (pn - 7) * BM; } else { base = G; ldc = G_COLS; colt = (pn - 16) * BM; }
        const bool gate = pn >= 16;
        const int col0 = colt + wc * 32 + 8 * fq;
        f32x4 bv[2][2];
#pragma unroll
        for (int bj = 0; bj < 2; ++bj)
#pragma unroll
            for (int n = 0; n < 2; ++n) bv[bj][n] = gate ? *(const f32x4*)(bmerge + col0 + bj * HALF + 4 * n) : (f32x4){0.f, 0.f, 0.f, 0.f};
#pragma unroll
        for (int ai = 0; ai < 2; ++ai)
#pragma unroll
            for (int m = 0; m < 4; ++m) { bf16* rowp = base + (size_t)(row0 + ai * HALF + m * 16) * ldc + col0;
#pragma unroll
                for (int bj = 0; bj < 2; ++bj) { f32x4 v0 = acc[ai][bj][m][0] + bv[bj][0], v1 = acc[ai][bj][m][1] + bv[bj][1];
                    if (gate) {
#pragma unroll
                        for (int j = 0; j < 4; ++j) { v0[j] = sigmoidf_(v0[j]); v1[j] = sigmoidf_(v1[j]); } }
                    v4u w; w.x = pk2(v0[0], v0[1]); w.y = pk2(v0[2], v0[3]); w.z = pk2(v1[0], v1[1]); w.w = pk2(v1[2], v1[3]);
                    *(v4u*)(rowp + bj * HALF) = w; } }
    }
};
struct EpiMix2 {
    static constexpr bool PERM = true; static constexpr int MID_T = 8;
    const bf16* G; bf16* Zout;
    __device__ __forceinline__ void mid(f32x4 (&acc)[2][2][4][2], const Unit& u, int wr, int wc, int fr, int fq) const {
        int row0 = u.pm * BM + wr * 64 + fr; LAUNDER(row0); const int col0 = u.pn * BM + wc * 32 + 8 * fq;
#pragma unroll
        for (int ai = 0; ai < 2; ++ai)
#pragma unroll
            for (int m = 0; m < 4; ++m) { const size_t r = (size_t)(row0 + ai * HALF + m * 16);
#pragma unroll
                for (int bj = 0; bj < 2; ++bj) { const int c = col0 + bj * HALF;
                    const v4u ga = *(const v4u*)(G + r * G_COLS + c), gb = *(const v4u*)(G + r * G_COLS + DM + c);
                    acc[ai][bj][m][0][0] *= bflo(ga.x) * __builtin_amdgcn_rcpf(bflo(gb.x)); acc[ai][bj][m][0][1] *= bfhi(ga.x) * __builtin_amdgcn_rcpf(bfhi(gb.x));
                    acc[ai][bj][m][0][2] *= bflo(ga.y) * __builtin_amdgcn_rcpf(bflo(gb.y)); acc[ai][bj][m][0][3] *= bfhi(ga.y) * __builtin_amdgcn_rcpf(bfhi(gb.y));
                    acc[ai][bj][m][1][0] *= bflo(ga.z) * __builtin_amdgcn_rcpf(bflo(gb.z)); acc[ai][bj][m][1][1] *= bfhi(ga.z) * __builtin_amdgcn_rcpf(bfhi(gb.z));
                    acc[ai][bj][m][1][2] *= bflo(ga.w) * __builtin_amdgcn_rcpf(bflo(gb.w)); acc[ai][bj][m][1][3] *= bfhi(ga.w) * __builtin_amdgcn_rcpf(bfhi(gb.w));
                    __builtin_amdgcn_sched_barrier(0); } }
    }
    __device__ __forceinline__ void operator()(const f32x4 (&acc)[2][2][4][2], const Unit& u, int wr, int wc, int fr, int fq) const {
        const int row0 = u.pm * BM + wr * 64 + fr, col0 = u.pn * BM + wc * 32 + 8 * fq;
#pragma unroll
        for (int ai = 0; ai < 2; ++ai)
#pragma unroll
            for (int m = 0; m < 4; ++m) { const size_t r = (size_t)(row0 + ai * HALF + m * 16);
#pragma unroll
                for (int bj = 0; bj < 2; ++bj) { const int c = col0 + bj * HALF;
                    const v4u gv = *(const v4u*)(G + r * G_COLS + DM + c);
                    const f32x4 v0 = acc[ai][bj][m][0], v1 = acc[ai][bj][m][1];
                    v4u w; w.x = pk2(v0[0] * bflo(gv.x), v0[1] * bfhi(gv.x)); w.y = pk2(v0[2] * bflo(gv.y), v0[3] * bfhi(gv.y));
                    w.z = pk2(v1[0] * bflo(gv.z), v1[1] * bfhi(gv.z)); w.w = pk2(v1[2] * bflo(gv.w), v1[3] * bfhi(gv.w));
                    *(v4u*)(Zout + r * DM + c) = w; } }
    }
};
struct EpiRes {
    static constexpr bool PERM = true; static constexpr int MID_T = -1;
    const float* X; bf16* O;
    __device__ __forceinline__ void operator()(const f32x4 (&acc)[2][2][4][2], const Unit& u, int wr, int wc, int fr, int fq) const {
        const int row0 = u.pm * BM + wr * 64 + fr, col0 = u.pn * BM + wc * 32 + 8 * fq;
#pragma unroll
        for (int ai = 0; ai < 2; ++ai)
#pragma unroll
            for (int m = 0; m < 4; ++m) { const size_t off = (size_t)(row0 + ai * HALF + m * 16) * DM + col0;
#pragma unroll
                for (int bj = 0; bj < 2; ++bj) { const f32x4 x0 = *(const f32x4*)(X + off + bj * HALF) + acc[ai][bj][m][0], x1 = *(const f32x4*)(X + off + bj * HALF + 4) + acc[ai][bj][m][1];
                    v4u w; w.x = pk2(x0[0], x0[1]); w.y = pk2(x0[2], x0[3]); w.z = pk2(x1[0], x1[1]); w.w = pk2(x1[2], x1[3]);
                    *(v4u*)(O + off + bj * HALF) = w; } }
    }
};
struct EpiSwiglu {
    static constexpr bool PERM = false; static constexpr int MID_T = -1;
    bf16* H; const float* lr; const LAS int* tab;
    __device__ __forceinline__ void operator()(const f32x4 (&acc)[2][2][4][2], const Unit& u, int wr, int wc, int fr, int fq) const {
        const int rl0 = wr * 64 + fr, row0 = u.pm * BM + rl0, col0 = u.pn * 128 + wc * 16 + 4 * fq, slot0 = (u.pm - tab[u.e]) * 256 + rl0, cnt = tab[33 + u.e];
#pragma unroll
        for (int ai = 0; ai < 2; ++ai)
#pragma unroll
            for (int m = 0; m < 4; ++m) { bf16* rowp = H + (size_t)(row0 + ai * HALF + m * 16) * DEXP + col0;
                const int slot = slot0 + ai * HALF + m * 16; const float rs = slot < cnt ? lr[(size_t)u.e * NTOK + slot] : 0.f;
#pragma unroll
                for (int bj = 0; bj < 2; ++bj) { const f32x4 gt = acc[ai][bj][m][0] * rs, up = acc[ai][bj][m][1] * rs; f32x4 o;
#pragma unroll
                    for (int j = 0; j < 4; ++j) o[j] = gt[j] * sigmoidf_(gt[j]) * up[j];
                    v2u w; w.x = pk2(o[0], o[1]); w.y = pk2(o[2], o[3]);
                    *(v2u*)(rowp + bj * 64) = w; } }
    }
};
struct EpiStoreY {
    static constexpr bool PERM = true; static constexpr int MID_T = -1;
    const int* ltok; const float* lw; const LAS int* tab; int* inv; bf16* Y;
    __device__ __forceinline__ void operator()(const f32x4 (&acc)[2][2][4][2], const Unit& u, int wr, int wc, int fr, int fq) const {
        const int rl0 = wr * 64 + fr, col0 = u.pn * BM + wc * 32 + 8 * fq, slot0 = (u.pm - tab[u.e]) * 256, cnt = tab[33 + u.e];
#pragma unroll
        for (int ai = 0; ai < 2; ++ai)
#pragma unroll
            for (int m = 0; m < 4; ++m) { const int rl = rl0 + ai * HALF + m * 16, slot = slot0 + rl, r = u.pm * BM + rl; const bool ok = slot < cnt;
                const int t2 = ok ? ltok[(size_t)u.e * NTOK + slot] : -1; const float w = ok ? lw[(size_t)u.e * NTOK + slot] : 0.f;
                if (ok && u.pn == 0 && wc == 0 && fq == 0) inv[t2] = r;
                bf16* rowp = Y + (size_t)r * DM + col0;
#pragma unroll
                for (int bj = 0; bj < 2; ++bj) { const f32x4 v0 = acc[ai][bj][m][0] * w, v1 = acc[ai][bj][m][1] * w;
                    v4u o; o.x = pk2(v0[0], v0[1]); o.y = pk2(v0[2], v0[3]); o.z = pk2(v1[0], v1[1]); o.w = pk2(v1[2], v1[3]);
                    *(v4u*)(rowp + bj * HALF) = o; } }
    }
};
}

#define XB_TMO      128
#define XB_XCNT(j)  (256  + 64 * (j))
#define XB_XSUB(j)  (1280 + 64 * (j))
#define XB_XGEN(j)  (2304 + 64 * (j))
#define XB_TOP      3328
#define XB_TOPGEN   3392
#define XCD_BAR_WORDS 3456
#define XB_SPIN_CAP (1u << 18)
__device__ __forceinline__ unsigned xb_ld(unsigned* p)              { return __hip_atomic_load(p, __ATOMIC_RELAXED, __HIP_MEMORY_SCOPE_AGENT); }
__device__ __forceinline__ unsigned xb_add(unsigned* p, unsigned v) { return __hip_atomic_fetch_add(p, v, __ATOMIC_RELAXED, __HIP_MEMORY_SCOPE_AGENT); }
__device__ __forceinline__ unsigned xb_xcc_id() { return (unsigned)__builtin_amdgcn_s_getreg((3 << 11) | 20) & 0xFu; }
#define XB_SPIN(cond, bar) do { unsigned _sp = 0; while (cond) { __builtin_amdgcn_s_sleep(1); \
    if ((++_sp & 255u) == 0u) { if (xb_ld(&(bar)[XB_TMO])) break; if (_sp > XB_SPIN_CAP) { atomicAdd(&(bar)[XB_TMO], 1u); break; } } } } while (0)
struct XcdBarrier { unsigned* bar; unsigned x; volatile LAS unsigned* st; };
__device__ __forceinline__ XcdBarrier xcd_barrier_post(unsigned* bar, volatile LAS unsigned* st) {
    XcdBarrier b; b.bar = bar; b.x = xb_xcc_id(); b.st = st;
    if (threadIdx.x == 0) (void)xb_add(&bar[XB_XCNT(b.x)], 1u);
    return b;
}
__device__ __forceinline__ void xcd_barrier_complete(unsigned* bar, unsigned x, unsigned& nloc, unsigned& nx) {
    const unsigned G = gridDim.x * gridDim.y * gridDim.z;
    unsigned sum, cnt, mine, sp = 0u;
    for (;;) {
        sum = 0u; cnt = 0u; mine = 0u;
#pragma unroll
        for (unsigned j = 0; j < 16; ++j) { const unsigned c = xb_ld(&bar[XB_XCNT(j)]); sum += c; cnt += (c > 0u) ? 1u : 0u; mine = (j == x) ? c : mine; }
        if (sum == G) break;
        __builtin_amdgcn_s_sleep(1);
        if ((++sp & 255u) == 0u) { if (xb_ld(&bar[XB_TMO])) break; if (sp > XB_SPIN_CAP) { atomicAdd(&bar[XB_TMO], 1u); break; } }
    }
    nloc = mine > 0u ? mine : 1u; nx = cnt > 0u ? cnt : 1u;
}
__device__ __forceinline__ void xcd_barrier(const XcdBarrier& b) {
    asm volatile("s_waitcnt vmcnt(0)" ::: "memory");
    __syncthreads();
    if (threadIdx.x == 0) {
        unsigned* bar = b.bar;
        __builtin_amdgcn_s_waitcnt(0);
        unsigned nloc = b.st[0], nx = b.st[1];
        if (nloc == 0u) { xcd_barrier_complete(bar, b.x, nloc, nx); b.st[0] = nloc; b.st[1] = nx; }
        const unsigned old = xb_add(&bar[XB_XSUB(b.x)], 1u);
        const unsigned gen = old / nloc;
        if (old + 1u == (gen + 1u) * nloc) {
            __builtin_amdgcn_fence(__ATOMIC_RELEASE, "agent");
            asm volatile("s_waitcnt vmcnt(0)" ::: "memory");
            const unsigned og = xb_add(&bar[XB_TOP], 1u);
            const unsigned tg = og / nx;
            if (og + 1u == (tg + 1u) * nx) xb_add(&bar[XB_TOPGEN], 1u);
            else XB_SPIN(xb_ld(&bar[XB_TOPGEN]) == tg, bar);
            __builtin_amdgcn_fence(__ATOMIC_ACQUIRE, "agent");
            xb_add(&bar[XB_XGEN(b.x)], 1u);
            asm volatile("s_waitcnt vmcnt(0)" ::: "memory");
        } else {
            XB_SPIN(xb_ld(&bar[XB_XGEN(b.x)]) == gen, bar);
            __builtin_amdgcn_fence(__ATOMIC_ACQUIRE, "agent");
            asm volatile("s_waitcnt vmcnt(0)" ::: "memory");
        }
    }
    __syncthreads();
}

struct Args { const void* in[30]; float* out; unsigned char* ws; int ph_lo, ph_hi, li, variant; };
struct Frame {
    LAS unsigned char* lds; volatile LAS unsigned* MISC;
    int tid, lane, wave, G, bid, variant;
    unsigned char* ws;
};
enum { I_X = 0, I_POS, I_N1G, I_WIN, I_MUP, I_MUN, I_WD0, I_WDUP, I_AG0, I_AGUP, I_GUP, I_KK, I_KA, I_RK, I_GNW, I_GNB, I_WROUT, I_QNG, I_KNG, I_WAOUT, I_BMERGE, I_WOUT,
       I_N2G, I_WRG, I_BRG, I_WRE, I_BRE, I_WGATE, I_WUP, I_WDOWN };

template <class RowMap>
DI void transpose_item(const float* W, int K, int N, bf16* WT, const RowMap& rm, LAS float* scr, int item, int lane, int ldk = 0, int koff = 0, const float* rs = nullptr) {
    if (ldk == 0) ldk = K;
    const int nblk = N / 32, kb = item / nblk, nb = item % nblk, k0 = 64 * kb, n0 = 32 * nb;
#pragma unroll
    for (int i = 0; i < 8; ++i) { const int kk = 8 * i + (lane >> 3);
        const f32x4 v = *(const GAS f32x4*)(W + (size_t)(k0 + kk) * N + n0 + 4 * (lane & 7));
        LAS float* d = scr + kk * 33 + 4 * (lane & 7); d[0] = v[0]; d[1] = v[1]; d[2] = v[2]; d[3] = v[3]; }
    LDS_WAIT(); asm volatile("" ::: "memory");
    const int c = lane & 7;
    f32x4 ra = (f32x4){1.f, 1.f, 1.f, 1.f}, rb = ra; if (rs) { ra = *(const f32x4*)(rs + k0 + 8 * c); rb = *(const f32x4*)(rs + k0 + 8 * c + 4); }
#pragma unroll
    for (int j = 0; j < 4; ++j) { const int n = (lane >> 3) + 8 * j; const LAS float* s = scr + (8 * c) * 33 + n;
        v4u o; o.x = pk2(s[0 * 33] * ra[0], s[1 * 33] * ra[1]); o.y = pk2(s[2 * 33] * ra[2], s[3 * 33] * ra[3]); o.z = pk2(s[4 * 33] * rb[0], s[5 * 33] * rb[1]); o.w = pk2(s[6 * 33] * rb[2], s[7 * 33] * rb[3]);
        *(GAS v4u*)(WT + (size_t)rm(n0 + n) * ldk + koff + k0 + 8 * c) = o; }
    LDS_WAIT(); asm volatile("" ::: "memory");
}
struct RmId { DI int operator()(int n) const { return n; } };
struct RmGate { DI int operator()(int n) const { return 32 * (n >> 4) + (n & 15); } };
struct RmUp { DI int operator()(int n) const { return 32 * (n >> 4) + 16 + (n & 15); } };

DI void p0_prologue(Frame& F, const Args& a) {
    LAS float* scr = (LAS float*)(F.lds + F.wave * 16384);
    const int gw = F.bid * NWAVES + F.wave, NGW = F.G * NWAVES;
    unsigned char* ws = F.ws;
    constexpr int I_IN = (DM / 64) * (IN_COLS / 32), I_R = (512 / 64) * (DM / 32), I_A = (256 / 64) * (DM / 32), I_O = (DM / 64) * (DM / 32), I_G = (128 / 64) * (512 / 32), I_L = 512 / 32;
    constexpr int NITEMS = I_IN + I_R + I_A + I_O + I_G + 4 * I_L;
    for (int it = gw; it < NITEMS; it += NGW) {
        int r = it;
        if (r < I_IN) { transpose_item((const float*)a.in[I_WIN], DM, IN_COLS, (bf16*)(ws + WS_WIN_T), RmId(), scr, r, F.lane); continue; } r -= I_IN;
        if (r < I_R) { transpose_item((const float*)a.in[I_WROUT], 512, DM, (bf16*)(ws + WS_WR_T), RmId(), scr, r, F.lane, YC_COLS, 0); continue; } r -= I_R;
        if (r < I_A) { transpose_item((const float*)a.in[I_WAOUT], 256, DM, (bf16*)(ws + WS_WR_T), RmId(), scr, r, F.lane, YC_COLS, 512); continue; } r -= I_A;
        if (r < I_O) { transpose_item((const float*)a.in[I_WOUT], DM, DM, (bf16*)(ws + WS_WOUT_T), RmId(), scr, r, F.lane); continue; } r -= I_O;
        if (r < I_G) { transpose_item((const float*)a.in[I_GUP], 128, 512, (bf16*)(ws + WS_GUP_T), RmId(), scr, r, F.lane); continue; } r -= I_G;
        { const int d = r / I_L, rr = r % I_L;
          if (d < 2) transpose_item((const float*)a.in[I_WDUP] + (size_t)d * 64 * 512, 64, 512, (bf16*)(ws + WS_WUP_T) + (size_t)d * 512 * 64, RmId(), scr, rr, F.lane);
          else transpose_item((const float*)a.in[I_AGUP] + (size_t)(d - 2) * 64 * 512, 64, 512, (bf16*)(ws + WS_AUP_T) + (size_t)(d - 2) * 512 * 64, RmId(), scr, rr, F.lane); }
    }
    { const float* g2 = (const float*)a.in[I_N2G]; const float* wre = (const float*)a.in[I_WRE]; const float* wrg = (const float*)a.in[I_WRG];
      bf16* hi = (bf16*)(ws + WS_RT_HI); bf16* lo = (bf16*)(ws + WS_RT_LO);
      for (int i = F.bid * 512 + F.tid; i < 64 * DM; i += F.G * 512) { const int n = i / DM, k = i % DM;
          float v = 0.f; if (n < 32) v = g2[k] * wre[k * 32 + n]; else if (n < 36) v = g2[k] * wrg[k * 4 + (n - 32)];
          const unsigned h = pk2(v, 0.f) & 0xffffu; const float hf = bflo(h); hi[i] = (bf16)h; lo[i] = (bf16)(pk2(v - hf, 0.f) & 0xffffu); } }
    { const float* x = (const float*)a.in[I_X]; const float* g1 = (const float*)a.in[I_N1G]; bf16* hb = (bf16*)(ws + WS_HB);
      f32x4 gv[4];
#pragma unroll
      for (int j = 0; j < 4; ++j) gv[j] = ((const f32x4*)g1)[F.lane + 64 * j];
      for (int m = gw; m < NTOK; m += NGW) {
          const GAS f32x4* xr = (const GAS f32x4*)(x + (size_t)m * DM) + F.lane; f32x4 v[4]; float s = 0.f;
#pragma unroll
          for (int j = 0; j < 4; ++j) { v[j] = xr[64 * j]; s += (v[j].x * v[j].x + v[j].y * v[j].y) + (v[j].z * v[j].z + v[j].w * v[j].w); }
          const float rstd = 1.f / sqrtf(wave_sum(s) * (1.f / DM) + NORM_EPS);
          GAS v2u* o8 = (GAS v2u*)(hb + (size_t)m * DM) + F.lane;
#pragma unroll
          for (int j = 0; j < 4; ++j) { v2u w; w.x = pk2(v[j].x * rstd * gv[j].x, v[j].y * rstd * gv[j].y); w.y = pk2(v[j].z * rstd * gv[j].z, v[j].w * rstd * gv[j].w); o8[64 * j] = w; } } }
}

DI void p1b_qkprep(Frame& F, const Args& a) {
    bf16* PT = (bf16*)(F.ws + WS_PT);
    const int* pos = (const int*)a.in[I_POS];
    const int sub = F.lane & 7;
    const f32x4 qg0 = ((const f32x4*)a.in[I_QNG])[2 * sub], qg1 = ((const f32x4*)a.in[I_QNG])[2 * sub + 1];
    const f32x4 kg0 = ((const f32x4*)a.in[I_KNG])[2 * sub], kg1 = ((const f32x4*)a.in[I_KNG])[2 * sub + 1];
    constexpr float IF2PI[8] = {0.15915494309189535f, 0.03086376340470123f, 0.005985185712713705f, 0.001160663641240061f, 0.00022507907903927653f, 4.364795279280289e-05f, 8.464330808241401e-06f, 1.6414262627950345e-06f};
    const int nvec = NTOK * 24, stride = (F.G * 512) >> 3;
    for (int vid0 = (F.bid * 512 + F.tid) >> 3; vid0 < nvec; vid0 += 4 * stride) {
        v4u raw[4]; int pv[4];
#pragma unroll
        for (int u = 0; u < 4; ++u) { const int vid = vid0 + u * stride; if (vid < nvec) { const int tok = vid / 24, v = vid % 24; const bool isq = v < 12; const int head = isq ? v : v - 12;
            raw[u] = *(const v4u*)(PT + (size_t)tok * AT_COLS + (isq ? 0 : 768) + head * 64 + sub * 8); pv[u] = pos[tok]; } else { raw[u] = (v4u){0u, 0u, 0u, 0u}; pv[u] = 0; } }
#pragma unroll
        for (int u = 0; u < 4; ++u) { const int vid = vid0 + u * stride; const bool act = vid < nvec; const int vv = act ? vid : 0;
            const int tok = vv / 24, v = vv % 24; const bool isq = v < 12; const int head = isq ? v : v - 12;
            bf16* p = PT + (size_t)tok * AT_COLS + (isq ? 0 : 768) + head * 64 + sub * 8;
            float y[8] = {bflo(raw[u].x), bfhi(raw[u].x), bflo(raw[u].y), bfhi(raw[u].y), bflo(raw[u].z), bfhi(raw[u].z), bflo(raw[u].w), bfhi(raw[u].w)};
            float ss = 0.f;
#pragma unroll
            for (int j = 0; j < 8; ++j) ss += y[j] * y[j];
            ss += __shfl_xor(ss, 1); ss += __shfl_xor(ss, 2); ss += __shfl_xor(ss, 4);
            const float rstd = 1.f / sqrtf(ss * (1.f / 64.f) + NORM_EPS);
            const f32x4 g0 = isq ? qg0 : kg0, g1 = isq ? qg1 : kg1;
#pragma unroll
            for (int j = 0; j < 4; ++j) { y[j] = y[j] * rstd * g0[j]; y[4 + j] = y[4 + j] * rstd * g1[j]; }
            const float pf = (float)pv[u];
#pragma unroll
            for (int j = 0; j < 8; ++j) {
                const float partner = __shfl_xor(y[j], 1);
                float r = pf * IF2PI[j]; r = r - floorf(r);
                const float sn = __builtin_amdgcn_sinf(r), cs = __builtin_amdgcn_cosf(r);
                const float rot = y[j] * cs + (sub == 0 ? -partner : partner) * sn;
                if (sub < 2) y[j] = rot;
            }
            if (isq) {
#pragma unroll
                for (int j = 0; j < 8; ++j) y[j] *= 0.18033688011112042f;
            }
            v4u o; o.x = pk2(y[0], y[1]); o.y = pk2(y[2], y[3]); o.z = pk2(y[4], y[5]); o.w = pk2(y[6], y[7]);
            if (act && !VAR(64)) *(v4u*)p = o; }
    }
}

DI void p1c_preshift(Frame& F, const Args& a) {
    if (F.tid >= 448) return;
    const bf16* PR = (const bf16*)(F.ws + WS_PR); bf16* PS = (bf16*)a.out;
    const int rsub = F.tid / 224, cg8 = (F.tid % 224) * 8;
    const float* mup = (const float*)a.in[I_MUP] + cg8; const float* mun = (const float*)a.in[I_MUN] + cg8;
    const f32x4 mp0 = *(const f32x4*)mup, mp1 = *(const f32x4*)(mup + 4), mn0 = *(const f32x4*)mun, mn1 = *(const f32x4*)(mun + 4);
    const int mode = (cg8 >= 1536 && cg8 < 1600) ? 1 : (cg8 >= 1664 ? 2 : 0);
    const int rows_per = NTOK / F.G;
    for (int r0 = F.bid * rows_per + rsub; r0 < (F.bid + 1) * rows_per; r0 += 8) {
        v4u cur[4], prv[4], nxt[4];
#pragma unroll
        for (int u = 0; u < 4; ++u) { const int row = r0 + 2 * u, t = row % SEQ; const bf16* p = PR + (size_t)row * RW_COLS + cg8;
            cur[u] = *(const v4u*)p; prv[u] = *(const v4u*)(p - (t > 0 ? RW_COLS : 0)); nxt[u] = *(const v4u*)(p + (t < SEQ - 1 ? RW_COLS : 0)); }
#pragma unroll
        for (int u = 0; u < 4; ++u) { const int row = r0 + 2 * u, t = row % SEQ; const float fp = t > 0 ? 1.f : 0.f, fn = t < SEQ - 1 ? 1.f : 0.f;
            const unsigned cw[4] = {cur[u].x, cur[u].y, cur[u].z, cur[u].w}, pw[4] = {prv[u].x, prv[u].y, prv[u].z, prv[u].w}, nw[4] = {nxt[u].x, nxt[u].y, nxt[u].z, nxt[u].w};
            float y[8];
#pragma unroll
            for (int j = 0; j < 4; ++j) {
                const float c0 = bflo(cw[j]), c1 = bfhi(cw[j]), p0 = bflo(pw[j]) * fp, p1 = bfhi(pw[j]) * fp, n0 = bflo(nw[j]) * fn, n1 = bfhi(nw[j]) * fn;
                const float m0 = j < 2 ? mp0[2 * j] : mp1[2 * j - 4], m1 = j < 2 ? mp0[2 * j + 1] : mp1[2 * j - 3], q0 = j < 2 ? mn0[2 * j] : mn1[2 * j - 4], q1 = j < 2 ? mn0[2 * j + 1] : mn1[2 * j - 3];
                y[2 * j] = c0 + m0 * (p0 - c0) + q0 * (n0 - c0); y[2 * j + 1] = c1 + m1 * (p1 - c1) + q1 * (n1 - c1); }
            if (mode == 1) {
#pragma unroll
                for (int j = 0; j < 8; ++j) y[j] = 1.f - 2.f * __builtin_amdgcn_rcpf(1.f + __builtin_amdgcn_exp2f(2.88539008f * y[j])); }
            if (mode == 2) {
#pragma unroll
                for (int j = 0; j < 8; ++j) y[j] = sigmoidf_(y[j]); }
            v4u o; o.x = pk2(y[0], y[1]); o.y = pk2(y[2], y[3]); o.z = pk2(y[4], y[5]); o.w = pk2(y[6], y[7]);
            if (!VAR(64)) *(v4u*)(PS + (size_t)row * RW_COLS + cg8) = o; }
    }
}

DI bf16x8 pack8(float a0, float a1, float a2, float a3, float a4, float a5, float a6, float a7) {
    v4u p; p.x = pk2(a0, a1); p.y = pk2(a2, a3); p.z = pk2(a4, a5); p.w = pk2(a6, a7); return __builtin_bit_cast(bf16x8, p);
}
DI void attn_unit(Frame& F, int b, int hh, int span) {
    const bf16* PT = (const bf16*)(F.ws + WS_PT); bf16* Og = (bf16*)(F.ws + WS_OG); float* Lse = (float*)(F.ws + WS_LSE); bf16* YA = (bf16*)(F.ws + WS_YA);
    LAS unsigned char* vbuf = F.lds + F.wave * 9216;
    const int lane = F.lane, n = lane & 31, half = lane >> 5;
    const int T0 = span * 512; const size_t rowbase = (size_t)b * SEQ;
    for (int su = F.wave; su < 48; su += 8) {
        const int g = su >> 4, s16 = su & 15, dsh = 2 * g, L = SEQ >> dsh, per_r = 16 >> dsh;
        const int r = s16 / per_r, sb = s16 % per_r, l0 = (T0 >> dsh) + sb * 32, head = 4 * g + hh;
        const int tq = ((l0 + n) << dsh) + r;
        const bf16* qp = PT + (rowbase + tq) * AT_COLS + head * 64 + 8 * half;
        bf16x8 qf[4];
#pragma unroll
        for (int kk = 0; kk < 4; ++kk) qf[kk] = *(const bf16x8*)(qp + 16 * kk);
        f32x16 o0, o1;
#pragma unroll
        for (int i = 0; i < 16; ++i) { o0[i] = 0.f; o1[i] = 0.f; }
        float mrun = -1e30f, lrun = 0.f;
        const int kb_lo = l0 >= 64 ? 0 : (64 - l0) >> 5, kb_hi = min(4, (L + 32 - l0) >> 5);
        bf16x8 kfn[4]; v4u vvn[4];
#define ATT_PRELOAD(kbx) do { const int lk0_ = l0 - 64 + 32 * (kbx); \
            _Pragma("unroll") for (int j = 0; j < 4; ++j) { const int idx = lane + 64 * j, key = idx >> 3, ch = idx & 7; const int tk_ = ((lk0_ + key) << dsh) + r; \
                vvn[j] = *(const v4u*)(PT + (rowbase + tk_) * AT_COLS + 1536 + head * 64 + ch * 8); } \
            const int tk2_ = ((lk0_ + n) << dsh) + r; const bf16* kp_ = PT + (rowbase + tk2_) * AT_COLS + 768 + head * 64 + 8 * half; \
            _Pragma("unroll") for (int kk = 0; kk < 4; ++kk) kfn[kk] = *(const bf16x8*)(kp_ + 16 * kk); } while (0)
        ATT_PRELOAD(kb_lo);
        for (int kb = kb_lo; kb <= kb_hi; ++kb) {
            LAS unsigned char* vb = vbuf + (kb & 1) * 4608;
            bf16x8 kf[4];
#pragma unroll
            for (int j = 0; j < 4; ++j) { const int idx = lane + 64 * j, key = idx >> 3, ch = idx & 7; *(LAS v4u*)(vb + key * 144 + ch * 16) = vvn[j]; kf[j] = kfn[j]; }
            if (kb < kb_hi) ATT_PRELOAD(kb + 1);
            f32x16 s;
#pragma unroll
            for (int i = 0; i < 16; ++i) s[i] = 0.f;
#pragma unroll
            for (int kk = 0; kk < 4; ++kk) s = MFMA32(kf[kk], qf[kk], s);
            if (kb == 0) {
#pragma unroll
                for (int i = 0; i < 16; ++i) if (crow(i, half) < n) s[i] = -1e30f; }
            if (kb == 4) {
#pragma unroll
                for (int i = 0; i < 16; ++i) if (crow(i, half) > n) s[i] = -1e30f; }
            float mx = s[0];
#pragma unroll
            for (int i = 1; i < 16; ++i) mx = fmaxf(mx, s[i]);
            mx = fmaxf(mx, __shfl_xor(mx, 32));
            const float mnew = fmaxf(mrun, mx), alpha = __builtin_amdgcn_exp2f(mrun - mnew); mrun = mnew;
            float ps = 0.f;
#pragma unroll
            for (int i = 0; i < 16; ++i) { s[i] = __builtin_amdgcn_exp2f(s[i] - mnew); ps += s[i]; }
            lrun = lrun * alpha + ps;
#pragma unroll
            for (int i = 0; i < 16; ++i) { o0[i] *= alpha; o1[i] *= alpha; }
            const bf16x8 pf0 = pack8(s[0], s[1], s[2], s[3], s[4], s[5], s[6], s[7]), pf1 = pack8(s[8], s[9], s[10], s[11], s[12], s[13], s[14], s[15]);
#pragma unroll
            for (int g2 = 0; g2 < 2; ++g2) {
                bf16x8 vf0, vf1;
#pragma unroll
                for (int si = 0; si < 8; ++si) { const int key = 16 * g2 + (si & 3) + 8 * (si >> 2) + 4 * half;
                    vf0[si] = *(const LAS short*)(vb + key * 144 + n * 2); vf1[si] = *(const LAS short*)(vb + key * 144 + (n + 32) * 2); }
                o0 = MFMA32(vf0, g2 ? pf1 : pf0, o0); o1 = MFMA32(vf1, g2 ? pf1 : pf0, o1);
            }
        }
#undef ATT_PRELOAD
        const float ltot = lrun + __shfl_xor(lrun, 32), inv = 1.f / ltot;
        bf16* op = Og + ((size_t)g * NTOK + rowbase + tq) * 256 + hh * 64;
#pragma unroll
        for (int q4 = 0; q4 < 4; ++q4) { const int d0 = 8 * q4 + 4 * half;
            v2u w0; w0.x = pk2(o0[4 * q4] * inv, o0[4 * q4 + 1] * inv); w0.y = pk2(o0[4 * q4 + 2] * inv, o0[4 * q4 + 3] * inv); *(v2u*)(op + d0) = w0;
            v2u w1; w1.x = pk2(o1[4 * q4] * inv, o1[4 * q4 + 1] * inv); w1.y = pk2(o1[4 * q4 + 2] * inv, o1[4 * q4 + 3] * inv); *(v2u*)(op + 32 + d0) = w1; }
        if (half == 0) Lse[((size_t)g * NTOK + rowbase + tq) * 4 + hh] = mrun + __builtin_amdgcn_logf(ltot);
    }
    VM_WAIT(); __syncthreads();
    __builtin_amdgcn_fence(__ATOMIC_ACQUIRE, "agent"); VM_WAIT();
    {
        const size_t tok = rowbase + T0 + F.tid;
        const float l0 = Lse[(0 * (size_t)NTOK + tok) * 4 + hh], l1 = Lse[(1 * (size_t)NTOK + tok) * 4 + hh], l2 = Lse[(2 * (size_t)NTOK + tok) * 4 + hh];
        const float mx = fmaxf(l0, fmaxf(l1, l2));
        float a0 = __builtin_amdgcn_exp2f(l0 - mx), a1 = __builtin_amdgcn_exp2f(l1 - mx), a2 = __builtin_amdgcn_exp2f(l2 - mx);
        const float inv = 1.f / (a0 + a1 + a2); a0 *= inv; a1 *= inv; a2 *= inv;
        const bf16* p0 = Og + (0 * (size_t)NTOK + tok) * 256 + hh * 64; const bf16* p1 = Og + (1 * (size_t)NTOK + tok) * 256 + hh * 64; const bf16* p2 = Og + (2 * (size_t)NTOK + tok) * 256 + hh * 64;
        bf16* yo = YA + tok * 256 + hh * 64;
#pragma unroll
        for (int c = 0; c < 8; ++c) { const v4u x0 = *(const v4u*)(p0 + 8 * c), x1 = *(const v4u*)(p1 + 8 * c), x2 = *(const v4u*)(p2 + 8 * c); v4u o;
            o.x = pk2(a0 * bflo(x0.x) + a1 * bflo(x1.x) + a2 * bflo(x2.x), a0 * bfhi(x0.x) + a1 * bfhi(x1.x) + a2 * bfhi(x2.x));
            o.y = pk2(a0 * bflo(x0.y) + a1 * bflo(x1.y) + a2 * bflo(x2.y), a0 * bfhi(x0.y) + a1 * bfhi(x1.y) + a2 * bfhi(x2.y));
            o.z = pk2(a0 * bflo(x0.z) + a1 * bflo(x1.z) + a2 * bflo(x2.z), a0 * bfhi(x0.z) + a1 * bfhi(x1.z) + a2 * bfhi(x2.z));
            o.w = pk2(a0 * bflo(x0.w) + a1 * bflo(x1.w) + a2 * bflo(x2.w), a0 * bfhi(x0.w) + a1 * bfhi(x1.w) + a2 * bfhi(x2.w));
            *(v4u*)(yo + 8 * c) = o; }
    }
    __syncthreads();
}

DI f32x4 ld4bf(const bf16* p) { const v2u u = *(const v2u*)p; return (f32x4){bflo(u.x), bfhi(u.x), bflo(u.y), bfhi(u.y)}; }
DI f32x4 shift4(const bf16* prow, bool hasp, bool hasn, const float* mup, const float* mun, int col) {
    const f32x4 u = ld4bf(prow + col);
    const float mp = hasp ? 1.f : 0.f, mn = hasn ? 1.f : 0.f;
    const f32x4 up = ld4bf(prow + (hasp ? -RW_COLS : 0) + col) * mp, un = ld4bf(prow + (hasn ? RW_COLS : 0) + col) * mn;
    return u + *(const f32x4*)(mup + col) * (up - u) + *(const f32x4*)(mun + col) * (un - u);
}
DI float red8(float v) {
    v += __builtin_bit_cast(float, __builtin_amdgcn_update_dpp(0, __builtin_bit_cast(int, v), 0xB1, 0xF, 0xF, true));
    v += __builtin_bit_cast(float, __builtin_amdgcn_update_dpp(0, __builtin_bit_cast(int, v), 0x4E, 0xF, 0xF, true));
    v += __builtin_bit_cast(float, __builtin_amdgcn_update_dpp(0, __builtin_bit_cast(int, v), 0x141, 0xF, 0xF, true));
    return v;
}
constexpr int SC_CH = 32, SC_NCH = SEQ / SC_CH;
constexpr int FP = 68, ARR_SZ = 32 * 144, ARRBUF_SZ = 5 * ARR_SZ + 32 * FP * 4;
#define SC_ARR(ab, arr) (F.lds + (ab) * ARRBUF_SZ + (arr) * ARR_SZ)
#define SC_E2(ab) ((LAS float*)(F.lds + (ab) * ARRBUF_SZ + 5 * ARR_SZ))
constexpr int SCL_CONST = 2 * ARRBUF_SZ, SCL_IMG = 65536, SCL_IMGSZ = 35072, SCL_MABT = SCL_IMG + 2 * SCL_IMGSZ;
constexpr int IM_AT = 0, IM_RT = 4608, IM_BT = 9216, IM_KT = 14336, IM_VT = 19456, IM_MAK = 24576, IM_NB = 27136, IM_NK = 29696, IM_T = 32256, IM_GC = 34816;
constexpr int P144 = 144, P80 = 80;
#define SC_IMG(ib) (F.lds + SCL_IMG + (ib) * SCL_IMGSZ)
#define SC_CONST ((LAS float*)(F.lds + SCL_CONST))
DI f32x4 up4(v2u u) { return (f32x4){bflo(u.x), bfhi(u.x), bflo(u.y), bfhi(u.y)}; }
template <int KIND> struct PrepRaw { bf16x8 xf[4]; v2u ga[4], gb[4], gc[4]; };
template <int KIND>
DI void prep_load(Frame& F, const bf16* PS, int b, int h, int dir, int c, PrepRaw<KIND>& R) {
    const int q = F.wave - 4, jt = q & 1, lane = F.lane, n = lane & 31, half = lane >> 5;
    const int tl = SC_CH * c + n, t = dir ? (SEQ - 1 - tl) : tl, hc = h * 64;
    const bf16* pr = PS + ((size_t)b * SEQ + t) * RW_COLS;
#pragma unroll
    for (int kk = 0; kk < 4; ++kk) R.xf[kk] = *(const bf16x8*)(pr + (KIND ? 1600 : 1536) + 16 * kk + 8 * half);
#pragma unroll
    for (int q4 = 0; q4 < 4; ++q4) { const int j = 32 * jt + 8 * q4 + 4 * half, jo = 32 * (1 - jt) + 8 * q4 + 4 * half;
        R.ga[q4] = *(const v2u*)(pr + (KIND ? 512 : 0) + hc + j);
        R.gb[q4] = *(const v2u*)(pr + (KIND ? 512 + hc + jo : 1024 + hc + j));
        if (KIND) R.gc[q4] = *(const v2u*)(pr + hc + j); }
}
template <int KIND>
DI void prep_compute(Frame& F, int b, int h, int dir, int c, const PrepRaw<KIND>& R, const bf16x8 (&af)[4]) {
    const int q = F.wave - 4, jt = q & 1, lane = F.lane, n = lane & 31, half = lane >> 5, ab = c & 1;
    const LAS float* cm = SC_CONST;
    f32x16 D;
#pragma unroll
    for (int i = 0; i < 16; ++i) D[i] = 0.f;
    if (KIND == 0) {
#pragma unroll
        for (int kk = 0; kk < 4; ++kk) D = MFMA32(R.xf[kk], af[kk], D);
        const int j = 32 * jt + n; const float w0j = cm[j];
        float e2[16];
#pragma unroll
        for (int i = 0; i < 16; ++i) e2[i] = 0.8750387749f * sigmoidf_(D[i] + w0j);
        float gs[4], ps[4];
#pragma unroll
        for (int g = 0; g < 4; ++g) { gs[g] = (e2[4 * g] + e2[4 * g + 1]) + (e2[4 * g + 2] + e2[4 * g + 3]); ps[g] = __shfl_xor(gs[g], 32); }
        float off = 0.f;
        LAS float* Eb = SC_E2(ab) + j;
#pragma unroll
        for (int g = 0; g < 4; ++g) {
            float run = off + (half ? ps[g] : 0.f);
#pragma unroll
            for (int ii = 0; ii < 4; ++ii) { const int i = 4 * g + ii, tau = 8 * g + 4 * half + ii; run += e2[i]; Eb[tau * FP] = run; }
            off += gs[g] + ps[g];
        }
#pragma unroll
        for (int q4 = 0; q4 < 4; ++q4) { const int jj = 32 * jt + 8 * q4 + 4 * half;
            *(LAS v2u*)(SC_ARR(ab, 3) + n * P144 + jj * 2) = R.ga[q4];
            *(LAS v2u*)(SC_ARR(ab, 4) + n * P144 + jj * 2) = R.gb[q4]; }
    } else {
#pragma unroll
        for (int kk = 0; kk < 4; ++kk) D = MFMA32(af[kk], R.xf[kk], D);
        float ss = 0.f;
#pragma unroll
        for (int q4 = 0; q4 < 4; ++q4) { const int j = 32 * jt + 8 * q4 + 4 * half, jo = 32 * (1 - jt) + 8 * q4 + 4 * half;
            const f32x4 kr = up4(R.ga[q4]) * *(const LAS f32x4*)(cm + 128 + j), ko = up4(R.gb[q4]) * *(const LAS f32x4*)(cm + 128 + jo);
            ss += (kr[0] * kr[0] + kr[1] * kr[1]) + (kr[2] * kr[2] + kr[3] * kr[3]) + (ko[0] * ko[0] + ko[1] * ko[1]) + (ko[2] * ko[2] + ko[3] * ko[3]); }
        ss += __shfl_xor(ss, 32);
        const float inv = __builtin_amdgcn_rcpf(fmaxf(__builtin_amdgcn_sqrtf(ss), 1e-12f));
        float bs = 0.f;
#pragma unroll
        for (int q4 = 0; q4 < 4; ++q4) { const int j = 32 * jt + 8 * q4 + 4 * half;
            const f32x4 az = *(const LAS f32x4*)(cm + 64 + j), kkv = *(const LAS f32x4*)(cm + 128 + j), kav = *(const LAS f32x4*)(cm + 192 + j), rkv = *(const LAS f32x4*)(cm + 256 + j);
            const f32x4 kpr = up4(R.ga[q4]), rr = up4(R.gc[q4]);
            f32x4 av, kk4, kd4;
#pragma unroll
            for (int jj = 0; jj < 4; ++jj) { av[jj] = sigmoidf_(D[4 * q4 + jj] + az[jj]); kk4[jj] = kpr[jj] * kkv[jj] * inv; kd4[jj] = kpr[jj] * (1.f + (av[jj] - 1.f) * kav[jj]); bs += rr[jj] * kd4[jj] * rkv[jj]; }
            v2u w; w.x = pk2(kd4[0], kd4[1]); w.y = pk2(kd4[2], kd4[3]); *(LAS v2u*)(SC_ARR(ab, 0) + n * P144 + j * 2) = w;
            w.x = pk2(kk4[0] * av[0], kk4[1] * av[1]); w.y = pk2(kk4[2] * av[2], kk4[3] * av[3]); *(LAS v2u*)(SC_ARR(ab, 1) + n * P144 + j * 2) = w;
            w.x = pk2(-kk4[0], -kk4[1]); w.y = pk2(-kk4[2], -kk4[3]); *(LAS v2u*)(SC_ARR(ab, 2) + n * P144 + j * 2) = w; }
        bs += __shfl_xor(bs, 32);
        const int tl = SC_CH * c + n, t = dir ? (SEQ - 1 - tl) : tl;
        if (half == 0 && !VAR(255)) ((float*)(F.ws + WS_BSUM))[(((size_t)dir * NTOK + (size_t)b * SEQ + t) * 8 + h) * 2 + jt] = bs;
    }
}
DI void scan_consts(Frame& F, const Args& a, int h, int dir) {
    LAS float* cm = SC_CONST; const int i = F.tid - 256, hc = h * 64;
    if (i < 64) { cm[i] = ((const float*)a.in[I_WD0])[dir * 512 + hc + i]; cm[64 + i] = ((const float*)a.in[I_AG0])[dir * 512 + hc + i];
        cm[128 + i] = ((const float*)a.in[I_KK])[hc + i]; cm[192 + i] = ((const float*)a.in[I_KA])[hc + i]; cm[256 + i] = ((const float*)a.in[I_RK])[hc + i]; }
}
#define SC_BARRIER() do { asm volatile("s_waitcnt lgkmcnt(0)" ::: "memory"); __builtin_amdgcn_s_barrier(); asm volatile("" ::: "memory"); } while (0)
DI bf16x8 ld_perm(const LAS unsigned char* row, int ks, int half) {
    const v2u a0 = *(const LAS v2u*)(row + (16 * ks + 4 * half) * 2), a1 = *(const LAS v2u*)(row + (16 * ks + 8 + 4 * half) * 2);
    const v4u r = {a0.x, a0.y, a1.x, a1.y}; return __builtin_bit_cast(bf16x8, r);
}
DI bf16x8 packacc(const f32x16& x, int ks) { return ks ? pack8(x[8], x[9], x[10], x[11], x[12], x[13], x[14], x[15]) : pack8(x[0], x[1], x[2], x[3], x[4], x[5], x[6], x[7]); }
DI bf16x8 frag_scaled(const LAS unsigned char* arow, const LAS float* erow, int kk, float sgn, bool ezero) {
    const v4u xr = *(const LAS v4u*)(arow + 32 * kk);
    f32x4 e0 = *(const LAS f32x4*)(erow + 16 * kk), e1 = *(const LAS f32x4*)(erow + 16 * kk + 4);
    if (ezero) { e0 = (f32x4){0.f, 0.f, 0.f, 0.f}; e1 = e0; }
    const float x[8] = {bflo(xr.x), bfhi(xr.x), bflo(xr.y), bfhi(xr.y), bflo(xr.z), bfhi(xr.z), bflo(xr.w), bfhi(xr.w)};
    float y[8];
#pragma unroll
    for (int j = 0; j < 4; ++j) { y[j] = x[j] * __builtin_amdgcn_exp2f(sgn * e0[j]); y[4 + j] = x[4 + j] * __builtin_amdgcn_exp2f(sgn * e1[j]); }
    return pack8(y[0], y[1], y[2], y[3], y[4], y[5], y[6], y[7]);
}
template <bool LO>
DI void scan_build(Frame& F, int p, int bw) {
    int lane = F.lane; LAUNDER(lane); const int n = lane & 31, half = lane >> 5, ab = p & 1;
    LAS unsigned char* img = SC_IMG(p & 1);
    const LAS float* E = SC_E2(ab) + n * FP + 8 * half;
    const LAS float* Eex = SC_E2(ab) + (n > 0 ? n - 1 : 0) * FP + 8 * half;
    const LAS unsigned char* KDr = SC_ARR(ab, 0) + n * P144 + 16 * half; const LAS unsigned char* BBr = SC_ARR(ab, 1) + n * P144 + 16 * half;
    const LAS unsigned char* AAr = SC_ARR(ab, 2) + n * P144 + 16 * half; const LAS unsigned char* Rr = SC_ARR(ab, 3) + n * P144 + 16 * half;
    if (LO && bw == 2) {
        if (VAR(16)) return;
        f32x16 z, pacc;
#pragma unroll
        for (int i = 0; i < 16; ++i) z[i] = 0.f;
#pragma unroll
        for (int kk = 0; kk < 4; ++kk) z = MFMA32(frag_scaled(BBr, E, kk, 1.f, false), frag_scaled(AAr, Eex, kk, -1.f, n == 0), z);
#pragma unroll
        for (int i = 0; i < 16; ++i) { const int srow = crow(i, half); z[i] = (srow < n) ? z[i] : 0.f; }
        LAS unsigned char* zi = F.lds + SCL_MABT;
#pragma unroll
        for (int k = 0; k < 4; ++k) {
            LAS unsigned char* zk = zi + k * (32 * P80);
#pragma unroll
            for (int i = 0; i < 16; ++i) *(LAS unsigned short*)(zk + crow(i, half) * P80 + n * 2) = (unsigned short)(pk2(z[i], 0.f) & 0xffffu);
            LDS_WAIT(); asm volatile("" ::: "memory");
            const bf16x8 zb0 = packacc(z, 0), zb1 = packacc(z, 1);
            f32x16 zn;
#pragma unroll
            for (int i = 0; i < 16; ++i) zn[i] = 0.f;
            zn = MFMA32(ld_perm(zk + n * P80, 0, half), zb0, zn); zn = MFMA32(ld_perm(zk + n * P80, 1, half), zb1, zn);
            z = zn;
        }
#pragma unroll
        for (int i = 0; i < 16; ++i) pacc[i] = z[i] + ((crow(i, half) == n) ? 1.f : 0.f);
#pragma unroll
        for (int k = 3; k >= 0; --k) {
            const LAS unsigned char* zk = zi + k * (32 * P80);
            const bf16x8 qb0 = packacc(pacc, 0), qb1 = packacc(pacc, 1);
            pacc = MFMA32(ld_perm(zk + n * P80, 0, half), qb0, pacc); pacc = MFMA32(ld_perm(zk + n * P80, 1, half), qb1, pacc);
        }
#pragma unroll
        for (int g = 0; g < 4; ++g) { v2u w; w.x = pk2(pacc[4 * g], pacc[4 * g + 1]); w.y = pk2(pacc[4 * g + 2], pacc[4 * g + 3]); *(LAS v2u*)(img + IM_T + n * P80 + (8 * g + 4 * half) * 2) = w; }
    } else if (LO && bw == 3) {
        if (VAR(32)) return;
#pragma unroll
        for (int kk = 0; kk < 4; ++kk) { const bf16x8 f = frag_scaled(BBr, E, kk, 1.f, false);
            const v4u vr = *(const LAS v4u*)(SC_ARR(ab, 4) + n * P144 + 16 * half + 32 * kk); const bf16x8 vf = __builtin_bit_cast(bf16x8, vr);
#pragma unroll
            for (int e = 0; e < 8; ++e) { *(LAS unsigned short*)(img + IM_BT + (16 * kk + 8 * half + e) * P80 + n * 2) = (unsigned short)f[e];
                *(LAS unsigned short*)(img + IM_VT + (16 * kk + 8 * half + e) * P80 + n * 2) = (unsigned short)vf[e]; } }
        ((LAS float*)(img + IM_GC))[lane] = __builtin_amdgcn_exp2f(-(SC_E2(ab)[31 * FP + lane]));
    } else if (!LO && bw <= 6) {
        if (VAR(32)) return;
        bf16x8 fa[4], fb[4];
        if (bw == 4 || bw == 5) {
#pragma unroll
            for (int kk = 0; kk < 4; ++kk) { fb[kk] = frag_scaled(bw == 4 ? AAr : Rr, bw == 4 ? Eex : E, kk, -1.f, bw == 4 && n == 0);
                *(LAS bf16x8*)(img + (bw == 4 ? IM_AT : IM_RT) + n * P144 + (16 * kk + 8 * half) * 2) = fb[kk]; }
#pragma unroll
            for (int kk = 0; kk < 4; ++kk) fa[kk] = frag_scaled(bw == 4 ? KDr : BBr, E, kk, 1.f, false);
        } else {
#pragma unroll
            for (int kk = 0; kk < 4; ++kk) { fa[kk] = frag_scaled(KDr, E, kk, 1.f, false);
#pragma unroll
                for (int e = 0; e < 8; ++e) *(LAS unsigned short*)(img + IM_KT + (16 * kk + 8 * half + e) * P80 + n * 2) = (unsigned short)fa[kk][e]; }
#pragma unroll
            for (int kk = 0; kk < 4; ++kk) fb[kk] = frag_scaled(Rr, E, kk, -1.f, false);
        }
        f32x16 x;
#pragma unroll
        for (int i = 0; i < 16; ++i) x[i] = 0.f;
#pragma unroll
        for (int kk = 0; kk < 4; ++kk) x = MFMA32(fa[kk], fb[kk], x);
        LAS unsigned char* gi = img + (bw == 4 ? IM_MAK : (bw == 5 ? IM_NB : IM_NK));
#pragma unroll
        for (int g = 0; g < 4; ++g) { float m_[4];
#pragma unroll
            for (int e = 0; e < 4; ++e) { const int srow = 8 * g + 4 * half + e; m_[e] = ((bw == 4) ? srow < n : srow <= n) ? x[4 * g + e] : 0.f; }
            v2u w_; w_.x = pk2(m_[0], m_[1]); w_.y = pk2(m_[2], m_[3]); *(LAS v2u*)(gi + n * P80 + (8 * g + 4 * half) * 2) = w_; }
    }
}
template <int KIND>
DI void scan_helper(Frame& F, const Args& a, int b, int h, int dir) {
    const bf16* PS = (const bf16*)a.out;
    const int q = F.wave - 4, jt = q & 1, n = F.lane & 31, half = F.lane >> 5;
    const bf16* WT = (const bf16*)(F.ws + (KIND ? WS_AUP_T : WS_WUP_T)) + ((size_t)dir * 512 + h * 64 + 32 * jt + n) * 64 + 8 * half;
    bf16x8 af[4];
#pragma unroll
    for (int kk = 0; kk < 4; ++kk) af[kk] = *(const bf16x8*)(WT + 16 * kk);
    PrepRaw<KIND> Ra, Rb;
    prep_load<KIND>(F, PS, b, h, dir, 0, Ra);
    prep_load<KIND>(F, PS, b, h, dir, 1, Rb);
    prep_compute<KIND>(F, b, h, dir, 0, Ra, af);
    prep_load<KIND>(F, PS, b, h, dir, 2, Ra);
    SC_BARRIER();
    prep_compute<KIND>(F, b, h, dir, 1, Rb, af);
    prep_load<KIND>(F, PS, b, h, dir, 3, Rb);
    SC_BARRIER();
#pragma unroll 1
    for (int s2 = 0; s2 < SC_NCH; s2 += 2) {
        if (s2 + 2 < SC_NCH && !VAR(4)) prep_compute<KIND>(F, b, h, dir, s2 + 2, Ra, af);
        if (!VAR(8)) prep_load<KIND>(F, PS, b, h, dir, (s2 + 4) & (SC_NCH - 1), Ra);
        SC_BARRIER();
        if (s2 + 3 < SC_NCH && !VAR(4)) prep_compute<KIND>(F, b, h, dir, s2 + 3, Rb, af);
        if (!VAR(8)) prep_load<KIND>(F, PS, b, h, dir, (s2 + 5) & (SC_NCH - 1), Rb);
        SC_BARRIER();
    }
}
DI void scan_builder_only(Frame& F) {
    SC_BARRIER();
    scan_build<true>(F, 0, F.wave); if (F.wave == 3) scan_build<false>(F, 0, 6);
    SC_BARRIER();
#pragma unroll 1
    for (int s = 0; s < SC_NCH; ++s) { if (s + 1 < SC_NCH && !VAR(2)) { scan_build<true>(F, s + 1, F.wave); if (F.wave == 3) scan_build<false>(F, s + 1, 6); } SC_BARRIER(); }
}
DI void scan_sequencer(Frame& F, int b, int h, int dir) {
    const int it = F.wave, lane = F.lane, n = lane & 31, half = lane >> 5;
    f32x16 D0, D1;
#pragma unroll
    for (int i = 0; i < 16; ++i) { D0[i] = 0.f; D1[i] = 0.f; }
    bf16* wkv = (bf16*)(F.ws + WS_WKV) + ((size_t)dir * NTOK + (size_t)b * SEQ) * 512 + h * 64 + 32 * it + n;
    SC_BARRIER();
    scan_build<false>(F, 0, 4 + it);
    SC_BARRIER();
#pragma unroll 1
    for (int c = 0; c < SC_NCH; ++c) {
        if (VAR(1)) { if (c + 1 < SC_NCH && !VAR(2)) scan_build<false>(F, c + 1, 4 + it); SC_BARRIER(); continue; }
        const LAS unsigned char* img = SC_IMG(c & 1);
        const LAS unsigned char* atr = img + IM_AT + n * P144; const LAS unsigned char* rtr = img + IM_RT + n * P144;
        const LAS unsigned char* vtr = img + IM_VT + (32 * it + n) * P80 + 16 * half;
        const bf16x8 sb00 = packacc(D0, 0), sb01 = packacc(D0, 1), sb10 = packacc(D1, 0), sb11 = packacc(D1, 1);
        const bf16x8 vt0 = *(const LAS bf16x8*)vtr, vt1 = *(const LAS bf16x8*)(vtr + 32);
        f32x16 U, Y;
#pragma unroll
        for (int i = 0; i < 16; ++i) { U[i] = 0.f; Y[i] = 0.f; }
        U = MFMA32(ld_perm(atr, 0, half), sb00, U); Y = MFMA32(ld_perm(rtr, 0, half), sb00, Y);
        U = MFMA32(ld_perm(atr, 1, half), sb01, U); Y = MFMA32(ld_perm(rtr, 1, half), sb01, Y);
        U = MFMA32(ld_perm(atr + 64, 0, half), sb10, U); Y = MFMA32(ld_perm(rtr + 64, 0, half), sb10, Y);
        U = MFMA32(ld_perm(atr + 64, 1, half), sb11, U); Y = MFMA32(ld_perm(rtr + 64, 1, half), sb11, Y);
        { const LAS unsigned char* mk = img + IM_MAK + n * P80 + 16 * half; const LAS unsigned char* nk = img + IM_NK + n * P80 + 16 * half;
          U = MFMA32(*(const LAS bf16x8*)mk, vt0, U); U = MFMA32(*(const LAS bf16x8*)(mk + 32), vt1, U);
          Y = MFMA32(*(const LAS bf16x8*)nk, vt0, Y); Y = MFMA32(*(const LAS bf16x8*)(nk + 32), vt1, Y); }
        f32x16 SA;
#pragma unroll
        for (int i = 0; i < 16; ++i) SA[i] = 0.f;
        { const LAS unsigned char* tr = img + IM_T + n * P80; const bf16x8 ub0 = packacc(U, 0), ub1 = packacc(U, 1);
          SA = MFMA32(ld_perm(tr, 0, half), ub0, SA); SA = MFMA32(ld_perm(tr, 1, half), ub1, SA); }
        const bf16x8 sab0 = packacc(SA, 0), sab1 = packacc(SA, 1);
        { const LAS unsigned char* nb = img + IM_NB + n * P80; Y = MFMA32(ld_perm(nb, 0, half), sab0, Y); Y = MFMA32(ld_perm(nb, 1, half), sab1, Y); }
        { const int tl0 = SC_CH * c;
#pragma unroll
          for (int i = 0; i < 16; ++i) { const int tl = tl0 + crow(i, half), t = dir ? (SEQ - 1 - tl) : tl; if (!VAR(255)) wkv[(size_t)t * 512] = (bf16)(pk2(Y[i], 0.f) & 0xffffu); } }
        { const LAS unsigned char* b0 = img + IM_BT + n * P80; const LAS unsigned char* k0 = img + IM_KT + n * P80 + 16 * half;
          D0 = MFMA32(ld_perm(b0, 0, half), sab0, D0); D1 = MFMA32(ld_perm(b0 + 32 * P80, 0, half), sab0, D1);
          D0 = MFMA32(ld_perm(b0, 1, half), sab1, D0); D1 = MFMA32(ld_perm(b0 + 32 * P80, 1, half), sab1, D1);
          D0 = MFMA32(*(const LAS bf16x8*)k0, vt0, D0); D1 = MFMA32(*(const LAS bf16x8*)(k0 + 32 * P80), vt0, D1);
          D0 = MFMA32(*(const LAS bf16x8*)(k0 + 32), vt1, D0); D1 = MFMA32(*(const LAS bf16x8*)(k0 + 32 * P80 + 32), vt1, D1);
          const LAS float* gc = (const LAS float*)(img + IM_GC) + 4 * half;
#pragma unroll
          for (int g = 0; g < 4; ++g) { const f32x4 g0 = *(const LAS f32x4*)(gc + 8 * g), g1 = *(const LAS f32x4*)(gc + 32 + 8 * g);
#pragma unroll
              for (int e = 0; e < 4; ++e) { D0[4 * g + e] *= g0[e]; D1[4 * g + e] *= g1[e]; } } }
        if (c + 1 < SC_NCH && !VAR(2)) scan_build<false>(F, c + 1, 4 + it);
        SC_BARRIER();
    }
}
DI void scan_unit(Frame& F, const Args& a, int b, int h, int dir) {
    if (F.wave >= 4) { scan_consts(F, a, h, dir); LDS_WAIT(); }
    __syncthreads();
    if (F.wave < 2) scan_sequencer(F, b, h, dir);
    else if (F.wave < 4) scan_builder_only(F);
    else if ((F.wave - 4) >> 1) scan_helper<1>(F, a, b, h, dir);
    else scan_helper<0>(F, a, b, h, dir);
}

DI void post_consts(Frame& F, const Args& a) {
    LAS float* cm = (LAS float*)F.lds;
    cm[F.tid] = ((const float*)a.in[I_GNW])[F.tid]; cm[512 + F.tid] = ((const float*)a.in[I_GNB])[F.tid];
    LDS_WAIT(); __syncthreads();
}
DI void post_item(Frame& F, const bf16* PS, int item) {
    const int tile = item >> 3, h = item & 7, hc = h * 64;
    const int lane = F.lane, n = lane & 31; int half = lane >> 5; LAUNDER(half);
    const bf16* GT = (const bf16*)(F.ws + WS_GUP_T);
    const bf16* WKV = (const bf16*)(F.ws + WS_WKV); const float* BS = (const float*)(F.ws + WS_BSUM); bf16* YR = (bf16*)(F.ws + WS_YR);
    const LAS float* cm = (const LAS float*)F.lds;
    const size_t tok = (size_t)tile * 32 + n;
    const bf16* pr = PS + tok * RW_COLS;
    bf16x8 bfr[8];
#pragma unroll
    for (int kk = 0; kk < 8; ++kk) bfr[kk] = *(const bf16x8*)(pr + 1664 + 16 * kk + 8 * half);
    f32x4 x[2][4]; v2u vr[2][4];
#pragma unroll
    for (int ct = 0; ct < 2; ++ct)
#pragma unroll
        for (int q4 = 0; q4 < 4; ++q4) { const int c = hc + 32 * ct + 8 * q4 + 4 * half;
            x[ct][q4] = up4(*(const v2u*)(WKV + tok * 512 + c)) + up4(*(const v2u*)(WKV + ((size_t)NTOK + tok) * 512 + c));
            vr[ct][q4] = *(const v2u*)(pr + 1024 + c); }
    const f32x2 b0 = *(const f32x2*)(BS + (tok * 8 + h) * 2), b1 = *(const f32x2*)(BS + (((size_t)NTOK + tok) * 8 + h) * 2);
    f32x16 g0, g1;
#pragma unroll
    for (int i = 0; i < 16; ++i) { g0[i] = 0.f; g1[i] = 0.f; }
    const bf16* gp = GT + (size_t)(hc + n) * 128 + 8 * half;
#pragma unroll
    for (int kk = 0; kk < 8; ++kk) { g0 = MFMA32(*(const bf16x8*)(gp + 16 * kk), bfr[kk], g0); g1 = MFMA32(*(const bf16x8*)(gp + 32 * 128 + 16 * kk), bfr[kk], g1); }
    float sm = 0.f;
#pragma unroll
    for (int ct = 0; ct < 2; ++ct)
#pragma unroll
        for (int q4 = 0; q4 < 4; ++q4) sm += (x[ct][q4][0] + x[ct][q4][1]) + (x[ct][q4][2] + x[ct][q4][3]);
    sm += __shfl_xor(sm, 32);
    const float mean = sm * (1.f / 64.f); float vs = 0.f;
#pragma unroll
    for (int ct = 0; ct < 2; ++ct)
#pragma unroll
        for (int q4 = 0; q4 < 4; ++q4) { const f32x4 d = x[ct][q4] - mean; vs += (d[0] * d[0] + d[1] * d[1]) + (d[2] * d[2] + d[3] * d[3]); }
    vs += __shfl_xor(vs, 32);
    const float rstd = 1.f / sqrtf(vs * (1.f / 64.f) + GN_EPS);
    const float bsum = (b0.x + b0.y) + (b1.x + b1.y);
#pragma unroll
    for (int ct = 0; ct < 2; ++ct)
#pragma unroll
        for (int q4 = 0; q4 < 4; ++q4) { const int c = hc + 32 * ct + 8 * q4 + 4 * half;
            const f32x4 y = (x[ct][q4] - mean) * rstd * *(const LAS f32x4*)(cm + c) + *(const LAS f32x4*)(cm + 512 + c) + up4(vr[ct][q4]) * bsum;
            f32x4 gg; if (ct == 0) gg = (f32x4){g0[4 * q4], g0[4 * q4 + 1], g0[4 * q4 + 2], g0[4 * q4 + 3]}; else gg = (f32x4){g1[4 * q4], g1[4 * q4 + 1], g1[4 * q4 + 2], g1[4 * q4 + 3]};
            const f32x4 o = y * gg; v2u w; w.x = pk2(o[0], o[1]); w.y = pk2(o[2], o[3]);
            *(v2u*)(YR + tok * YC_COLS + c) = w; }
    if (h < 4) {
        const bf16* ya = (const bf16*)(F.ws + WS_YA) + tok * 256 + h * 64 + 32 * half; bf16* yc = YR + tok * YC_COLS + 512 + h * 64 + 32 * half;
#pragma unroll
        for (int e = 0; e < 4; ++e) *(v4u*)(yc + 8 * e) = *(const v4u*)(ya + 8 * e); }
}

DI void p5_router_tile(Frame& F, const Args& a, int tile) {
    const int lane = F.lane, n = lane & 31, half = lane >> 5;
    const size_t tok = (size_t)tile * 32 + n;
    const bf16* xr = (const bf16*)(F.ws + WS_X1) + tok * DM + 8 * half;
    const bf16* RH = (const bf16*)(F.ws + WS_RT_HI) + (size_t)n * DM + 8 * half; const bf16* RL = (const bf16*)(F.ws + WS_RT_LO) + (size_t)n * DM + 8 * half;
    f32x16 d0, d1;
#pragma unroll
    for (int i = 0; i < 16; ++i) { d0[i] = 0.f; d1[i] = 0.f; }
    float ss = 0.f;
#pragma unroll 8
    for (int kk = 0; kk < 64; ++kk) {
        const v4u xv = *(const v4u*)(xr + 16 * kk);
        const float x8[8] = {bflo(xv.x), bfhi(xv.x), bflo(xv.y), bfhi(xv.y), bflo(xv.z), bfhi(xv.z), bflo(xv.w), bfhi(xv.w)};
#pragma unroll
        for (int j = 0; j < 8; ++j) ss += x8[j] * x8[j];
        const bf16x8 bh = __builtin_bit_cast(bf16x8, xv);
        const bf16x8 ah0 = *(const bf16x8*)(RH + 16 * kk), ah1 = *(const bf16x8*)(RH + 32 * DM + 16 * kk), al0 = *(const bf16x8*)(RL + 16 * kk), al1 = *(const bf16x8*)(RL + 32 * DM + 16 * kk);
        d0 = MFMA32(ah0, bh, d0); d0 = MFMA32(al0, bh, d0);
        d1 = MFMA32(ah1, bh, d1); d1 = MFMA32(al1, bh, d1);
    }
    ss += __shfl_xor(ss, 32);
    const float rstd = 1.f / sqrtf(ss * (1.f / DM) + NORM_EPS);
    const float* brg = (const float*)a.in[I_BRG]; const float* bre = (const float*)a.in[I_BRE];
    float gl[4];
#pragma unroll
    for (int j = 0; j < 4; ++j) gl[j] = __shfl(d1[j] * rstd + brg[j], n);
    int grp = 0; float gmax = gl[0];
#pragma unroll
    for (int j = 1; j < 4; ++j) if (gl[j] > gmax) { gmax = gl[j]; grp = j; }
    float gsum = 0.f;
#pragma unroll
    for (int j = 0; j < 4; ++j) gsum += __expf(gl[j] - gmax);
    const float grp_p = 1.f / gsum;
    const f32x4 bv = *(const f32x4*)(bre + 8 * grp + 4 * half);
    float cv[4];
#pragma unroll
    for (int j = 0; j < 4; ++j) { float v = d0[j]; v = grp == 1 ? d0[4 + j] : v; v = grp == 2 ? d0[8 + j] : v; v = grp == 3 ? d0[12 + j] : v; cv[j] = v * rstd + bv[j]; }
    float m1v = cv[0]; int m1i = 0;
#pragma unroll
    for (int j = 1; j < 4; ++j) if (cv[j] > m1v) { m1v = cv[j]; m1i = j; }
    float m2v = -3.0e38f; int m2i = 0;
#pragma unroll
    for (int j = 0; j < 4; ++j) if (j != m1i && cv[j] > m2v) { m2v = cv[j]; m2i = j; }
    m1i += 4 * half; m2i += 4 * half;
    const float t1v = __shfl_xor(m1v, 32), t2v = __shfl_xor(m2v, 32); const int t1i = __shfl_xor(m1i, 32), t2i = __shfl_xor(m2i, 32);
    auto better = [](float av, int ai, float bv_, int bi) { return av > bv_ || (av == bv_ && ai < bi); };
    float top1v, top2v; int top1i, top2i;
    if (better(m1v, m1i, t1v, t1i)) { top1v = m1v; top1i = m1i; if (better(m2v, m2i, t1v, t1i)) { top2v = m2v; top2i = m2i; } else { top2v = t1v; top2i = t1i; } }
    else { top1v = t1v; top1i = t1i; if (better(m1v, m1i, t2v, t2i)) { top2v = m1v; top2i = m1i; } else { top2v = t2v; top2i = t2i; } }
    const float w0 = grp_p / (1.f + __expf(top2v - top1v)), w1 = grp_p - w0;
    const int mye = 8 * grp + (half ? top2i : top1i); const float myw = half ? w1 : w0;
    unsigned long long mymask = 0ull; int cnt_l = 0;
    for (int e = 0; e < NEXP; ++e) { const unsigned long long m = __ballot(mye == e); if (mye == e) mymask = m; if (lane == e) cnt_l = __popcll(m); }
    int base_l = 0;
    if (lane < NEXP && cnt_l > 0 && !VAR(64)) base_l = (int)__hip_atomic_fetch_add((unsigned*)(F.ws + WS_CTL) + CW_CNT + 64 * lane, (unsigned)cnt_l, RLX_AGENT);
    const int mybase = __shfl(base_l, mye);
    const int pos = mybase + __popcll(mymask & ((1ull << lane) - 1ull));
    if (!VAR(64)) { ((int*)(F.ws + WS_LTOK))[(size_t)mye * NTOK + pos] = (int)tok * 2 + half;
    ((float*)(F.ws + WS_LW))[(size_t)mye * NTOK + pos] = myw; ((float*)(F.ws + WS_LR))[(size_t)mye * NTOK + pos] = rstd; }
}
DI void p5_phase(Frame& F, const Args& a) {
    const int gw = F.bid * NWAVES + F.wave, NGW = F.G * NWAVES;
    if (!VAR(256)) for (int tile = F.wave * F.G + F.bid; tile < NTOK / 32; tile += NGW) p5_router_tile(F, a, tile);
    if (F.bid == 0 && F.tid < 128) ((v4u*)((bf16*)(F.ws + WS_X1) + (size_t)NTOK * DM))[F.tid] = (v4u){0u, 0u, 0u, 0u};
    LAS float* scr = (LAS float*)(F.lds + F.wave * 16384);
    constexpr int IPE = 256;
    if (!VAR(128)) for (int it = gw; it < NEXP * 3 * IPE; it += NGW) {
        const int e = it / (3 * IPE), r = it % (3 * IPE), which = r / IPE, item = r % IPE;
        if (which == 0) transpose_item((const float*)a.in[I_WGATE] + (size_t)e * DM * DEXP, DM, DEXP, (bf16*)(F.ws + WS_WGU_T) + (size_t)e * DM * DM, RmGate(), scr, item, F.lane, 0, 0, (const float*)a.in[I_N2G]);
        else if (which == 1) transpose_item((const float*)a.in[I_WUP] + (size_t)e * DM * DEXP, DM, DEXP, (bf16*)(F.ws + WS_WGU_T) + (size_t)e * DM * DM, RmUp(), scr, item, F.lane, 0, 0, (const float*)a.in[I_N2G]);
        else transpose_item((const float*)a.in[I_WDOWN] + (size_t)e * DEXP * DM, DEXP, DM, (bf16*)(F.ws + WS_WD_T) + (size_t)e * DM * DEXP, RmId(), scr, item, F.lane);
    }
}
DI int moe_table(Frame& F) {
    LAS int* tab = (LAS int*)(F.lds + TAB_OFF);
    if (F.tid == 0) { int acc = 0;
        for (int e = 0; e < NEXP; ++e) { const int c = (int)__hip_atomic_load((unsigned*)(F.ws + WS_CTL) + CW_CNT + 64 * e, RLX_AGENT); tab[e] = acc; tab[33 + e] = c; acc += (c + 255) >> 8; }
        tab[32] = acc; }
    __syncthreads();
    return tab[32];
}
DI void p6_gather(Frame& F) {
    const int nT = moe_table(F);
    const LAS int* tab = (const LAS int*)(F.lds + TAB_OFF);
    const bf16* h2 = (const bf16*)(F.ws + WS_H2); bf16* Xg = (bf16*)(F.ws + WS_XG);
    const int* ltok = (const int*)(F.ws + WS_LTOK); const float* lw = (const float*)(F.ws + WS_LW);
    const int nrows = nT * 256, rstride = F.G * NWAVES;
    for (int R0 = F.bid * NWAVES + F.wave; R0 < nrows; R0 += 4 * rstride) {
        int tk[4], kq[4]; float wv[4];
#pragma unroll
        for (int u = 0; u < 4; ++u) { const int R = R0 + u * rstride; tk[u] = -1; kq[u] = 0; wv[u] = 0.f;
            if (R < nrows) { const int tile = R >> 8; int e = 0;
                for (int k = 1; k < NEXP; ++k) e += (tab[k] <= tile) ? 1 : 0;
                const int slot = R - tab[e] * 256;
                if (slot < tab[33 + e]) { const int t2 = ltok[(size_t)e * NTOK + slot]; tk[u] = t2 >> 1; kq[u] = t2 & 1; wv[u] = lw[(size_t)e * NTOK + slot]; } } }
        v4u d0[4], d1[4];
#pragma unroll
        for (int u = 0; u < 4; ++u) { const v4u* src = (const v4u*)(h2 + (size_t)(tk[u] < 0 ? NTOK : tk[u]) * DM); d0[u] = src[F.lane]; d1[u] = src[F.lane + 64]; }
#pragma unroll
        for (int u = 0; u < 4; ++u) { const int R = R0 + u * rstride; if (R < nrows) { v4u* dst = (v4u*)(Xg + (size_t)R * DM); dst[F.lane] = d0[u]; dst[F.lane + 64] = d1[u];
            if (F.lane == 0) { ((float*)(F.ws + WS_ROWW))[R] = wv[u]; if (tk[u] >= 0) ((int*)(F.ws + WS_INV))[tk[u] * 2 + kq[u]] = R; } } }
    }
}

__global__ void __launch_bounds__(NWAVES * 64, 2) mk_fwd(Args args) {
    extern __shared__ __attribute__((aligned(16))) unsigned char lds[];
    Frame F;
    F.lds = (LAS unsigned char*)lds; F.MISC = (volatile LAS unsigned*)(F.lds + MISC_OFF);
    F.tid = threadIdx.x; F.lane = F.tid & 63; F.wave = __builtin_amdgcn_readfirstlane(F.tid >> 6); F.G = gridDim.x; F.bid = blockIdx.x; F.ws = args.ws; F.variant = args.variant;
    for (int u = F.tid; u < (LDS_BYTES - RING_BYTES) / 4; u += NWAVES * 64) ((LAS unsigned*)(F.lds + RING_BYTES))[u] = 0u;
    __syncthreads();
    const int lo = args.ph_lo, hi = args.ph_hi;
    const bool multi = (hi - lo) > 1;
    XcdBarrier bar; bar.bar = (unsigned*)(args.ws + WS_CTL) + CW_BAR + args.li * XCD_BAR_WORDS; bar.x = 0; bar.st = nullptr;
    if (multi) bar = xcd_barrier_post((unsigned*)(args.ws + WS_CTL) + CW_BAR + args.li * XCD_BAR_WORDS, F.MISC + 8);
#ifndef PH_MASK
#define PH_MASK 0xFFFFFFFFu
#endif
#define REFRESH() do { F.lane = (int)__builtin_amdgcn_mbcnt_hi(~0u, __builtin_amdgcn_mbcnt_lo(~0u, 0u)); F.tid = F.wave * 64 + F.lane; } while (0)
#define IN(k) ((((PH_MASK) >> (k)) & 1u) && lo <= (k) && (k) < hi)
#define SEAM(k) do { if (IN(k) && IN((k) + 1)) xcd_barrier(bar); } while (0)
    unsigned char* ws = args.ws;

    if (IN(0)) { REFRESH(); p0_prologue(F, args); } SEAM(0);
    if (IN(1)) { REFRESH();
        pg8::Gemm g{(const bf16*)(ws + WS_HB), (const bf16*)(ws + WS_WIN_T), DM, 0, nullptr, nullptr}; pg8::StaticOrder S; S.init(NTOK, IN_COLS, F.G, F.bid);
        pg8::EpiIn E{(bf16*)(ws + WS_PR), (bf16*)(ws + WS_PT), (bf16*)(ws + WS_G), (const float*)args.in[I_BMERGE]};
        pg8::gemm_phase<pg8::EpiIn, pg8::StaticOrder, true, true>(F.lds, g, S, E);
    } SEAM(1);
    if (IN(2)) { REFRESH(); if (!VAR(128)) p1b_qkprep(F, args); if (!VAR(256)) p1c_preshift(F, args); } SEAM(2);
    if (IN(3)) { REFRESH(); for (int u = F.bid; u < 256; u += F.G) attn_unit(F, u >> 4, (u >> 2) & 3, u & 3); } SEAM(3);
    if (IN(4)) { REFRESH(); for (int u = F.bid; u < 256; u += F.G) scan_unit(F, args, u >> 4, (u >> 1) & 7, u & 1); } SEAM(4);
    if (IN(5)) { REFRESH(); post_consts(F, args);
#pragma unroll 1
        for (int item = F.bid * NWAVES + F.wave; item < NTOK / 32 * 8; item += F.G * NWAVES) post_item(F, (const bf16*)args.out, item); } SEAM(5);
    if (IN(6)) { REFRESH();
        pg8::Gemm g{(const bf16*)(ws + WS_YR), (const bf16*)(ws + WS_WR_T), YC_COLS, 0, nullptr, nullptr}; pg8::StaticOrder S; S.init(NTOK, DM, F.G, F.bid);
        pg8::EpiMix2 E{(const bf16*)(ws + WS_G), (bf16*)(ws + WS_Z)};
        pg8::gemm_phase<pg8::EpiMix2, pg8::StaticOrder, true, true>(F.lds, g, S, E);
    } SEAM(6);
    if (IN(8)) { REFRESH();
        pg8::Gemm g{(const bf16*)(ws + WS_Z), (const bf16*)(ws + WS_WOUT_T), DM, 0, nullptr, nullptr}; pg8::StaticOrder S; S.init(NTOK, DM, F.G, F.bid);
        pg8::EpiRes E{(const float*)args.in[I_X], (bf16*)(ws + WS_X1)};
        pg8::gemm_phase<pg8::EpiRes, pg8::StaticOrder, true, true>(F.lds, g, S, E);
    } SEAM(8);
    if (IN(9)) { REFRESH(); p5_phase(F, args); } SEAM(9);
    if (IN(11)) { REFRESH();
        const int nT = moe_table(F);
        pg8::Gemm g{(const bf16*)(ws + WS_X1), (const bf16*)(ws + WS_WGU_T), DM, (size_t)DM * DM * 2, (const int*)(ws + WS_LTOK), (const LAS int*)(F.lds + TAB_OFF)}; pg8::GroupedOrder S{(const LAS int*)(F.lds + TAB_OFF), nT, F.G, F.bid};
        pg8::EpiSwiglu E{(bf16*)(ws + WS_HH), (const float*)(ws + WS_LR), (const LAS int*)(F.lds + TAB_OFF)};
        pg8::gemm_phase<pg8::EpiSwiglu, pg8::GroupedOrder, true, true, true>(F.lds, g, S, E);
    } SEAM(11);
    if (IN(12)) { REFRESH();
        const int nT = moe_table(F);
        pg8::Gemm g{(const bf16*)(ws + WS_HH), (const bf16*)(ws + WS_WD_T), DEXP, (size_t)DM * DEXP * 2, nullptr, nullptr}; pg8::GroupedOrder S{(const LAS int*)(F.lds + TAB_OFF), nT, F.G, F.bid};
        pg8::EpiStoreY E{(const int*)(ws + WS_LTOK), (const float*)(ws + WS_LW), (const LAS int*)(F.lds + TAB_OFF), (int*)(ws + WS_INV), (bf16*)(ws + WS_YB)};
        pg8::gemm_phase<pg8::EpiStoreY, pg8::GroupedOrder, true, true>(F.lds, g, S, E);
    } SEAM(12);
    if (IN(13)) { REFRESH();
        const int* inv = (const int*)(ws + WS_INV); const bf16* Y = (const bf16*)(ws + WS_YB);
        const int tstride = F.G * NWAVES;
        for (int tok0 = F.bid * NWAVES + F.wave; tok0 < NTOK; tok0 += 4 * tstride) {
            int r0[4], r1[4];
#pragma unroll
            for (int u = 0; u < 4; ++u) { const int tok = tok0 + u * tstride; r0[u] = inv[tok * 2]; r1[u] = inv[tok * 2 + 1]; }
#pragma unroll
            for (int u = 0; u < 4; ++u) { const int tok = tok0 + u * tstride;
                f32x4* o = (f32x4*)(args.out + (size_t)tok * DM) + F.lane; const v2u* xb = (const v2u*)((const bf16*)(ws + WS_X1) + (size_t)tok * DM) + F.lane;
                const v2u* y0 = (const v2u*)(Y + (size_t)r0[u] * DM) + F.lane; const v2u* y1 = (const v2u*)(Y + (size_t)r1[u] * DM) + F.lane;
                v2u xv[4], a0[4], a1[4];
#pragma unroll
                for (int j = 0; j < 4; ++j) { xv[j] = xb[64 * j]; a0[j] = y0[64 * j]; a1[j] = y1[64 * j]; }
#pragma unroll
                for (int j = 0; j < 4; ++j) { f32x4 v; v[0] = bflo(xv[j].x) + bflo(a0[j].x) + bflo(a1[j].x); v[1] = bfhi(xv[j].x) + bfhi(a0[j].x) + bfhi(a1[j].x); v[2] = bflo(xv[j].y) + bflo(a0[j].y) + bflo(a1[j].y); v[3] = bfhi(xv[j].y) + bfhi(a0[j].y) + bfhi(a1[j].y); if (!VAR(64)) o[64 * j] = v; } }
        }
    }
#undef IN
#undef SEAM
}

constexpr int NPHASE = 14;
extern "C" void kernel_launch(void* const* d_in, const int* in_sizes, int n_in, void* d_out, int out_size, void* d_ws, size_t ws_size, hipStream_t stream) {
    static int grid = 0;
    if (grid == 0) {
        if (n_in != 30 || ws_size < WS_END) { fprintf(stderr, "kernel_launch: need 30 inputs and >= %zu bytes of workspace (got %d, %zu)\n", (size_t)WS_END, n_in, ws_size); grid = -1; return; }
        int dev = 0, cus = 0;
        if (hipGetDevice(&dev) != hipSuccess || hipDeviceGetAttribute(&cus, hipDeviceAttributeMultiprocessorCount, dev) != hipSuccess) { grid = -1; return; }
        if (hipFuncSetAttribute((const void*)mk_fwd, hipFuncAttributeMaxDynamicSharedMemorySize, LDS_BYTES) != hipSuccess) { fprintf(stderr, "kernel_launch: hipFuncSetAttribute failed\n"); grid = -1; return; }
        int per_cu = 0;
        if (hipOccupancyMaxActiveBlocksPerMultiprocessor(&per_cu, (const void*)mk_fwd, NWAVES * 64, LDS_BYTES) != hipSuccess || per_cu < 1) fprintf(stderr, "kernel_launch: occupancy query reports %d\n", per_cu);
        (void)hipGetLastError();
        grid = cus;
    }
    if (grid < 0) return;
    hipMemsetAsync((char*)d_ws + WS_CTL, 0, CTL_ZERO_BYTES, stream);
    Args a{};
    for (int i = 0; i < 30; ++i) a.in[i] = d_in[i];
    a.out = (float*)d_out; a.ws = (unsigned char*)d_ws;
#if defined(PROBE_REPEAT)
#ifdef PROBE_VARIANT
#define PROBE_VARIANT_V PROBE_VARIANT
#else
#define PROBE_VARIANT_V 0
#endif
    { const int k = PROBE_REPEAT; int li = 0;
      const int cuts[5][2] = {{0, k}, {k, k + 1}, {k, k + 1}, {k + 1, NPHASE}, {0, 0}};
      for (int i = 0; i < 4; ++i) { if (cuts[i][1] <= cuts[i][0]) continue; a.ph_lo = cuts[i][0]; a.ph_hi = cuts[i][1]; a.li = li++; a.variant = (i == 2) ? PROBE_VARIANT_V : 0; hipLaunchKernelGGL(mk_fwd, dim3(grid), dim3(NWAVES * 64), LDS_BYTES, stream, a); } }
#elif !defined(MK_MULTI_LAUNCH)
    a.ph_lo = 0; a.ph_hi = NPHASE; a.li = 0;
    hipLaunchKernelGGL(mk_fwd, dim3(grid), dim3(NWAVES * 64), LDS_BYTES, stream, a);
#else
    for (int p = 0; p < NPHASE; ++p) { a.ph_lo = p; a.ph_hi = p + 1; a.li = 0; hipLaunchKernelGGL(mk_fwd, dim3(grid), dim3(NWAVES * 64), LDS_BYTES, stream, a); }
#endif
}
```

```cpp
#include <hip/hip_runtime.h>
#include <cstdio>
#include <cstdint>

constexpr int BATCH = 16, SEQ = 2048, DM = 1024, NTOK = BATCH * SEQ;
constexpr int RW_COLS = 1792, AT_COLS = 2304, G_COLS = 2048, IN_COLS = 6144;
constexpr int NEXP = 32, DEXP = 512;
constexpr int MAXTILES = 288;
constexpr float NORM_EPS = 1e-6f, GN_EPS = 64e-5f;

#define GAS __attribute__((address_space(1)))
#define LAS __attribute__((address_space(3)))
typedef unsigned short bf16;
typedef unsigned v4u __attribute__((ext_vector_type(4)));
typedef unsigned v2u __attribute__((ext_vector_type(2)));
typedef float f32x4 __attribute__((ext_vector_type(4)));
typedef float f32x2 __attribute__((ext_vector_type(2)));
typedef float f32x16 __attribute__((ext_vector_type(16)));
typedef short bf16x8 __attribute__((ext_vector_type(8)));
typedef __bf16 bf16x2_t __attribute__((ext_vector_type(2)));
typedef GAS unsigned gu32;
#define RLX_AGENT __ATOMIC_RELAXED, __HIP_MEMORY_SCOPE_AGENT
#define LDS_WAIT() asm volatile("s_waitcnt lgkmcnt(0)" ::: "memory")
#define VM_WAIT() asm volatile("s_waitcnt vmcnt(0)" ::: "memory")
#define DI __device__ __forceinline__
#ifdef PROBE_VARIANT
#define VAR(b) (F.variant & (b))
#else
#define VAR(b) 0
#endif
#define LAUNDER(x) asm volatile("" : "+v"(x))

DI unsigned pk2(float lo, float hi) { f32x2 v = {lo, hi}; bf16x2_t b = __builtin_convertvector(v, bf16x2_t); return __builtin_bit_cast(unsigned, b); }
DI float bflo(unsigned u) { return __builtin_bit_cast(float, u << 16); }
DI float bfhi(unsigned u) { return __builtin_bit_cast(float, u & 0xffff0000u); }
DI float sigmoidf_(float x) { return __builtin_amdgcn_rcpf(1.f + __builtin_amdgcn_exp2f(-1.44269504f * x)); }
DI float wave_sum(float v) {
#pragma unroll
    for (int o = 1; o < 64; o <<= 1) v += __shfl_xor(v, o);
    return v;
}
DI int crow(int reg, int h) { return (reg & 3) + 8 * (reg >> 2) + 4 * h; }
#define MFMA32(a, b, c) __builtin_amdgcn_mfma_f32_32x32x16_bf16((a), (b), (c), 0, 0, 0)

constexpr size_t MiB = 1u << 20;
constexpr size_t WS_CTL = 0, CTL_ZERO_BYTES = 1 * MiB;
constexpr size_t WS_WIN_T = 1 * MiB;
constexpr size_t WS_WR_T = 13 * MiB;
constexpr size_t WS_WA_T = 14 * MiB;
constexpr size_t WS_WOUT_T = 15 * MiB;
constexpr size_t WS_GUP_T = 17 * MiB;
constexpr size_t WS_RT_HI = 17 * MiB + 256 * 1024;
constexpr size_t WS_RT_LO = 17 * MiB + 384 * 1024;
constexpr size_t WS_WUP_T = 17 * MiB + 512 * 1024;
constexpr size_t WS_AUP_T = 17 * MiB + 640 * 1024;
constexpr size_t RG_A = 18 * MiB, RG_B = 82 * MiB, RG_C = 194 * MiB, RG_D = 338 * MiB, RG_E = 466 * MiB, WS_END = 512 * MiB;
constexpr size_t WS_HB = RG_A;
constexpr size_t WS_PR = RG_B;
constexpr size_t WS_PT = RG_C;
constexpr size_t WS_G = RG_D;
constexpr size_t WS_OG = RG_A;
constexpr size_t WS_LSE = RG_A + 48 * MiB;
constexpr size_t WS_YA = RG_E;
constexpr size_t WS_BSUM = RG_E + 16 * MiB;
constexpr size_t WS_WKV = RG_C;
constexpr size_t WS_YR = RG_A;
constexpr int YC_COLS = 768;
constexpr size_t WS_X1 = RG_A;
constexpr size_t WS_Z1 = RG_C;
constexpr size_t WS_Z = RG_C + 64 * MiB;
constexpr size_t WS_H2 = RG_B;
constexpr size_t WS_LTOK = RG_E + 20 * MiB;
constexpr size_t WS_LW = RG_E + 24 * MiB;
constexpr size_t WS_ROWTOK = RG_E + 28 * MiB;
constexpr size_t WS_ROWW = RG_E + 29 * MiB;
constexpr size_t WS_WGU_T = RG_D;
constexpr size_t WS_WD_T = 434 * MiB;
constexpr size_t WS_XG = RG_C;
constexpr size_t WS_HH = RG_C;
constexpr size_t WS_YB = RG_C + 72 * MiB;
constexpr size_t WS_LR = RG_E + 34 * MiB;
constexpr size_t WS_INV = RG_E + 30 * MiB;
constexpr int CW_BAR = 4096;
constexpr int CW_CNT = 32768;

constexpr int RING_BYTES = 155648;
constexpr int MISC_OFF = RING_BYTES + 320;
constexpr int TAB_OFF = RING_BYTES + 1024;
constexpr int LDS_BYTES = 163840;
constexpr int NWAVES = 8;

namespace pg8 {
constexpr int BM = 256, BK = 64, HALF = 128, HTB = HALF * BK * 2, STAGE_BYTES = 8 * HTB, NXCD = 8, WGM = 8;
__host__ __device__ __forceinline__ int lds_byte(int r, int c) { const int st = (r >> 4) * 2 + (c >> 5), rr = r & 15, cc = c & 31, ob = rr * 64 + cc * 2; return st * 1024 + (ob ^ (((ob >> 9) & 1) << 5)); }
__host__ __device__ __forceinline__ void stage_rc(int b, int& R, int& C) { const int st = b / 1024, sb = b % 1024, swz = sb ^ (((sb >> 9) & 1) << 5); R = (st >> 1) * 16 + swz / 64; C = (st & 1) * 32 + (swz % 64) / 2; }
__host__ __device__ __forceinline__ int perm32(int rho) { const int n = rho >> 4, i = rho & 15; return 8 * (i >> 2) + 4 * n + (i & 3); }

struct Unit { int pm, pn, e; };
struct Gemm { const bf16* A; const bf16* Bt; int K; size_t bgroup; const int* ltok; const LAS int* tab; };

struct StaticOrder {
    int nM, nN, nwg, G, c;
    __device__ void init(int M, int N, int G_, int c_) { nM = M / BM; nN = N / BM; nwg = nM * nN; G = G_; c = c_; }
    __device__ bool next(int i, Unit& u) const {
        const long L = (long)i * G + c; if (L >= nwg) return false;
        int wgid = (int)L; { const int q = nwg / NXCD, r = nwg % NXCD, xcd = wgid % NXCD, off = wgid / NXCD; wgid = (xcd < r ? xcd * (q + 1) : r * (q + 1) + (xcd - r) * q) + off; }
        const int nig = WGM * nN, gid = wgid / nig, fm = gid * WGM, gsz = (nM - fm) < WGM ? (nM - fm) : WGM;
        u.pm = fm + ((wgid % nig) % gsz); u.pn = (wgid % nig) / gsz; u.e = 0; return true;
    }
};
struct GroupedOrder {
    const LAS int* tstart; int nT, G, c;
    __device__ bool next(int i, Unit& u) const {
        const int L = i * G + c; if (L >= nT * 4) return false;
        u.pm = L >> 2; u.pn = L & 3; int e = 0;
        for (int k = 1; k < NEXP; ++k) e += (tstart[k] <= u.pm) ? 1 : 0;
        u.e = e; return true;
    }
};

template <class Epi, class Sched, bool ALIGN_EPI = false, bool SP2 = false, bool GATHER = false>
__device__ __forceinline__ void gemm_phase(LAS unsigned char* lds, const Gemm g, const Sched& S, const Epi& E) {
    const int tid = threadIdx.x, wid = __builtin_amdgcn_readfirstlane(tid >> 6), lane = tid & 63, wr = wid >> 2, wc = wid & 3, fr = lane & 15, fq = lane >> 4;
    const int K = g.K, nt = K / BK;
    unsigned voffA[2], voffB[2];
#pragma unroll
    for (int i = 0; i < 2; ++i) { int R, C; stage_rc(tid * 16 + i * 8192, R, C); const int Rb = Epi::PERM ? ((R & ~31) + perm32(R & 31)) : R;
        voffA[i] = (unsigned)(R * K + C) * 2u; voffB[i] = (unsigned)(Rb * K + C) * 2u; }
    const size_t kstep = (size_t)(BK * 2);
    const size_t hstep = (size_t)HALF * K * 2;
    const size_t tstep = 2 * hstep;
    const unsigned ldsw = (unsigned)wid * 1024u;
    const int aoff = lds_byte(wr * 64 + fr, fq * 8), boff = lds_byte(wc * 32 + fr, fq * 8);
    const size_t hstepA = GATHER ? 0 : hstep;
    unsigned voffGc[2][2], voffGn[2][2];
#define PG8_GOFF(dst, un) do { if constexpr (GATHER) { _Pragma("unroll") for (int _h = 0; _h < 2; ++_h) _Pragma("unroll") for (int _i = 0; _i < 2; ++_i) { int R_, C_; stage_rc(tid * 16 + _i * 8192, R_, C_); \
        const int slot_ = ((un).pm - g.tab[(un).e]) * 256 + _h * 128 + R_; const int tok_ = slot_ < g.tab[33 + (un).e] ? (g.ltok[(size_t)(un).e * NTOK + slot_] >> 1) : NTOK; \
        dst[_h][_i] = (unsigned)(tok_ * K + C_) * 2u; } } } while (0)
#define PG8_VA(sel, h) (GATHER ? ((sel) ? voffGn[h] : voffGc[h]) : voffA)
#define PG8_SA(b, h) (((b) * 2 + (h)) * HTB)
#define PG8_SB(b, h) ((4 + (b) * 2 + (h)) * HTB)
#define PG8_STAGE(bufoff, gbase, voff) do { _Pragma("unroll") for (int _i = 0; _i < 2; ++_i) \
        __builtin_amdgcn_global_load_lds((const unsigned*)((const char*)(gbase) + (voff)[_i]), (LAS unsigned*)(lds + (bufoff) + ldsw + _i * 8192), 16, 0, 0); } while (0)
#define PG8_LDA(dst, b, h) do { _Pragma("unroll") for (int m = 0; m < 4; ++m) _Pragma("unroll") for (int k = 0; k < 2; ++k) dst[m][k] = *(const LAS bf16x8*)(lds + PG8_SA(b, h) + aoff + m * 2048 + k * 1024); } while (0)
#define PG8_LDB(dst, b, h) do { _Pragma("unroll") for (int n = 0; n < 2; ++n) _Pragma("unroll") for (int k = 0; k < 2; ++k) dst[n][k] = *(const LAS bf16x8*)(lds + PG8_SB(b, h) + boff + n * 2048 + k * 1024); } while (0)
#define PG8_MMA(ai, bj, At, Bt) do { __builtin_amdgcn_s_setprio(1); _Pragma("unroll") for (int m = 0; m < 4; ++m) _Pragma("unroll") for (int n = 0; n < 2; ++n) _Pragma("unroll") for (int k = 0; k < 2; ++k) \
        acc[ai][bj][m][n] = __builtin_amdgcn_mfma_f32_16x16x32_bf16(Bt[n][k], At[m][k], acc[ai][bj][m][n], 0, 0, 0); __builtin_amdgcn_s_setprio(0); } while (0)
#define PG8_WAIT_V(n) asm volatile("s_waitcnt vmcnt(" #n ")" ::: "memory")
#define PG8_WAIT_L(n) asm volatile("s_waitcnt lgkmcnt(" #n ")" ::: "memory")
#define PG8_BAR __builtin_amdgcn_s_barrier()
#define PG8_SCHED __builtin_amdgcn_sched_barrier(0)
    Unit cur, nxt; int ui = 0;
    if (!S.next(0, cur)) return;
    f32x4 acc[2][2][4][2];
#pragma unroll
    for (int a = 0; a < 2; ++a)
#pragma unroll
        for (int b = 0; b < 2; ++b)
#pragma unroll
            for (int m = 0; m < 4; ++m)
#pragma unroll
                for (int n = 0; n < 2; ++n) acc[a][b][m][n] = (f32x4){0.f, 0.f, 0.f, 0.f};
    bf16x8 At[4][2], B0[2][2], B1[2][2];
    const char* cA = (const char*)g.A + (GATHER ? 0 : (size_t)cur.pm * tstep); const char* cB = (const char*)g.Bt + (size_t)cur.e * g.bgroup + (size_t)cur.pn * tstep;
    PG8_GOFF(voffGc, cur);
    if constexpr (SP2) {
        PG8_STAGE(PG8_SB(0, 0), cB, voffB); PG8_STAGE(PG8_SB(0, 1), cB + hstep, voffB); PG8_STAGE(PG8_SA(0, 0), cA, PG8_VA(false, 0)); PG8_STAGE(PG8_SA(0, 1), cA + hstepA, PG8_VA(false, 1));
        if (wr == 1) PG8_BAR;
        PG8_WAIT_V(2); PG8_BAR;
        PG8_STAGE(PG8_SB(1, 0), cB + kstep, voffB); PG8_STAGE(PG8_SA(1, 0), cA + kstep, PG8_VA(false, 0)); PG8_STAGE(PG8_SB(1, 1), cB + hstep + kstep, voffB);
        PG8_WAIT_V(6); PG8_BAR;
    } else {
        PG8_STAGE(PG8_SB(0, 0), cB, voffB); PG8_STAGE(PG8_SA(0, 0), cA, PG8_VA(false, 0)); PG8_STAGE(PG8_SB(0, 1), cB + hstep, voffB); PG8_STAGE(PG8_SA(0, 1), cA + hstepA, PG8_VA(false, 1));
        if (wr == 1) PG8_BAR;
        PG8_WAIT_V(4); PG8_BAR;
        PG8_STAGE(PG8_SB(1, 0), cB + kstep, voffB); PG8_STAGE(PG8_SA(1, 0), cA + kstep, PG8_VA(false, 0)); PG8_STAGE(PG8_SB(1, 1), cB + hstep + kstep, voffB);
        PG8_WAIT_V(6); PG8_BAR;
    }
    for (;;) {
        const bool has_next = S.next(ui + 1, nxt);
        const char* nA = has_next ? (const char*)g.A + (GATHER ? 0 : (size_t)nxt.pm * tstep) : cA;
        if (has_next) PG8_GOFF(voffGn, nxt); const char* nB = has_next ? (const char*)g.Bt + (size_t)nxt.e * g.bgroup + (size_t)nxt.pn * tstep : cB;
        for (int t = 0; t < nt; t += 2) {
            if constexpr (Epi::MID_T >= 0) { if (t == Epi::MID_T) E.mid(acc, cur, wr, wc, fr, fq); }
            const bool last = (t == nt - 2); const bool seln = last && has_next;
            const char* a1 = cA + (size_t)(t + 1) * kstep;
            const char* a2 = last ? nA : cA + (size_t)(t + 2) * kstep; const char* b2 = last ? nB : cB + (size_t)(t + 2) * kstep;
            const char* a3 = a2 + kstep; const char* b3 = b2 + kstep;
            if constexpr (SP2) {
            PG8_LDB(B0, 0, 0); PG8_LDB(B1, 0, 1); PG8_SCHED; PG8_LDA(At, 0, 0); PG8_STAGE(PG8_SA(1, 1), a1 + hstepA, PG8_VA(false, 1));
            PG8_WAIT_V(8); PG8_WAIT_L(0); PG8_BAR; PG8_MMA(0, 0, At, B0); PG8_MMA(0, 1, At, B1); PG8_BAR; PG8_SCHED;
            PG8_LDA(At, 0, 1); PG8_STAGE(PG8_SB(0, 0), b2, voffB); PG8_STAGE(PG8_SB(0, 1), b2 + hstep, voffB); PG8_STAGE(PG8_SA(0, 0), a2, PG8_VA(seln, 0));
            PG8_WAIT_V(8); PG8_WAIT_L(0); PG8_BAR; PG8_MMA(1, 0, At, B0); PG8_MMA(1, 1, At, B1); PG8_BAR; PG8_SCHED;
            PG8_LDB(B0, 1, 0); PG8_LDB(B1, 1, 1); PG8_SCHED; PG8_LDA(At, 1, 0); PG8_STAGE(PG8_SA(0, 1), a2 + hstepA, PG8_VA(seln, 1));
            PG8_WAIT_V(8); PG8_WAIT_L(0); PG8_BAR; PG8_MMA(0, 0, At, B0); PG8_MMA(0, 1, At, B1); PG8_BAR; PG8_SCHED;
            PG8_LDA(At, 1, 1); PG8_STAGE(PG8_SB(1, 0), b3, voffB); PG8_STAGE(PG8_SB(1, 1), b3 + hstep, voffB); PG8_STAGE(PG8_SA(1, 0), a3, PG8_VA(seln, 0));
            PG8_WAIT_V(8); PG8_WAIT_L(0); PG8_BAR; PG8_MMA(1, 0, At, B0); PG8_MMA(1, 1, At, B1); PG8_BAR; PG8_SCHED;
            } else {
            PG8_LDB(B0, 0, 0); PG8_SCHED; PG8_LDA(At, 0, 0); PG8_STAGE(PG8_SA(1, 1), a1 + hstepA, PG8_VA(false, 1));
            PG8_WAIT_L(8); PG8_BAR; PG8_WAIT_L(0); PG8_MMA(0, 0, At, B0); PG8_BAR; PG8_SCHED;
            PG8_LDB(B1, 0, 1); PG8_STAGE(PG8_SB(0, 0), b2, voffB);
            PG8_BAR; PG8_WAIT_L(0); PG8_MMA(0, 1, At, B1); PG8_BAR;
            PG8_LDA(At, 0, 1); PG8_STAGE(PG8_SA(0, 0), a2, PG8_VA(seln, 0));
            PG8_BAR; PG8_WAIT_L(0); PG8_MMA(1, 0, At, B0); PG8_BAR; PG8_SCHED;
            PG8_STAGE(PG8_SB(0, 1), b2 + hstep, voffB);
            PG8_WAIT_V(6); PG8_BAR; PG8_MMA(1, 1, At, B1); PG8_BAR;
            PG8_LDB(B0, 1, 0); PG8_SCHED; PG8_LDA(At, 1, 0); PG8_STAGE(PG8_SA(0, 1), a2 + hstepA, PG8_VA(seln, 1));
            PG8_WAIT_L(8); PG8_BAR; PG8_WAIT_L(0); PG8_MMA(0, 0, At, B0); PG8_BAR; PG8_SCHED;
            PG8_LDB(B1, 1, 1); PG8_STAGE(PG8_SB(1, 0), b3, voffB);
            PG8_BAR; PG8_WAIT_L(0); PG8_MMA(0, 1, At, B1); PG8_BAR;
            PG8_LDA(At, 1, 1); PG8_STAGE(PG8_SA(1, 0), a3, PG8_VA(seln, 0));
            PG8_BAR; PG8_WAIT_L(0); PG8_MMA(1, 0, At, B0); PG8_BAR; PG8_SCHED;
            PG8_STAGE(PG8_SB(1, 1), b3 + hstep, voffB);
            PG8_WAIT_V(6); PG8_BAR; PG8_MMA(1, 1, At, B1); PG8_BAR;
            }
        }
        if constexpr (ALIGN_EPI) { if (wr == 0) PG8_BAR; }
        E(acc, cur, wr, wc, fr, fq);
        if (!has_next) break;
#pragma unroll
        for (int a = 0; a < 2; ++a)
#pragma unroll
            for (int b = 0; b < 2; ++b)
#pragma unroll
                for (int m = 0; m < 4; ++m)
#pragma unroll
                    for (int n = 0; n < 2; ++n) acc[a][b][m][n] = (f32x4){0.f, 0.f, 0.f, 0.f};
        cur = nxt; cA = nA; cB = nB; ++ui;
        if constexpr (GATHER) { voffGc[0][0] = voffGn[0][0]; voffGc[0][1] = voffGn[0][1]; voffGc[1][0] = voffGn[1][0]; voffGc[1][1] = voffGn[1][1]; }
        if constexpr (ALIGN_EPI) { if (wr == 1) PG8_BAR; }
    }
    PG8_WAIT_V(0);
    if constexpr (!ALIGN_EPI) { if (wr == 0) PG8_BAR; }
    PG8_BAR;
#undef PG8_SA
#undef PG8_GOFF
#undef PG8_VA
#undef PG8_SB
#undef PG8_STAGE
#undef PG8_LDA
#undef PG8_LDB
#undef PG8_MMA
#undef PG8_WAIT_V
#undef PG8_WAIT_L
#undef PG8_BAR
#undef PG8_SCHED
}

DI unsigned q8(float x) { return (unsigned)fmaxf(255.f * sigmoidf_(x) + 0.5f, 1.f); }
DI float ub(unsigned w, int j) { return (float)((w >> (8 * j)) & 0xffu); }
struct EpiIn {
    static constexpr bool PERM = true; static constexpr int MID_T = -1;
    bf16* PR; bf16* PT; unsigned char* Gq; const float* bmerge;
    __device__ __forceinline__ void operator()(const f32x4 (&acc)[2][2][4][2], const Unit& u, int wr, int wc, int fr, int fq) const {
        const int row0 = u.pm * BM + wr * 64 + fr; const int pn = u.pn;
        if (pn >= 16) {
            const int col0 = (pn - 16) * BM + wc * 32 + 8 * fq;
            f32x4 bv[2][2];
#pragma unroll
            for (int bj = 0; bj < 2; ++bj)
#pragma unroll
                for (int n = 0; n < 2; ++n) bv[bj][n] = *(const f32x4*)(bmerge + col0 + bj * HALF + 4 * n);
            unsigned char* gp = Gq + (size_t)row0 * G_COLS + (pn - 16) * 256 + wc * 64 + fq * 16;
#pragma unroll
            for (int ai = 0; ai < 2; ++ai)
#pragma unroll
                for (int m = 0; m < 4; ++m) { unsigned w[4];
#pragma unroll
                    for (int bj = 0; bj < 2; ++bj)
#pragma unroll
                        for (int n = 0; n < 2; ++n) { const f32x4 v = acc[ai][bj][m][n] + bv[bj][n]; w[bj * 2 + n] = q8(v[0]) | (q8(v[1]) << 8) | (q8(v[2]) << 16) | (q8(v[3]) << 24); }
                    *(v4u*)(gp + (size_t)(ai * HALF + m * 16) * G_COLS) = (v4u){w[0], w[1], w[2], w[3]}; }
            return; }
        bf16* base; int ldc, colt;
        if (pn < 7) { base = PR; ldc = RW_COLS; colt = pn * BM; } else { base = PT; ldc = AT_COLS; colt = (pn - 7) * BM; }
        const int col0 = colt + wc * 32 + 8 * fq;
#pragma unroll
        for (int ai = 0; ai < 2; ++ai)
#pragma unroll
            for (int m = 0; m < 4; ++m) { bf16* rowp = base + (size_t)(row0 + ai * HALF + m * 16) * ldc + col0;
#pragma unroll
                for (int bj = 0; bj < 2; ++bj) { const f32x4 v0 = acc[ai][bj][m][0], v1 = acc[ai][bj][m][1];
                    v4u w; w.x = pk2(v0[0], v0[1]); w.y = pk2(v0[2], v0[3]); w.z = pk2(v1[0], v1[1]); w.w = pk2(v1[2], v1[3]);
                    *(v4u*)(rowp + bj * HALF) = w; } }
    }
};
struct EpiMix2 {
    static constexpr bool PERM = true; static constexpr int MID_T = 8;
    const unsigned char* Gq; bf16* Zout;
    __device__ __forceinline__ void mid(f32x4 (&acc)[2][2][4][2], const Unit& u, int wr, int wc, int fr, int fq) const {
        int row0 = u.pm * BM + wr * 64 + fr; LAUNDER(row0);
        const unsigned char* gp = Gq + u.pn * 256 + wc * 64 + fq * 16;
#pragma unroll
        for (int ai = 0; ai < 2; ++ai)
#pragma unroll
            for (int m = 0; m < 4; ++m) { const size_t r = (size_t)(row0 + ai * HALF + m * 16);
                const v4u ga = *(const v4u*)(gp + r * G_COLS), gb = *(const v4u*)(gp + r * G_COLS + 1024);
                const unsigned aw[4] = {ga.x, ga.y, ga.z, ga.w}, bw[4] = {gb.x, gb.y, gb.z, gb.w};
#pragma unroll
                for (int bj = 0; bj < 2; ++bj)
#pragma unroll
                    for (int n = 0; n < 2; ++n)
#pragma unroll
                        for (int j = 0; j < 4; ++j) acc[ai][bj][m][n][j] *= ub(aw[bj * 2 + n], j) * __builtin_amdgcn_rcpf(ub(bw[bj * 2 + n], j));
                __builtin_amdgcn_sched_barrier(0); }
    }
    __device__ __forceinline__ void operator()(const f32x4 (&acc)[2][2][4][2], const Unit& u, int wr, int wc, int fr, int fq) const {
        const int row0 = u.pm * BM + wr * 64 + fr, col0 = u.pn * BM + wc * 32 + 8 * fq;
        const unsigned char* gp = Gq + u.pn * 256 + wc * 64 + fq * 16 + 1024;
#pragma unroll
        for (int ai = 0; ai < 2; ++ai)
#pragma unroll
            for (int m = 0; m < 4; ++m) { const size_t r = (size_t)(row0 + ai * HALF + m * 16);
                const v4u gb = *(const v4u*)(gp + r * G_COLS); const unsigned bw[4] = {gb.x, gb.y, gb.z, gb.w};
#pragma unroll
                for (int bj = 0; bj < 2; ++bj) { const int c = col0 + bj * HALF;
                    const f32x4 v0 = acc[ai][bj][m][0] * (1.f / 255.f), v1 = acc[ai][bj][m][1] * (1.f / 255.f); const unsigned b0 = bw[bj * 2], b1 = bw[bj * 2 + 1];
                    v4u w; w.x = pk2(v0[0] * ub(b0, 0), v0[1] * ub(b0, 1)); w.y = pk2(v0[2] * ub(b0, 2), v0[3] * ub(b0, 3));
                    w.z = pk2(v1[0] * ub(b1, 0), v1[1] * ub(b1, 1)); w.w = pk2(v1[2] * ub(b1, 2), v1[3] * ub(b1, 3));
                    *(v4u*)(Zout + r * DM + c) = w; } }
    }
};
struct EpiRes {
    static constexpr bool PERM = true; static constexpr int MID_T = -1;
    const float* X; bf16* O;
    __device__ __forceinline__ void operator()(const f32x4 (&acc)[2][2][4][2], const Unit& u, int wr, int wc, int fr, int fq) const {
        const int row0 = u.pm * BM + wr * 64 + fr, col0 = u.pn * BM + wc * 32 + 8 * fq;
#pragma unroll
        for (int ai = 0; ai < 2; ++ai)
#pragma unroll
            for (int m = 0; m < 4; ++m) { const size_t off = (size_t)(row0 + ai * HALF + m * 16) * DM + col0;
#pragma unroll
                for (int bj = 0; bj < 2; ++bj) { const f32x4 x0 = *(const f32x4*)(X + off + bj * HALF) + acc[ai][bj][m][0], x1 = *(const f32x4*)(X + off + bj * HALF + 4) + acc[ai][bj][m][1];
                    v4u w; w.x = pk2(x0[0], x0[1]); w.y = pk2(x0[2], x0[3]); w.z = pk2(x1[0], x1[1]); w.w = pk2(x1[2], x1[3]);
                    *(v4u*)(O + off + bj * HALF) = w; } }
    }
};
struct EpiSwiglu {
    static constexpr bool PERM = false; static constexpr int MID_T = -1;
    bf16* H; const float* lr; const LAS int* tab;
    __device__ __forceinline__ void operator()(const f32x4 (&acc)[2][2][4][2], const Unit& u, int wr, int wc, int fr, int fq) const {
        const int rl0 = wr * 64 + fr, row0 = u.pm * BM + rl0, col0 = u.pn * 128 + wc * 16 + 4 * fq, slot0 = (u.pm - tab[u.e]) * 256 + rl0, cnt = tab[33 + u.e];
#pragma unroll
        for (int ai = 0; ai < 2; ++ai)
#pragma unroll
            for (int m = 0; m < 4; ++m) { bf16* rowp = H + (size_t)(row0 + ai * HALF + m * 16) * DEXP + col0;
                const int slot = slot0 + ai * HALF + m * 16; const float rs = slot < cnt ? lr[(size_t)u.e * NTOK + slot] : 0.f;
#pragma unroll
                for (int bj = 0; bj < 2; ++bj) { const f32x4 gt = acc[ai][bj][m][0] * rs, up = acc[ai][bj][m][1] * rs; f32x4 o;
#pragma unroll
                    for (int j = 0; j < 4; ++j) o[j] = gt[j] * sigmoidf_(gt[j]) * up[j];
                    v2u w; w.x = pk2(o[0], o[1]); w.y = pk2(o[2], o[3]);
                    *(v2u*)(rowp + bj * 64) = w; } }
    }
};
struct EpiStoreY {
    static constexpr bool PERM = true; static constexpr int MID_T = -1;
    const int* ltok; const float* lw; const LAS int* tab; int* inv; bf16* Y;
    __device__ __forceinline__ void operator()(const f32x4 (&acc)[2][2][4][2], const Unit& u, int wr, int wc, int fr, int fq) const {
        const int rl0 = wr * 64 + fr, col0 = u.pn * BM + wc * 32 + 8 * fq, slot0 = (u.pm - tab[u.e]) * 256, cnt = tab[33 + u.e];
#pragma unroll
        for (int ai = 0; ai < 2; ++ai)
#pragma unroll
            for (int m = 0; m < 4; ++m) { const int rl = rl0 + ai * HALF + m * 16, slot = slot0 + rl, r = u.pm * BM + rl; const bool ok = slot < cnt;
                const int t2 = ok ? ltok[(size_t)u.e * NTOK + slot] : -1; const float w = ok ? lw[(size_t)u.e * NTOK + slot] : 0.f;
                if (ok && u.pn == 0 && wc == 0 && fq == 0) inv[t2] = r;
                bf16* rowp = Y + (size_t)r * DM + col0;
#pragma unroll
                for (int bj = 0; bj < 2; ++bj) { const f32x4 v0 = acc[ai][bj][m][0] * w, v1 = acc[ai][bj][m][1] * w;
                    v4u o; o.x = pk2(v0[0], v0[1]); o.y = pk2(v0[2], v0[3]); o.z = pk2(v1[0], v1[1]); o.w = pk2(v1[2], v1[3]);
                    *(v4u*)(rowp + bj * HALF) = o; } }
    }
};
}

#define XB_TMO      128
#define XB_XCNT(j)  (256  + 64 * (j))
#define XB_XSUB(j)  (1280 + 64 * (j))
#define XB_XGEN(j)  (2304 + 64 * (j))
#define XB_TOP      3328
#define XB_TOPGEN   3392
#define XCD_BAR_WORDS 3456
#define XB_SPIN_CAP (1u << 18)
__device__ __forceinline__ unsigned xb_ld(unsigned* p)              { return __hip_atomic_load(p, __ATOMIC_RELAXED, __HIP_MEMORY_SCOPE_AGENT); }
__device__ __forceinline__ unsigned xb_add(unsigned* p, unsigned v) { return __hip_atomic_fetch_add(p, v, __ATOMIC_RELAXED, __HIP_MEMORY_SCOPE_AGENT); }
__device__ __forceinline__ unsigned xb_xcc_id() { return (unsigned)__builtin_amdgcn_s_getreg((3 << 11) | 20) & 0xFu; }
#define XB_SPIN(cond, bar) do { unsigned _sp = 0; while (cond) { __builtin_amdgcn_s_sleep(1); \
    if ((++_sp & 255u) == 0u) { if (xb_ld(&(bar)[XB_TMO])) break; if (_sp > XB_SPIN_CAP) { atomicAdd(&(bar)[XB_TMO], 1u); break; } } } } while (0)
struct XcdBarrier { unsigned* bar; unsigned x; volatile LAS unsigned* st; };
__device__ __forceinline__ XcdBarrier xcd_barrier_post(unsigned* bar, volatile LAS unsigned* st) {
    XcdBarrier b; b.bar = bar; b.x = xb_xcc_id(); b.st = st;
    if (threadIdx.x == 0) (void)xb_add(&bar[XB_XCNT(b.x)], 1u);
    return b;
}
__device__ __forceinline__ void xcd_barrier_complete(unsigned* bar, unsigned x, unsigned& nloc, unsigned& nx) {
    const unsigned G = gridDim.x * gridDim.y * gridDim.z;
    unsigned sum, cnt, mine, sp = 0u;
    for (;;) {
        sum = 0u; cnt = 0u; mine = 0u;
#pragma unroll
        for (unsigned j = 0; j < 16; ++j) { const unsigned c = xb_ld(&bar[XB_XCNT(j)]); sum += c; cnt += (c > 0u) ? 1u : 0u; mine = (j == x) ? c : mine; }
        if (sum == G) break;
        __builtin_amdgcn_s_sleep(1);
        if ((++sp & 255u) == 0u) { if (xb_ld(&bar[XB_TMO])) break; if (sp > XB_SPIN_CAP) { atomicAdd(&bar[XB_TMO], 1u); break; } }
    }
    nloc = mine > 0u ? mine : 1u; nx = cnt > 0u ? cnt : 1u;
}
__device__ __forceinline__ void xcd_barrier(const XcdBarrier& b) {
    asm volatile("s_waitcnt vmcnt(0)" ::: "memory");
    __syncthreads();
    if (threadIdx.x == 0) {
        unsigned* bar = b.bar;
        __builtin_amdgcn_s_waitcnt(0);
        unsigned nloc = b.st[0], nx = b.st[1];
        if (nloc == 0u) { xcd_barrier_complete(bar, b.x, nloc, nx); b.st[0] = nloc; b.st[1] = nx; }
        const unsigned old = xb_add(&bar[XB_XSUB(b.x)], 1u);
        const unsigned gen = old / nloc;
        if (old + 1u == (gen + 1u) * nloc) {
            __builtin_amdgcn_fence(__ATOMIC_RELEASE, "agent");
            asm volatile("s_waitcnt vmcnt(0)" ::: "memory");
            const unsigned og = xb_add(&bar[XB_TOP], 1u);
            const unsigned tg = og / nx;
            if (og + 1u == (tg + 1u) * nx) xb_add(&bar[XB_TOPGEN], 1u);
            else XB_SPIN(xb_ld(&bar[XB_TOPGEN]) == tg, bar);
            __builtin_amdgcn_fence(__ATOMIC_ACQUIRE, "agent");
            xb_add(&bar[XB_XGEN(b.x)], 1u);
            asm volatile("s_waitcnt vmcnt(0)" ::: "memory");
        } else {
            XB_SPIN(xb_ld(&bar[XB_XGEN(b.x)]) == gen, bar);
            __builtin_amdgcn_fence(__ATOMIC_ACQUIRE, "agent");
            asm volatile("s_waitcnt vmcnt(0)" ::: "memory");
        }
    }
    __syncthreads();
}

struct Args { const void* in[30]; float* out; unsigned char* ws; int ph_lo, ph_hi, li, variant; };
struct Frame {
    LAS unsigned char* lds; volatile LAS unsigned* MISC;
    int tid, lane, wave, G, bid, variant;
    unsigned char* ws;
};
enum { I_X = 0, I_POS, I_N1G, I_WIN, I_MUP, I_MUN, I_WD0, I_WDUP, I_AG0, I_AGUP, I_GUP, I_KK, I_KA, I_RK, I_GNW, I_GNB, I_WROUT, I_QNG, I_KNG, I_WAOUT, I_BMERGE, I_WOUT,
       I_N2G, I_WRG, I_BRG, I_WRE, I_BRE, I_WGATE, I_WUP, I_WDOWN };

template <class RowMap>
DI void transpose_item(const float* W, int K, int N, bf16* WT, const RowMap& rm, LAS float* scr, int item, int lane, int ldk = 0, int koff = 0, const float* rs = nullptr) {
    if (ldk == 0) ldk = K;
    const int nblk = N / 32, kb = item / nblk, nb = item % nblk, k0 = 64 * kb, n0 = 32 * nb;
#pragma unroll
    for (int i = 0; i < 8; ++i) { const int kk = 8 * i + (lane >> 3);
        const f32x4 v = *(const GAS f32x4*)(W + (size_t)(k0 + kk) * N + n0 + 4 * (lane & 7));
        LAS float* d = scr + kk * 33 + 4 * (lane & 7); d[0] = v[0]; d[1] = v[1]; d[2] = v[2]; d[3] = v[3]; }
    LDS_WAIT(); asm volatile("" ::: "memory");
    const int c = lane & 7;
    f32x4 ra = (f32x4){1.f, 1.f, 1.f, 1.f}, rb = ra; if (rs) { ra = *(const f32x4*)(rs + k0 + 8 * c); rb = *(const f32x4*)(rs + k0 + 8 * c + 4); }
#pragma unroll
    for (int j = 0; j < 4; ++j) { const int n = (lane >> 3) + 8 * j; const LAS float* s = scr + (8 * c) * 33 + n;
        v4u o; o.x = pk2(s[0 * 33] * ra[0], s[1 * 33] * ra[1]); o.y = pk2(s[2 * 33] * ra[2], s[3 * 33] * ra[3]); o.z = pk2(s[4 * 33] * rb[0], s[5 * 33] * rb[1]); o.w = pk2(s[6 * 33] * rb[2], s[7 * 33] * rb[3]);
        *(GAS v4u*)(WT + (size_t)rm(n0 + n) * ldk + koff + k0 + 8 * c) = o; }
    LDS_WAIT(); asm volatile("" ::: "memory");
}
struct RmId { DI int operator()(int n) const { return n; } };
struct RmGate { DI int operator()(int n) const { return 32 * (n >> 4) + (n & 15); } };
struct RmUp { DI int operator()(int n) const { return 32 * (n >> 4) + 16 + (n & 15); } };

DI void p0_prologue(Frame& F, const Args& a) {
    LAS float* scr = (LAS float*)(F.lds + F.wave * 16384);
    const int gw = F.bid * NWAVES + F.wave, NGW = F.G * NWAVES;
    unsigned char* ws = F.ws;
    constexpr int I_IN = (DM / 64) * (IN_COLS / 32), I_R = (512 / 64) * (DM / 32), I_A = (256 / 64) * (DM / 32), I_O = (DM / 64) * (DM / 32), I_G = (128 / 64) * (512 / 32), I_L = 512 / 32;
    constexpr int NITEMS = I_IN + I_R + I_A + I_O + I_G + 4 * I_L;
    for (int it = gw; it < NITEMS; it += NGW) {
        int r = it;
        if (r < I_IN) { transpose_item((const float*)a.in[I_WIN], DM, IN_COLS, (bf16*)(ws + WS_WIN_T), RmId(), scr, r, F.lane); continue; } r -= I_IN;
        if (r < I_R) { transpose_item((const float*)a.in[I_WROUT], 512, DM, (bf16*)(ws + WS_WR_T), RmId(), scr, r, F.lane, YC_COLS, 0); continue; } r -= I_R;
        if (r < I_A) { transpose_item((const float*)a.in[I_WAOUT], 256, DM, (bf16*)(ws + WS_WR_T), RmId(), scr, r, F.lane, YC_COLS, 512); continue; } r -= I_A;
        if (r < I_O) { transpose_item((const float*)a.in[I_WOUT], DM, DM, (bf16*)(ws + WS_WOUT_T), RmId(), scr, r, F.lane); continue; } r -= I_O;
        if (r < I_G) { transpose_item((const float*)a.in[I_GUP], 128, 512, (bf16*)(ws + WS_GUP_T), RmId(), scr, r, F.lane); continue; } r -= I_G;
        { const int d = r / I_L, rr = r % I_L;
          if (d < 2) transpose_item((const float*)a.in[I_WDUP] + (size_t)d * 64 * 512, 64, 512, (bf16*)(ws + WS_WUP_T) + (size_t)d * 512 * 64, RmId(), scr, rr, F.lane);
          else transpose_item((const float*)a.in[I_AGUP] + (size_t)(d - 2) * 64 * 512, 64, 512, (bf16*)(ws + WS_AUP_T) + (size_t)(d - 2) * 512 * 64, RmId(), scr, rr, F.lane); }
    }
    { const float* g2 = (const float*)a.in[I_N2G]; const float* wre = (const float*)a.in[I_WRE]; const float* wrg = (const float*)a.in[I_WRG];
      bf16* hi = (bf16*)(ws + WS_RT_HI); bf16* lo = (bf16*)(ws + WS_RT_LO);
      for (int i = F.bid * 512 + F.tid; i < 64 * DM; i += F.G * 512) { const int n = i / DM, k = i % DM;
          float v = 0.f; if (n < 32) v = g2[k] * wre[k * 32 + n]; else if (n < 36) v = g2[k] * wrg[k * 4 + (n - 32)];
          const unsigned h = pk2(v, 0.f) & 0xffffu; const float hf = bflo(h); hi[i] = (bf16)h; lo[i] = (bf16)(pk2(v - hf, 0.f) & 0xffffu); } }
    { const float* x = (const float*)a.in[I_X]; const float* g1 = (const float*)a.in[I_N1G]; bf16* hb = (bf16*)(ws + WS_HB);
      f32x4 gv[4];
#pragma unroll
      for (int j = 0; j < 4; ++j) gv[j] = ((const f32x4*)g1)[F.lane + 64 * j];
      for (int m = gw; m < NTOK; m += NGW) {
          const GAS f32x4* xr = (const GAS f32x4*)(x + (size_t)m * DM) + F.lane; f32x4 v[4]; float s = 0.f;
#pragma unroll
          for (int j = 0; j < 4; ++j) { v[j] = xr[64 * j]; s += (v[j].x * v[j].x + v[j].y * v[j].y) + (v[j].z * v[j].z + v[j].w * v[j].w); }
          const float rstd = 1.f / sqrtf(wave_sum(s) * (1.f / DM) + NORM_EPS);
          GAS v2u* o8 = (GAS v2u*)(hb + (size_t)m * DM) + F.lane;
#pragma unroll
          for (int j = 0; j < 4; ++j) { v2u w; w.x = pk2(v[j].x * rstd * gv[j].x, v[j].y * rstd * gv[j].y); w.y = pk2(v[j].z * rstd * gv[j].z, v[j].w * rstd * gv[j].w); o8[64 * j] = w; } } }
}

DI void p1b_qkprep(Frame& F, const Args& a) {
    bf16* PT = (bf16*)(F.ws + WS_PT);
    const int* pos = (const int*)a.in[I_POS];
    const int sub = F.lane & 7;
    const f32x4 qg0 = ((const f32x4*)a.in[I_QNG])[2 * sub], qg1 = ((const f32x4*)a.in[I_QNG])[2 * sub + 1];
    const f32x4 kg0 = ((const f32x4*)a.in[I_KNG])[2 * sub], kg1 = ((const f32x4*)a.in[I_KNG])[2 * sub + 1];
    constexpr float IF2PI[8] = {0.15915494309189535f, 0.03086376340470123f, 0.005985185712713705f, 0.001160663641240061f, 0.00022507907903927653f, 4.364795279280289e-05f, 8.464330808241401e-06f, 1.6414262627950345e-06f};
    const int nvec = NTOK * 24, stride = (F.G * 512) >> 3;
    for (int vid0 = (F.bid * 512 + F.tid) >> 3; vid0 < nvec; vid0 += 4 * stride) {
        v4u raw[4]; int pv[4];
#pragma unroll
        for (int u = 0; u < 4; ++u) { const int vid = vid0 + u * stride; if (vid < nvec) { const int tok = vid / 24, v = vid % 24; const bool isq = v < 12; const int head = isq ? v : v - 12;
            raw[u] = *(const v4u*)(PT + (size_t)tok * AT_COLS + (isq ? 0 : 768) + head * 64 + sub * 8); pv[u] = pos[tok]; } else { raw[u] = (v4u){0u, 0u, 0u, 0u}; pv[u] = 0; } }
#pragma unroll
        for (int u = 0; u < 4; ++u) { const int vid = vid0 + u * stride; const bool act = vid < nvec; const int vv = act ? vid : 0;
            const int tok = vv / 24, v = vv % 24; const bool isq = v < 12; const int head = isq ? v : v - 12;
            bf16* p = PT + (size_t)tok * AT_COLS + (isq ? 0 : 768) + head * 64 + sub * 8;
            float y[8] = {bflo(raw[u].x), bfhi(raw[u].x), bflo(raw[u].y), bfhi(raw[u].y), bflo(raw[u].z), bfhi(raw[u].z), bflo(raw[u].w), bfhi(raw[u].w)};
            float ss = 0.f;
#pragma unroll
            for (int j = 0; j < 8; ++j) ss += y[j] * y[j];
            ss += __shfl_xor(ss, 1); ss += __shfl_xor(ss, 2); ss += __shfl_xor(ss, 4);
            const float rstd = 1.f / sqrtf(ss * (1.f / 64.f) + NORM_EPS);
            const f32x4 g0 = isq ? qg0 : kg0, g1 = isq ? qg1 : kg1;
#pragma unroll
            for (int j = 0; j < 4; ++j) { y[j] = y[j] * rstd * g0[j]; y[4 + j] = y[4 + j] * rstd * g1[j]; }
            const float pf = (float)pv[u];
#pragma unroll
            for (int j = 0; j < 8; ++j) {
                const float partner = __shfl_xor(y[j], 1);
                float r = pf * IF2PI[j]; r = r - floorf(r);
                const float sn = __builtin_amdgcn_sinf(r), cs = __builtin_amdgcn_cosf(r);
                const float rot = y[j] * cs + (sub == 0 ? -partner : partner) * sn;
                if (sub < 2) y[j] = rot;
            }
            if (isq) {
#pragma unroll
                for (int j = 0; j < 8; ++j) y[j] *= 0.18033688011112042f;
            }
            v4u o; o.x = pk2(y[0], y[1]); o.y = pk2(y[2], y[3]); o.z = pk2(y[4], y[5]); o.w = pk2(y[6], y[7]);
            if (act && !VAR(64)) *(v4u*)p = o; }
    }
}

DI void p1c_preshift(Frame& F, const Args& a) {
    if (F.tid >= 448) return;
    const bf16* PR = (const bf16*)(F.ws + WS_PR); bf16* PS = (bf16*)a.out;
    const int rsub = F.tid / 224, cg8 = (F.tid % 224) * 8;
    const float* mup = (const float*)a.in[I_MUP] + cg8; const float* mun = (const float*)a.in[I_MUN] + cg8;
    const f32x4 mp0 = *(const f32x4*)mup, mp1 = *(const f32x4*)(mup + 4), mn0 = *(const f32x4*)mun, mn1 = *(const f32x4*)(mun + 4);
    const int mode = (cg8 >= 1536 && cg8 < 1600) ? 1 : (cg8 >= 1664 ? 2 : 0);
    const int rows_per = NTOK / F.G;
    for (int r0 = F.bid * rows_per + rsub; r0 < (F.bid + 1) * rows_per; r0 += 8) {
        v4u cur[4], prv[4], nxt[4];
#pragma unroll
        for (int u = 0; u < 4; ++u) { const int row = r0 + 2 * u, t = row % SEQ; const bf16* p = PR + (size_t)row * RW_COLS + cg8;
            cur[u] = *(const v4u*)p; prv[u] = *(const v4u*)(p - (t > 0 ? RW_COLS : 0)); nxt[u] = *(const v4u*)(p + (t < SEQ - 1 ? RW_COLS : 0)); }
#pragma unroll
        for (int u = 0; u < 4; ++u) { const int row = r0 + 2 * u, t = row % SEQ; const float fp = t > 0 ? 1.f : 0.f, fn = t < SEQ - 1 ? 1.f : 0.f;
            const unsigned cw[4] = {cur[u].x, cur[u].y, cur[u].z, cur[u].w}, pw[4] = {prv[u].x, prv[u].y, prv[u].z, prv[u].w}, nw[4] = {nxt[u].x, nxt[u].y, nxt[u].z, nxt[u].w};
            float y[8];
#pragma unroll
            for (int j = 0; j < 4; ++j) {
                const float c0 = bflo(cw[j]), c1 = bfhi(cw[j]), p0 = bflo(pw[j]) * fp, p1 = bfhi(pw[j]) * fp, n0 = bflo(nw[j]) * fn, n1 = bfhi(nw[j]) * fn;
                const float m0 = j < 2 ? mp0[2 * j] : mp1[2 * j - 4], m1 = j < 2 ? mp0[2 * j + 1] : mp1[2 * j - 3], q0 = j < 2 ? mn0[2 * j] : mn1[2 * j - 4], q1 = j < 2 ? mn0[2 * j + 1] : mn1[2 * j - 3];
                y[2 * j] = c0 + m0 * (p0 - c0) + q0 * (n0 - c0); y[2 * j + 1] = c1 + m1 * (p1 - c1) + q1 * (n1 - c1); }
            if (mode == 1) {
#pragma unroll
                for (int j = 0; j < 8; ++j) y[j] = 1.f - 2.f * __builtin_amdgcn_rcpf(1.f + __builtin_amdgcn_exp2f(2.88539008f * y[j])); }
            if (mode == 2) {
#pragma unroll
                for (int j = 0; j < 8; ++j) y[j] = sigmoidf_(y[j]); }
            v4u o; o.x = pk2(y[0], y[1]); o.y = pk2(y[2], y[3]); o.z = pk2(y[4], y[5]); o.w = pk2(y[6], y[7]);
            if (!VAR(64)) *(v4u*)(PS + (size_t)row * RW_COLS + cg8) = o; }
    }
}

DI bf16x8 pack8(float a0, float a1, float a2, float a3, float a4, float a5, float a6, float a7) {
    v4u p; p.x = pk2(a0, a1); p.y = pk2(a2, a3); p.z = pk2(a4, a5); p.w = pk2(a6, a7); return __builtin_bit_cast(bf16x8, p);
}
DI void attn_unit(Frame& F, int b, int hh, int span) {
    const bf16* PT = (const bf16*)(F.ws + WS_PT); bf16* Og = (bf16*)(F.ws + WS_OG); float* Lse = (float*)(F.ws + WS_LSE); bf16* YA = (bf16*)(F.ws + WS_YA);
    LAS unsigned char* vbuf = F.lds + F.wave * 9216;
    const int lane = F.lane, n = lane & 31, half = lane >> 5;
    const int T0 = span * 512; const size_t rowbase = (size_t)b * SEQ;
    for (int su = F.wave; su < 48; su += 8) {
        const int g = su >> 4, s16 = su & 15, dsh = 2 * g, L = SEQ >> dsh, per_r = 16 >> dsh;
        const int r = s16 / per_r, sb = s16 % per_r, l0 = (T0 >> dsh) + sb * 32, head = 4 * g + hh;
        const int tq = ((l0 + n) << dsh) + r;
        const bf16* qp = PT + (rowbase + tq) * AT_COLS + head * 64 + 8 * half;
        bf16x8 qf[4];
#pragma unroll
        for (int kk = 0; kk < 4; ++kk) qf[kk] = *(const bf16x8*)(qp + 16 * kk);
        f32x16 o0, o1;
#pragma unroll
        for (int i = 0; i < 16; ++i) { o0[i] = 0.f; o1[i] = 0.f; }
        float mrun = -1e30f, lrun = 0.f;
        const int kb_lo = l0 >= 64 ? 0 : (64 - l0) >> 5, kb_hi = min(4, (L + 32 - l0) >> 5);
        bf16x8 kfn[4]; v4u vvn[4];
#define ATT_PRELOAD(kbx) do { const int lk0_ = l0 - 64 + 32 * (kbx); \
            _Pragma("unroll") for (int j = 0; j < 4; ++j) { const int idx = lane + 64 * j, key = idx >> 3, ch = idx & 7; const int tk_ = ((lk0_ + key) << dsh) + r; \
                vvn[j] = *(const v4u*)(PT + (rowbase + tk_) * AT_COLS + 1536 + head * 64 + ch * 8); } \
            const int tk2_ = ((lk0_ + n) << dsh) + r; const bf16* kp_ = PT + (rowbase + tk2_) * AT_COLS + 768 + head * 64 + 8 * half; \
            _Pragma("unroll") for (int kk = 0; kk < 4; ++kk) kfn[kk] = *(const bf16x8*)(kp_ + 16 * kk); } while (0)
        ATT_PRELOAD(kb_lo);
        for (int kb = kb_lo; kb <= kb_hi; ++kb) {
            LAS unsigned char* vb = vbuf + (kb & 1) * 4608;
            bf16x8 kf[4];
#pragma unroll
            for (int j = 0; j < 4; ++j) { const int idx = lane + 64 * j, key = idx >> 3, ch = idx & 7; *(LAS v4u*)(vb + key * 144 + ch * 16) = vvn[j]; kf[j] = kfn[j]; }
            if (kb < kb_hi) ATT_PRELOAD(kb + 1);
            f32x16 s;
#pragma unroll
            for (int i = 0; i < 16; ++i) s[i] = 0.f;
#pragma unroll
            for (int kk = 0; kk < 4; ++kk) s = MFMA32(kf[kk], qf[kk], s);
            if (kb == 0) {
#pragma unroll
                for (int i = 0; i < 16; ++i) if (crow(i, half) < n) s[i] = -1e30f; }
            if (kb == 4) {
#pragma unroll
                for (int i = 0; i < 16; ++i) if (crow(i, half) > n) s[i] = -1e30f; }
            float mx = s[0];
#pragma unroll
            for (int i = 1; i < 16; ++i) mx = fmaxf(mx, s[i]);
            mx = fmaxf(mx, __shfl_xor(mx, 32));
            const float mnew = fmaxf(mrun, mx), alpha = __builtin_amdgcn_exp2f(mrun - mnew); mrun = mnew;
            float ps = 0.f;
#pragma unroll
            for (int i = 0; i < 16; ++i) { s[i] = __builtin_amdgcn_exp2f(s[i] - mnew); ps += s[i]; }
            lrun = lrun * alpha + ps;
#pragma unroll
            for (int i = 0; i < 16; ++i) { o0[i] *= alpha; o1[i] *= alpha; }
            const bf16x8 pf0 = pack8(s[0], s[1], s[2], s[3], s[4], s[5], s[6], s[7]), pf1 = pack8(s[8], s[9], s[10], s[11], s[12], s[13], s[14], s[15]);
#pragma unroll
            for (int g2 = 0; g2 < 2; ++g2) {
                bf16x8 vf0, vf1;
#pragma unroll
                for (int si = 0; si < 8; ++si) { const int key = 16 * g2 + (si & 3) + 8 * (si >> 2) + 4 * half;
                    vf0[si] = *(const LAS short*)(vb + key * 144 + n * 2); vf1[si] = *(const LAS short*)(vb + key * 144 + (n + 32) * 2); }
                o0 = MFMA32(vf0, g2 ? pf1 : pf0, o0); o1 = MFMA32(vf1, g2 ? pf1 : pf0, o1);
            }
        }
#undef ATT_PRELOAD
        const float ltot = lrun + __shfl_xor(lrun, 32), inv = 1.f / ltot;
        bf16* op = Og + ((size_t)g * NTOK + rowbase + tq) * 256 + hh * 64;
#pragma unroll
        for (int q4 = 0; q4 < 4; ++q4) { const int d0 = 8 * q4 + 4 * half;
            v2u w0; w0.x = pk2(o0[4 * q4] * inv, o0[4 * q4 + 1] * inv); w0.y = pk2(o0[4 * q4 + 2] * inv, o0[4 * q4 + 3] * inv); *(v2u*)(op + d0) = w0;
            v2u w1; w1.x = pk2(o1[4 * q4] * inv, o1[4 * q4 + 1] * inv); w1.y = pk2(o1[4 * q4 + 2] * inv, o1[4 * q4 + 3] * inv); *(v2u*)(op + 32 + d0) = w1; }
        if (half == 0) Lse[((size_t)g * NTOK + rowbase + tq) * 4 + hh] = mrun + __builtin_amdgcn_logf(ltot);
    }
    VM_WAIT(); __syncthreads();
    __builtin_amdgcn_fence(__ATOMIC_ACQUIRE, "agent"); VM_WAIT();
    {
        const size_t tok = rowbase + T0 + F.tid;
        const float l0 = Lse[(0 * (size_t)NTOK + tok) * 4 + hh], l1 = Lse[(1 * (size_t)NTOK + tok) * 4 + hh], l2 = Lse[(2 * (size_t)NTOK + tok) * 4 + hh];
        const float mx = fmaxf(l0, fmaxf(l1, l2));
        float a0 = __builtin_amdgcn_exp2f(l0 - mx), a1 = __builtin_amdgcn_exp2f(l1 - mx), a2 = __builtin_amdgcn_exp2f(l2 - mx);
        const float inv = 1.f / (a0 + a1 + a2); a0 *= inv; a1 *= inv; a2 *= inv;
        const bf16* p0 = Og + (0 * (size_t)NTOK + tok) * 256 + hh * 64; const bf16* p1 = Og + (1 * (size_t)NTOK + tok) * 256 + hh * 64; const bf16* p2 = Og + (2 * (size_t)NTOK + tok) * 256 + hh * 64;
        bf16* yo = YA + tok * 256 + hh * 64;
#pragma unroll
        for (int c = 0; c < 8; ++c) { const v4u x0 = *(const v4u*)(p0 + 8 * c), x1 = *(const v4u*)(p1 + 8 * c), x2 = *(const v4u*)(p2 + 8 * c); v4u o;
            o.x = pk2(a0 * bflo(x0.x) + a1 * bflo(x1.x) + a2 * bflo(x2.x), a0 * bfhi(x0.x) + a1 * bfhi(x1.x) + a2 * bfhi(x2.x));
            o.y = pk2(a0 * bflo(x0.y) + a1 * bflo(x1.y) + a2 * bflo(x2.y), a0 * bfhi(x0.y) + a1 * bfhi(x1.y) + a2 * bfhi(x2.y));
            o.z = pk2(a0 * bflo(x0.z) + a1 * bflo(x1.z) + a2 * bflo(x2.z), a0 * bfhi(x0.z) + a1 * bfhi(x1.z) + a2 * bfhi(x2.z));
            o.w = pk2(a0 * bflo(x0.w) + a1 * bflo(x1.w) + a2 * bflo(x2.w), a0 * bfhi(x0.w) + a1 * bfhi(x1.w) + a2 * bfhi(x2.w));
            *(v4u*)(yo + 8 * c) = o; }
    }
    __syncthreads();
}

DI f32x4 ld4bf(const bf16* p) { const v2u u = *(const v2u*)p; return (f32x4){bflo(u.x), bfhi(u.x), bflo(u.y), bfhi(u.y)}; }
DI f32x4 shift4(const bf16* prow, bool hasp, bool hasn, const float* mup, const float* mun, int col) {
    const f32x4 u = ld4bf(prow + col);
    const float mp = hasp ? 1.f : 0.f, mn = hasn ? 1.f : 0.f;
    const f32x4 up = ld4bf(prow + (hasp ? -RW_COLS : 0) + col) * mp, un = ld4bf(prow + (hasn ? RW_COLS : 0) + col) * mn;
    return u + *(const f32x4*)(mup + col) * (up - u) + *(const f32x4*)(mun + col) * (un - u);
}
DI float red8(float v) {
    v += __builtin_bit_cast(float, __builtin_amdgcn_update_dpp(0, __builtin_bit_cast(int, v), 0xB1, 0xF, 0xF, true));
    v += __builtin_bit_cast(float, __builtin_amdgcn_update_dpp(0, __builtin_bit_cast(int, v), 0x4E, 0xF, 0xF, true));
    v += __builtin_bit_cast(float, __builtin_amdgcn_update_dpp(0, __builtin_bit_cast(int, v), 0x141, 0xF, 0xF, true));
    return v;
}
constexpr int SC_CH = 32, SC_NCH = SEQ / SC_CH;
constexpr int FP = 68, ARR_SZ = 32 * 144, ARRBUF_SZ = 5 * ARR_SZ + 32 * FP * 4;
#define SC_ARR(ab, arr) (F.lds + (ab) * ARRBUF_SZ + (arr) * ARR_SZ)
#define SC_E2(ab) ((LAS float*)(F.lds + (ab) * ARRBUF_SZ + 5 * ARR_SZ))
constexpr int SCL_CONST = 2 * ARRBUF_SZ, SCL_IMG = 65536, SCL_IMGSZ = 35072, SCL_MABT = SCL_IMG + 2 * SCL_IMGSZ;
constexpr int IM_AT = 0, IM_RT = 4608, IM_BT = 9216, IM_KT = 14336, IM_VT = 19456, IM_MAK = 24576, IM_NB = 27136, IM_NK = 29696, IM_T = 32256, IM_GC = 34816;
constexpr int P144 = 144, P80 = 80;
#define SC_IMG(ib) (F.lds + SCL_IMG + (ib) * SCL_IMGSZ)
#define SC_CONST ((LAS float*)(F.lds + SCL_CONST))
DI f32x4 up4(v2u u) { return (f32x4){bflo(u.x), bfhi(u.x), bflo(u.y), bfhi(u.y)}; }
template <int KIND> struct PrepRaw { bf16x8 xf[4]; v2u ga[4], gb[4], gc[4]; };
template <int KIND>
DI void prep_load(Frame& F, const bf16* PS, int b, int h, int dir, int c, PrepRaw<KIND>& R) {
    const int q = F.wave - 4, jt = q & 1, lane = F.lane, n = lane & 31, half = lane >> 5;
    const int tl = SC_CH * c + n, t = dir ? (SEQ - 1 - tl) : tl, hc = h * 64;
    const bf16* pr = PS + ((size_t)b * SEQ + t) * RW_COLS;
#pragma unroll
    for (int kk = 0; kk < 4; ++kk) R.xf[kk] = *(const bf16x8*)(pr + (KIND ? 1600 : 1536) + 16 * kk + 8 * half);
#pragma unroll
    for (int q4 = 0; q4 < 4; ++q4) { const int j = 32 * jt + 8 * q4 + 4 * half, jo = 32 * (1 - jt) + 8 * q4 + 4 * half;
        R.ga[q4] = *(const v2u*)(pr + (KIND ? 512 : 0) + hc + j);
        R.gb[q4] = *(const v2u*)(pr + (KIND ? 512 + hc + jo : 1024 + hc + j));
        if (KIND) R.gc[q4] = *(const v2u*)(pr + hc + j); }
}
template <int KIND>
DI void prep_compute(Frame& F, int b, int h, int dir, int c, const PrepRaw<KIND>& R, const bf16x8 (&af)[4]) {
    const int q = F.wave - 4, jt = q & 1, lane = F.lane, n = lane & 31, half = lane >> 5, ab = c & 1;
    const LAS float* cm = SC_CONST;
    f32x16 D;
#pragma unroll
    for (int i = 0; i < 16; ++i) D[i] = 0.f;
    if (KIND == 0) {
#pragma unroll
        for (int kk = 0; kk < 4; ++kk) D = MFMA32(R.xf[kk], af[kk], D);
        const int j = 32 * jt + n; const float w0j = cm[j];
        float e2[16];
#pragma unroll
        for (int i = 0; i < 16; ++i) e2[i] = 0.8750387749f * sigmoidf_(D[i] + w0j);
        float gs[4], ps[4];
#pragma unroll
        for (int g = 0; g < 4; ++g) { gs[g] = (e2[4 * g] + e2[4 * g + 1]) + (e2[4 * g + 2] + e2[4 * g + 3]); ps[g] = __shfl_xor(gs[g], 32); }
        float off = 0.f;
        LAS float* Eb = SC_E2(ab) + j;
#pragma unroll
        for (int g = 0; g < 4; ++g) {
            float run = off + (half ? ps[g] : 0.f);
#pragma unroll
            for (int ii = 0; ii < 4; ++ii) { const int i = 4 * g + ii, tau = 8 * g + 4 * half + ii; run += e2[i]; Eb[tau * FP] = run; }
            off += gs[g] + ps[g];
        }
#pragma unroll
        for (int q4 = 0; q4 < 4; ++q4) { const int jj = 32 * jt + 8 * q4 + 4 * half;
            *(LAS v2u*)(SC_ARR(ab, 3) + n * P144 + jj * 2) = R.ga[q4];
            *(LAS v2u*)(SC_ARR(ab, 4) + n * P144 + jj * 2) = R.gb[q4]; }
    } else {
#pragma unroll
        for (int kk = 0; kk < 4; ++kk) D = MFMA32(af[kk], R.xf[kk], D);
        float ss = 0.f;
#pragma unroll
        for (int q4 = 0; q4 < 4; ++q4) { const int j = 32 * jt + 8 * q4 + 4 * half, jo = 32 * (1 - jt) + 8 * q4 + 4 * half;
            const f32x4 kr = up4(R.ga[q4]) * *(const LAS f32x4*)(cm + 128 + j), ko = up4(R.gb[q4]) * *(const LAS f32x4*)(cm + 128 + jo);
            ss += (kr[0] * kr[0] + kr[1] * kr[1]) + (kr[2] * kr[2] + kr[3] * kr[3]) + (ko[0] * ko[0] + ko[1] * ko[1]) + (ko[2] * ko[2] + ko[3] * ko[3]); }
        ss += __shfl_xor(ss, 32);
        const float inv = __builtin_amdgcn_rcpf(fmaxf(__builtin_amdgcn_sqrtf(ss), 1e-12f));
        float bs = 0.f;
#pragma unroll
        for (int q4 = 0; q4 < 4; ++q4) { const int j = 32 * jt + 8 * q4 + 4 * half;
            const f32x4 az = *(const LAS f32x4*)(cm + 64 + j), kkv = *(const LAS f32x4*)(cm + 128 + j), kav = *(const LAS f32x4*)(cm + 192 + j), rkv = *(const LAS f32x4*)(cm + 256 + j);
            const f32x4 kpr = up4(R.ga[q4]), rr = up4(R.gc[q4]);
            f32x4 av, kk4, kd4;
#pragma unroll
            for (int jj = 0; jj < 4; ++jj) { av[jj] = sigmoidf_(D[4 * q4 + jj] + az[jj]); kk4[jj] = kpr[jj] * kkv[jj] * inv; kd4[jj] = kpr[jj] * (1.f + (av[jj] - 1.f) * kav[jj]); bs += rr[jj] * kd4[jj] * rkv[jj]; }
            v2u w; w.x = pk2(kd4[0], kd4[1]); w.y = pk2(kd4[2], kd4[3]); *(LAS v2u*)(SC_ARR(ab, 0) + n * P144 + j * 2) = w;
            w.x = pk2(kk4[0] * av[0], kk4[1] * av[1]); w.y = pk2(kk4[2] * av[2], kk4[3] * av[3]); *(LAS v2u*)(SC_ARR(ab, 1) + n * P144 + j * 2) = w;
            w.x = pk2(-kk4[0], -kk4[1]); w.y = pk2(-kk4[2], -kk4[3]); *(LAS v2u*)(SC_ARR(ab, 2) + n * P144 + j * 2) = w; }
        bs += __shfl_xor(bs, 32);
        const int tl = SC_CH * c + n, t = dir ? (SEQ - 1 - tl) : tl;
        if (half == 0 && !VAR(255)) ((float*)(F.ws + WS_BSUM))[(((size_t)dir * NTOK + (size_t)b * SEQ + t) * 8 + h) * 2 + jt] = bs;
    }
}
DI void scan_consts(Frame& F, const Args& a, int h, int dir) {
    LAS float* cm = SC_CONST; const int i = F.tid - 256, hc = h * 64;
    if (i < 64) { cm[i] = ((const float*)a.in[I_WD0])[dir * 512 + hc + i]; cm[64 + i] = ((const float*)a.in[I_AG0])[dir * 512 + hc + i];
        cm[128 + i] = ((const float*)a.in[I_KK])[hc + i]; cm[192 + i] = ((const float*)a.in[I_KA])[hc + i]; cm[256 + i] = ((const float*)a.in[I_RK])[hc + i]; }
}
#define SC_BARRIER() do { asm volatile("s_waitcnt lgkmcnt(0)" ::: "memory"); __builtin_amdgcn_s_barrier(); asm volatile("" ::: "memory"); } while (0)
DI bf16x8 ld_perm(const LAS unsigned char* row, int ks, int half) {
    const v2u a0 = *(const LAS v2u*)(row + (16 * ks + 4 * half) * 2), a1 = *(const LAS v2u*)(row + (16 * ks + 8 + 4 * half) * 2);
    const v4u r = {a0.x, a0.y, a1.x, a1.y}; return __builtin_bit_cast(bf16x8, r);
}
DI bf16x8 packacc(const f32x16& x, int ks) { return ks ? pack8(x[8], x[9], x[10], x[11], x[12], x[13], x[14], x[15]) : pack8(x[0], x[1], x[2], x[3], x[4], x[5], x[6], x[7]); }
DI bf16x8 frag_scaled(const LAS unsigned char* arow, const LAS float* erow, int kk, float sgn, bool ezero) {
    const v4u xr = *(const LAS v4u*)(arow + 32 * kk);
    f32x4 e0 = *(const LAS f32x4*)(erow + 16 * kk), e1 = *(const LAS f32x4*)(erow + 16 * kk + 4);
    if (ezero) { e0 = (f32x4){0.f, 0.f, 0.f, 0.f}; e1 = e0; }
    const float x[8] = {bflo(xr.x), bfhi(xr.x), bflo(xr.y), bfhi(xr.y), bflo(xr.z), bfhi(xr.z), bflo(xr.w), bfhi(xr.w)};
    float y[8];
#pragma unroll
    for (int j = 0; j < 4; ++j) { y[j] = x[j] * __builtin_amdgcn_exp2f(sgn * e0[j]); y[4 + j] = x[4 + j] * __builtin_amdgcn_exp2f(sgn * e1[j]); }
    return pack8(y[0], y[1], y[2], y[3], y[4], y[5], y[6], y[7]);
}
template <bool LO>
DI void scan_build(Frame& F, int p, int bw) {
    int lane = F.lane; LAUNDER(lane); const int n = lane & 31, half = lane >> 5, ab = p & 1;
    LAS unsigned char* img = SC_IMG(p & 1);
    const LAS float* E = SC_E2(ab) + n * FP + 8 * half;
    const LAS float* Eex = SC_E2(ab) + (n > 0 ? n - 1 : 0) * FP + 8 * half;
    const LAS unsigned char* KDr = SC_ARR(ab, 0) + n * P144 + 16 * half; const LAS unsigned char* BBr = SC_ARR(ab, 1) + n * P144 + 16 * half;
    const LAS unsigned char* AAr = SC_ARR(ab, 2) + n * P144 + 16 * half; const LAS unsigned char* Rr = SC_ARR(ab, 3) + n * P144 + 16 * half;
    if (LO && bw == 2) {
        if (VAR(16)) return;
        f32x16 z, pacc;
#pragma unroll
        for (int i = 0; i < 16; ++i) z[i] = 0.f;
#pragma unroll
        for (int kk = 0; kk < 4; ++kk) z = MFMA32(frag_scaled(BBr, E, kk, 1.f, false), frag_scaled(AAr, Eex, kk, -1.f, n == 0), z);
#pragma unroll
        for (int i = 0; i < 16; ++i) { const int srow = crow(i, half); z[i] = (srow < n) ? z[i] : 0.f; }
        LAS unsigned char* zi = F.lds + SCL_MABT;
#pragma unroll
        for (int k = 0; k < 4; ++k) {
            LAS unsigned char* zk = zi + k * (32 * P80);
#pragma unroll
            for (int i = 0; i < 16; ++i) *(LAS unsigned short*)(zk + crow(i, half) * P80 + n * 2) = (unsigned short)(pk2(z[i], 0.f) & 0xffffu);
            LDS_WAIT(); asm volatile("" ::: "memory");
            const bf16x8 zb0 = packacc(z, 0), zb1 = packacc(z, 1);
            f32x16 zn;
#pragma unroll
            for (int i = 0; i < 16; ++i) zn[i] = 0.f;
            zn = MFMA32(ld_perm(zk + n * P80, 0, half), zb0, zn); zn = MFMA32(ld_perm(zk + n * P80, 1, half), zb1, zn);
            z = zn;
        }
#pragma unroll
        for (int i = 0; i < 16; ++i) pacc[i] = z[i] + ((crow(i, half) == n) ? 1.f : 0.f);
#pragma unroll
        for (int k = 3; k >= 0; --k) {
            const LAS unsigned char* zk = zi + k * (32 * P80);
            const bf16x8 qb0 = packacc(pacc, 0), qb1 = packacc(pacc, 1);
            pacc = MFMA32(ld_perm(zk + n * P80, 0, half), qb0, pacc); pacc = MFMA32(ld_perm(zk + n * P80, 1, half), qb1, pacc);
        }
#pragma unroll
        for (int g = 0; g < 4; ++g) { v2u w; w.x = pk2(pacc[4 * g], pacc[4 * g + 1]); w.y = pk2(pacc[4 * g + 2], pacc[4 * g + 3]); *(LAS v2u*)(img + IM_T + n * P80 + (8 * g + 4 * half) * 2) = w; }
    } else if (LO && bw == 3) {
        if (VAR(32)) return;
#pragma unroll
        for (int kk = 0; kk < 4; ++kk) { const bf16x8 f = frag_scaled(BBr, E, kk, 1.f, false);
            const v4u vr = *(const LAS v4u*)(SC_ARR(ab, 4) + n * P144 + 16 * half + 32 * kk); const bf16x8 vf = __builtin_bit_cast(bf16x8, vr);
#pragma unroll
            for (int e = 0; e < 8; ++e) { *(LAS unsigned short*)(img + IM_BT + (16 * kk + 8 * half + e) * P80 + n * 2) = (unsigned short)f[e];
                *(LAS unsigned short*)(img + IM_VT + (16 * kk + 8 * half + e) * P80 + n * 2) = (unsigned short)vf[e]; } }
        ((LAS float*)(img + IM_GC))[lane] = __builtin_amdgcn_exp2f(-(SC_E2(ab)[31 * FP + lane]));
    } else if (!LO && bw <= 6) {
        if (VAR(32)) return;
        bf16x8 fa[4], fb[4];
        if (bw == 4 || bw == 5) {
#pragma unroll
            for (int kk = 0; kk < 4; ++kk) { fb[kk] = frag_scaled(bw == 4 ? AAr : Rr, bw == 4 ? Eex : E, kk, -1.f, bw == 4 && n == 0);
                *(LAS bf16x8*)(img + (bw == 4 ? IM_AT : IM_RT) + n * P144 + (16 * kk + 8 * half) * 2) = fb[kk]; }
#pragma unroll
            for (int kk = 0; kk < 4; ++kk) fa[kk] = frag_scaled(bw == 4 ? KDr : BBr, E, kk, 1.f, false);
        } else {
#pragma unroll
            for (int kk = 0; kk < 4; ++kk) { fa[kk] = frag_scaled(KDr, E, kk, 1.f, false);
#pragma unroll
                for (int e = 0; e < 8; ++e) *(LAS unsigned short*)(img + IM_KT + (16 * kk + 8 * half + e) * P80 + n * 2) = (unsigned short)fa[kk][e]; }
#pragma unroll
            for (int kk = 0; kk < 4; ++kk) fb[kk] = frag_scaled(Rr, E, kk, -1.f, false);
        }
        f32x16 x;
#pragma unroll
        for (int i = 0; i < 16; ++i) x[i] = 0.f;
#pragma unroll
        for (int kk = 0; kk < 4; ++kk) x = MFMA32(fa[kk], fb[kk], x);
        LAS unsigned char* gi = img + (bw == 4 ? IM_MAK : (bw == 5 ? IM_NB : IM_NK));
#pragma unroll
        for (int g = 0; g < 4; ++g) { float m_[4];
#pragma unroll
            for (int e = 0; e < 4; ++e) { const int srow = 8 * g + 4 * half + e; m_[e] = ((bw == 4) ? srow < n : srow <= n) ? x[4 * g + e] : 0.f; }
            v2u w_; w_.x = pk2(m_[0], m_[1]); w_.y = pk2(m_[2], m_[3]); *(LAS v2u*)(gi + n * P80 + (8 * g + 4 * half) * 2) = w_; }
    }
}
template <int KIND>
DI void scan_helper(Frame& F, const Args& a, int b, int h, int dir) {
    const bf16* PS = (const bf16*)a.out;
    const int q = F.wave - 4, jt = q & 1, n = F.lane & 31, half = F.lane >> 5;
    const bf16* WT = (const bf16*)(F.ws + (KIND ? WS_AUP_T : WS_WUP_T)) + ((size_t)dir * 512 + h * 64 + 32 * jt + n) * 64 + 8 * half;
    bf16x8 af[4];
#pragma unroll
    for (int kk = 0; kk < 4; ++kk) af[kk] = *(const bf16x8*)(WT + 16 * kk);
    PrepRaw<KIND> Ra, Rb;
    prep_load<KIND>(F, PS, b, h, dir, 0, Ra);
    prep_load<KIND>(F, PS, b, h, dir, 1, Rb);
    prep_compute<KIND>(F, b, h, dir, 0, Ra, af);
    prep_load<KIND>(F, PS, b, h, dir, 2, Ra);
    SC_BARRIER();
    prep_compute<KIND>(F, b, h, dir, 1, Rb, af);
    prep_load<KIND>(F, PS, b, h, dir, 3, Rb);
    SC_BARRIER();
#pragma unroll 1
    for (int s2 = 0; s2 < SC_NCH; s2 += 2) {
        if (s2 + 2 < SC_NCH && !VAR(4)) prep_compute<KIND>(F, b, h, dir, s2 + 2, Ra, af);
        if (!VAR(8)) prep_load<KIND>(F, PS, b, h, dir, (s2 + 4) & (SC_NCH - 1), Ra);
        SC_BARRIER();
        if (s2 + 3 < SC_NCH && !VAR(4)) prep_compute<KIND>(F, b, h, dir, s2 + 3, Rb, af);
        if (!VAR(8)) prep_load<KIND>(F, PS, b, h, dir, (s2 + 5) & (SC_NCH - 1), Rb);
        SC_BARRIER();
    }
}
DI void scan_builder_only(Frame& F) {
    SC_BARRIER();
    scan_build<true>(F, 0, F.wave); if (F.wave == 3) scan_build<false>(F, 0, 6);
    SC_BARRIER();
#pragma unroll 1
    for (int s = 0; s < SC_NCH; ++s) { if (s + 1 < SC_NCH && !VAR(2)) { scan_build<true>(F, s + 1, F.wave); if (F.wave == 3) scan_build<false>(F, s + 1, 6); } SC_BARRIER(); }
}
DI void scan_sequencer(Frame& F, int b, int h, int dir) {
    const int it = F.wave, lane = F.lane, n = lane & 31, half = lane >> 5;
    f32x16 D0, D1;
#pragma unroll
    for (int i = 0; i < 16; ++i) { D0[i] = 0.f; D1[i] = 0.f; }
    bf16* wkv = (bf16*)(F.ws + WS_WKV) + ((size_t)dir * NTOK + (size_t)b * SEQ) * 512 + h * 64 + 32 * it + n;
    SC_BARRIER();
    scan_build<false>(F, 0, 4 + it);
    SC_BARRIER();
#pragma unroll 1
    for (int c = 0; c < SC_NCH; ++c) {
        if (VAR(1)) { if (c + 1 < SC_NCH && !VAR(2)) scan_build<false>(F, c + 1, 4 + it); SC_BARRIER(); continue; }
        const LAS unsigned char* img = SC_IMG(c & 1);
        const LAS unsigned char* atr = img + IM_AT + n * P144; const LAS unsigned char* rtr = img + IM_RT + n * P144;
        const LAS unsigned char* vtr = img + IM_VT + (32 * it + n) * P80 + 16 * half;
        const bf16x8 sb00 = packacc(D0, 0), sb01 = packacc(D0, 1), sb10 = packacc(D1, 0), sb11 = packacc(D1, 1);
        const bf16x8 vt0 = *(const LAS bf16x8*)vtr, vt1 = *(const LAS bf16x8*)(vtr + 32);
        f32x16 U, Y;
#pragma unroll
        for (int i = 0; i < 16; ++i) { U[i] = 0.f; Y[i] = 0.f; }
        U = MFMA32(ld_perm(atr, 0, half), sb00, U); Y = MFMA32(ld_perm(rtr, 0, half), sb00, Y);
        U = MFMA32(ld_perm(atr, 1, half), sb01, U); Y = MFMA32(ld_perm(rtr, 1, half), sb01, Y);
        U = MFMA32(ld_perm(atr + 64, 0, half), sb10, U); Y = MFMA32(ld_perm(rtr + 64, 0, half), sb10, Y);
        U = MFMA32(ld_perm(atr + 64, 1, half), sb11, U); Y = MFMA32(ld_perm(rtr + 64, 1, half), sb11, Y);
        { const LAS unsigned char* mk = img + IM_MAK + n * P80 + 16 * half; const LAS unsigned char* nk = img + IM_NK + n * P80 + 16 * half;
          U = MFMA32(*(const LAS bf16x8*)mk, vt0, U); U = MFMA32(*(const LAS bf16x8*)(mk + 32), vt1, U);
          Y = MFMA32(*(const LAS bf16x8*)nk, vt0, Y); Y = MFMA32(*(const LAS bf16x8*)(nk + 32), vt1, Y); }
        f32x16 SA;
#pragma unroll
        for (int i = 0; i < 16; ++i) SA[i] = 0.f;
        { const LAS unsigned char* tr = img + IM_T + n * P80; const bf16x8 ub0 = packacc(U, 0), ub1 = packacc(U, 1);
          SA = MFMA32(ld_perm(tr, 0, half), ub0, SA); SA = MFMA32(ld_perm(tr, 1, half), ub1, SA); }
        const bf16x8 sab0 = packacc(SA, 0), sab1 = packacc(SA, 1);
        { const LAS unsigned char* nb = img + IM_NB + n * P80; Y = MFMA32(ld_perm(nb, 0, half), sab0, Y); Y = MFMA32(ld_perm(nb, 1, half), sab1, Y); }
        { const int tl0 = SC_CH * c;
#pragma unroll
          for (int i = 0; i < 16; ++i) { const int tl = tl0 + crow(i, half), t = dir ? (SEQ - 1 - tl) : tl; if (!VAR(255)) wkv[(size_t)t * 512] = (bf16)(pk2(Y[i], 0.f) & 0xffffu); } }
        { const LAS unsigned char* b0 = img + IM_BT + n * P80; const LAS unsigned char* k0 = img + IM_KT + n * P80 + 16 * half;
          D0 = MFMA32(ld_perm(b0, 0, half), sab0, D0); D1 = MFMA32(ld_perm(b0 + 32 * P80, 0, half), sab0, D1);
          D0 = MFMA32(ld_perm(b0, 1, half), sab1, D0); D1 = MFMA32(ld_perm(b0 + 32 * P80, 1, half), sab1, D1);
          D0 = MFMA32(*(const LAS bf16x8*)k0, vt0, D0); D1 = MFMA32(*(const LAS bf16x8*)(k0 + 32 * P80), vt0, D1);
          D0 = MFMA32(*(const LAS bf16x8*)(k0 + 32), vt1, D0); D1 = MFMA32(*(const LAS bf16x8*)(k0 + 32 * P80 + 32), vt1, D1);
          const LAS float* gc = (const LAS float*)(img + IM_GC) + 4 * half;
#pragma unroll
          for (int g = 0; g < 4; ++g) { const f32x4 g0 = *(const LAS f32x4*)(gc + 8 * g), g1 = *(const LAS f32x4*)(gc + 32 + 8 * g);
#pragma unroll
              for (int e = 0; e < 4; ++e) { D0[4 * g + e] *= g0[e]; D1[4 * g + e] *= g1[e]; } } }
        if (c + 1 < SC_NCH && !VAR(2)) scan_build<false>(F, c + 1, 4 + it);
        SC_BARRIER();
    }
}
DI void scan_unit(Frame& F, const Args& a, int b, int h, int dir) {
    if (F.wave >= 4) { scan_consts(F, a, h, dir); LDS_WAIT(); }
    __syncthreads();
    if (F.wave < 2) scan_sequencer(F, b, h, dir);
    else if (F.wave < 4) scan_builder_only(F);
    else if ((F.wave - 4) >> 1) scan_helper<1>(F, a, b, h, dir);
    else scan_helper<0>(F, a, b, h, dir);
}

DI void post_consts(Frame& F, const Args& a) {
    LAS float* cm = (LAS float*)F.lds;
    cm[F.tid] = ((const float*)a.in[I_GNW])[F.tid]; cm[512 + F.tid] = ((const float*)a.in[I_GNB])[F.tid];
    LDS_WAIT(); __syncthreads();
}
DI void post_item(Frame& F, const bf16* PS, int item) {
    const int tile = item >> 3, h = item & 7, hc = h * 64;
    const int lane = F.lane, n = lane & 31; int half = lane >> 5; LAUNDER(half);
    const bf16* GT = (const bf16*)(F.ws + WS_GUP_T);
    const bf16* WKV = (const bf16*)(F.ws + WS_WKV); const float* BS = (const float*)(F.ws + WS_BSUM); bf16* YR = (bf16*)(F.ws + WS_YR);
    const LAS float* cm = (const LAS float*)F.lds;
    const size_t tok = (size_t)tile * 32 + n;
    const bf16* pr = PS + tok * RW_COLS;
    bf16x8 bfr[8];
#pragma unroll
    for (int kk = 0; kk < 8; ++kk) bfr[kk] = *(const bf16x8*)(pr + 1664 + 16 * kk + 8 * half);
    f32x4 x[2][4]; v2u vr[2][4];
#pragma unroll
    for (int ct = 0; ct < 2; ++ct)
#pragma unroll
        for (int q4 = 0; q4 < 4; ++q4) { const int c = hc + 32 * ct + 8 * q4 + 4 * half;
            x[ct][q4] = up4(*(const v2u*)(WKV + tok * 512 + c)) + up4(*(const v2u*)(WKV + ((size_t)NTOK + tok) * 512 + c));
            vr[ct][q4] = *(const v2u*)(pr + 1024 + c); }
    const f32x2 b0 = *(const f32x2*)(BS + (tok * 8 + h) * 2), b1 = *(const f32x2*)(BS + (((size_t)NTOK + tok) * 8 + h) * 2);
    f32x16 g0, g1;
#pragma unroll
    for (int i = 0; i < 16; ++i) { g0[i] = 0.f; g1[i] = 0.f; }
    const bf16* gp = GT + (size_t)(hc + n) * 128 + 8 * half;
#pragma unroll
    for (int kk = 0; kk < 8; ++kk) { g0 = MFMA32(*(const bf16x8*)(gp + 16 * kk), bfr[kk], g0); g1 = MFMA32(*(const bf16x8*)(gp + 32 * 128 + 16 * kk), bfr[kk], g1); }
    float sm = 0.f;
#pragma unroll
    for (int ct = 0; ct < 2; ++ct)
#pragma unroll
        for (int q4 = 0; q4 < 4; ++q4) sm += (x[ct][q4][0] + x[ct][q4][1]) + (x[ct][q4][2] + x[ct][q4][3]);
    sm += __shfl_xor(sm, 32);
    const float mean = sm * (1.f / 64.f); float vs = 0.f;
#pragma unroll
    for (int ct = 0; ct < 2; ++ct)
#pragma unroll
        for (int q4 = 0; q4 < 4; ++q4) { const f32x4 d = x[ct][q4] - mean; vs += (d[0] * d[0] + d[1] * d[1]) + (d[2] * d[2] + d[3] * d[3]); }
    vs += __shfl_xor(vs, 32);
    const float rstd = 1.f / sqrtf(vs * (1.f / 64.f) + GN_EPS);
    const float bsum = (b0.x + b0.y) + (b1.x + b1.y);
#pragma unroll
    for (int ct = 0; ct < 2; ++ct)
#pragma unroll
        for (int q4 = 0; q4 < 4; ++q4) { const int c = hc + 32 * ct + 8 * q4 + 4 * half;
            const f32x4 y = (x[ct][q4] - mean) * rstd * *(const LAS f32x4*)(cm + c) + *(const LAS f32x4*)(cm + 512 + c) + up4(vr[ct][q4]) * bsum;
            f32x4 gg; if (ct == 0) gg = (f32x4){g0[4 * q4], g0[4 * q4 + 1], g0[4 * q4 + 2], g0[4 * q4 + 3]}; else gg = (f32x4){g1[4 * q4], g1[4 * q4 + 1], g1[4 * q4 + 2], g1[4 * q4 + 3]};
            const f32x4 o = y * gg; v2u w; w.x = pk2(o[0], o[1]); w.y = pk2(o[2], o[3]);
            *(v2u*)(YR + tok * YC_COLS + c) = w; }
    if (h < 4) {
        const bf16* ya = (const bf16*)(F.ws + WS_YA) + tok * 256 + h * 64 + 32 * half; bf16* yc = YR + tok * YC_COLS + 512 + h * 64 + 32 * half;
#pragma unroll
        for (int e = 0; e < 4; ++e) *(v4u*)(yc + 8 * e) = *(const v4u*)(ya + 8 * e); }
}

DI void p5_router_tile(Frame& F, const Args& a, int tile) {
    const int lane = F.lane, n = lane & 31, half = lane >> 5;
    const size_t tok = (size_t)tile * 32 + n;
    const bf16* xr = (const bf16*)(F.ws + WS_X1) + tok * DM + 8 * half;
    const bf16* RH = (const bf16*)(F.ws + WS_RT_HI) + (size_t)n * DM + 8 * half; const bf16* RL = (const bf16*)(F.ws + WS_RT_LO) + (size_t)n * DM + 8 * half;
    f32x16 d0, d1;
#pragma unroll
    for (int i = 0; i < 16; ++i) { d0[i] = 0.f; d1[i] = 0.f; }
    float ss = 0.f;
#pragma unroll 8
    for (int kk = 0; kk < 64; ++kk) {
        const v4u xv = *(const v4u*)(xr + 16 * kk);
        const float x8[8] = {bflo(xv.x), bfhi(xv.x), bflo(xv.y), bfhi(xv.y), bflo(xv.z), bfhi(xv.z), bflo(xv.w), bfhi(xv.w)};
#pragma unroll
        for (int j = 0; j < 8; ++j) ss += x8[j] * x8[j];
        const bf16x8 bh = __builtin_bit_cast(bf16x8, xv);
        const bf16x8 ah0 = *(const bf16x8*)(RH + 16 * kk), ah1 = *(const bf16x8*)(RH + 32 * DM + 16 * kk), al0 = *(const bf16x8*)(RL + 16 * kk), al1 = *(const bf16x8*)(RL + 32 * DM + 16 * kk);
        d0 = MFMA32(ah0, bh, d0); d0 = MFMA32(al0, bh, d0);
        d1 = MFMA32(ah1, bh, d1); d1 = MFMA32(al1, bh, d1);
    }
    ss += __shfl_xor(ss, 32);
    const float rstd = 1.f / sqrtf(ss * (1.f / DM) + NORM_EPS);
    const float* brg = (const float*)a.in[I_BRG]; const float* bre = (const float*)a.in[I_BRE];
    float gl[4];
#pragma unroll
    for (int j = 0; j < 4; ++j) gl[j] = __shfl(d1[j] * rstd + brg[j], n);
    int grp = 0; float gmax = gl[0];
#pragma unroll
    for (int j = 1; j < 4; ++j) if (gl[j] > gmax) { gmax = gl[j]; grp = j; }
    float gsum = 0.f;
#pragma unroll
    for (int j = 0; j < 4; ++j) gsum += __expf(gl[j] - gmax);
    const float grp_p = 1.f / gsum;
    const f32x4 bv = *(const f32x4*)(bre + 8 * grp + 4 * half);
    float cv[4];
#pragma unroll
    for (int j = 0; j < 4; ++j) { float v = d0[j]; v = grp == 1 ? d0[4 + j] : v; v = grp == 2 ? d0[8 + j] : v; v = grp == 3 ? d0[12 + j] : v; cv[j] = v * rstd + bv[j]; }
    float m1v = cv[0]; int m1i = 0;
#pragma unroll
    for (int j = 1; j < 4; ++j) if (cv[j] > m1v) { m1v = cv[j]; m1i = j; }
    float m2v = -3.0e38f; int m2i = 0;
#pragma unroll
    for (int j = 0; j < 4; ++j) if (j != m1i && cv[j] > m2v) { m2v = cv[j]; m2i = j; }
    m1i += 4 * half; m2i += 4 * half;
    const float t1v = __shfl_xor(m1v, 32), t2v = __shfl_xor(m2v, 32); const int t1i = __shfl_xor(m1i, 32), t2i = __shfl_xor(m2i, 32);
    auto better = [](float av, int ai, float bv_, int bi) { return av > bv_ || (av == bv_ && ai < bi); };
    float top1v, top2v; int top1i, top2i;
    if (better(m1v, m1i, t1v, t1i)) { top1v = m1v; top1i = m1i; if (better(m2v, m2i, t1v, t1i)) { top2v = m2v; top2i = m2i; } else { top2v = t1v; top2i = t1i; } }
    else { top1v = t1v; top1i = t1i; if (better(m1v, m1i, t2v, t2i)) { top2v = m1v; top2i = m1i; } else { top2v = t2v; top2i = t2i; } }
    const float w0 = grp_p / (1.f + __expf(top2v - top1v)), w1 = grp_p - w0;
    const int mye = 8 * grp + (half ? top2i : top1i); const float myw = half ? w1 : w0;
    unsigned long long mymask = 0ull; int cnt_l = 0;
    for (int e = 0; e < NEXP; ++e) { const unsigned long long m = __ballot(mye == e); if (mye == e) mymask = m; if (lane == e) cnt_l = __popcll(m); }
    int base_l = 0;
    if (lane < NEXP && cnt_l > 0 && !VAR(64)) base_l = (int)__hip_atomic_fetch_add((unsigned*)(F.ws + WS_CTL) + CW_CNT + 64 * lane, (unsigned)cnt_l, RLX_AGENT);
    const int mybase = __shfl(base_l, mye);
    const int pos = mybase + __popcll(mymask & ((1ull << lane) - 1ull));
    if (!VAR(64)) { ((int*)(F.ws + WS_LTOK))[(size_t)mye * NTOK + pos] = (int)tok * 2 + half;
    ((float*)(F.ws + WS_LW))[(size_t)mye * NTOK + pos] = myw; ((float*)(F.ws + WS_LR))[(size_t)mye * NTOK + pos] = rstd; }
}
DI void p5_phase(Frame& F, const Args& a) {
    const int gw = F.bid * NWAVES + F.wave, NGW = F.G * NWAVES;
    if (!VAR(256)) for (int tile = F.wave * F.G + F.bid; tile < NTOK / 32; tile += NGW) p5_router_tile(F, a, tile);
    if (F.bid == 0 && F.tid < 128) ((v4u*)((bf16*)(F.ws + WS_X1) + (size_t)NTOK * DM))[F.tid] = (v4u){0u, 0u, 0u, 0u};
    LAS float* scr = (LAS float*)(F.lds + F.wave * 16384);
    constexpr int IPE = 256;
    if (!VAR(128)) for (int it = gw; it < NEXP * 3 * IPE; it += NGW) {
        const int e = it / (3 * IPE), r = it % (3 * IPE), which = r / IPE, item = r % IPE;
        if (which == 0) transpose_item((const float*)a.in[I_WGATE] + (size_t)e * DM * DEXP, DM, DEXP, (bf16*)(F.ws + WS_WGU_T) + (size_t)e * DM * DM, RmGate(), scr, item, F.lane, 0, 0, (const float*)a.in[I_N2G]);
        else if (which == 1) transpose_item((const float*)a.in[I_WUP] + (size_t)e * DM * DEXP, DM, DEXP, (bf16*)(F.ws + WS_WGU_T) + (size_t)e * DM * DM, RmUp(), scr, item, F.lane, 0, 0, (const float*)a.in[I_N2G]);
        else transpose_item((const float*)a.in[I_WDOWN] + (size_t)e * DEXP * DM, DEXP, DM, (bf16*)(F.ws + WS_WD_T) + (size_t)e * DM * DEXP, RmId(), scr, item, F.lane);
    }
}
DI int moe_table(Frame& F) {
    LAS int* tab = (LAS int*)(F.lds + TAB_OFF);
    if (F.tid == 0) { int acc = 0;
        for (int e = 0; e < NEXP; ++e) { const int c = (int)__hip_atomic_load((unsigned*)(F.ws + WS_CTL) + CW_CNT + 64 * e, RLX_AGENT); tab[e] = acc; tab[33 + e] = c; acc += (c + 255) >> 8; }
        tab[32] = acc; }
    __syncthreads();
    return tab[32];
}
DI void p6_gather(Frame& F) {
    const int nT = moe_table(F);
    const LAS int* tab = (const LAS int*)(F.lds + TAB_OFF);
    const bf16* h2 = (const bf16*)(F.ws + WS_H2); bf16* Xg = (bf16*)(F.ws + WS_XG);
    const int* ltok = (const int*)(F.ws + WS_LTOK); const float* lw = (const float*)(F.ws + WS_LW);
    const int nrows = nT * 256, rstride = F.G * NWAVES;
    for (int R0 = F.bid * NWAVES + F.wave; R0 < nrows; R0 += 4 * rstride) {
        int tk[4], kq[4]; float wv[4];
#pragma unroll
        for (int u = 0; u < 4; ++u) { const int R = R0 + u * rstride; tk[u] = -1; kq[u] = 0; wv[u] = 0.f;
            if (R < nrows) { const int tile = R >> 8; int e = 0;
                for (int k = 1; k < NEXP; ++k) e += (tab[k] <= tile) ? 1 : 0;
                const int slot = R - tab[e] * 256;
                if (slot < tab[33 + e]) { const int t2 = ltok[(size_t)e * NTOK + slot]; tk[u] = t2 >> 1; kq[u] = t2 & 1; wv[u] = lw[(size_t)e * NTOK + slot]; } } }
        v4u d0[4], d1[4];
#pragma unroll
        for (int u = 0; u < 4; ++u) { const v4u* src = (const v4u*)(h2 + (size_t)(tk[u] < 0 ? NTOK : tk[u]) * DM); d0[u] = src[F.lane]; d1[u] = src[F.lane + 64]; }
#pragma unroll
        for (int u = 0; u < 4; ++u) { const int R = R0 + u * rstride; if (R < nrows) { v4u* dst = (v4u*)(Xg + (size_t)R * DM); dst[F.lane] = d0[u]; dst[F.lane + 64] = d1[u];
            if (F.lane == 0) { ((float*)(F.ws + WS_ROWW))[R] = wv[u]; if (tk[u] >= 0) ((int*)(F.ws + WS_INV))[tk[u] * 2 + kq[u]] = R; } } }
    }
}

__global__ void __launch_bounds__(NWAVES * 64, 2) mk_fwd(Args args) {
    extern __shared__ __attribute__((aligned(16))) unsigned char lds[];
    Frame F;
    F.lds = (LAS unsigned char*)lds; F.MISC = (volatile LAS unsigned*)(F.lds + MISC_OFF);
    F.tid = threadIdx.x; F.lane = F.tid & 63; F.wave = __builtin_amdgcn_readfirstlane(F.tid >> 6); F.G = gridDim.x; F.bid = blockIdx.x; F.ws = args.ws; F.variant = args.variant;
    for (int u = F.tid; u < (LDS_BYTES - RING_BYTES) / 4; u += NWAVES * 64) ((LAS unsigned*)(F.lds + RING_BYTES))[u] = 0u;
    __syncthreads();
    const int lo = args.ph_lo, hi = args.ph_hi;
    const bool multi = (hi - lo) > 1;
    XcdBarrier bar; bar.bar = (unsigned*)(args.ws + WS_CTL) + CW_BAR + args.li * XCD_BAR_WORDS; bar.x = 0; bar.st = nullptr;
    if (multi) bar = xcd_barrier_post((unsigned*)(args.ws + WS_CTL) + CW_BAR + args.li * XCD_BAR_WORDS, F.MISC + 8);
#ifndef PH_MASK
#define PH_MASK 0xFFFFFFFFu
#endif
#define REFRESH() do { F.lane = (int)__builtin_amdgcn_mbcnt_hi(~0u, __builtin_amdgcn_mbcnt_lo(~0u, 0u)); F.tid = F.wave * 64 + F.lane; } while (0)
#define IN(k) ((((PH_MASK) >> (k)) & 1u) && lo <= (k) && (k) < hi)
#define SEAM(k) do { if (IN(k) && IN((k) + 1)) xcd_barrier(bar); } while (0)
    unsigned char* ws = args.ws;

    if (IN(0)) { REFRESH(); p0_prologue(F, args); } SEAM(0);
    if (IN(1)) { REFRESH();
        pg8::Gemm g{(const bf16*)(ws + WS_HB), (const bf16*)(ws + WS_WIN_T), DM, 0, nullptr, nullptr}; pg8::StaticOrder S; S.init(NTOK, IN_COLS, F.G, F.bid);
        pg8::EpiIn E{(bf16*)(ws + WS_PR), (bf16*)(ws + WS_PT), (unsigned char*)(ws + WS_G), (const float*)args.in[I_BMERGE]};
        pg8::gemm_phase<pg8::EpiIn, pg8::StaticOrder, true, true>(F.lds, g, S, E);
    } SEAM(1);
    if (IN(2)) { REFRESH(); if (!VAR(128)) p1b_qkprep(F, args); if (!VAR(256)) p1c_preshift(F, args); } SEAM(2);
    if (IN(3)) { REFRESH(); for (int u = F.bid; u < 256; u += F.G) attn_unit(F, u >> 4, (u >> 2) & 3, u & 3); } SEAM(3);
    if (IN(4)) { REFRESH(); for (int u = F.bid; u < 256; u += F.G) scan_unit(F, args, u >> 4, (u >> 1) & 7, u & 1); } SEAM(4);
    if (IN(5)) { REFRESH(); post_consts(F, args);
#pragma unroll 1
        for (int item = F.bid * NWAVES + F.wave; item < NTOK / 32 * 8; item += F.G * NWAVES) post_item(F, (const bf16*)args.out, item); } SEAM(5);
    if (IN(6)) { REFRESH();
        pg8::Gemm g{(const bf16*)(ws + WS_YR), (const bf16*)(ws + WS_WR_T), YC_COLS, 0, nullptr, nullptr}; pg8::StaticOrder S; S.init(NTOK, DM, F.G, F.bid);
        pg8::EpiMix2 E{(const unsigned char*)(ws + WS_G), (bf16*)(ws + WS_Z)};
        pg8::gemm_phase<pg8::EpiMix2, pg8::StaticOrder, true, true>(F.lds, g, S, E);
    } SEAM(6);
    if (IN(8)) { REFRESH();
        pg8::Gemm g{(const bf16*)(ws + WS_Z), (const bf16*)(ws + WS_WOUT_T), DM, 0, nullptr, nullptr}; pg8::StaticOrder S; S.init(NTOK, DM, F.G, F.bid);
        pg8::EpiRes E{(const float*)args.in[I_X], (bf16*)(ws + WS_X1)};
        pg8::gemm_phase<pg8::EpiRes, pg8::StaticOrder, true, true>(F.lds, g, S, E);
    } SEAM(8);
    if (IN(9)) { REFRESH(); p5_phase(F, args); } SEAM(9);
    if (IN(11)) { REFRESH();
        const int nT = moe_table(F);
        pg8::Gemm g{(const bf16*)(ws + WS_X1), (const bf16*)(ws + WS_WGU_T), DM, (size_t)DM * DM * 2, (const int*)(ws + WS_LTOK), (const LAS int*)(F.lds + TAB_OFF)}; pg8::GroupedOrder S{(const LAS int*)(F.lds + TAB_OFF), nT, F.G, F.bid};
        pg8::EpiSwiglu E{(bf16*)(ws + WS_HH), (const float*)(ws + WS_LR), (const LAS int*)(F.lds + TAB_OFF)};
        pg8::gemm_phase<pg8::EpiSwiglu, pg8::GroupedOrder, true, true, true>(F.lds, g, S, E);
    } SEAM(11);
    if (IN(12)) { REFRESH();
        const int nT = moe_table(F);
        pg8::Gemm g{(const bf16*)(ws + WS_HH), (const bf16*)(ws + WS_WD_T), DEXP, (size_t)DM * DEXP * 2, nullptr, nullptr}; pg8::GroupedOrder S{(const LAS int*)(F.lds + TAB_OFF), nT, F.G, F.bid};
        pg8::EpiStoreY E{(const int*)(ws + WS_LTOK), (const float*)(ws + WS_LW), (const LAS int*)(F.lds + TAB_OFF), (int*)(ws + WS_INV), (bf16*)(ws + WS_YB)};
        pg8::gemm_phase<pg8::EpiStoreY, pg8::GroupedOrder, true, true>(F.lds, g, S, E);
    } SEAM(12);
    if (IN(13)) { REFRESH();
        const int* inv = (const int*)(ws + WS_INV); const bf16* Y = (const bf16*)(ws + WS_YB);
        const int tstride = F.G * NWAVES;
        for (int tok0 = F.bid * NWAVES + F.wave; tok0 < NTOK; tok0 += 4 * tstride) {
            int r0[4], r1[4];
#pragma unroll
            for (int u = 0; u < 4; ++u) { const int tok = tok0 + u * tstride; r0[u] = inv[tok * 2]; r1[u] = inv[tok * 2 + 1]; }
#pragma unroll
            for (int u = 0; u < 4; ++u) { const int tok = tok0 + u * tstride;
                f32x4* o = (f32x4*)(args.out + (size_t)tok * DM) + F.lane; const v2u* xb = (const v2u*)((const bf16*)(ws + WS_X1) + (size_t)tok * DM) + F.lane;
                const v2u* y0 = (const v2u*)(Y + (size_t)r0[u] * DM) + F.lane; const v2u* y1 = (const v2u*)(Y + (size_t)r1[u] * DM) + F.lane;
                v2u xv[4], a0[4], a1[4];
#pragma unroll
                for (int j = 0; j < 4; ++j) { xv[j] = xb[64 * j]; a0[j] = y0[64 * j]; a1[j] = y1[64 * j]; }
#pragma unroll
                for (int j = 0; j < 4; ++j) { f32x4 v; v[0] = bflo(xv[j].x) + bflo(a0[j].x) + bflo(a1[j].x); v[1] = bfhi(xv[j].x) + bfhi(a0[j].x) + bfhi(a1[j].x); v[2] = bflo(xv[j].y) + bflo(a0[j].y) + bflo(a1[j].y); v[3] = bfhi(xv[j].y) + bfhi(a0[j].y) + bfhi(a1[j].y); if (!VAR(64)) o[64 * j] = v; } }
        }
    }
#undef IN
#undef SEAM
}

constexpr int NPHASE = 14;
extern "C" void kernel_launch(void* const* d_in, const int* in_sizes, int n_in, void* d_out, int out_size, void* d_ws, size_t ws_size, hipStream_t stream) {
    static int grid = 0;
    if (grid == 0) {
        if (n_in != 30 || ws_size < WS_END) { fprintf(stderr, "kernel_launch: need 30 inputs and >= %zu bytes of workspace (got %d, %zu)\n", (size_t)WS_END, n_in, ws_size); grid = -1; return; }
        int dev = 0, cus = 0;
        if (hipGetDevice(&dev) != hipSuccess || hipDeviceGetAttribute(&cus, hipDeviceAttributeMultiprocessorCount, dev) != hipSuccess) { grid = -1; return; }
        if (hipFuncSetAttribute((const void*)mk_fwd, hipFuncAttributeMaxDynamicSharedMemorySize, LDS_BYTES) != hipSuccess) { fprintf(stderr, "kernel_launch: hipFuncSetAttribute failed\n"); grid = -1; return; }
        int per_cu = 0;
        if (hipOccupancyMaxActiveBlocksPerMultiprocessor(&per_cu, (const void*)mk_fwd, NWAVES * 64, LDS_BYTES) != hipSuccess || per_cu < 1) fprintf(stderr, "kernel_launch: occupancy query reports %d\n", per_cu);
        (void)hipGetLastError();
        grid = cus;
    }
    if (grid < 0) return;
    hipMemsetAsync((char*)d_ws + WS_CTL, 0, CTL_ZERO_BYTES, stream);
    Args a{};
    for (int i = 0; i < 30; ++i) a.in[i] = d_in[i];
    a.out = (float*)d_out; a.ws = (unsigned char*)d_ws;
#if defined(PROBE_REPEAT)
#ifdef PROBE_VARIANT
#define PROBE_VARIANT_V PROBE_VARIANT
#else
#define PROBE_VARIANT_V 0
#endif
    { const int k = PROBE_REPEAT; int li = 0;
      const int cuts[5][2] = {{0, k}, {k, k + 1}, {k, k + 1}, {k + 1, NPHASE}, {0, 0}};
      for (int i = 0; i < 4; ++i) { if (cuts[i][1] <= cuts[i][0]) continue; a.ph_lo = cuts[i][0]; a.ph_hi = cuts[i][1]; a.li = li++; a.variant = (i == 2) ? PROBE_VARIANT_V : 0; hipLaunchKernelGGL(mk_fwd, dim3(grid), dim3(NWAVES * 64), LDS_BYTES, stream, a); } }
#elif !defined(MK_MULTI_LAUNCH)
    a.ph_lo = 0; a.ph_hi = NPHASE; a.li = 0;
    hipLaunchKernelGGL(mk_fwd, dim3(grid), dim3(NWAVES * 64), LDS_BYTES, stream, a);
#else
    for (int p = 0; p < NPHASE; ++p) { a.ph_lo = p; a.ph_hi = p + 1; a.li = 0; hipLaunchKernelGGL(mk_fwd, dim3(grid), dim3(NWAVES * 64), LDS_BYTES, stream, a); }
#endif
}
```

```cpp
#include <hip/hip_runtime.h>
#include <cstdio>
#include <cstdint>

constexpr int BATCH = 16, SEQ = 2048, DM = 1024, NTOK = BATCH * SEQ;
constexpr int RW_COLS = 1792, AT_COLS = 2304, G_COLS = 2048, IN_COLS = 6144;
constexpr int NEXP = 32, DEXP = 512;
constexpr int MAXTILES = 288;
constexpr float NORM_EPS = 1e-6f, GN_EPS = 64e-5f;

#define GAS __attribute__((address_space(1)))
#define LAS __attribute__((address_space(3)))
typedef unsigned short bf16;
typedef unsigned v4u __attribute__((ext_vector_type(4)));
typedef unsigned v2u __attribute__((ext_vector_type(2)));
typedef float f32x4 __attribute__((ext_vector_type(4)));
typedef float f32x2 __attribute__((ext_vector_type(2)));
typedef float f32x16 __attribute__((ext_vector_type(16)));
typedef short bf16x8 __attribute__((ext_vector_type(8)));
typedef __bf16 bf16x2_t __attribute__((ext_vector_type(2)));
typedef GAS unsigned gu32;
#define RLX_AGENT __ATOMIC_RELAXED, __HIP_MEMORY_SCOPE_AGENT
#define LDS_WAIT() asm volatile("s_waitcnt lgkmcnt(0)" ::: "memory")
#define VM_WAIT() asm volatile("s_waitcnt vmcnt(0)" ::: "memory")
#define DI __device__ __forceinline__
#ifdef PROBE_VARIANT
#define VAR(b) (F.variant & (b))
#else
#define VAR(b) 0
#endif
#define LAUNDER(x) asm volatile("" : "+v"(x))

DI unsigned pk2(float lo, float hi) { f32x2 v = {lo, hi}; bf16x2_t b = __builtin_convertvector(v, bf16x2_t); return __builtin_bit_cast(unsigned, b); }
DI float bflo(unsigned u) { return __builtin_bit_cast(float, u << 16); }
DI float bfhi(unsigned u) { return __builtin_bit_cast(float, u & 0xffff0000u); }
DI float sigmoidf_(float x) { return __builtin_amdgcn_rcpf(1.f + __builtin_amdgcn_exp2f(-1.44269504f * x)); }
DI float wave_sum(float v) {
#pragma unroll
    for (int o = 1; o < 64; o <<= 1) v += __shfl_xor(v, o);
    return v;
}
DI int crow(int reg, int h) { return (reg & 3) + 8 * (reg >> 2) + 4 * h; }
#define MFMA32(a, b, c) __builtin_amdgcn_mfma_f32_32x32x16_bf16((a), (b), (c), 0, 0, 0)

constexpr size_t MiB = 1u << 20;
constexpr size_t WS_CTL = 0, CTL_ZERO_BYTES = 192 * 1024;
constexpr size_t WS_WIN_T = 1 * MiB;
constexpr size_t WS_WR_T = 13 * MiB;
constexpr size_t WS_WA_T = 14 * MiB;
constexpr size_t WS_WOUT_T = 15 * MiB;
constexpr size_t WS_GUP_T = 17 * MiB;
constexpr size_t WS_RT_HI = 17 * MiB + 256 * 1024;
constexpr size_t WS_RT_LO = 17 * MiB + 384 * 1024;
constexpr size_t WS_WUP_T = 17 * MiB + 512 * 1024;
constexpr size_t WS_AUP_T = 17 * MiB + 640 * 1024;
constexpr size_t RG_A = 18 * MiB, RG_B = 82 * MiB, RG_C = 194 * MiB, RG_D = 338 * MiB, RG_E = 466 * MiB, WS_END = 512 * MiB;
constexpr size_t WS_HB = RG_A;
constexpr size_t WS_PR = RG_B;
constexpr size_t WS_PT = RG_C;
constexpr size_t WS_G = RG_D;
constexpr size_t WS_OG = RG_A;
constexpr size_t WS_LSE = RG_A + 48 * MiB;
constexpr size_t WS_YA = RG_E;
constexpr size_t WS_BSUM = RG_E + 16 * MiB;
constexpr size_t WS_WKV = RG_C;
constexpr size_t WS_YR = RG_A;
constexpr int YC_COLS = 768;
constexpr size_t WS_X1 = RG_A;
constexpr size_t WS_Z1 = RG_C;
constexpr size_t WS_Z = RG_C + 64 * MiB;
constexpr size_t WS_H2 = RG_B;
constexpr size_t WS_LTOK = RG_E + 20 * MiB;
constexpr size_t WS_LW = RG_E + 24 * MiB;
constexpr size_t WS_ROWTOK = RG_E + 28 * MiB;
constexpr size_t WS_ROWW = RG_E + 29 * MiB;
constexpr size_t WS_WGU_T = RG_D;
constexpr size_t WS_WD_T = RG_B + 16 * MiB;
constexpr size_t WS_XG = RG_C;
constexpr size_t WS_HH = RG_C;
constexpr size_t WS_YB = RG_C + 72 * MiB;
constexpr size_t WS_LR = RG_E + 34 * MiB;
constexpr size_t WS_XB = RG_D + 64 * MiB;
constexpr size_t WS_RSTD1 = RG_E + 38 * MiB;
constexpr size_t WS_INV = RG_E + 30 * MiB;
constexpr int CW_BAR = 4096;
constexpr int CW_CNT = 32768;

constexpr int RING_BYTES = 155648;
constexpr int MISC_OFF = RING_BYTES + 320;
constexpr int TAB_OFF = RING_BYTES + 1024;
constexpr int LDS_BYTES = 163840;
constexpr int NWAVES = 8;

namespace pg8 {
constexpr int BM = 256, BK = 64, HALF = 128, HTB = HALF * BK * 2, STAGE_BYTES = 8 * HTB, NXCD = 8, WGM = 8;
__host__ __device__ __forceinline__ int lds_byte(int r, int c) { const int st = (r >> 4) * 2 + (c >> 5), rr = r & 15, cc = c & 31, ob = rr * 64 + cc * 2; return st * 1024 + (ob ^ (((ob >> 9) & 1) << 5)); }
__host__ __device__ __forceinline__ void stage_rc(int b, int& R, int& C) { const int st = b / 1024, sb = b % 1024, swz = sb ^ (((sb >> 9) & 1) << 5); R = (st >> 1) * 16 + swz / 64; C = (st & 1) * 32 + (swz % 64) / 2; }
__host__ __device__ __forceinline__ int perm32(int rho) { const int n = rho >> 4, i = rho & 15; return 8 * (i >> 2) + 4 * n + (i & 3); }

struct Unit { int pm, pn, e; };
struct Gemm { const bf16* A; const bf16* Bt; int K; size_t bgroup; const int* ltok; const LAS int* tab; };

struct StaticOrder {
    int nM, nN, nwg, G, c;
    __device__ void init(int M, int N, int G_, int c_) { nM = M / BM; nN = N / BM; nwg = nM * nN; G = G_; c = c_; }
    __device__ bool next(int i, Unit& u) const {
        const long L = (long)i * G + c; if (L >= nwg) return false;
        int wgid = (int)L; { const int q = nwg / NXCD, r = nwg % NXCD, xcd = wgid % NXCD, off = wgid / NXCD; wgid = (xcd < r ? xcd * (q + 1) : r * (q + 1) + (xcd - r) * q) + off; }
        const int nig = WGM * nN, gid = wgid / nig, fm = gid * WGM, gsz = (nM - fm) < WGM ? (nM - fm) : WGM;
        u.pm = fm + ((wgid % nig) % gsz); u.pn = (wgid % nig) / gsz; u.e = 0; return true;
    }
};
struct GroupedOrder {
    const LAS int* tstart; int nT, G, c;
    __device__ bool next(int i, Unit& u) const {
        const int n7 = nT * 4; int L;
        if ((G & 7) == 0) { const int x = c & 7, j = c >> 3, nfull = n7 / G;
            if (i < nfull) L = i * G + x * (G >> 3) + j;
            else { const int e7 = n7 - nfull * G, s = (((e7 + 7) >> 3) + 3) & ~3;
                if (i > nfull || j >= s) return false; L = nfull * G + x * s + j; } }
        else L = i * G + c;
        if (L >= n7) return false;
        u.pm = L >> 2; u.pn = L & 3; int e = 0;
        for (int k = 1; k < NEXP; ++k) e += (tstart[k] <= u.pm) ? 1 : 0;
        u.e = e; return true;
    }
};

template <class Epi, class Sched, bool ALIGN_EPI = false, bool SP2 = false, bool GATHER = false>
__device__ __forceinline__ void gemm_phase(LAS unsigned char* lds, const Gemm g, const Sched& S, const Epi& E) {
    const int tid = threadIdx.x, wid = __builtin_amdgcn_readfirstlane(tid >> 6), lane = tid & 63, wr = wid >> 2, wc = wid & 3, fr = lane & 15, fq = lane >> 4;
    const int K = g.K, nt = K / BK;
    unsigned voffA[2], voffB[2];
#pragma unroll
    for (int i = 0; i < 2; ++i) { int R, C; stage_rc(tid * 16 + i * 8192, R, C);
        const int Rb = Epi::PERM ? (64 * (R >> 5) + 16 * ((R >> 2) & 3) + 4 * ((R >> 4) & 1) + (R & 3)) : R;
        voffA[i] = (unsigned)(R * K + C) * 2u; voffB[i] = (unsigned)(Rb * K + C) * 2u; }
    const size_t kstep = (size_t)(BK * 2);
    const size_t hstep = (size_t)HALF * K * 2;
    const size_t tstep = 2 * hstep;
    const unsigned ldsw = (unsigned)wid * 1024u;
    const int aoff = lds_byte(wr * 64 + fr, fq * 8), boff = lds_byte(wc * 32 + fr, fq * 8);
    const size_t hstepB = Epi::PERM ? (size_t)8 * K * 2 : hstep;
    const size_t hstepA = GATHER ? 0 : hstep;
    unsigned voffGc[2][2], voffGn[2][2];
#define PG8_GOFF(dst, un) do { if constexpr (GATHER) { _Pragma("unroll") for (int _h = 0; _h < 2; ++_h) _Pragma("unroll") for (int _i = 0; _i < 2; ++_i) { int R_, C_; stage_rc(tid * 16 + _i * 8192, R_, C_); \
        const int slot_ = ((un).pm - g.tab[(un).e]) * 256 + _h * 128 + R_; const int raw_ = g.ltok[(size_t)(un).e * NTOK + slot_]; const int tok_ = slot_ < g.tab[33 + (un).e] ? (raw_ >> 1) : NTOK; \
        dst[_h][_i] = (unsigned)(tok_ * K + C_) * 2u; } } } while (0)
#define PG8_VA(sel, h) (GATHER ? ((sel) ? voffGn[h] : voffGc[h]) : voffA)
#define PG8_SA(b, h) (((b) * 2 + (h)) * HTB)
#define PG8_SB(b, h) ((4 + (b) * 2 + (h)) * HTB)
#define PG8_STAGE(bufoff, gbase, voff) do { _Pragma("unroll") for (int _i = 0; _i < 2; ++_i) \
        __builtin_amdgcn_global_load_lds((const unsigned*)((const char*)(gbase) + (voff)[_i]), (LAS unsigned*)(lds + (bufoff) + ldsw + _i * 8192), 16, 0, 0); } while (0)
#define PG8_LDA(dst, b, h) do { _Pragma("unroll") for (int m = 0; m < 4; ++m) _Pragma("unroll") for (int k = 0; k < 2; ++k) dst[m][k] = *(const LAS bf16x8*)(lds + PG8_SA(b, h) + aoff + m * 2048 + k * 1024); } while (0)
#define PG8_LDB(dst, b, h) do { _Pragma("unroll") for (int n = 0; n < 2; ++n) _Pragma("unroll") for (int k = 0; k < 2; ++k) dst[n][k] = *(const LAS bf16x8*)(lds + PG8_SB(b, h) + boff + n * 2048 + k * 1024); } while (0)
#define PG8_MMA(ai, bj, At, Bt) do { __builtin_amdgcn_s_setprio(1); _Pragma("unroll") for (int m = 0; m < 4; ++m) _Pragma("unroll") for (int n = 0; n < 2; ++n) _Pragma("unroll") for (int k = 0; k < 2; ++k) \
        acc[ai][bj][m][n] = __builtin_amdgcn_mfma_f32_16x16x32_bf16(Bt[n][k], At[m][k], acc[ai][bj][m][n], 0, 0, 0); __builtin_amdgcn_s_setprio(0); } while (0)
#define PG8_WAIT_V(n) asm volatile("s_waitcnt vmcnt(" #n ")" ::: "memory")
#define PG8_WAIT_L(n) asm volatile("s_waitcnt lgkmcnt(" #n ")" ::: "memory")
#define PG8_BAR __builtin_amdgcn_s_barrier()
#define PG8_SCHED __builtin_amdgcn_sched_barrier(0)
    Unit cur, nxt; int ui = 0;
    if (!S.next(0, cur)) return;
    f32x4 acc[2][2][4][2];
#pragma unroll
    for (int a = 0; a < 2; ++a)
#pragma unroll
        for (int b = 0; b < 2; ++b)
#pragma unroll
            for (int m = 0; m < 4; ++m)
#pragma unroll
                for (int n = 0; n < 2; ++n) acc[a][b][m][n] = (f32x4){0.f, 0.f, 0.f, 0.f};
    bf16x8 At[4][2], B0[2][2], B1[2][2];
    const char* cA = (const char*)g.A + (GATHER ? 0 : (size_t)cur.pm * tstep); const char* cB = (const char*)g.Bt + (size_t)cur.e * g.bgroup + (size_t)cur.pn * tstep;
    PG8_GOFF(voffGc, cur);
    if constexpr (SP2) {
        PG8_STAGE(PG8_SB(0, 0), cB, voffB); PG8_STAGE(PG8_SB(0, 1), cB + hstepB, voffB); PG8_STAGE(PG8_SA(0, 0), cA, PG8_VA(false, 0)); PG8_STAGE(PG8_SA(0, 1), cA + hstepA, PG8_VA(false, 1));
        if (wr == 1) PG8_BAR;
        PG8_WAIT_V(2); PG8_BAR;
        PG8_STAGE(PG8_SB(1, 0), cB + kstep, voffB); PG8_STAGE(PG8_SA(1, 0), cA + kstep, PG8_VA(false, 0)); PG8_STAGE(PG8_SB(1, 1), cB + hstepB + kstep, voffB);
        PG8_WAIT_V(6); PG8_BAR;
    } else {
        PG8_STAGE(PG8_SB(0, 0), cB, voffB); PG8_STAGE(PG8_SA(0, 0), cA, PG8_VA(false, 0)); PG8_STAGE(PG8_SB(0, 1), cB + hstepB, voffB); PG8_STAGE(PG8_SA(0, 1), cA + hstepA, PG8_VA(false, 1));
        if (wr == 1) PG8_BAR;
        PG8_WAIT_V(4); PG8_BAR;
        PG8_STAGE(PG8_SB(1, 0), cB + kstep, voffB); PG8_STAGE(PG8_SA(1, 0), cA + kstep, PG8_VA(false, 0)); PG8_STAGE(PG8_SB(1, 1), cB + hstepB + kstep, voffB);
        PG8_WAIT_V(6); PG8_BAR;
    }
    for (;;) {
        const bool has_next = S.next(ui + 1, nxt);
        const char* nA = has_next ? (const char*)g.A + (GATHER ? 0 : (size_t)nxt.pm * tstep) : cA;
        if (has_next) PG8_GOFF(voffGn, nxt); const char* nB = has_next ? (const char*)g.Bt + (size_t)nxt.e * g.bgroup + (size_t)nxt.pn * tstep : cB;
        if constexpr (Epi::META) { if (wid < 4) E.meta_dma(cur, wid, fq * 16 + fr, ui & 1); }
        for (int t = 0; t < nt; t += 2) {
            if constexpr (Epi::MID_T >= 0) { if (t == Epi::MID_T) E.mid(acc, cur, wr, wc, fr, fq); }
            const bool last = (t == nt - 2); const bool seln = last && has_next;
            const char* a1 = cA + (size_t)(t + 1) * kstep;
            const char* a2 = last ? nA : cA + (size_t)(t + 2) * kstep; const char* b2 = last ? nB : cB + (size_t)(t + 2) * kstep;
            const char* a3 = a2 + kstep; const char* b3 = b2 + kstep;
            if constexpr (SP2) {
            PG8_LDB(B0, 0, 0); PG8_LDB(B1, 0, 1); PG8_SCHED; PG8_LDA(At, 0, 0); PG8_STAGE(PG8_SA(1, 1), a1 + hstepA, PG8_VA(false, 1));
            PG8_WAIT_V(8); PG8_WAIT_L(0); PG8_BAR; PG8_MMA(0, 0, At, B0); PG8_MMA(0, 1, At, B1); PG8_BAR; PG8_SCHED;
            PG8_LDA(At, 0, 1); PG8_STAGE(PG8_SB(0, 0), b2, voffB); PG8_STAGE(PG8_SB(0, 1), b2 + hstepB, voffB); PG8_STAGE(PG8_SA(0, 0), a2, PG8_VA(seln, 0));
            PG8_WAIT_V(8); PG8_WAIT_L(0); PG8_BAR; PG8_MMA(1, 0, At, B0); PG8_MMA(1, 1, At, B1); PG8_BAR; PG8_SCHED;
            PG8_LDB(B0, 1, 0); PG8_LDB(B1, 1, 1); PG8_SCHED; PG8_LDA(At, 1, 0); PG8_STAGE(PG8_SA(0, 1), a2 + hstepA, PG8_VA(seln, 1));
            PG8_WAIT_V(8); PG8_WAIT_L(0); PG8_BAR; PG8_MMA(0, 0, At, B0); PG8_MMA(0, 1, At, B1); PG8_BAR; PG8_SCHED;
            PG8_LDA(At, 1, 1); PG8_STAGE(PG8_SB(1, 0), b3, voffB); PG8_STAGE(PG8_SB(1, 1), b3 + hstepB, voffB); PG8_STAGE(PG8_SA(1, 0), a3, PG8_VA(seln, 0));
            PG8_WAIT_V(8); PG8_WAIT_L(0); PG8_BAR; PG8_MMA(1, 0, At, B0); PG8_MMA(1, 1, At, B1); PG8_BAR; PG8_SCHED;
            } else {
            PG8_LDB(B0, 0, 0); PG8_SCHED; PG8_LDA(At, 0, 0); PG8_STAGE(PG8_SA(1, 1), a1 + hstepA, PG8_VA(false, 1));
            PG8_WAIT_L(8); PG8_BAR; PG8_WAIT_L(0); PG8_MMA(0, 0, At, B0); PG8_BAR; PG8_SCHED;
            PG8_LDB(B1, 0, 1); PG8_STAGE(PG8_SB(0, 0), b2, voffB);
            PG8_BAR; PG8_WAIT_L(0); PG8_MMA(0, 1, At, B1); PG8_BAR;
            PG8_LDA(At, 0, 1); PG8_STAGE(PG8_SA(0, 0), a2, PG8_VA(seln, 0));
            PG8_BAR; PG8_WAIT_L(0); PG8_MMA(1, 0, At, B0); PG8_BAR; PG8_SCHED;
            PG8_STAGE(PG8_SB(0, 1), b2 + hstepB, voffB);
            PG8_WAIT_V(6); PG8_BAR; PG8_MMA(1, 1, At, B1); PG8_BAR;
            PG8_LDB(B0, 1, 0); PG8_SCHED; PG8_LDA(At, 1, 0); PG8_STAGE(PG8_SA(0, 1), a2 + hstepA, PG8_VA(seln, 1));
            PG8_WAIT_L(8); PG8_BAR; PG8_WAIT_L(0); PG8_MMA(0, 0, At, B0); PG8_BAR; PG8_SCHED;
            PG8_LDB(B1, 1, 1); PG8_STAGE(PG8_SB(1, 0), b3, voffB);
            PG8_BAR; PG8_WAIT_L(0); PG8_MMA(0, 1, At, B1); PG8_BAR;
            PG8_LDA(At, 1, 1); PG8_STAGE(PG8_SA(1, 0), a3, PG8_VA(seln, 0));
            PG8_BAR; PG8_WAIT_L(0); PG8_MMA(1, 0, At, B0); PG8_BAR; PG8_SCHED;
            PG8_STAGE(PG8_SB(1, 1), b3 + hstepB, voffB);
            PG8_WAIT_V(6); PG8_BAR; PG8_MMA(1, 1, At, B1); PG8_BAR;
            }
        }
        if constexpr (ALIGN_EPI) { if (wr == 0) PG8_BAR; }
        if constexpr (Epi::META) E(acc, cur, wr, wc, fr, fq, ui & 1); else E(acc, cur, wr, wc, fr, fq);
        if (!has_next) break;
#pragma unroll
        for (int a = 0; a < 2; ++a)
#pragma unroll
            for (int b = 0; b < 2; ++b)
#pragma unroll
                for (int m = 0; m < 4; ++m)
#pragma unroll
                    for (int n = 0; n < 2; ++n) acc[a][b][m][n] = (f32x4){0.f, 0.f, 0.f, 0.f};
        cur = nxt; cA = nA; cB = nB; ++ui;
        if constexpr (GATHER) { voffGc[0][0] = voffGn[0][0]; voffGc[0][1] = voffGn[0][1]; voffGc[1][0] = voffGn[1][0]; voffGc[1][1] = voffGn[1][1]; }
        if constexpr (ALIGN_EPI) { if (wr == 1) PG8_BAR; }
    }
    PG8_WAIT_V(0);
    if constexpr (!ALIGN_EPI) { if (wr == 0) PG8_BAR; }
    PG8_BAR;
#undef PG8_SA
#undef PG8_GOFF
#undef PG8_VA
#undef PG8_SB
#undef PG8_STAGE
#undef PG8_LDA
#undef PG8_LDB
#undef PG8_MMA
#undef PG8_WAIT_V
#undef PG8_WAIT_L
#undef PG8_BAR
#undef PG8_SCHED
}

DI unsigned q8(float x) { return (unsigned)fmaxf(255.f * sigmoidf_(x) + 0.5f, 1.f); }
DI float ub(unsigned w, int j) { return (float)((w >> (8 * j)) & 0xffu); }
DI unsigned dppx1(unsigned v) { return (unsigned)__builtin_amdgcn_update_dpp(0, (int)v, 0xB1, 0xF, 0xF, true); }
template <bool NT = true>
DI void store_rows2(bf16* pe, size_t ldc, bool odd, const v4u& p0, const v4u& p1) {
    const v4u send = odd ? p0 : p1; const v4u recv = (v4u){dppx1(send.x), dppx1(send.y), dppx1(send.z), dppx1(send.w)};
    if constexpr (NT) { __builtin_nontemporal_store(odd ? recv : p0, (v4u*)pe); __builtin_nontemporal_store(odd ? p1 : recv, (v4u*)(pe + ldc)); }
    else { *(v4u*)pe = odd ? recv : p0; *(v4u*)(pe + ldc) = odd ? p1 : recv; }
}
template <bool NT = true>
DI void store_rows2p(bf16* pe0, bf16* pe1, bool odd, const v4u& p0, const v4u& p1) {
    const v4u send = odd ? p0 : p1; const v4u recv = (v4u){dppx1(send.x), dppx1(send.y), dppx1(send.z), dppx1(send.w)};
    if constexpr (NT) { __builtin_nontemporal_store(odd ? recv : p0, (v4u*)pe0); __builtin_nontemporal_store(odd ? p1 : recv, (v4u*)pe1); }
    else { *(v4u*)pe0 = odd ? recv : p0; *(v4u*)pe1 = odd ? p1 : recv; }
}
struct EpiIn {
    static constexpr bool PERM = true; static constexpr int MID_T = -1; static constexpr bool META = true;
    bf16* PR; bf16* PT; unsigned char* Gq; const float* bmerge; const int* pos; const float* qng; const float* kng; const float* rstd1; LAS unsigned* mt;
    __device__ __forceinline__ void meta_dma(const Unit& u, int wid, int lane, int par) const {
        __builtin_amdgcn_global_load_lds((const unsigned*)(rstd1 + u.pm * BM + wid * 64 + lane), mt + par * 512 + wid * 64, 4, 0, 0); }
    __device__ __forceinline__ void operator()(const f32x4 (&acc)[2][2][4][2], const Unit& u, int wr, int wc, int fr, int fq, int par) const {
        const int row0 = u.pm * BM + wr * 64 + fr; const int pn = u.pn;
        int mro = wr * 64 + fr; LAUNDER(mro); const LAS unsigned* mr = mt + par * 512 + mro;
#define EPI_RS(ai, m) __builtin_bit_cast(float, mr[(ai) * HALF + (m) * 16])
        if (pn >= 16) {
            const int col0 = (pn - 16) * BM + wc * 64 + 16 * fq;
            f32x4 bv[2][2];
#pragma unroll
            for (int bj = 0; bj < 2; ++bj)
#pragma unroll
                for (int n = 0; n < 2; ++n) bv[bj][n] = *(const f32x4*)(bmerge + col0 + bj * 8 + 4 * n);
            unsigned char* gp = Gq + (size_t)row0 * G_COLS + col0;
#pragma unroll
            for (int ai = 0; ai < 2; ++ai)
#pragma unroll
                for (int m = 0; m < 4; ++m) { unsigned w[4];
#pragma unroll
                    for (int bj = 0; bj < 2; ++bj)
#pragma unroll
                        for (int n = 0; n < 2; ++n) { const f32x4 v = acc[ai][bj][m][n] * EPI_RS(ai, m) + bv[bj][n]; w[bj * 2 + n] = q8(v[0]) | (q8(v[1]) << 8) | (q8(v[2]) << 16) | (q8(v[3]) << 24); }
                    *(v4u*)(gp + (size_t)(ai * HALF + m * 16) * G_COLS) = (v4u){w[0], w[1], w[2], w[3]}; }
            return; }
        if (pn >= 7 && pn < 13) {
            const bool isq = pn < 10;
            int pcur = pos[row0];
            const float* gp = (isq ? qng : kng) + 16 * fq; const f32x4 g0 = *(const f32x4*)gp, g1 = *(const f32x4*)(gp + 4), g2 = *(const f32x4*)(gp + 8), g3 = *(const f32x4*)(gp + 12);
            constexpr float IF2PI[8] = {0.15915494309189535f, 0.03086376340470123f, 0.005985185712713705f, 0.001160663641240061f, 0.00022507907903927653f, 4.364795279280289e-05f, 8.464330808241401e-06f, 1.6414262627950345e-06f};
            const int col0 = (pn - 7) * BM + wc * 64 + 16 * fq;
#pragma unroll
            for (int ai = 0; ai < 2; ++ai)
#pragma unroll
                for (int m = 0; m < 4; ++m) { const int row = row0 + ai * HALF + m * 16; bf16* pe = PT + (size_t)(row - (fr & 1)) * AT_COLS + (pn - 7) * BM + wc * 64 + (2 * fq + (fr & 1)) * 8;
                    const int pnext = pos[(ai == 1 && m == 3) ? row : (m == 3 ? row0 + HALF : row + 16)];
                    const float rs_ = EPI_RS(ai, m); const f32x4 a0 = acc[ai][0][m][0] * rs_, a1 = acc[ai][0][m][1] * rs_, a2 = acc[ai][1][m][0] * rs_, a3 = acc[ai][1][m][1] * rs_;
                    float s = ((a0[0] * a0[0] + a0[1] * a0[1]) + (a0[2] * a0[2] + a0[3] * a0[3])) + ((a1[0] * a1[0] + a1[1] * a1[1]) + (a1[2] * a1[2] + a1[3] * a1[3]))
                            + ((a2[0] * a2[0] + a2[1] * a2[1]) + (a2[2] * a2[2] + a2[3] * a2[3])) + ((a3[0] * a3[0] + a3[1] * a3[1]) + (a3[2] * a3[2] + a3[3] * a3[3]));
                    s += __shfl_xor(s, 16); s += __shfl_xor(s, 32);
                    const float rs = (1.f / sqrtf(s * (1.f / 64.f) + NORM_EPS)) * (isq ? 0.18033688011112042f : 1.f);
                    float y[16];
#pragma unroll
                    for (int j = 0; j < 4; ++j) { y[j] = a0[j] * g0[j]; y[4 + j] = a1[j] * g1[j]; y[8 + j] = a2[j] * g2[j]; y[12 + j] = a3[j] * g3[j]; }
                    const float pf = (float)pcur; pcur = pnext;
#pragma unroll
                    for (int j = 0; j < 8; ++j) { float r = pf * IF2PI[j]; r = r - floorf(r);
                        const float sn = __builtin_amdgcn_sinf(r), cs = __builtin_amdgcn_cosf(r);
                        const float lo = y[j] * cs - y[8 + j] * sn, hi = y[8 + j] * cs + y[j] * sn;
                        if (fq == 0) { y[j] = lo; y[8 + j] = hi; } }
                    v4u w0, w1; w0.x = pk2(y[0] * rs, y[1] * rs); w0.y = pk2(y[2] * rs, y[3] * rs); w0.z = pk2(y[4] * rs, y[5] * rs); w0.w = pk2(y[6] * rs, y[7] * rs);
                    w1.x = pk2(y[8] * rs, y[9] * rs); w1.y = pk2(y[10] * rs, y[11] * rs); w1.z = pk2(y[12] * rs, y[13] * rs); w1.w = pk2(y[14] * rs, y[15] * rs);
                    store_rows2(pe, AT_COLS, fr & 1, w0, w1);
                    __builtin_amdgcn_sched_barrier(0); }
            return; }
        bf16* base; int ldc, colt;
        if (pn < 7) { base = PR; ldc = RW_COLS; colt = pn * BM; } else { base = PT; ldc = AT_COLS; colt = (pn - 7) * BM; }
        const int col0 = colt + wc * 64 + 16 * fq;
#pragma unroll
        for (int ai = 0; ai < 2; ++ai)
#pragma unroll
            for (int m = 0; m < 4; ++m) { bf16* pe = base + (size_t)(row0 - (fr & 1) + ai * HALF + m * 16) * ldc + colt + wc * 64 + (2 * fq + (fr & 1)) * 8; v4u w[2];
#pragma unroll
                for (int bj = 0; bj < 2; ++bj) { const f32x4 v0 = acc[ai][bj][m][0] * EPI_RS(ai, m), v1 = acc[ai][bj][m][1] * EPI_RS(ai, m);
                    w[bj].x = pk2(v0[0], v0[1]); w[bj].y = pk2(v0[2], v0[3]); w[bj].z = pk2(v1[0], v1[1]); w[bj].w = pk2(v1[2], v1[3]); }
                store_rows2(pe, ldc, fr & 1, w[0], w[1]); }
    }
};
#undef EPI_RS
struct EpiMix2 {
    static constexpr bool PERM = true; static constexpr int MID_T = 8; static constexpr bool META = false;
    const unsigned char* Gq; bf16* Zout;
    __device__ __forceinline__ void mid(f32x4 (&acc)[2][2][4][2], const Unit& u, int wr, int wc, int fr, int fq) const {
        int row0 = u.pm * BM + wr * 64 + fr; LAUNDER(row0);
        const unsigned char* gp = Gq + u.pn * 256 + wc * 64 + fq * 16;
#pragma unroll
        for (int ai = 0; ai < 2; ++ai)
#pragma unroll
            for (int m = 0; m < 4; ++m) { const size_t r = (size_t)(row0 + ai * HALF + m * 16);
                const v4u ga = *(const v4u*)(gp + r * G_COLS), gb = *(const v4u*)(gp + r * G_COLS + 1024);
                const unsigned aw[4] = {ga.x, ga.y, ga.z, ga.w}, bw[4] = {gb.x, gb.y, gb.z, gb.w};
#pragma unroll
                for (int bj = 0; bj < 2; ++bj)
#pragma unroll
                    for (int n = 0; n < 2; ++n)
#pragma unroll
                        for (int j = 0; j < 4; ++j) acc[ai][bj][m][n][j] *= ub(aw[bj * 2 + n], j) * __builtin_amdgcn_rcpf(ub(bw[bj * 2 + n], j));
                __builtin_amdgcn_sched_barrier(0); }
    }
    __device__ __forceinline__ void operator()(const f32x4 (&acc)[2][2][4][2], const Unit& u, int wr, int wc, int fr, int fq) const {
        const int row0 = u.pm * BM + wr * 64 + fr, col0 = u.pn * BM + wc * 64 + 16 * fq;
        const unsigned char* gp = Gq + u.pn * 256 + wc * 64 + fq * 16 + 1024;
#pragma unroll
        for (int ai = 0; ai < 2; ++ai)
#pragma unroll
            for (int m = 0; m < 4; ++m) { const size_t r = (size_t)(row0 + ai * HALF + m * 16);
                const v4u gb = *(const v4u*)(gp + r * G_COLS); const unsigned bw[4] = {gb.x, gb.y, gb.z, gb.w};
                v4u w[2];
#pragma unroll
                for (int bj = 0; bj < 2; ++bj) {
                    const f32x4 v0 = acc[ai][bj][m][0] * (1.f / 255.f), v1 = acc[ai][bj][m][1] * (1.f / 255.f); const unsigned b0 = bw[bj * 2], b1 = bw[bj * 2 + 1];
                    w[bj].x = pk2(v0[0] * ub(b0, 0), v0[1] * ub(b0, 1)); w[bj].y = pk2(v0[2] * ub(b0, 2), v0[3] * ub(b0, 3));
                    w[bj].z = pk2(v1[0] * ub(b1, 0), v1[1] * ub(b1, 1)); w[bj].w = pk2(v1[2] * ub(b1, 2), v1[3] * ub(b1, 3)); }
                store_rows2<false>(Zout + (r - (fr & 1)) * DM + u.pn * BM + wc * 64 + (2 * fq + (fr & 1)) * 8, DM, fr & 1, w[0], w[1]); }
    }
};
struct EpiRes {
    static constexpr bool PERM = true; static constexpr int MID_T = -1; static constexpr bool META = false;
    const bf16* X; bf16* O;
    __device__ __forceinline__ void operator()(const f32x4 (&acc)[2][2][4][2], const Unit& u, int wr, int wc, int fr, int fq) const {
        const int row0 = u.pm * BM + wr * 64 + fr, col0 = u.pn * BM + wc * 64 + 16 * fq;
#pragma unroll
        for (int ai = 0; ai < 2; ++ai)
#pragma unroll
            for (int m = 0; m < 4; ++m) { const size_t off = (size_t)(row0 + ai * HALF + m * 16) * DM + col0;
                v4u w[2];
#pragma unroll
                for (int bj = 0; bj < 2; ++bj) { const v4u xq = *(const v4u*)(X + off + bj * 8); const f32x4 x0 = (f32x4){bflo(xq.x), bfhi(xq.x), bflo(xq.y), bfhi(xq.y)} + acc[ai][bj][m][0], x1 = (f32x4){bflo(xq.z), bfhi(xq.z), bflo(xq.w), bfhi(xq.w)} + acc[ai][bj][m][1];
                    w[bj].x = pk2(x0[0], x0[1]); w[bj].y = pk2(x0[2], x0[3]); w[bj].z = pk2(x1[0], x1[1]); w[bj].w = pk2(x1[2], x1[3]); }
                store_rows2<false>(O + (size_t)(row0 - (fr & 1) + ai * HALF + m * 16) * DM + u.pn * BM + wc * 64 + (2 * fq + (fr & 1)) * 8, DM, fr & 1, w[0], w[1]); }
    }
};
struct EpiSwiglu {
    static constexpr bool PERM = false; static constexpr int MID_T = -1; static constexpr bool META = true;
    bf16* H; const float* lr; const LAS int* tab; LAS unsigned* mt;
    __device__ __forceinline__ void meta_dma(const Unit& u, int wid, int lane, int par) const {
        const int slot = (u.pm - tab[u.e]) * 256 + wid * 64 + lane;
        __builtin_amdgcn_global_load_lds((const unsigned*)(lr + (size_t)u.e * NTOK + slot), mt + par * 512 + wid * 64, 4, 0, 0); }
    __device__ __forceinline__ void operator()(const f32x4 (&acc)[2][2][4][2], const Unit& u, int wr, int wc, int fr, int fq, int par) const {
        const int rl0 = wr * 64 + fr, row0 = u.pm * BM + rl0, col0 = u.pn * 128 + wc * 16 + 4 * fq, slot0 = (u.pm - tab[u.e]) * 256 + rl0, cnt = tab[33 + u.e];
#pragma unroll
        for (int ai = 0; ai < 2; ++ai)
#pragma unroll
            for (int m = 0; m < 4; ++m) { bf16* rowp = H + (size_t)(row0 + ai * HALF + m * 16) * DEXP + col0;
                const float rs = (slot0 + ai * HALF + m * 16 < cnt) ? __builtin_bit_cast(float, mt[par * 512 + rl0 + ai * HALF + m * 16]) : 0.f;
#pragma unroll
                for (int bj = 0; bj < 2; ++bj) { const f32x4 gt = acc[ai][bj][m][0] * rs, up = acc[ai][bj][m][1] * rs; f32x4 o;
#pragma unroll
                    for (int j = 0; j < 4; ++j) o[j] = gt[j] * sigmoidf_(gt[j]) * up[j];
                    v2u w; w.x = pk2(o[0], o[1]); w.y = pk2(o[2], o[3]);
                    *(v2u*)(rowp + bj * 64) = w; } }
    }
};
struct EpiStoreY {
    static constexpr bool PERM = true; static constexpr int MID_T = -1; static constexpr bool META = true;
    const int* ltok; const float* lw; const LAS int* tab; bf16* Y; LAS unsigned* mt;
    __device__ __forceinline__ void meta_dma(const Unit& u, int wid, int lane, int par) const {
        const int slot = (u.pm - tab[u.e]) * 256 + wid * 64 + lane;
        __builtin_amdgcn_global_load_lds((const unsigned*)(ltok + (size_t)u.e * NTOK + slot), mt + par * 512 + wid * 64, 4, 0, 0);
        __builtin_amdgcn_global_load_lds((const unsigned*)(lw + (size_t)u.e * NTOK + slot), mt + par * 512 + 256 + wid * 64, 4, 0, 0); }
    __device__ __forceinline__ void operator()(const f32x4 (&acc)[2][2][4][2], const Unit& u, int wr, int wc, int fr, int fq, int par) const {
        const int rl0 = wr * 64 + fr, slot0 = (u.pm - tab[u.e]) * 256, cnt = tab[33 + u.e];
        const int po = u.pn * BM + wc * 64 + (2 * fq + (fr & 1)) * 8;
#pragma unroll
        for (int ai = 0; ai < 2; ++ai)
#pragma unroll
            for (int m = 0; m < 4; ++m) { const int rl = rl0 + ai * HALF + m * 16; const bool ok = slot0 + rl < cnt;
                const int t2 = ok ? (int)mt[par * 512 + rl] : 2 * NTOK; const float w = ok ? __builtin_bit_cast(float, mt[par * 512 + 256 + rl]) : 0.f;
                const int t2p = (int)dppx1((unsigned)t2);
                v4u o[2];
#pragma unroll
                for (int bj = 0; bj < 2; ++bj) { const f32x4 v0 = acc[ai][bj][m][0] * w, v1 = acc[ai][bj][m][1] * w;
                    o[bj].x = pk2(v0[0], v0[1]); o[bj].y = pk2(v0[2], v0[3]); o[bj].z = pk2(v1[0], v1[1]); o[bj].w = pk2(v1[2], v1[3]); }
                store_rows2p<true>(Y + (size_t)((fr & 1) ? t2p : t2) * DM + po, Y + (size_t)((fr & 1) ? t2 : t2p) * DM + po, fr & 1, o[0], o[1]); }
    }
};
}

#define XB_TMO      128
#define XB_XCNT(j)  (256  + 64 * (j))
#define XB_XSUB(j)  (1280 + 64 * (j))
#define XB_XGEN(j)  (2304 + 64 * (j))
#define XB_TOP      3328
#define XB_TOPGEN   3392
#define XCD_BAR_WORDS 3456
#define XB_SPIN_CAP (1u << 18)
__device__ __forceinline__ unsigned xb_ld(unsigned* p)              { return __hip_atomic_load(p, __ATOMIC_RELAXED, __HIP_MEMORY_SCOPE_AGENT); }
__device__ __forceinline__ unsigned xb_add(unsigned* p, unsigned v) { return __hip_atomic_fetch_add(p, v, __ATOMIC_RELAXED, __HIP_MEMORY_SCOPE_AGENT); }
__device__ __forceinline__ unsigned xb_xcc_id() { return (unsigned)__builtin_amdgcn_s_getreg((3 << 11) | 20) & 0xFu; }
#define XB_SPIN(cond, bar) do { unsigned _sp = 0; while (cond) { __builtin_amdgcn_s_sleep(1); \
    if ((++_sp & 255u) == 0u) { if (xb_ld(&(bar)[XB_TMO])) break; if (_sp > XB_SPIN_CAP) { atomicAdd(&(bar)[XB_TMO], 1u); break; } } } } while (0)
struct XcdBarrier { unsigned* bar; unsigned x; volatile LAS unsigned* st; };
__device__ __forceinline__ XcdBarrier xcd_barrier_post(unsigned* bar, volatile LAS unsigned* st) {
    XcdBarrier b; b.bar = bar; b.x = xb_xcc_id(); b.st = st;
    if (threadIdx.x == 0) (void)xb_add(&bar[XB_XCNT(b.x)], 1u);
    return b;
}
__device__ __forceinline__ void xcd_barrier_complete(unsigned* bar, unsigned x, unsigned& nloc, unsigned& nx) {
    const unsigned G = gridDim.x * gridDim.y * gridDim.z;
    unsigned sum, cnt, mine, sp = 0u;
    for (;;) {
        sum = 0u; cnt = 0u; mine = 0u;
#pragma unroll
        for (unsigned j = 0; j < 16; ++j) { const unsigned c = xb_ld(&bar[XB_XCNT(j)]); sum += c; cnt += (c > 0u) ? 1u : 0u; mine = (j == x) ? c : mine; }
        if (sum == G) break;
        __builtin_amdgcn_s_sleep(1);
        if ((++sp & 255u) == 0u) { if (xb_ld(&bar[XB_TMO])) break; if (sp > XB_SPIN_CAP) { atomicAdd(&bar[XB_TMO], 1u); break; } }
    }
    nloc = mine > 0u ? mine : 1u; nx = cnt > 0u ? cnt : 1u;
}
__device__ __forceinline__ void xcd_barrier(const XcdBarrier& b) {
    asm volatile("s_waitcnt vmcnt(0)" ::: "memory");
    __syncthreads();
    if (threadIdx.x == 0) {
        unsigned* bar = b.bar;
        __builtin_amdgcn_s_waitcnt(0);
        unsigned nloc = b.st[0], nx = b.st[1];
        if (nloc == 0u) { xcd_barrier_complete(bar, b.x, nloc, nx); b.st[0] = nloc; b.st[1] = nx; }
        const unsigned old = xb_add(&bar[XB_XSUB(b.x)], 1u);
        const unsigned gen = old / nloc;
        if (old + 1u == (gen + 1u) * nloc) {
            __builtin_amdgcn_fence(__ATOMIC_RELEASE, "agent");
            asm volatile("s_waitcnt vmcnt(0)" ::: "memory");
            const unsigned og = xb_add(&bar[XB_TOP], 1u);
            const unsigned tg = og / nx;
            if (og + 1u == (tg + 1u) * nx) xb_add(&bar[XB_TOPGEN], 1u);
            else XB_SPIN(xb_ld(&bar[XB_TOPGEN]) == tg, bar);
            __builtin_amdgcn_fence(__ATOMIC_ACQUIRE, "agent");
            xb_add(&bar[XB_XGEN(b.x)], 1u);
            asm volatile("s_waitcnt vmcnt(0)" ::: "memory");
        } else {
            XB_SPIN(xb_ld(&bar[XB_XGEN(b.x)]) == gen, bar);
            __builtin_amdgcn_fence(__ATOMIC_ACQUIRE, "agent");
            asm volatile("s_waitcnt vmcnt(0)" ::: "memory");
        }
    }
    __syncthreads();
}

struct Args { const void* in[30]; float* out; unsigned char* ws; int ph_lo, ph_hi, li, variant; };
struct Frame {
    LAS unsigned char* lds; volatile LAS unsigned* MISC;
    int tid, lane, wave, G, bid, variant;
    unsigned char* ws;
};
enum { I_X = 0, I_POS, I_N1G, I_WIN, I_MUP, I_MUN, I_WD0, I_WDUP, I_AG0, I_AGUP, I_GUP, I_KK, I_KA, I_RK, I_GNW, I_GNB, I_WROUT, I_QNG, I_KNG, I_WAOUT, I_BMERGE, I_WOUT,
       I_N2G, I_WRG, I_BRG, I_WRE, I_BRE, I_WGATE, I_WUP, I_WDOWN };

template <class RowMap>
DI void transpose_item(const float* W, int K, int N, bf16* WT, const RowMap& rm, LAS float* scr, int item, int lane, int ldk = 0, int koff = 0, const float* rs = nullptr) {
    if (ldk == 0) ldk = K;
    const int nblk = N / 32, kb = item / nblk, nb = item % nblk, k0 = 64 * kb, n0 = 32 * nb;
#pragma unroll
    for (int i = 0; i < 8; ++i) { const int kk = 8 * i + (lane >> 3);
        const f32x4 v = __builtin_nontemporal_load((const GAS f32x4*)(W + (size_t)(k0 + kk) * N + n0 + 4 * (lane & 7)));
        LAS float* d = scr + kk * 33 + 4 * (lane & 7); d[0] = v[0]; d[1] = v[1]; d[2] = v[2]; d[3] = v[3]; }
    LDS_WAIT(); asm volatile("" ::: "memory");
    const int c = lane & 7;
    f32x4 ra = (f32x4){1.f, 1.f, 1.f, 1.f}, rb = ra; if (rs) { ra = *(const f32x4*)(rs + k0 + 8 * c); rb = *(const f32x4*)(rs + k0 + 8 * c + 4); }
#pragma unroll
    for (int j = 0; j < 4; ++j) { const int n = (lane >> 3) + 8 * j; const LAS float* s = scr + (8 * c) * 33 + n;
        v4u o; o.x = pk2(s[0 * 33] * ra[0], s[1 * 33] * ra[1]); o.y = pk2(s[2 * 33] * ra[2], s[3 * 33] * ra[3]); o.z = pk2(s[4 * 33] * rb[0], s[5 * 33] * rb[1]); o.w = pk2(s[6 * 33] * rb[2], s[7 * 33] * rb[3]);
        *(GAS v4u*)(WT + (size_t)rm(n0 + n) * ldk + koff + k0 + 8 * c) = o; }
    LDS_WAIT(); asm volatile("" ::: "memory");
}
struct RmId { DI int operator()(int n) const { return n; } };
struct RmGate { DI int operator()(int n) const { return 32 * (n >> 4) + (n & 15); } };
struct RmUp { DI int operator()(int n) const { return 32 * (n >> 4) + 16 + (n & 15); } };

DI void p0_prologue(Frame& F, const Args& a) {
    LAS float* scr = (LAS float*)(F.lds + F.wave * 16384);
    const int gw = F.bid * NWAVES + F.wave, NGW = F.G * NWAVES;
    unsigned char* ws = F.ws;
    constexpr int I_IN = (DM / 64) * (IN_COLS / 32), I_R = (512 / 64) * (DM / 32), I_A = (256 / 64) * (DM / 32), I_O = (DM / 64) * (DM / 32), I_G = (128 / 64) * (512 / 32), I_L = 512 / 32;
    constexpr int NITEMS = I_IN + I_R + I_A + I_O + I_G + 4 * I_L;
    for (int it = gw; it < NITEMS; it += NGW) {
        int r = it;
        if (r < I_IN) { transpose_item((const float*)a.in[I_WIN], DM, IN_COLS, (bf16*)(ws + WS_WIN_T), RmId(), scr, r, F.lane, 0, 0, (const float*)a.in[I_N1G]); continue; } r -= I_IN;
        if (r < I_R) { transpose_item((const float*)a.in[I_WROUT], 512, DM, (bf16*)(ws + WS_WR_T), RmId(), scr, r, F.lane, YC_COLS, 0); continue; } r -= I_R;
        if (r < I_A) { transpose_item((const float*)a.in[I_WAOUT], 256, DM, (bf16*)(ws + WS_WR_T), RmId(), scr, r, F.lane, YC_COLS, 512); continue; } r -= I_A;
        if (r < I_O) { transpose_item((const float*)a.in[I_WOUT], DM, DM, (bf16*)(ws + WS_WOUT_T), RmId(), scr, r, F.lane); continue; } r -= I_O;
        if (r < I_G) { transpose_item((const float*)a.in[I_GUP], 128, 512, (bf16*)(ws + WS_GUP_T), RmId(), scr, r, F.lane); continue; } r -= I_G;
        { const int d = r / I_L, rr = r % I_L;
          if (d < 2) transpose_item((const float*)a.in[I_WDUP] + (size_t)d * 64 * 512, 64, 512, (bf16*)(ws + WS_WUP_T) + (size_t)d * 512 * 64, RmId(), scr, rr, F.lane);
          else transpose_item((const float*)a.in[I_AGUP] + (size_t)(d - 2) * 64 * 512, 64, 512, (bf16*)(ws + WS_AUP_T) + (size_t)(d - 2) * 512 * 64, RmId(), scr, rr, F.lane); }
    }
    { const float* g2 = (const float*)a.in[I_N2G]; const float* wre = (const float*)a.in[I_WRE]; const float* wrg = (const float*)a.in[I_WRG];
      bf16* hi = (bf16*)(ws + WS_RT_HI); bf16* lo = (bf16*)(ws + WS_RT_LO);
      for (int i = F.bid * 512 + F.tid; i < 64 * DM; i += F.G * 512) { const int n = i / DM, k = i % DM;
          float v = 0.f; if (n < 32) v = g2[k] * wre[k * 32 + n]; else if (n < 36) v = g2[k] * wrg[k * 4 + (n - 32)];
          const unsigned h = pk2(v, 0.f) & 0xffffu; const float hf = bflo(h);
          const int pos = (((k >> 4) * 4 + (n >> 5)) * 64 + (n & 31) + 32 * ((k >> 3) & 1)) * 8 + (k & 7);
          hi[pos] = (bf16)h; hi[pos + 2 * 64 * 8] = (bf16)(pk2(v - hf, 0.f) & 0xffffu); } }
    { const float* x = (const float*)a.in[I_X]; float* rs1 = (float*)(ws + WS_RSTD1);
      for (int m = gw; m < NTOK; m += NGW) {
          const GAS f32x4* xr = (const GAS f32x4*)(x + (size_t)m * DM) + F.lane; f32x4 v[4]; float s = 0.f;
#pragma unroll
          for (int j = 0; j < 4; ++j) { v[j] = __builtin_nontemporal_load(xr + 64 * j); s += (v[j].x * v[j].x + v[j].y * v[j].y) + (v[j].z * v[j].z + v[j].w * v[j].w); }
          const float rstd = 1.f / sqrtf(wave_sum(s) * (1.f / DM) + NORM_EPS);
          if (F.lane == 0) rs1[m] = rstd;
          GAS v2u* x8 = (GAS v2u*)((bf16*)(ws + WS_XB) + (size_t)m * DM) + F.lane;
#pragma unroll
          for (int j = 0; j < 4; ++j) { v2u xw; xw.x = pk2(v[j].x, v[j].y); xw.y = pk2(v[j].z, v[j].w); __builtin_nontemporal_store(xw, x8 + 64 * j); } } }
}

DI void p1c_preshift(Frame& F, const Args& a) {
    if (F.tid >= 448) return;
    const bf16* PR = (const bf16*)(F.ws + WS_PR); bf16* PS = (bf16*)a.out;
    const int rsub = F.tid / 224, cg8 = (F.tid % 224) * 8;
    const float* mup = (const float*)a.in[I_MUP] + cg8; const float* mun = (const float*)a.in[I_MUN] + cg8;
    const f32x4 mp0 = *(const f32x4*)mup, mp1 = *(const f32x4*)(mup + 4), mn0 = *(const f32x4*)mun, mn1 = *(const f32x4*)(mun + 4);
    const int mode = (cg8 >= 1536 && cg8 < 1600) ? 1 : (cg8 >= 1664 ? 2 : 0);
    const int rows_per = NTOK / F.G, hrows = rows_per / 2;
    for (int rb = F.bid * rows_per + rsub * hrows; rb < F.bid * rows_per + (rsub + 1) * hrows; rb += 16) {
        v4u w[18];
#pragma unroll
        for (int i = 0; i < 18; ++i) { int row = rb - 1 + i; row = row < 0 ? 0 : (row > NTOK - 1 ? NTOK - 1 : row); w[i] = __builtin_nontemporal_load((const v4u*)(PR + (size_t)row * RW_COLS + cg8)); }
#pragma unroll
        for (int i = 0; i < 16; ++i) { const int row = rb + i, t = row % SEQ; const float fp = t > 0 ? 1.f : 0.f, fn = t < SEQ - 1 ? 1.f : 0.f;
            const unsigned cw[4] = {w[i + 1].x, w[i + 1].y, w[i + 1].z, w[i + 1].w}, pw[4] = {w[i].x, w[i].y, w[i].z, w[i].w}, nw[4] = {w[i + 2].x, w[i + 2].y, w[i + 2].z, w[i + 2].w};
            float y[8];
#pragma unroll
            for (int j = 0; j < 4; ++j) {
                const float c0 = bflo(cw[j]), c1 = bfhi(cw[j]), p0 = bflo(pw[j]) * fp, p1 = bfhi(pw[j]) * fp, n0 = bflo(nw[j]) * fn, n1 = bfhi(nw[j]) * fn;
                const float m0 = j < 2 ? mp0[2 * j] : mp1[2 * j - 4], m1 = j < 2 ? mp0[2 * j + 1] : mp1[2 * j - 3], q0 = j < 2 ? mn0[2 * j] : mn1[2 * j - 4], q1 = j < 2 ? mn0[2 * j + 1] : mn1[2 * j - 3];
                y[2 * j] = c0 + m0 * (p0 - c0) + q0 * (n0 - c0); y[2 * j + 1] = c1 + m1 * (p1 - c1) + q1 * (n1 - c1); }
            if (mode == 1) {
#pragma unroll
                for (int j = 0; j < 8; ++j) y[j] = 1.f - 2.f * __builtin_amdgcn_rcpf(1.f + __builtin_amdgcn_exp2f(2.88539008f * y[j])); }
            if (mode == 2) {
#pragma unroll
                for (int j = 0; j < 8; ++j) y[j] = sigmoidf_(y[j]); }
            v4u o; o.x = pk2(y[0], y[1]); o.y = pk2(y[2], y[3]); o.z = pk2(y[4], y[5]); o.w = pk2(y[6], y[7]);
            if (!VAR(64)) *(v4u*)(PS + (size_t)row * RW_COLS + cg8) = o; }
    }
}

DI bf16x8 pack8(float a0, float a1, float a2, float a3, float a4, float a5, float a6, float a7) {
    v4u p; p.x = pk2(a0, a1); p.y = pk2(a2, a3); p.z = pk2(a4, a5); p.w = pk2(a6, a7); return __builtin_bit_cast(bf16x8, p);
}
constexpr int ATT_ACC = 8 * 9216, ATT_LSE = ATT_ACC + 512 * 144;
DI f32x4 up4a(v2u u) { return (f32x4){bflo(u.x), bfhi(u.x), bflo(u.y), bfhi(u.y)}; }
DI void attn_unit(Frame& F, int b, int hh, int span) {
    const bf16* PT = (const bf16*)(F.ws + WS_PT); bf16* Og = (bf16*)(F.ws + WS_OG); float* Lse = (float*)(F.ws + WS_LSE); bf16* YA = (bf16*)(F.ws + WS_YA);
    LAS unsigned char* vbuf = F.lds + F.wave * 9216;
    const int lane = F.lane, n = lane & 31, half = lane >> 5;
    const int T0 = span * 512; const size_t rowbase = (size_t)b * SEQ;
    struct SubP { int g, dsh, r, l0, head, tq, kb_lo, kb_hi; };
    auto subp = [&](int su) __attribute__((always_inline)) { SubP p; p.g = su >> 4; const int s16 = su & 15; p.dsh = 2 * p.g; const int L = SEQ >> p.dsh, per_r = 16 >> p.dsh;
        p.r = s16 / per_r; const int sb = s16 % per_r; p.l0 = (T0 >> p.dsh) + sb * 32; p.head = 4 * p.g + hh; p.tq = ((p.l0 + n) << p.dsh) + p.r;
        p.kb_lo = p.l0 >= 64 ? 0 : (64 - p.l0) >> 5; p.kb_hi = min(4, (L + 32 - p.l0) >> 5); return p; };
    bf16x8 qf[4], kfn[4]; v4u vvn[4];
#define ATT_QLOAD(P, Q) do { const bf16* qp_ = PT + (rowbase + (P).tq) * AT_COLS + (P).head * 64 + 8 * half; _Pragma("unroll") for (int kk = 0; kk < 4; ++kk) Q[kk] = *(const bf16x8*)(qp_ + 16 * kk); } while (0)
#define ATT_PRELOAD(P, kbx) do { const int lk0_ = (P).l0 - 64 + 32 * (kbx); \
            _Pragma("unroll") for (int j = 0; j < 4; ++j) { const int idx = lane + 64 * j, key = idx >> 3, ch = idx & 7; const int tk_ = ((lk0_ + key) << (P).dsh) + (P).r; \
                vvn[j] = *(const v4u*)(PT + (rowbase + tk_) * AT_COLS + 1536 + (P).head * 64 + ch * 8); } \
            const int tk2_ = ((lk0_ + n) << (P).dsh) + (P).r; const bf16* kp_ = PT + (rowbase + tk2_) * AT_COLS + 768 + (P).head * 64 + 8 * half; \
            _Pragma("unroll") for (int kk = 0; kk < 4; ++kk) kfn[kk] = *(const bf16x8*)(kp_ + 16 * kk); } while (0)
    SubP cur = subp(F.wave);
    ATT_QLOAD(cur, qf); ATT_PRELOAD(cur, cur.kb_lo);
    for (int su = F.wave; su < 48; su += 8) {
        const bool has_next = su + 8 < 48; const SubP nxt = subp(has_next ? su + 8 : su);
        const int g = cur.g, tq = cur.tq, kb_lo = cur.kb_lo, kb_hi = cur.kb_hi;
        bf16x8 qn[4];
        f32x16 o0, o1;
#pragma unroll
        for (int i = 0; i < 16; ++i) { o0[i] = 0.f; o1[i] = 0.f; }
        float mrun = -1e30f, lrun = 0.f;
        for (int kb = kb_lo; kb <= kb_hi; ++kb) {
            LAS unsigned char* vb = vbuf + (kb & 1) * 4608;
            bf16x8 kf[4];
#pragma unroll
            for (int j = 0; j < 4; ++j) { const int idx = lane + 64 * j, key = idx >> 3, ch = idx & 7; *(LAS v4u*)(vb + key * 144 + ch * 16) = vvn[j]; kf[j] = kfn[j]; }
            if (kb < kb_hi) ATT_PRELOAD(cur, kb + 1);
            else if (has_next) { ATT_QLOAD(nxt, qn); ATT_PRELOAD(nxt, nxt.kb_lo); }
            f32x16 s;
#pragma unroll
            for (int i = 0; i < 16; ++i) s[i] = 0.f;
#pragma unroll
            for (int kk = 0; kk < 4; ++kk) s = MFMA32(kf[kk], qf[kk], s);
            if (kb == 0) {
#pragma unroll
                for (int i = 0; i < 16; ++i) if (crow(i, half) < n) s[i] = -1e30f; }
            if (kb == 4) {
#pragma unroll
                for (int i = 0; i < 16; ++i) if (crow(i, half) > n) s[i] = -1e30f; }
            float mx = s[0];
#pragma unroll
            for (int i = 1; i < 16; ++i) mx = fmaxf(mx, s[i]);
            mx = fmaxf(mx, __shfl_xor(mx, 32));
            const float mnew = fmaxf(mrun, mx), alpha = __builtin_amdgcn_exp2f(mrun - mnew); mrun = mnew;
            float ps = 0.f;
#pragma unroll
            for (int i = 0; i < 16; ++i) { s[i] = __builtin_amdgcn_exp2f(s[i] - mnew); ps += s[i]; }
            lrun = lrun * alpha + ps;
#pragma unroll
            for (int i = 0; i < 16; ++i) { o0[i] *= alpha; o1[i] *= alpha; }
            const bf16x8 pf0 = pack8(s[0], s[1], s[2], s[3], s[4], s[5], s[6], s[7]), pf1 = pack8(s[8], s[9], s[10], s[11], s[12], s[13], s[14], s[15]);
#pragma unroll
            for (int g2 = 0; g2 < 2; ++g2) {
                bf16x8 vf0, vf1;
#pragma unroll
                for (int si = 0; si < 8; ++si) { const int key = 16 * g2 + (si & 3) + 8 * (si >> 2) + 4 * half;
                    vf0[si] = *(const LAS short*)(vb + key * 144 + n * 2); vf1[si] = *(const LAS short*)(vb + key * 144 + (n + 32) * 2); }
                o0 = MFMA32(vf0, g2 ? pf1 : pf0, o0); o1 = MFMA32(vf1, g2 ? pf1 : pf0, o1);
            }
        }
#undef ATT_PRELOAD
#undef ATT_QLOAD
        const float ltot = lrun + __shfl_xor(lrun, 32), inv = 1.f / ltot; float lse = mrun + __builtin_amdgcn_logf(ltot);
        LAS unsigned char* arow = F.lds + ATT_ACC + (tq - T0) * 144; LAS float* alse = (LAS float*)(F.lds + ATT_LSE) + (tq - T0);
        float wo = 0.f, wn = 1.f;
        if (g > 0) { const float lo_ = *alse, mx = fmaxf(lo_, lse), a_ = __builtin_amdgcn_exp2f(lo_ - mx), b_ = __builtin_amdgcn_exp2f(lse - mx), is = 1.f / (a_ + b_);
            wo = a_ * is; wn = b_ * is; lse = mx + __builtin_amdgcn_logf(a_ + b_); }
        wn *= inv;
        bf16* yo = (bf16*)(F.ws + WS_YR) + (rowbase + tq) * YC_COLS + 512 + hh * 64;
#pragma unroll
        for (int q4 = 0; q4 < 4; ++q4) { const int d0 = 8 * q4 + 4 * half;
            f32x4 a = (f32x4){o0[4 * q4], o0[4 * q4 + 1], o0[4 * q4 + 2], o0[4 * q4 + 3]} * wn, c = (f32x4){o1[4 * q4], o1[4 * q4 + 1], o1[4 * q4 + 2], o1[4 * q4 + 3]} * wn;
            if (g > 0) { a += up4a(*(const LAS v2u*)(arow + d0 * 2)) * wo; c += up4a(*(const LAS v2u*)(arow + (32 + d0) * 2)) * wo; }
            v2u w0; w0.x = pk2(a[0], a[1]); w0.y = pk2(a[2], a[3]); v2u w1; w1.x = pk2(c[0], c[1]); w1.y = pk2(c[2], c[3]);
            if (g < 2) { *(LAS v2u*)(arow + d0 * 2) = w0; *(LAS v2u*)(arow + (32 + d0) * 2) = w1; }
            else { *(v2u*)(yo + d0) = w0; *(v2u*)(yo + 32 + d0) = w1; } }
        if (g < 2 && half == 0) *alse = lse;
        if (has_next && nxt.g != g) __syncthreads();
        if (has_next) {
#pragma unroll
            for (int kk = 0; kk < 4; ++kk) qf[kk] = qn[kk];
            cur = nxt; }
    }
    __syncthreads();
}

DI f32x4 ld4bf(const bf16* p) { const v2u u = *(const v2u*)p; return (f32x4){bflo(u.x), bfhi(u.x), bflo(u.y), bfhi(u.y)}; }
DI f32x4 shift4(const bf16* prow, bool hasp, bool hasn, const float* mup, const float* mun, int col) {
    const f32x4 u = ld4bf(prow + col);
    const float mp = hasp ? 1.f : 0.f, mn = hasn ? 1.f : 0.f;
    const f32x4 up = ld4bf(prow + (hasp ? -RW_COLS : 0) + col) * mp, un = ld4bf(prow + (hasn ? RW_COLS : 0) + col) * mn;
    return u + *(const f32x4*)(mup + col) * (up - u) + *(const f32x4*)(mun + col) * (un - u);
}
DI float red8(float v) {
    v += __builtin_bit_cast(float, __builtin_amdgcn_update_dpp(0, __builtin_bit_cast(int, v), 0xB1, 0xF, 0xF, true));
    v += __builtin_bit_cast(float, __builtin_amdgcn_update_dpp(0, __builtin_bit_cast(int, v), 0x4E, 0xF, 0xF, true));
    v += __builtin_bit_cast(float, __builtin_amdgcn_update_dpp(0, __builtin_bit_cast(int, v), 0x141, 0xF, 0xF, true));
    return v;
}
constexpr int SC_CH = 32, SC_NCH = SEQ / SC_CH;
constexpr int FP = 68, ARR_SZ = 32 * 144, ARRBUF_SZ = 5 * ARR_SZ + 32 * FP * 4;
#define SC_ARR(ab, arr) (F.lds + (ab) * ARRBUF_SZ + (arr) * ARR_SZ)
#define SC_E2(ab) ((LAS float*)(F.lds + (ab) * ARRBUF_SZ + 5 * ARR_SZ))
constexpr int SCL_CONST = 2 * ARRBUF_SZ, SCL_IMG = 65536, SCL_IMGSZ = 35072, SCL_MABT = SCL_IMG + 2 * SCL_IMGSZ;
constexpr int IM_AT = 0, IM_RT = 4608, IM_BT = 9216, IM_KT = 14336, IM_VT = 19456, IM_MAK = 24576, IM_NB = 27136, IM_NK = 29696, IM_T = 32256, IM_GC = 34816;
constexpr int P144 = 144, P80 = 80;
#define SC_IMG(ib) (F.lds + SCL_IMG + (ib) * SCL_IMGSZ)
#define SC_CONST ((LAS float*)(F.lds + SCL_CONST))
DI f32x4 up4(v2u u) { return (f32x4){bflo(u.x), bfhi(u.x), bflo(u.y), bfhi(u.y)}; }
template <int KIND> struct PrepRaw { bf16x8 xf[4]; v2u ga[4], gb[4], gc[4]; };
template <int KIND>
DI void prep_load(Frame& F, const bf16* PS, int b, int h, int dir, int c, PrepRaw<KIND>& R) {
    const int q = F.wave - 4, jt = q & 1, lane = F.lane, n = lane & 31, half = lane >> 5;
    const int tl = SC_CH * c + n, t = dir ? (SEQ - 1 - tl) : tl, hc = h * 64;
    const bf16* pr = PS + ((size_t)b * SEQ + t) * RW_COLS;
#pragma unroll
    for (int kk = 0; kk < 4; ++kk) R.xf[kk] = *(const bf16x8*)(pr + (KIND ? 1600 : 1536) + 16 * kk + 8 * half);
#pragma unroll
    for (int q4 = 0; q4 < 4; ++q4) { const int j = 32 * jt + 8 * q4 + 4 * half, jo = 32 * (1 - jt) + 8 * q4 + 4 * half;
        R.ga[q4] = *(const v2u*)(pr + (KIND ? 512 : 0) + hc + j);
        R.gb[q4] = *(const v2u*)(pr + (KIND ? 512 + hc + jo : 1024 + hc + j));
        if (KIND) R.gc[q4] = *(const v2u*)(pr + hc + j); }
}
template <int KIND>
DI void prep_compute(Frame& F, int b, int h, int dir, int c, const PrepRaw<KIND>& R, const bf16x8 (&af)[4]) {
    const int q = F.wave - 4, jt = q & 1, lane = F.lane, n = lane & 31, half = lane >> 5, ab = c & 1;
    const LAS float* cm = SC_CONST;
    f32x16 D;
#pragma unroll
    for (int i = 0; i < 16; ++i) D[i] = 0.f;
    if (KIND == 0) {
#pragma unroll
        for (int kk = 0; kk < 4; ++kk) D = MFMA32(R.xf[kk], af[kk], D);
        const int j = 32 * jt + n; const float w0j = cm[j];
        float e2[16];
#pragma unroll
        for (int i = 0; i < 16; ++i) e2[i] = 0.8750387749f * sigmoidf_(D[i] + w0j);
        float gs[4], ps[4];
#pragma unroll
        for (int g = 0; g < 4; ++g) { gs[g] = (e2[4 * g] + e2[4 * g + 1]) + (e2[4 * g + 2] + e2[4 * g + 3]); ps[g] = __shfl_xor(gs[g], 32); }
        float off = 0.f;
        LAS float* Eb = SC_E2(ab) + j;
#pragma unroll
        for (int g = 0; g < 4; ++g) {
            float run = off + (half ? ps[g] : 0.f);
#pragma unroll
            for (int ii = 0; ii < 4; ++ii) { const int i = 4 * g + ii, tau = 8 * g + 4 * half + ii; run += e2[i]; Eb[tau * FP] = run; }
            off += gs[g] + ps[g];
        }
#pragma unroll
        for (int q4 = 0; q4 < 4; ++q4) { const int jj = 32 * jt + 8 * q4 + 4 * half;
            *(LAS v2u*)(SC_ARR(ab, 3) + n * P144 + jj * 2) = R.ga[q4];
            *(LAS v2u*)(SC_ARR(ab, 4) + n * P144 + jj * 2) = R.gb[q4]; }
    } else {
#pragma unroll
        for (int kk = 0; kk < 4; ++kk) D = MFMA32(af[kk], R.xf[kk], D);
        float ss = 0.f;
#pragma unroll
        for (int q4 = 0; q4 < 4; ++q4) { const int j = 32 * jt + 8 * q4 + 4 * half, jo = 32 * (1 - jt) + 8 * q4 + 4 * half;
            const f32x4 kr = up4(R.ga[q4]) * *(const LAS f32x4*)(cm + 128 + j), ko = up4(R.gb[q4]) * *(const LAS f32x4*)(cm + 128 + jo);
            ss += (kr[0] * kr[0] + kr[1] * kr[1]) + (kr[2] * kr[2] + kr[3] * kr[3]) + (ko[0] * ko[0] + ko[1] * ko[1]) + (ko[2] * ko[2] + ko[3] * ko[3]); }
        ss += __shfl_xor(ss, 32);
        const float inv = __builtin_amdgcn_rcpf(fmaxf(__builtin_amdgcn_sqrtf(ss), 1e-12f));
        float bs = 0.f;
#pragma unroll
        for (int q4 = 0; q4 < 4; ++q4) { const int j = 32 * jt + 8 * q4 + 4 * half;
            const f32x4 az = *(const LAS f32x4*)(cm + 64 + j), kkv = *(const LAS f32x4*)(cm + 128 + j), kav = *(const LAS f32x4*)(cm + 192 + j), rkv = *(const LAS f32x4*)(cm + 256 + j);
            const f32x4 kpr = up4(R.ga[q4]), rr = up4(R.gc[q4]);
            f32x4 av, kk4, kd4;
#pragma unroll
            for (int jj = 0; jj < 4; ++jj) { av[jj] = sigmoidf_(D[4 * q4 + jj] + az[jj]); kk4[jj] = kpr[jj] * kkv[jj] * inv; kd4[jj] = kpr[jj] * (1.f + (av[jj] - 1.f) * kav[jj]); bs += rr[jj] * kd4[jj] * rkv[jj]; }
            v2u w; w.x = pk2(kd4[0], kd4[1]); w.y = pk2(kd4[2], kd4[3]); *(LAS v2u*)(SC_ARR(ab, 0) + n * P144 + j * 2) = w;
            w.x = pk2(kk4[0] * av[0], kk4[1] * av[1]); w.y = pk2(kk4[2] * av[2], kk4[3] * av[3]); *(LAS v2u*)(SC_ARR(ab, 1) + n * P144 + j * 2) = w;
            w.x = pk2(-kk4[0], -kk4[1]); w.y = pk2(-kk4[2], -kk4[3]); *(LAS v2u*)(SC_ARR(ab, 2) + n * P144 + j * 2) = w; }
        bs += __shfl_xor(bs, 32);
        const int tl = SC_CH * c + n, t = dir ? (SEQ - 1 - tl) : tl;
        if (half == 0 && !VAR(255)) ((float*)(F.ws + WS_BSUM))[(((size_t)dir * NTOK + (size_t)b * SEQ + t) * 8 + h) * 2 + jt] = bs;
    }
}
DI void scan_consts(Frame& F, const Args& a, int h, int dir) {
    LAS float* cm = SC_CONST; const int i = F.tid - 256, hc = h * 64;
    if (i < 64) { cm[i] = ((const float*)a.in[I_WD0])[dir * 512 + hc + i]; cm[64 + i] = ((const float*)a.in[I_AG0])[dir * 512 + hc + i];
        cm[128 + i] = ((const float*)a.in[I_KK])[hc + i]; cm[192 + i] = ((const float*)a.in[I_KA])[hc + i]; cm[256 + i] = ((const float*)a.in[I_RK])[hc + i]; }
}
#define SC_BARRIER() do { asm volatile("s_waitcnt lgkmcnt(0)" ::: "memory"); __builtin_amdgcn_s_barrier(); asm volatile("" ::: "memory"); } while (0)
DI bf16x8 ld_perm(const LAS unsigned char* row, int ks, int half) {
    const v2u a0 = *(const LAS v2u*)(row + (16 * ks + 4 * half) * 2), a1 = *(const LAS v2u*)(row + (16 * ks + 8 + 4 * half) * 2);
    const v4u r = {a0.x, a0.y, a1.x, a1.y}; return __builtin_bit_cast(bf16x8, r);
}
DI bf16x8 packacc(const f32x16& x, int ks) { return ks ? pack8(x[8], x[9], x[10], x[11], x[12], x[13], x[14], x[15]) : pack8(x[0], x[1], x[2], x[3], x[4], x[5], x[6], x[7]); }
DI bf16x8 frag_scaled(const LAS unsigned char* arow, const LAS float* erow, int kk, float sgn, bool ezero) {
    const v4u xr = *(const LAS v4u*)(arow + 32 * kk);
    f32x4 e0 = *(const LAS f32x4*)(erow + 16 * kk), e1 = *(const LAS f32x4*)(erow + 16 * kk + 4);
    if (ezero) { e0 = (f32x4){0.f, 0.f, 0.f, 0.f}; e1 = e0; }
    const float x[8] = {bflo(xr.x), bfhi(xr.x), bflo(xr.y), bfhi(xr.y), bflo(xr.z), bfhi(xr.z), bflo(xr.w), bfhi(xr.w)};
    float y[8];
#pragma unroll
    for (int j = 0; j < 4; ++j) { y[j] = x[j] * __builtin_amdgcn_exp2f(sgn * e0[j]); y[4 + j] = x[4 + j] * __builtin_amdgcn_exp2f(sgn * e1[j]); }
    return pack8(y[0], y[1], y[2], y[3], y[4], y[5], y[6], y[7]);
}
template <bool LO>
DI void scan_build(Frame& F, int p, int bw) {
    int lane = F.lane; LAUNDER(lane); const int n = lane & 31, half = lane >> 5, ab = p & 1;
    LAS unsigned char* img = SC_IMG(p & 1);
    const LAS float* E = SC_E2(ab) + n * FP + 8 * half;
    const LAS float* Eex = SC_E2(ab) + (n > 0 ? n - 1 : 0) * FP + 8 * half;
    const LAS unsigned char* KDr = SC_ARR(ab, 0) + n * P144 + 16 * half; const LAS unsigned char* BBr = SC_ARR(ab, 1) + n * P144 + 16 * half;
    const LAS unsigned char* AAr = SC_ARR(ab, 2) + n * P144 + 16 * half; const LAS unsigned char* Rr = SC_ARR(ab, 3) + n * P144 + 16 * half;
    if (LO && bw == 2) {
        if (VAR(16)) return;
        f32x16 z, pacc;
#pragma unroll
        for (int i = 0; i < 16; ++i) z[i] = 0.f;
#pragma unroll
        for (int kk = 0; kk < 4; ++kk) z = MFMA32(frag_scaled(BBr, E, kk, 1.f, false), frag_scaled(AAr, Eex, kk, -1.f, n == 0), z);
#pragma unroll
        for (int i = 0; i < 16; ++i) { const int srow = crow(i, half); z[i] = (srow < n) ? z[i] : 0.f; }
        LAS unsigned char* zi = F.lds + SCL_MABT;
#pragma unroll
        for (int k = 0; k < 4; ++k) {
            LAS unsigned char* zk = zi + k * (32 * P80);
#pragma unroll
            for (int i = 0; i < 16; ++i) *(LAS unsigned short*)(zk + crow(i, half) * P80 + n * 2) = (unsigned short)(pk2(z[i], 0.f) & 0xffffu);
            LDS_WAIT(); asm volatile("" ::: "memory");
            const bf16x8 zb0 = packacc(z, 0), zb1 = packacc(z, 1);
            f32x16 zn;
#pragma unroll
            for (int i = 0; i < 16; ++i) zn[i] = 0.f;
            zn = MFMA32(ld_perm(zk + n * P80, 0, half), zb0, zn); zn = MFMA32(ld_perm(zk + n * P80, 1, half), zb1, zn);
            z = zn;
        }
#pragma unroll
        for (int i = 0; i < 16; ++i) pacc[i] = z[i] + ((crow(i, half) == n) ? 1.f : 0.f);
#pragma unroll
        for (int k = 3; k >= 0; --k) {
            const LAS unsigned char* zk = zi + k * (32 * P80);
            const bf16x8 qb0 = packacc(pacc, 0), qb1 = packacc(pacc, 1);
            pacc = MFMA32(ld_perm(zk + n * P80, 0, half), qb0, pacc); pacc = MFMA32(ld_perm(zk + n * P80, 1, half), qb1, pacc);
        }
#pragma unroll
        for (int g = 0; g < 4; ++g) { v2u w; w.x = pk2(pacc[4 * g], pacc[4 * g + 1]); w.y = pk2(pacc[4 * g + 2], pacc[4 * g + 3]); *(LAS v2u*)(img + IM_T + n * P80 + (8 * g + 4 * half) * 2) = w; }
    } else if (LO && bw == 3) {
        if (VAR(32)) return;
#pragma unroll
        for (int kk = 0; kk < 4; ++kk) { const bf16x8 f = frag_scaled(BBr, E, kk, 1.f, false);
            const v4u vr = *(const LAS v4u*)(SC_ARR(ab, 4) + n * P144 + 16 * half + 32 * kk); const bf16x8 vf = __builtin_bit_cast(bf16x8, vr);
#pragma unroll
            for (int e = 0; e < 8; ++e) { *(LAS unsigned short*)(img + IM_BT + (16 * kk + 8 * half + e) * P80 + n * 2) = (unsigned short)f[e];
                *(LAS unsigned short*)(img + IM_VT + (16 * kk + 8 * half + e) * P80 + n * 2) = (unsigned short)vf[e]; } }
        ((LAS float*)(img + IM_GC))[lane] = __builtin_amdgcn_exp2f(-(SC_E2(ab)[31 * FP + lane]));
    } else if (!LO && bw <= 6) {
        if (VAR(32)) return;
        bf16x8 fa[4], fb[4];
        if (bw == 4 || bw == 5) {
#pragma unroll
            for (int kk = 0; kk < 4; ++kk) { fb[kk] = frag_scaled(bw == 4 ? AAr : Rr, bw == 4 ? Eex : E, kk, -1.f, bw == 4 && n == 0);
                *(LAS bf16x8*)(img + (bw == 4 ? IM_AT : IM_RT) + n * P144 + (16 * kk + 8 * half) * 2) = fb[kk]; }
#pragma unroll
            for (int kk = 0; kk < 4; ++kk) fa[kk] = frag_scaled(bw == 4 ? KDr : BBr, E, kk, 1.f, false);
        } else {
#pragma unroll
            for (int kk = 0; kk < 4; ++kk) { fa[kk] = frag_scaled(KDr, E, kk, 1.f, false);
#pragma unroll
                for (int e = 0; e < 8; ++e) *(LAS unsigned short*)(img + IM_KT + (16 * kk + 8 * half + e) * P80 + n * 2) = (unsigned short)fa[kk][e]; }
#pragma unroll
            for (int kk = 0; kk < 4; ++kk) fb[kk] = frag_scaled(Rr, E, kk, -1.f, false);
        }
        f32x16 x;
#pragma unroll
        for (int i = 0; i < 16; ++i) x[i] = 0.f;
#pragma unroll
        for (int kk = 0; kk < 4; ++kk) x = MFMA32(fa[kk], fb[kk], x);
        LAS unsigned char* gi = img + (bw == 4 ? IM_MAK : (bw == 5 ? IM_NB : IM_NK));
#pragma unroll
        for (int g = 0; g < 4; ++g) { float m_[4];
#pragma unroll
            for (int e = 0; e < 4; ++e) { const int srow = 8 * g + 4 * half + e; m_[e] = ((bw == 4) ? srow < n : srow <= n) ? x[4 * g + e] : 0.f; }
            v2u w_; w_.x = pk2(m_[0], m_[1]); w_.y = pk2(m_[2], m_[3]); *(LAS v2u*)(gi + n * P80 + (8 * g + 4 * half) * 2) = w_; }
    }
}
template <int KIND>
DI void scan_helper(Frame& F, const Args& a, int b, int h, int dir) {
    const bf16* PS = (const bf16*)a.out;
    const int q = F.wave - 4, jt = q & 1, n = F.lane & 31, half = F.lane >> 5;
    const bf16* WT = (const bf16*)(F.ws + (KIND ? WS_AUP_T : WS_WUP_T)) + ((size_t)dir * 512 + h * 64 + 32 * jt + n) * 64 + 8 * half;
    bf16x8 af[4];
#pragma unroll
    for (int kk = 0; kk < 4; ++kk) af[kk] = *(const bf16x8*)(WT + 16 * kk);
    PrepRaw<KIND> Ra, Rb;
    prep_load<KIND>(F, PS, b, h, dir, 0, Ra);
    prep_load<KIND>(F, PS, b, h, dir, 1, Rb);
    prep_compute<KIND>(F, b, h, dir, 0, Ra, af);
    prep_load<KIND>(F, PS, b, h, dir, 2, Ra);
    SC_BARRIER();
    prep_compute<KIND>(F, b, h, dir, 1, Rb, af);
    prep_load<KIND>(F, PS, b, h, dir, 3, Rb);
    SC_BARRIER();
#pragma unroll 1
    for (int s2 = 0; s2 < SC_NCH; s2 += 2) {
        if (s2 + 2 < SC_NCH && !VAR(4)) prep_compute<KIND>(F, b, h, dir, s2 + 2, Ra, af);
        if (!VAR(8)) prep_load<KIND>(F, PS, b, h, dir, (s2 + 4) & (SC_NCH - 1), Ra);
        SC_BARRIER();
        if (s2 + 3 < SC_NCH && !VAR(4)) prep_compute<KIND>(F, b, h, dir, s2 + 3, Rb, af);
        if (!VAR(8)) prep_load<KIND>(F, PS, b, h, dir, (s2 + 5) & (SC_NCH - 1), Rb);
        SC_BARRIER();
    }
}
DI void scan_builder_only(Frame& F) {
    SC_BARRIER();
    scan_build<true>(F, 0, F.wave); if (F.wave == 3) scan_build<false>(F, 0, 6);
    SC_BARRIER();
#pragma unroll 1
    for (int s = 0; s < SC_NCH; ++s) { if (s + 1 < SC_NCH && !VAR(2)) { scan_build<true>(F, s + 1, F.wave); if (F.wave == 3) scan_build<false>(F, s + 1, 6); } SC_BARRIER(); }
}
DI void scan_sequencer(Frame& F, int b, int h, int dir) {
    const int it = F.wave, lane = F.lane, n = lane & 31, half = lane >> 5;
    f32x16 D0, D1;
#pragma unroll
    for (int i = 0; i < 16; ++i) { D0[i] = 0.f; D1[i] = 0.f; }
    bf16* wkv = (bf16*)(F.ws + WS_WKV) + ((size_t)dir * NTOK + (size_t)b * SEQ) * 512 + h * 64 + 32 * it + n;
    SC_BARRIER();
    scan_build<false>(F, 0, 4 + it);
    SC_BARRIER();
#pragma unroll 1
    for (int c = 0; c < SC_NCH; ++c) {
        if (VAR(1)) { if (c + 1 < SC_NCH && !VAR(2)) scan_build<false>(F, c + 1, 4 + it); SC_BARRIER(); continue; }
        const LAS unsigned char* img = SC_IMG(c & 1);
        const LAS unsigned char* atr = img + IM_AT + n * P144; const LAS unsigned char* rtr = img + IM_RT + n * P144;
        const LAS unsigned char* vtr = img + IM_VT + (32 * it + n) * P80 + 16 * half;
        const bf16x8 sb00 = packacc(D0, 0), sb01 = packacc(D0, 1), sb10 = packacc(D1, 0), sb11 = packacc(D1, 1);
        const bf16x8 vt0 = *(const LAS bf16x8*)vtr, vt1 = *(const LAS bf16x8*)(vtr + 32);
        f32x16 U, Y;
#pragma unroll
        for (int i = 0; i < 16; ++i) { U[i] = 0.f; Y[i] = 0.f; }
        U = MFMA32(ld_perm(atr, 0, half), sb00, U); Y = MFMA32(ld_perm(rtr, 0, half), sb00, Y);
        U = MFMA32(ld_perm(atr, 1, half), sb01, U); Y = MFMA32(ld_perm(rtr, 1, half), sb01, Y);
        U = MFMA32(ld_perm(atr + 64, 0, half), sb10, U); Y = MFMA32(ld_perm(rtr + 64, 0, half), sb10, Y);
        U = MFMA32(ld_perm(atr + 64, 1, half), sb11, U); Y = MFMA32(ld_perm(rtr + 64, 1, half), sb11, Y);
        { const LAS unsigned char* mk = img + IM_MAK + n * P80 + 16 * half; const LAS unsigned char* nk = img + IM_NK + n * P80 + 16 * half;
          U = MFMA32(*(const LAS bf16x8*)mk, vt0, U); U = MFMA32(*(const LAS bf16x8*)(mk + 32), vt1, U);
          Y = MFMA32(*(const LAS bf16x8*)nk, vt0, Y); Y = MFMA32(*(const LAS bf16x8*)(nk + 32), vt1, Y); }
        f32x16 SA;
#pragma unroll
        for (int i = 0; i < 16; ++i) SA[i] = 0.f;
        { const LAS unsigned char* tr = img + IM_T + n * P80; const bf16x8 ub0 = packacc(U, 0), ub1 = packacc(U, 1);
          SA = MFMA32(ld_perm(tr, 0, half), ub0, SA); SA = MFMA32(ld_perm(tr, 1, half), ub1, SA); }
        const bf16x8 sab0 = packacc(SA, 0), sab1 = packacc(SA, 1);
        { const LAS unsigned char* nb = img + IM_NB + n * P80; Y = MFMA32(ld_perm(nb, 0, half), sab0, Y); Y = MFMA32(ld_perm(nb, 1, half), sab1, Y); }
        { const int tl0 = SC_CH * c;
#pragma unroll
          for (int i = 0; i < 16; ++i) { const int tl = tl0 + crow(i, half), t = dir ? (SEQ - 1 - tl) : tl; if (!VAR(255)) wkv[(size_t)t * 512] = (bf16)(pk2(Y[i], 0.f) & 0xffffu); } }
        { const LAS unsigned char* b0 = img + IM_BT + n * P80; const LAS unsigned char* k0 = img + IM_KT + n * P80 + 16 * half;
          D0 = MFMA32(ld_perm(b0, 0, half), sab0, D0); D1 = MFMA32(ld_perm(b0 + 32 * P80, 0, half), sab0, D1);
          D0 = MFMA32(ld_perm(b0, 1, half), sab1, D0); D1 = MFMA32(ld_perm(b0 + 32 * P80, 1, half), sab1, D1);
          D0 = MFMA32(*(const LAS bf16x8*)k0, vt0, D0); D1 = MFMA32(*(const LAS bf16x8*)(k0 + 32 * P80), vt0, D1);
          D0 = MFMA32(*(const LAS bf16x8*)(k0 + 32), vt1, D0); D1 = MFMA32(*(const LAS bf16x8*)(k0 + 32 * P80 + 32), vt1, D1);
          const LAS float* gc = (const LAS float*)(img + IM_GC) + 4 * half;
#pragma unroll
          for (int g = 0; g < 4; ++g) { const f32x4 g0 = *(const LAS f32x4*)(gc + 8 * g), g1 = *(const LAS f32x4*)(gc + 32 + 8 * g);
#pragma unroll
              for (int e = 0; e < 4; ++e) { D0[4 * g + e] *= g0[e]; D1[4 * g + e] *= g1[e]; } } }
        if (c + 1 < SC_NCH && !VAR(2)) scan_build<false>(F, c + 1, 4 + it);
        SC_BARRIER();
    }
}
DI void scan_unit(Frame& F, const Args& a, int b, int h, int dir) {
    if (F.wave >= 4) { scan_consts(F, a, h, dir); LDS_WAIT(); }
    __syncthreads();
    if (F.wave < 4) __builtin_amdgcn_s_setprio(1);
    if (F.wave < 2) scan_sequencer(F, b, h, dir);
    else if (F.wave < 4) scan_builder_only(F);
    else if ((F.wave - 4) >> 1) scan_helper<1>(F, a, b, h, dir);
    else scan_helper<0>(F, a, b, h, dir);
    __builtin_amdgcn_s_setprio(0);
}

DI void post_consts(Frame& F, const Args& a) {
    LAS float* cm = (LAS float*)F.lds;
    cm[F.tid] = ((const float*)a.in[I_GNW])[F.tid]; cm[512 + F.tid] = ((const float*)a.in[I_GNB])[F.tid];
    LDS_WAIT(); __syncthreads();
}
DI void post_item(Frame& F, const bf16* PS, int item) {
    const int tile = item >> 3, h = item & 7, hc = h * 64;
    const int lane = F.lane, n = lane & 31; int half = lane >> 5; LAUNDER(half);
    const bf16* GT = (const bf16*)(F.ws + WS_GUP_T);
    const bf16* WKV = (const bf16*)(F.ws + WS_WKV); const float* BS = (const float*)(F.ws + WS_BSUM); bf16* YR = (bf16*)(F.ws + WS_YR);
    const LAS float* cm = (const LAS float*)F.lds;
    const size_t tok = (size_t)tile * 32 + n;
    const bf16* pr = PS + tok * RW_COLS;
    bf16x8 bfr[8];
#pragma unroll
    for (int kk = 0; kk < 8; ++kk) bfr[kk] = *(const bf16x8*)(pr + 1664 + 16 * kk + 8 * half);
    f32x4 x[2][4]; v2u vr[2][4];
#pragma unroll
    for (int ct = 0; ct < 2; ++ct) { const int c0 = hc + 32 * ct + 16 * half;
#pragma unroll
        for (int p = 0; p < 2; ++p) { const v4u fa = __builtin_nontemporal_load((const v4u*)(WKV + tok * 512 + c0 + 8 * p)), fb = __builtin_nontemporal_load((const v4u*)(WKV + ((size_t)NTOK + tok) * 512 + c0 + 8 * p)), vv = *(const v4u*)(pr + 1024 + c0 + 8 * p);
            x[ct][2 * p] = up4((v2u){fa.x, fa.y}) + up4((v2u){fb.x, fb.y}); x[ct][2 * p + 1] = up4((v2u){fa.z, fa.w}) + up4((v2u){fb.z, fb.w});
            vr[ct][2 * p] = (v2u){vv.x, vv.y}; vr[ct][2 * p + 1] = (v2u){vv.z, vv.w}; } }
    const f32x2 b0 = *(const f32x2*)(BS + (tok * 8 + h) * 2), b1 = *(const f32x2*)(BS + (((size_t)NTOK + tok) * 8 + h) * 2);
    f32x16 g0, g1;
#pragma unroll
    for (int i = 0; i < 16; ++i) { g0[i] = 0.f; g1[i] = 0.f; }
    const bf16* gp = GT + (size_t)(hc + 16 * ((n >> 2) & 1) + 4 * (n >> 3) + (n & 3)) * 128 + 8 * half;
#pragma unroll
    for (int kk = 0; kk < 8; ++kk) { g0 = MFMA32(*(const bf16x8*)(gp + 16 * kk), bfr[kk], g0); g1 = MFMA32(*(const bf16x8*)(gp + 32 * 128 + 16 * kk), bfr[kk], g1); }
    float sm = 0.f;
#pragma unroll
    for (int ct = 0; ct < 2; ++ct)
#pragma unroll
        for (int q4 = 0; q4 < 4; ++q4) sm += (x[ct][q4][0] + x[ct][q4][1]) + (x[ct][q4][2] + x[ct][q4][3]);
    sm += __shfl_xor(sm, 32);
    const float mean = sm * (1.f / 64.f); float vs = 0.f;
#pragma unroll
    for (int ct = 0; ct < 2; ++ct)
#pragma unroll
        for (int q4 = 0; q4 < 4; ++q4) { const f32x4 d = x[ct][q4] - mean; vs += (d[0] * d[0] + d[1] * d[1]) + (d[2] * d[2] + d[3] * d[3]); }
    vs += __shfl_xor(vs, 32);
    const float rstd = 1.f / sqrtf(vs * (1.f / 64.f) + GN_EPS);
    const float bsum = (b0.x + b0.y) + (b1.x + b1.y);
#pragma unroll
    for (int ct = 0; ct < 2; ++ct) { v2u w[4];
#pragma unroll
        for (int q4 = 0; q4 < 4; ++q4) { const int c = hc + 32 * ct + 16 * half + 4 * q4;
            const f32x4 y = (x[ct][q4] - mean) * rstd * *(const LAS f32x4*)(cm + c) + *(const LAS f32x4*)(cm + 512 + c) + up4(vr[ct][q4]) * bsum;
            f32x4 gg; if (ct == 0) gg = (f32x4){g0[4 * q4], g0[4 * q4 + 1], g0[4 * q4 + 2], g0[4 * q4 + 3]}; else gg = (f32x4){g1[4 * q4], g1[4 * q4 + 1], g1[4 * q4 + 2], g1[4 * q4 + 3]};
            const f32x4 o = y * gg; w[q4].x = pk2(o[0], o[1]); w[q4].y = pk2(o[2], o[3]); }
        bf16* yp = YR + tok * YC_COLS + hc + 32 * ct + 16 * half;
        *(v4u*)yp = (v4u){w[0].x, w[0].y, w[1].x, w[1].y}; *(v4u*)(yp + 8) = (v4u){w[2].x, w[2].y, w[3].x, w[3].y}; }
}

DI void p5_router_tile(Frame& F, const Args& a, int tile) {
    const int lane = F.lane, n = lane & 31, half = lane >> 5;
    const size_t tok = (size_t)tile * 32 + n;
    const bf16* xr = (const bf16*)(F.ws + WS_X1) + tok * DM + 8 * half;
    const bf16x8* RT = (const bf16x8*)(F.ws + WS_RT_HI) + lane;
    f32x16 d0, d1;
#pragma unroll
    for (int i = 0; i < 16; ++i) { d0[i] = 0.f; d1[i] = 0.f; }
    float ss = 0.f;
#pragma unroll 8
    for (int kk = 0; kk < 64; ++kk) {
        const v4u xv = *(const v4u*)(xr + 16 * kk);
        const float x8[8] = {bflo(xv.x), bfhi(xv.x), bflo(xv.y), bfhi(xv.y), bflo(xv.z), bfhi(xv.z), bflo(xv.w), bfhi(xv.w)};
#pragma unroll
        for (int j = 0; j < 8; ++j) ss += x8[j] * x8[j];
        const bf16x8 bh = __builtin_bit_cast(bf16x8, xv);
        const bf16x8 ah0 = RT[(kk * 4 + 0) * 64], ah1 = RT[(kk * 4 + 1) * 64], al0 = RT[(kk * 4 + 2) * 64], al1 = RT[(kk * 4 + 3) * 64];
        d0 = MFMA32(ah0, bh, d0); d0 = MFMA32(al0, bh, d0);
        d1 = MFMA32(ah1, bh, d1); d1 = MFMA32(al1, bh, d1);
    }
    ss += __shfl_xor(ss, 32);
    const float rstd = 1.f / sqrtf(ss * (1.f / DM) + NORM_EPS);
    const float* brg = (const float*)a.in[I_BRG]; const float* bre = (const float*)a.in[I_BRE];
    float gl[4];
#pragma unroll
    for (int j = 0; j < 4; ++j) gl[j] = __shfl(d1[j] * rstd + brg[j], n);
    int grp = 0; float gmax = gl[0];
#pragma unroll
    for (int j = 1; j < 4; ++j) if (gl[j] > gmax) { gmax = gl[j]; grp = j; }
    float gsum = 0.f;
#pragma unroll
    for (int j = 0; j < 4; ++j) gsum += __expf(gl[j] - gmax);
    const float grp_p = 1.f / gsum;
    const f32x4 bv = *(const f32x4*)(bre + 8 * grp + 4 * half);
    float cv[4];
#pragma unroll
    for (int j = 0; j < 4; ++j) { float v = d0[j]; v = grp == 1 ? d0[4 + j] : v; v = grp == 2 ? d0[8 + j] : v; v = grp == 3 ? d0[12 + j] : v; cv[j] = v * rstd + bv[j]; }
    float m1v = cv[0]; int m1i = 0;
#pragma unroll
    for (int j = 1; j < 4; ++j) if (cv[j] > m1v) { m1v = cv[j]; m1i = j; }
    float m2v = -3.0e38f; int m2i = 0;
#pragma unroll
    for (int j = 0; j < 4; ++j) if (j != m1i && cv[j] > m2v) { m2v = cv[j]; m2i = j; }
    m1i += 4 * half; m2i += 4 * half;
    const float t1v = __shfl_xor(m1v, 32), t2v = __shfl_xor(m2v, 32); const int t1i = __shfl_xor(m1i, 32), t2i = __shfl_xor(m2i, 32);
    auto better = [](float av, int ai, float bv_, int bi) { return av > bv_ || (av == bv_ && ai < bi); };
    float top1v, top2v; int top1i, top2i;
    if (better(m1v, m1i, t1v, t1i)) { top1v = m1v; top1i = m1i; if (better(m2v, m2i, t1v, t1i)) { top2v = m2v; top2i = m2i; } else { top2v = t1v; top2i = t1i; } }
    else { top1v = t1v; top1i = t1i; if (better(m1v, m1i, t2v, t2i)) { top2v = m1v; top2i = m1i; } else { top2v = t2v; top2i = t2i; } }
    const float w0 = grp_p / (1.f + __expf(top2v - top1v)), w1 = grp_p - w0;
    const int mye = 8 * grp + (half ? top2i : top1i); const float myw = half ? w1 : w0;
    unsigned long long mymask = 0ull; int cnt_l = 0;
    for (int e = 0; e < NEXP; ++e) { const unsigned long long m = __ballot(mye == e); if (mye == e) mymask = m; if (lane == e) cnt_l = __popcll(m); }
    int base_l = 0;
    if (lane < NEXP && cnt_l > 0 && !VAR(64)) base_l = (int)__hip_atomic_fetch_add((unsigned*)(F.ws + WS_CTL) + CW_CNT + 64 * lane, (unsigned)cnt_l, RLX_AGENT);
    const int mybase = __shfl(base_l, mye);
    const int pos = mybase + __popcll(mymask & ((1ull << lane) - 1ull));
    if (!VAR(64)) { ((int*)(F.ws + WS_LTOK))[(size_t)mye * NTOK + pos] = (int)tok * 2 + half;
    ((float*)(F.ws + WS_LW))[(size_t)mye * NTOK + pos] = myw; ((float*)(F.ws + WS_LR))[(size_t)mye * NTOK + pos] = rstd; }
}
DI void moe_convert(Frame& F, const Args& a, int w0, int w1) {
    const int gw = F.bid * NWAVES + F.wave, NGW = F.G * NWAVES;
    LAS float* scr = (LAS float*)(F.lds + F.wave * 16384);
    constexpr int IPE = 256; const int nw = w1 - w0;
    if (!VAR(128)) for (int it = gw; it < NEXP * nw * IPE; it += NGW) {
        const int e = it / (nw * IPE), r = it % (nw * IPE), which = w0 + r / IPE, item = r % IPE;
        if (which == 0) transpose_item((const float*)a.in[I_WGATE] + (size_t)e * DM * DEXP, DM, DEXP, (bf16*)(F.ws + WS_WGU_T) + (size_t)e * DM * DM, RmGate(), scr, item, F.lane, 0, 0, (const float*)a.in[I_N2G]);
        else if (which == 1) transpose_item((const float*)a.in[I_WUP] + (size_t)e * DM * DEXP, DM, DEXP, (bf16*)(F.ws + WS_WGU_T) + (size_t)e * DM * DM, RmUp(), scr, item, F.lane, 0, 0, (const float*)a.in[I_N2G]);
        else transpose_item((const float*)a.in[I_WDOWN] + (size_t)e * DEXP * DM, DEXP, DM, (bf16*)(F.ws + WS_WD_T) + (size_t)e * DM * DEXP, RmId(), scr, item, F.lane);
    }
}
DI void p5_phase(Frame& F, const Args& a) {
    const int gw = F.bid * NWAVES + F.wave, NGW = F.G * NWAVES;
    if (!VAR(256)) {
        if (F.G == 256) { if (F.wave < 4) p5_router_tile(F, a, 128 * (F.bid & 7) + 4 * (F.bid >> 3) + F.wave); }
        else for (int tile = F.wave * F.G + F.bid; tile < NTOK / 32; tile += NGW) p5_router_tile(F, a, tile); }
    if (F.bid == 0 && F.tid < 128) ((v4u*)((bf16*)(F.ws + WS_X1) + (size_t)NTOK * DM))[F.tid] = (v4u){0u, 0u, 0u, 0u};
}
DI int moe_table(Frame& F) {
    LAS int* tab = (LAS int*)(F.lds + TAB_OFF);
    if (F.wave == 0) {
        const int lane = F.lane; int c = 0;
        if (lane < NEXP) c = (int)__hip_atomic_load((unsigned*)(F.ws + WS_CTL) + CW_CNT + 64 * lane, RLX_AGENT);
        const int t = (c + 255) >> 8; int incl = t;
#pragma unroll
        for (int o = 1; o < 32; o <<= 1) { const int v = __shfl_up(incl, o); if (lane >= o) incl += v; }
        if (lane < NEXP) { tab[lane] = incl - t; tab[33 + lane] = c; }
        if (lane == NEXP - 1) tab[32] = incl; }
    __syncthreads();
    return tab[32];
}
DI void p6_gather(Frame& F) {
    const int nT = moe_table(F);
    const LAS int* tab = (const LAS int*)(F.lds + TAB_OFF);
    const bf16* h2 = (const bf16*)(F.ws + WS_H2); bf16* Xg = (bf16*)(F.ws + WS_XG);
    const int* ltok = (const int*)(F.ws + WS_LTOK); const float* lw = (const float*)(F.ws + WS_LW);
    const int nrows = nT * 256, rstride = F.G * NWAVES;
    for (int R0 = F.bid * NWAVES + F.wave; R0 < nrows; R0 += 4 * rstride) {
        int tk[4], kq[4]; float wv[4];
#pragma unroll
        for (int u = 0; u < 4; ++u) { const int R = R0 + u * rstride; tk[u] = -1; kq[u] = 0; wv[u] = 0.f;
            if (R < nrows) { const int tile = R >> 8; int e = 0;
                for (int k = 1; k < NEXP; ++k) e += (tab[k] <= tile) ? 1 : 0;
                const int slot = R - tab[e] * 256;
                if (slot < tab[33 + e]) { const int t2 = ltok[(size_t)e * NTOK + slot]; tk[u] = t2 >> 1; kq[u] = t2 & 1; wv[u] = lw[(size_t)e * NTOK + slot]; } } }
        v4u d0[4], d1[4];
#pragma unroll
        for (int u = 0; u < 4; ++u) { const v4u* src = (const v4u*)(h2 + (size_t)(tk[u] < 0 ? NTOK : tk[u]) * DM); d0[u] = src[F.lane]; d1[u] = src[F.lane + 64]; }
#pragma unroll
        for (int u = 0; u < 4; ++u) { const int R = R0 + u * rstride; if (R < nrows) { v4u* dst = (v4u*)(Xg + (size_t)R * DM); dst[F.lane] = d0[u]; dst[F.lane + 64] = d1[u];
            if (F.lane == 0) { ((float*)(F.ws + WS_ROWW))[R] = wv[u]; if (tk[u] >= 0) ((int*)(F.ws + WS_INV))[tk[u] * 2 + kq[u]] = R; } } }
    }
}

__global__ void __launch_bounds__(NWAVES * 64, 2) mk_fwd(Args args) {
    extern __shared__ __attribute__((aligned(16))) unsigned char lds[];
    Frame F;
    F.lds = (LAS unsigned char*)lds; F.MISC = (volatile LAS unsigned*)(F.lds + MISC_OFF);
    F.tid = threadIdx.x; F.lane = F.tid & 63; F.wave = __builtin_amdgcn_readfirstlane(F.tid >> 6); F.G = gridDim.x; F.bid = blockIdx.x; F.ws = args.ws; F.variant = args.variant;
    for (int u = F.tid; u < (LDS_BYTES - RING_BYTES) / 4; u += NWAVES * 64) ((LAS unsigned*)(F.lds + RING_BYTES))[u] = 0u;
    __syncthreads();
    const int lo = args.ph_lo, hi = args.ph_hi;
    const bool multi = (hi - lo) > 1;
    XcdBarrier bar; bar.bar = (unsigned*)(args.ws + WS_CTL) + CW_BAR + args.li * XCD_BAR_WORDS; bar.x = 0; bar.st = nullptr;
    if (multi) bar = xcd_barrier_post((unsigned*)(args.ws + WS_CTL) + CW_BAR + args.li * XCD_BAR_WORDS, F.MISC + 8);
#ifndef PH_MASK
#define PH_MASK 0xFFFFFFFFu
#endif
#define REFRESH() do { F.lane = (int)__builtin_amdgcn_mbcnt_hi(~0u, __builtin_amdgcn_mbcnt_lo(~0u, 0u)); F.tid = F.wave * 64 + F.lane; } while (0)
#define IN(k) ((((PH_MASK) >> (k)) & 1u) && lo <= (k) && (k) < hi)
#define SEAM(k) do { if (IN(k) && IN((k) + 1)) xcd_barrier(bar); } while (0)
    unsigned char* ws = args.ws;

    if (IN(0)) { REFRESH(); p0_prologue(F, args); } SEAM(0);
    if (IN(1)) { REFRESH();
        pg8::Gemm g{(const bf16*)(ws + WS_XB), (const bf16*)(ws + WS_WIN_T), DM, 0, nullptr, nullptr}; pg8::StaticOrder S; S.init(NTOK, IN_COLS, F.G, F.bid);
        pg8::EpiIn E{(bf16*)(ws + WS_PR), (bf16*)(ws + WS_PT), (unsigned char*)(ws + WS_G), (const float*)args.in[I_BMERGE], (const int*)args.in[I_POS], (const float*)args.in[I_QNG], (const float*)args.in[I_KNG], (const float*)(ws + WS_RSTD1), (LAS unsigned*)(F.lds + pg8::STAGE_BYTES)};
        pg8::gemm_phase<pg8::EpiIn, pg8::StaticOrder, true, true>(F.lds, g, S, E);
    } SEAM(1);
    if (IN(3)) { REFRESH();
        if ((F.bid >> 3) & 1) { p1c_preshift(F, args); REFRESH(); for (int u = F.bid; u < 256; u += F.G) attn_unit(F, u >> 4, (u >> 2) & 3, u & 3); }
        else { for (int u = F.bid; u < 256; u += F.G) attn_unit(F, u >> 4, (u >> 2) & 3, u & 3); REFRESH(); p1c_preshift(F, args); }
    } SEAM(3);
    if (IN(4)) { REFRESH(); for (int u = F.bid; u < 256; u += F.G) scan_unit(F, args, u >> 4, (u >> 1) & 7, u & 1); } SEAM(4);
    if (IN(5)) { REFRESH(); post_consts(F, args);
#pragma unroll 1
        for (int item = F.bid * NWAVES + F.wave; item < NTOK / 32 * 8; item += F.G * NWAVES) post_item(F, (const bf16*)args.out, item); } SEAM(5);
    if (IN(6)) { REFRESH();
        pg8::Gemm g{(const bf16*)(ws + WS_YR), (const bf16*)(ws + WS_WR_T), YC_COLS, 0, nullptr, nullptr}; pg8::StaticOrder S; S.init(NTOK, DM, F.G, F.bid);
        pg8::EpiMix2 E{(const unsigned char*)(ws + WS_G), (bf16*)(ws + WS_Z)};
        if ((F.bid >> 3) & 1) { moe_convert(F, args, 2, 3); __syncthreads(); REFRESH(); }
        pg8::gemm_phase<pg8::EpiMix2, pg8::StaticOrder, true, true>(F.lds, g, S, E);
        if (!((F.bid >> 3) & 1)) { __syncthreads(); REFRESH(); moe_convert(F, args, 2, 3); }
    } SEAM(6);
    if (IN(8)) { REFRESH();
        pg8::Gemm g{(const bf16*)(ws + WS_Z), (const bf16*)(ws + WS_WOUT_T), DM, 0, nullptr, nullptr}; pg8::StaticOrder S; S.init(NTOK, DM, F.G, F.bid);
        pg8::EpiRes E{(const bf16*)(ws + WS_XB), (bf16*)(ws + WS_X1)};
        if ((F.bid >> 3) & 1) { moe_convert(F, args, 0, 2); __syncthreads(); REFRESH(); }
        pg8::gemm_phase<pg8::EpiRes, pg8::StaticOrder, true, true>(F.lds, g, S, E);
        if (!((F.bid >> 3) & 1)) { __syncthreads(); REFRESH(); moe_convert(F, args, 0, 2); }
    } SEAM(8);
    if (IN(9)) { REFRESH(); p5_phase(F, args); } SEAM(9);
    if (IN(11)) { REFRESH();
        const int nT = moe_table(F);
        pg8::Gemm g{(const bf16*)(ws + WS_X1), (const bf16*)(ws + WS_WGU_T), DM, (size_t)DM * DM * 2, (const int*)(ws + WS_LTOK), (const LAS int*)(F.lds + TAB_OFF)}; pg8::GroupedOrder S{(const LAS int*)(F.lds + TAB_OFF), nT, F.G, F.bid};
        pg8::EpiSwiglu E{(bf16*)(ws + WS_HH), (const float*)(ws + WS_LR), (const LAS int*)(F.lds + TAB_OFF), (LAS unsigned*)(F.lds + pg8::STAGE_BYTES)};
        pg8::gemm_phase<pg8::EpiSwiglu, pg8::GroupedOrder, true, true, true>(F.lds, g, S, E);
    } SEAM(11);
    if (IN(12)) { REFRESH();
        const int nT = moe_table(F);
        pg8::Gemm g{(const bf16*)(ws + WS_HH), (const bf16*)(ws + WS_WD_T), DEXP, (size_t)DM * DEXP * 2, nullptr, nullptr}; pg8::GroupedOrder S{(const LAS int*)(F.lds + TAB_OFF), nT, F.G, F.bid};
        pg8::EpiStoreY E{(const int*)(ws + WS_LTOK), (const float*)(ws + WS_LW), (const LAS int*)(F.lds + TAB_OFF), (bf16*)(ws + WS_YB), (LAS unsigned*)(F.lds + pg8::STAGE_BYTES)};
        pg8::gemm_phase<pg8::EpiStoreY, pg8::GroupedOrder, true, true>(F.lds, g, S, E);
    } SEAM(12);
    if (IN(13)) { REFRESH();
        const bf16* Y = (const bf16*)(ws + WS_YB);
        const int tstride = F.G * NWAVES;
        for (int tok0 = F.bid * NWAVES + F.wave; tok0 < NTOK; tok0 += 4 * tstride) {
#pragma unroll
            for (int u = 0; u < 4; ++u) { const int tok = tok0 + u * tstride;
                f32x4* o = (f32x4*)(args.out + (size_t)tok * DM) + F.lane; const v2u* xb = (const v2u*)((const bf16*)(ws + WS_X1) + (size_t)tok * DM) + F.lane;
                const v2u* y0 = (const v2u*)(Y + (size_t)tok * 2 * DM) + F.lane; const v2u* y1 = y0 + DM / 4;
                v2u xv[4], a0[4], a1[4];
#pragma unroll
                for (int j = 0; j < 4; ++j) { xv[j] = xb[64 * j]; a0[j] = y0[64 * j]; a1[j] = y1[64 * j]; }
#pragma unroll
                for (int j = 0; j < 4; ++j) { f32x4 v; v[0] = bflo(xv[j].x) + bflo(a0[j].x) + bflo(a1[j].x); v[1] = bfhi(xv[j].x) + bfhi(a0[j].x) + bfhi(a1[j].x); v[2] = bflo(xv[j].y) + bflo(a0[j].y) + bflo(a1[j].y); v[3] = bfhi(xv[j].y) + bfhi(a0[j].y) + bfhi(a1[j].y); if (!VAR(64)) o[64 * j] = v; } }
        }
    }
#undef IN
#undef SEAM
}

constexpr int NPHASE = 14;
extern "C" void kernel_launch(void* const* d_in, const int* in_sizes, int n_in, void* d_out, int out_size, void* d_ws, size_t ws_size, hipStream_t stream) {
    static int grid = 0;
    if (grid == 0) {
        if (n_in != 30 || ws_size < WS_END) { fprintf(stderr, "kernel_launch: need 30 inputs and >= %zu bytes of workspace (got %d, %zu)\n", (size_t)WS_END, n_in, ws_size); grid = -1; return; }
        int dev = 0, cus = 0;
        if (hipGetDevice(&dev) != hipSuccess || hipDeviceGetAttribute(&cus, hipDeviceAttributeMultiprocessorCount, dev) != hipSuccess) { grid = -1; return; }
        if (hipFuncSetAttribute((const void*)mk_fwd, hipFuncAttributeMaxDynamicSharedMemorySize, LDS_BYTES) != hipSuccess) { fprintf(stderr, "kernel_launch: hipFuncSetAttribute failed\n"); grid = -1; return; }
        int per_cu = 0;
        if (hipOccupancyMaxActiveBlocksPerMultiprocessor(&per_cu, (const void*)mk_fwd, NWAVES * 64, LDS_BYTES) != hipSuccess || per_cu < 1) fprintf(stderr, "kernel_launch: occupancy query reports %d\n", per_cu);
        (void)hipGetLastError();
        grid = cus;
    }
    if (grid < 0) return;
    hipMemsetAsync((char*)d_ws + WS_CTL, 0, CTL_ZERO_BYTES, stream);
    Args a{};
    for (int i = 0; i < 30; ++i) a.in[i] = d_in[i];
    a.out = (float*)d_out; a.ws = (unsigned char*)d_ws;
#if defined(PROBE_REPEAT)
#ifdef PROBE_VARIANT
#define PROBE_VARIANT_V PROBE_VARIANT
#else
#define PROBE_VARIANT_V 0
#endif
    { const int k = PROBE_REPEAT; int li = 0;
      const int cuts[5][2] = {{0, k}, {k, k + 1}, {k, k + 1}, {k + 1, NPHASE}, {0, 0}};
      for (int i = 0; i < 4; ++i) { if (cuts[i][1] <= cuts[i][0]) continue; a.ph_lo = cuts[i][0]; a.ph_hi = cuts[i][1]; a.li = li++; a.variant = (i == 2) ? PROBE_VARIANT_V : 0; hipLaunchKernelGGL(mk_fwd, dim3(grid), dim3(NWAVES * 64), LDS_BYTES, stream, a); } }
#elif !defined(MK_MULTI_LAUNCH)
    a.ph_lo = 0; a.ph_hi = NPHASE; a.li = 0;
    hipLaunchKernelGGL(mk_fwd, dim3(grid), dim3(NWAVES * 64), LDS_BYTES, stream, a);
#else
    for (int p = 0; p < NPHASE; ++p) { a.ph_lo = p; a.ph_hi = p + 1; a.li = 0; hipLaunchKernelGGL(mk_fwd, dim3(grid), dim3(NWAVES * 64), LDS_BYTES, stream, a); }
#endif
}
```
